# Optimizing an MI355X kernel written in HIP

```python
import jax
import jax.numpy as jnp
from jax import lax
import numpy as np

D_MODEL = 1024
BATCH = 32
SEQ = 256
DEPTH = 2
DEC_BATCH = 2
DEC_SEQ = 4096
PAST_LEN = 256

GRID_W = 64
D_LRU = 1024
LRU_BLOCKS = 8
LRU_BLOCK = D_LRU // LRU_BLOCKS
LRU_CONV_W = 4
LRU_CONV_PAD_L = 2
LRU_C = 8.0
HEAD_DIM = 64
HEADS_B = 8
KV_HEADS_B = 2
HEADS_C = 8
KV_HEADS_C = 2
D_QB = HEADS_B * HEAD_DIM
D_KVB = KV_HEADS_B * HEAD_DIM
D_QC = HEADS_C * HEAD_DIM
D_KVC = KV_HEADS_C * HEAD_DIM
WINDOW = 128
Q_BLOCK = 128
D_FF = 2816
FFN_CONV_W = 3
FFN_CONV_PAD_L = 1
ROPE_THETA = 10000.0
NORM_EPS = 1e-6
NEG_INF = -1e30
IN_SIZES = (D_LRU, D_LRU, D_QB, D_KVB, D_KVB, D_QC, D_KVC, D_KVC, D_MODEL, D_MODEL, D_MODEL)
D_IN = sum(IN_SIZES)

kernel_name = "hybrid_diffusion_prefix_step"


def rmsnorm(x, g):
    xf = x.astype(jnp.float32)
    y = xf * lax.rsqrt(jnp.mean(xf * xf, axis=-1, keepdims=True) + NORM_EPS)
    return (y * g.astype(jnp.float32)).astype(x.dtype)


def adaln_params(cond, w_mod, b_mod):
    m = jax.nn.silu(cond) @ w_mod + b_mod
    return [t[:, None, :] for t in jnp.split(m, 6, axis=-1)]


def modulate(x, g, shift, scale):
    return rmsnorm(x, g) * (1 + scale) + shift


def split_in(z):
    idx = np.cumsum(np.array(IN_SIZES))[:-1].tolist()
    return jnp.split(z, idx, axis=-1)


def dwconv(x, w, b, pad_left):
    k_w = w.shape[0]
    s = x.shape[1]
    xp = jnp.pad(x, ((0, 0), (pad_left, k_w - 1 - pad_left), (0, 0)))
    y = xp[:, 0:s] * w[0] + b
    for k in range(1, k_w):
        y = y + xp[:, k:k + s] * w[k]
    return y


def _rotate(x, pos):
    nf = x.shape[-1] // 2
    inv = ROPE_THETA ** (-jnp.arange(nf, dtype=jnp.float32) / nf)
    ang = pos.astype(jnp.float32)[:, None] * inv[None, :]
    cos = jnp.cos(ang)[None, :, None, :]
    sin = jnp.sin(ang)[None, :, None, :]
    x1, x2 = x[..., :nf], x[..., nf:]
    return jnp.concatenate([x1 * cos - x2 * sin, x1 * sin + x2 * cos], axis=-1)


def axial_rope(x):
    s = x.shape[1]
    rows = s // GRID_W
    row, col = jnp.meshgrid(jnp.arange(rows), jnp.arange(GRID_W), indexing="ij")
    xf = x.astype(jnp.float32)
    half = x.shape[-1] // 2
    y = jnp.concatenate([_rotate(xf[..., :half], row.reshape(-1)),
                         _rotate(xf[..., half:], col.reshape(-1))], axis=-1)
    return y.astype(x.dtype)


def rglru(x, wa, ba, wx, bx, lam, h0, reverse):
    b, s, c = x.shape
    xb = x.reshape(b, s, LRU_BLOCKS, LRU_BLOCK)
    r = jax.nn.sigmoid(jnp.einsum("bsnc,ncd->bsnd", xb, wa).reshape(b, s, c) + ba)
    i = jax.nn.sigmoid(jnp.einsum("bsnc,ncd->bsnd", xb, wx).reshape(b, s, c) + bx)
    log_a = -LRU_C * r.astype(jnp.float32) * jax.nn.softplus(-lam.astype(jnp.float32))
    a = jnp.exp(log_a)
    u = jnp.sqrt(-jnp.expm1(2.0 * log_a)) * (i * x).astype(jnp.float32)

    def step(h, au):
        a_t, u_t = au
        h = a_t * h + u_t
        return h, h

    h_last, hs = lax.scan(step, h0.astype(jnp.float32),
                          (a.transpose(1, 0, 2), u.transpose(1, 0, 2)), reverse=reverse)
    return hs.transpose(1, 0, 2).astype(x.dtype), h_last


def gqa_blocked(q, k, v, sink=None):
    b, s, hq, hd = q.shape
    hkv = k.shape[2]
    g = hq // hkv
    nb = s // Q_BLOCK
    qb = q.reshape(b, nb, Q_BLOCK, hkv, g, hd).transpose(1, 0, 2, 3, 4, 5)
    scale = hd ** -0.5

    def block(qblk):
        sc = jnp.einsum("bqkgd,blkd->bkgql", qblk, k,
                        preferred_element_type=jnp.float32) * scale
        if sink is None:
            p = jax.nn.softmax(sc, axis=-1)
        else:
            sk = jnp.broadcast_to(sink.astype(jnp.float32).reshape(1, hkv, g, 1, 1),
                                  sc.shape[:-1] + (1,))
            p = jax.nn.softmax(jnp.concatenate([sc, sk], axis=-1), axis=-1)[..., :-1]
        return jnp.einsum("bkgql,blkd->bqkgd", p.astype(v.dtype), v)

    o = lax.map(block, qb)
    return o.transpose(1, 0, 2, 3, 4, 5).reshape(b, s, hq * hd)


def window_attn_latent(q, k, v, k_ctx, v_ctx, sink):
    b, s, hq, hd = q.shape
    hkv = k.shape[2]
    g = hq // hkv
    nb = s // WINDOW
    pad = ((0, 0), (WINDOW, WINDOW), (0, 0), (0, 0))
    kp = jnp.pad(k, pad).reshape(b, nb + 2, WINDOW, hkv, hd)
    vp = jnp.pad(v, pad).reshape(b, nb + 2, WINDOW, hkv, hd)
    k_band = jnp.concatenate([kp[:, :-2], kp[:, 1:-1], kp[:, 2:]], axis=2)
    v_band = jnp.concatenate([vp[:, :-2], vp[:, 1:-1], vp[:, 2:]], axis=2)
    qb = q.reshape(b, nb, WINDOW, hkv, g, hd)
    scale = hd ** -0.5
    s_lat = jnp.einsum("bnqkgd,bnlkd->bnkgql", qb, k_band,
                       preferred_element_type=jnp.float32) * scale
    blk = jnp.arange(nb)[:, None, None] * WINDOW
    q_abs = blk + jnp.arange(WINDOW)[None, :, None]
    k_abs = blk + jnp.arange(3 * WINDOW)[None, None, :] - WINDOW
    valid = (jnp.abs(q_abs - k_abs) <= WINDOW) & (k_abs >= 0) & (k_abs < s)
    s_lat = jnp.where(valid[None, :, None, None], s_lat, NEG_INF)
    s_ctx = jnp.einsum("bnqkgd,blkd->bnkgql", qb, k_ctx,
                       preferred_element_type=jnp.float32) * scale
    sk = jnp.broadcast_to(sink.astype(jnp.float32).reshape(1, 1, hkv, g, 1, 1),
                          s_ctx.shape[:-1] + (1,))
    p = jax.nn.softmax(jnp.concatenate([s_lat, s_ctx, sk], axis=-1), axis=-1)
    p_lat = p[..., :3 * WINDOW].astype(v.dtype)
    p_ctx = p[..., 3 * WINDOW:-1].astype(v.dtype)
    o = (jnp.einsum("bnkgql,bnlkd->bnqkgd", p_lat, v_band)
         + jnp.einsum("bnkgql,blkd->bnqkgd", p_ctx, v_ctx))
    return o.reshape(b, s, hq * hd)


def token_mixers(h, lp, ctx):
    b, s, _ = h.shape
    xa, ya, qb, kb, vb, qc, kc, vc, ga, gb, gc = split_in(h @ lp["w_in"])
    is_ctx = ctx is None
    xconv = dwconv(xa, lp["lru_conv_w"], lp["lru_conv_b"], LRU_CONV_PAD_L)
    h0 = jnp.zeros((b, 2, D_LRU), jnp.float32) if is_ctx else ctx["state"]
    h_f, last_f = rglru(xconv, lp["lru_wa"][0], lp["lru_ba"][0], lp["lru_wx"][0],
                        lp["lru_bx"][0], lp["lru_lam"][0], h0[:, 0], reverse=False)
    h_b, last_b = rglru(xconv, lp["lru_wa"][1], lp["lru_ba"][1], lp["lru_wx"][1],
                        lp["lru_bx"][1], lp["lru_lam"][1], h0[:, 1], reverse=True)
    o_a = (h_f + h_b) * jax.nn.gelu(ya)
    qb = rmsnorm(qb.reshape(b, s, HEADS_B, HEAD_DIM), lp["qnorm_g"])
    kb = rmsnorm(kb.reshape(b, s, KV_HEADS_B, HEAD_DIM), lp["knorm_g"])
    vb = vb.reshape(b, s, KV_HEADS_B, HEAD_DIM)
    qc = qc.reshape(b, s, HEADS_C, HEAD_DIM)
    kc = kc.reshape(b, s, KV_HEADS_C, HEAD_DIM)
    vc = vc.reshape(b, s, KV_HEADS_C, HEAD_DIM)
    if is_ctx:
        o_b = gqa_blocked(qb, kb, vb)
        o_c = gqa_blocked(qc, kc, vc, lp["sink_c"])
    else:
        o_b = gqa_blocked(axial_rope(qb),
                          jnp.concatenate([ctx["kb"], axial_rope(kb)], axis=1),
                          jnp.concatenate([ctx["vb"], vb], axis=1))
        o_c = window_attn_latent(axial_rope(qc), axial_rope(kc), vc,
                                 ctx["kc"], ctx["vc"], lp["sink_c"])
    merged = (jax.nn.sigmoid(ga) * (o_a @ lp["w_oa"])
              + jax.nn.sigmoid(gb) * (o_b @ lp["w_ob"])
              + jax.nn.sigmoid(gc) * (o_c @ lp["w_oc"]))
    out = merged @ lp["w_out"]
    if is_ctx:
        return out, (kb, vb, kc, vc, jnp.stack([last_f, last_b], axis=1))
    return out, None


def conv_ffn(h, lp):
    gate, val = jnp.split(h @ lp["w_up"], 2, axis=-1)
    gate = dwconv(gate, lp["ffn_conv_w"], lp["ffn_conv_b"], FFN_CONV_PAD_L)
    return (jax.nn.gelu(gate) * val) @ lp["w_down"]


def layer(x, cond, lp, ctx):
    sh1, sc1, g1, sh2, sc2, g2 = adaln_params(cond, lp["w_mod"], lp["b_mod"])
    mix, ctx_out = token_mixers(modulate(x, lp["norm1_g"], sh1, sc1), lp, ctx)
    x = x + g1 * mix
    x = x + g2 * conv_ffn(modulate(x, lp["norm2_g"], sh2, sc2), lp)
    return x, ctx_out


def setup_inputs(seed: int = 0) -> dict:
    key = jax.random.key(seed)
    ks = jax.random.split(key, 40)

    def nrm(k, shape, scale):
        return jax.random.normal(k, shape, jnp.float32) * scale

    a0 = jax.random.uniform(ks[20], (DEPTH, 2, D_LRU), jnp.float32, 0.9, 0.999)
    return {
        "x_prompt": nrm(ks[0], (BATCH, SEQ, D_MODEL), 1.0),
        "x_sample": nrm(ks[1], (DEC_BATCH, DEC_SEQ, D_MODEL), 1.0),
        "c": nrm(ks[2], (DEC_BATCH, D_MODEL), 1.0),
        "cache_kb": nrm(ks[3], (DEC_BATCH, DEPTH, PAST_LEN, KV_HEADS_B, HEAD_DIM), 1.0),
        "cache_vb": nrm(ks[4], (DEC_BATCH, DEPTH, PAST_LEN, KV_HEADS_B, HEAD_DIM), 1.0),
        "cache_kc": nrm(ks[5], (DEC_BATCH, DEPTH, PAST_LEN, KV_HEADS_C, HEAD_DIM), 1.0),
        "cache_vc": nrm(ks[6], (DEC_BATCH, DEPTH, PAST_LEN, KV_HEADS_C, HEAD_DIM), 1.0),
        "state_lru": nrm(ks[7], (DEC_BATCH, DEPTH, 2, D_LRU), 0.5),
        "c_ctx": nrm(ks[8], (D_MODEL,), 1.0),
        "norm1_g": 1.0 + nrm(ks[9], (DEPTH, D_MODEL), 0.02),
        "norm2_g": 1.0 + nrm(ks[10], (DEPTH, D_MODEL), 0.02),
        "w_mod": nrm(ks[11], (DEPTH, D_MODEL, 6 * D_MODEL), 0.5 * D_MODEL ** -0.5),
        "b_mod": nrm(ks[12], (DEPTH, 6 * D_MODEL), 0.02),
        "w_in": nrm(ks[13], (DEPTH, D_MODEL, D_IN), D_MODEL ** -0.5),
        "lru_conv_w": nrm(ks[14], (DEPTH, LRU_CONV_W, D_LRU), LRU_CONV_W ** -0.5),
        "lru_conv_b": nrm(ks[15], (DEPTH, D_LRU), 0.02),
        "lru_wa": nrm(ks[16], (DEPTH, 2, LRU_BLOCKS, LRU_BLOCK, LRU_BLOCK), LRU_BLOCK ** -0.5),
        "lru_ba": nrm(ks[17], (DEPTH, 2, D_LRU), 0.02),
        "lru_wx": nrm(ks[18], (DEPTH, 2, LRU_BLOCKS, LRU_BLOCK, LRU_BLOCK), LRU_BLOCK ** -0.5),
        "lru_bx": nrm(ks[19], (DEPTH, 2, D_LRU), 0.02),
        "lru_lam": jnp.log(a0) - jnp.log1p(-a0),
        "qnorm_g": 1.0 + nrm(ks[21], (DEPTH, HEAD_DIM), 0.02),
        "knorm_g": 1.0 + nrm(ks[22], (DEPTH, HEAD_DIM), 0.02),
        "sink_c": nrm(ks[23], (DEPTH, HEADS_C), 0.5),
        "w_oa": nrm(ks[24], (DEPTH, D_LRU, D_MODEL), D_LRU ** -0.5),
        "w_ob": nrm(ks[25], (DEPTH, D_QB, D_MODEL), D_QB ** -0.5),
        "w_oc": nrm(ks[26], (DEPTH, D_QC, D_MODEL), D_QC ** -0.5),
        "w_out": nrm(ks[27], (DEPTH, D_MODEL, D_MODEL), D_MODEL ** -0.5),
        "w_up": nrm(ks[28], (DEPTH, D_MODEL, 2 * D_FF), D_MODEL ** -0.5),
        "ffn_conv_w": nrm(ks[29], (DEPTH, FFN_CONV_W, D_FF), FFN_CONV_W ** -0.5),
        "ffn_conv_b": nrm(ks[30], (DEPTH, D_FF), 0.02),
        "w_down": nrm(ks[31], (DEPTH, D_FF, D_MODEL), D_FF ** -0.5),
        "final_g": 1.0 + nrm(ks[32], (D_MODEL,), 0.02),
    }


def reference(x_prompt, x_sample, c, cache_kb, cache_vb, cache_kc, cache_vc, state_lru,
              c_ctx, norm1_g, norm2_g, w_mod, b_mod, w_in, lru_conv_w, lru_conv_b,
              lru_wa, lru_ba, lru_wx, lru_bx, lru_lam, qnorm_g, knorm_g, sink_c,
              w_oa, w_ob, w_oc, w_out, w_up, ffn_conv_w, ffn_conv_b, w_down, final_g):
    stacked = {
        "norm1_g": norm1_g, "norm2_g": norm2_g, "w_mod": w_mod, "b_mod": b_mod,
        "w_in": w_in, "lru_conv_w": lru_conv_w, "lru_conv_b": lru_conv_b,
        "lru_wa": lru_wa, "lru_ba": lru_ba, "lru_wx": lru_wx, "lru_bx": lru_bx,
        "lru_lam": lru_lam, "qnorm_g": qnorm_g, "knorm_g": knorm_g, "sink_c": sink_c,
        "w_oa": w_oa, "w_ob": w_ob, "w_oc": w_oc, "w_out": w_out, "w_up": w_up,
        "ffn_conv_w": ffn_conv_w, "ffn_conv_b": ffn_conv_b, "w_down": w_down,
    }
    cond_ctx = c_ctx[None, :]
    xp, xs = x_prompt, x_sample
    kbs, vbs, kcs, vcs, lrus = [], [], [], [], []
    for l in range(DEPTH):
        lp = {name: arr[l] for name, arr in stacked.items()}
        xp, (kb_l, vb_l, kc_l, vc_l, lru_l) = layer(xp, cond_ctx, lp, None)
        kbs.append(kb_l)
        vbs.append(vb_l)
        kcs.append(kc_l)
        vcs.append(vc_l)
        lrus.append(lru_l)
        cached = {"kb": cache_kb[:, l], "vb": cache_vb[:, l], "kc": cache_kc[:, l],
                  "vc": cache_vc[:, l], "state": state_lru[:, l]}
        xs, _ = layer(xs, c, lp, cached)
    y_prompt = rmsnorm(xp, final_g)
    y_sample = rmsnorm(xs, final_g)
    new_kb = jnp.stack(kbs, axis=1)
    new_vb = jnp.stack(vbs, axis=1)
    new_kc = jnp.stack(kcs, axis=1)
    new_vc = jnp.stack(vcs, axis=1)
    new_lru = jnp.stack(lrus, axis=1)
    return (y_prompt, y_sample, new_kb, new_vb, new_kc, new_vc, new_lru)
```

```cpp
#include <hip/hip_runtime.h>
#include <cstdio>
#include <cstdint>
#include <cmath>

#ifndef MK_PER_PHASE
#define MK_PER_PHASE 0
#endif

#define LAS __attribute__((address_space(3)))
#define GAS __attribute__((address_space(1)))
typedef _Float16 h16;
typedef _Float16 h16x8 __attribute__((ext_vector_type(8)));
typedef _Float16 h16x4 __attribute__((ext_vector_type(4)));
typedef _Float16 h16x2 __attribute__((ext_vector_type(2)));
typedef short s16x4 __attribute__((ext_vector_type(4)));
typedef float f32x2 __attribute__((ext_vector_type(2)));
typedef float f32x4 __attribute__((ext_vector_type(4)));
typedef float f32x16 __attribute__((ext_vector_type(16)));
typedef unsigned u32x2 __attribute__((ext_vector_type(2)));
typedef unsigned u32x4 __attribute__((ext_vector_type(4)));

constexpr int DM = 1024, NTOK = 16384, NCTX = 8192, SEQ = 256, LSEQ = 4096, NB_CTX = 32, NB_LAT = 2, DEPTH = 2;
constexpr int DIN = 6656, NMAIN = 3584, NGATE = 3072, DFF = 2816, DUP = 5632, DLRU = 1024;
constexpr int C_XA = 0, C_YA = 1024, C_QB = 2048, C_KB = 2560, C_VB = 2688, C_QC = 2816, C_KC = 3328, C_VC = 3456;
constexpr float NORM_EPS = 1e-6f;
constexpr float LOG2E = 1.4426950408889634f;
constexpr float QSCALE = 0.125f * LOG2E;
constexpr size_t O_Y = 0, O_KB = 16777216, O_VB = 18874368, O_KC = 20971520, O_VC = 23068672, O_LRU = 25165824, O_END = 25296896;
constexpr size_t MiB = 1u << 20;
constexpr size_t WS_CTL = 0, CTL_ZERO_BYTES = 64 * 1024;
constexpr size_t WS_MOD = 1 * MiB;
constexpr size_t WS_ROPE = 1 * MiB + 256 * 1024;
constexpr size_t WS_AGG = 1 * MiB + 320 * 1024;
constexpr size_t WS_CACHE = 2 * MiB;
constexpr size_t WS_W = 3 * MiB;
constexpr size_t W_IN = 0, W_OA = W_IN + (size_t)DIN * DM * 2, W_OB = W_OA + (size_t)DM * 1024 * 2, W_OC = W_OB + (size_t)DM * 512 * 2,
                 W_OUT = W_OC + (size_t)DM * 512 * 2, W_UP = W_OUT + (size_t)DM * DM * 2, W_DOWN = W_UP + (size_t)DUP * DM * 2,
                 W_LRU = W_DOWN + (size_t)DM * DFF * 2, W_END = W_LRU + (size_t)2 * 2 * 8 * 128 * 128 * 2;
static_assert(W_END <= 37 * MiB, "weights region");
constexpr size_t WS_H = 40 * MiB;
constexpr size_t WS_ZU = 72 * MiB;
constexpr size_t ZU_OA = (size_t)NTOK * NMAIN * 2, ZU_OB = ZU_OA + (size_t)NTOK * 1024 * 2, ZU_OC = ZU_OB + (size_t)NTOK * 512 * 2;
constexpr size_t WS_END = WS_ZU + (size_t)NTOK * DUP * 2;
static_assert(WS_END == 248 * MiB, "ws map");

__device__ __forceinline__ unsigned pk_h2(float lo, float hi) { f32x2 v = {lo, hi}; h16x2 h = __builtin_convertvector(v, h16x2); return __builtin_bit_cast(unsigned, h); }
__device__ __forceinline__ void unpack8(u32x4 w, float* x) { h16x8 h = __builtin_bit_cast(h16x8, w);
#pragma unroll
    for (int j = 0; j < 8; ++j) x[j] = (float)h[j]; }
__device__ __forceinline__ u32x4 pack8(const float* x) { u32x4 w; w.x = pk_h2(x[0], x[1]); w.y = pk_h2(x[2], x[3]); w.z = pk_h2(x[4], x[5]); w.w = pk_h2(x[6], x[7]); return w; }
__device__ __forceinline__ float fast_exp2(float x) { return __builtin_amdgcn_exp2f(x); }
__device__ __forceinline__ float fast_rcp(float x) { return __builtin_amdgcn_rcpf(x); }
__device__ __forceinline__ float sigmoidf_(float x) { return fast_rcp(1.0f + fast_exp2(-LOG2E * x)); }
__device__ __forceinline__ float gelu_tanh(float x) { const float t = x + 0.044715f * x * x * x; return x * fast_rcp(1.0f + fast_exp2(-2.0f * 0.7978845608028654f * LOG2E * t)); }
__device__ __forceinline__ float wave_sum(float v) {
#pragma unroll
    for (int o = 1; o < 64; o <<= 1) v += __shfl_xor(v, o);
    return v;
}

namespace pg8 {
constexpr int BM = 256, BK = 64, HALF = 128, HTB = HALF * BK * 2, STAGE_BYTES = 8 * HTB, NXCD = 8, WGM = 8;
__host__ __device__ __forceinline__ int lds_byte(int r, int c) { const int st = (r >> 4) * 2 + (c >> 5), rr = r & 15, cc = c & 31, ob = rr * 64 + cc * 2; return st * 1024 + (ob ^ (((ob >> 9) & 1) << 5)); }
__host__ __device__ __forceinline__ void stage_rc(int b, int& R, int& C) { const int st = b / 1024, sb = b % 1024, swz = sb ^ (((sb >> 9) & 1) << 5); R = (st >> 1) * 16 + swz / 64; C = (st & 1) * 32 + (swz % 64) / 2; }
__host__ __device__ __forceinline__ int perm32(int rho) { const int n = rho >> 4, i = rho & 15; return 8 * (i >> 2) + 4 * n + (i & 3); }
struct Unit { int pm, pn; };
struct Gemm { const h16* A; const h16* Bt; int M, N, K, lda; };
struct StaticOrder {
    int nM, nN, nwg, G, c;
    __host__ __device__ void init(int M, int N, int G_, int c_) { nM = M / BM; nN = N / BM; nwg = nM * nN; G = G_; c = c_; }
    __host__ __device__ bool next(int i, Unit& u) const {
        const long L = (long)i * G + c; if (L >= nwg) return false;
        int wgid = (int)L; { const int q = nwg / NXCD, r = nwg % NXCD, xcd = wgid % NXCD, off = wgid / NXCD; wgid = (xcd < r ? xcd * (q + 1) : r * (q + 1) + (xcd - r) * q) + off; }
        const int nig = WGM * nN, gid = wgid / nig, fm = gid * WGM, gsz = (nM - fm) < WGM ? (nM - fm) : WGM;
        u.pm = fm + ((wgid % nig) % gsz); u.pn = (wgid % nig) / gsz; return true;
    }
    __device__ __forceinline__ void a_ready(const Unit&) const {}
    __device__ __forceinline__ void done(const Unit&) const {}
};

template <int ACT> struct EpiF16 {
    static constexpr bool PERM = true, AFTER_DRAIN = false;
    h16* O; int ldc;
    __device__ __forceinline__ void operator()(const f32x4 (&acc)[2][2][4][2], const Unit& u, int wr, int wc, int fr, int fq) const {
        const int row0 = u.pm * BM + wr * 64 + fr, col0 = u.pn * BM + wc * 32 + 8 * fq;
#pragma unroll
        for (int ai = 0; ai < 2; ++ai)
#pragma unroll
            for (int m = 0; m < 4; ++m) { h16* rowp = O + (size_t)(row0 + ai * HALF + m * 16) * ldc + col0;
#pragma unroll
                for (int bj = 0; bj < 2; ++bj) { f32x4 v0 = acc[ai][bj][m][0], v1 = acc[ai][bj][m][1];
                    if (ACT == 1) {
#pragma unroll
                        for (int j = 0; j < 4; ++j) { v0[j] = sigmoidf_(v0[j]); v1[j] = sigmoidf_(v1[j]); } }
                    u32x4 w; w.x = pk_h2(v0[0], v0[1]); w.y = pk_h2(v0[2], v0[3]); w.z = pk_h2(v1[0], v1[1]); w.w = pk_h2(v1[2], v1[3]);
                    *(u32x4*)(rowp + bj * HALF) = w; } }
    }
};
template <int ACCUM> struct EpiGateMul {
    static constexpr bool PERM = true, AFTER_DRAIN = false;
    h16* Mg; const h16* G; int gcol0;
    __device__ __forceinline__ void operator()(const f32x4 (&acc)[2][2][4][2], const Unit& u, int wr, int wc, int fr, int fq) const {
        const int row0 = u.pm * BM + wr * 64 + fr, col0 = u.pn * BM + wc * 32 + 8 * fq;
#pragma unroll
        for (int ai = 0; ai < 2; ++ai)
#pragma unroll
            for (int m = 0; m < 4; ++m) { const size_t row = (size_t)(row0 + ai * HALF + m * 16);
#pragma unroll
                for (int bj = 0; bj < 2; ++bj) {
                    const u32x4 gw = *(const u32x4*)(G + row * NGATE + gcol0 + col0 + bj * HALF);
                    float g[8]; unpack8(gw, g);
                    float o[8];
                    if (ACCUM) { const u32x4 mw = *(const u32x4*)(Mg + row * DM + col0 + bj * HALF); unpack8(mw, o); }
                    else {
#pragma unroll
                        for (int j = 0; j < 8; ++j) o[j] = 0.f; }
                    const f32x4 v0 = acc[ai][bj][m][0], v1 = acc[ai][bj][m][1];
#pragma unroll
                    for (int j = 0; j < 4; ++j) { o[j] += g[j] * v0[j]; o[4 + j] += g[4 + j] * v1[j]; }
                    *(u32x4*)(Mg + row * DM + col0 + bj * HALF) = pack8(o); }
                asm volatile("" ::: "memory"); }
    }
};
struct EpiRes {
    static constexpr bool PERM = false, AFTER_DRAIN = false;
    const float* base_ctx; const float* base_lat; float* X; const float* gate;
    __device__ __forceinline__ void operator()(const f32x4 (&acc)[2][2][4][2], const Unit& u, int wr, int wc, int fr, int fq) const {
        const int cond = u.pm < 32 ? 0 : (u.pm < 48 ? 1 : 2);
        const float* gp = gate + (size_t)cond * 6144;
        const float* bp = u.pm < 32 ? base_ctx + (size_t)u.pm * BM * DM : base_lat + (size_t)(u.pm - 32) * BM * DM;
        float* xp = X + (size_t)u.pm * BM * DM;
        const int r0 = wr * 64 + fr, col0 = u.pn * BM + wc * 32 + 4 * fq;
#pragma unroll
        for (int ai = 0; ai < 2; ++ai)
#pragma unroll
            for (int m = 0; m < 4; ++m) { const size_t off = (size_t)(r0 + ai * HALF + m * 16) * DM + col0;
#pragma unroll
                for (int bj = 0; bj < 2; ++bj)
#pragma unroll
                    for (int n = 0; n < 2; ++n) { const f32x4 b = *(const f32x4*)(bp + off + bj * HALF + n * 16); const f32x4 gvv = *(const f32x4*)(gp + col0 + bj * HALF + n * 16);
                        *(f32x4*)(xp + off + bj * HALF + n * 16) = b + gvv * acc[ai][bj][m][n]; }
                asm volatile("" ::: "memory"); }
    }
};

template <class Epi, class Sched, bool ALIGN_EPI = false, bool SP2 = false>
__device__ __forceinline__ void gemm_phase(LAS unsigned char* lds, const Gemm g, const Sched& S, const Epi& E) {
    int tid_ = threadIdx.x; asm volatile("" : "+v"(tid_));
    const int tid = tid_, wid = __builtin_amdgcn_readfirstlane(tid >> 6), lane = tid & 63, wr = wid >> 2, wc = wid & 3, fr = lane & 15, fq = lane >> 4;
    const int K = g.K, nt = K / BK, lda = g.lda;
    unsigned voffA[2], voffB[2];
#pragma unroll
    for (int i = 0; i < 2; ++i) { int R, C; stage_rc(tid * 16 + i * 8192, R, C); const int Rb = Epi::PERM ? ((R & ~31) + perm32(R & 31)) : R;
        voffA[i] = (unsigned)(R * lda + C) * 2u; voffB[i] = (unsigned)(Rb * K + C) * 2u; }
    const size_t kstep = (size_t)(BK * 2);
    const size_t hstepA = (size_t)HALF * lda * 2, hstepB = (size_t)HALF * K * 2;
    const size_t tstepA = 2 * hstepA, tstepB = 2 * hstepB;
    const unsigned ldsw = (unsigned)wid * 1024u;
    const int aoff = lds_byte(wr * 64 + fr, fq * 8), boff = lds_byte(wc * 32 + fr, fq * 8);
#define PG8_SA(b, h) (((b) * 2 + (h)) * HTB)
#define PG8_SB(b, h) ((4 + (b) * 2 + (h)) * HTB)
#define PG8_STAGE(bufoff, gbase, voff) do { _Pragma("unroll") for (int _i = 0; _i < 2; ++_i) \
        __builtin_amdgcn_global_load_lds((const unsigned*)((const char*)(gbase) + (voff)[_i]), (LAS unsigned*)(lds + (bufoff) + ldsw + _i * 8192), 16, 0, 0); } while (0)
#define PG8_LDA(dst, b, h) do { _Pragma("unroll") for (int m = 0; m < 4; ++m) _Pragma("unroll") for (int k = 0; k < 2; ++k) dst[m][k] = *(const LAS h16x8*)(lds + PG8_SA(b, h) + aoff + m * 2048 + k * 1024); } while (0)
#define PG8_LDB(dst, b, h) do { _Pragma("unroll") for (int n = 0; n < 2; ++n) _Pragma("unroll") for (int k = 0; k < 2; ++k) dst[n][k] = *(const LAS h16x8*)(lds + PG8_SB(b, h) + boff + n * 2048 + k * 1024); } while (0)
#define PG8_MMA(ai, bj, At, Bt) do { __builtin_amdgcn_s_setprio(1); _Pragma("unroll") for (int m = 0; m < 4; ++m) _Pragma("unroll") for (int n = 0; n < 2; ++n) _Pragma("unroll") for (int k = 0; k < 2; ++k) \
        acc[ai][bj][m][n] = __builtin_amdgcn_mfma_f32_16x16x32_f16(Bt[n][k], At[m][k], acc[ai][bj][m][n], 0, 0, 0); __builtin_amdgcn_s_setprio(0); } while (0)
#define PG8_WAIT_V(n) asm volatile("s_waitcnt vmcnt(" #n ")" ::: "memory")
#define PG8_WAIT_L(n) asm volatile("s_waitcnt lgkmcnt(" #n ")" ::: "memory")
#define PG8_BAR __builtin_amdgcn_s_barrier()
#define PG8_SCHED __builtin_amdgcn_sched_barrier(0)
    Unit cur, nxt; int ui = 0;
    if (!S.next(0, cur)) return;
    f32x4 acc[2][2][4][2];
#pragma unroll
    for (int a = 0; a < 2; ++a)
#pragma unroll
        for (int b = 0; b < 2; ++b)
#pragma unroll
            for (int m = 0; m < 4; ++m)
#pragma unroll
                for (int n = 0; n < 2; ++n) acc[a][b][m][n] = (f32x4){0.f, 0.f, 0.f, 0.f};
    h16x8 At[4][2], B0[2][2], B1[2][2];
    const char* cA = (const char*)g.A + (size_t)cur.pm * tstepA; const char* cB = (const char*)g.Bt + (size_t)cur.pn * tstepB;
    S.a_ready(cur);
    if constexpr (SP2) {
        PG8_STAGE(PG8_SB(0, 0), cB, voffB); PG8_STAGE(PG8_SB(0, 1), cB + hstepB, voffB); PG8_STAGE(PG8_SA(0, 0), cA, voffA); PG8_STAGE(PG8_SA(0, 1), cA + hstepA, voffA);
        if (wr == 1) PG8_BAR;
        PG8_WAIT_V(2); PG8_BAR;
        PG8_STAGE(PG8_SB(1, 0), cB + kstep, voffB); PG8_STAGE(PG8_SA(1, 0), cA + kstep, voffA); PG8_STAGE(PG8_SB(1, 1), cB + hstepB + kstep, voffB);
        PG8_WAIT_V(6); PG8_BAR;
    } else {
        PG8_STAGE(PG8_SB(0, 0), cB, voffB); PG8_STAGE(PG8_SA(0, 0), cA, voffA); PG8_STAGE(PG8_SB(0, 1), cB + hstepB, voffB); PG8_STAGE(PG8_SA(0, 1), cA + hstepA, voffA);
        if (wr == 1) PG8_BAR;
        PG8_WAIT_V(4); PG8_BAR;
        PG8_STAGE(PG8_SB(1, 0), cB + kstep, voffB); PG8_STAGE(PG8_SA(1, 0), cA + kstep, voffA); PG8_STAGE(PG8_SB(1, 1), cB + hstepB + kstep, voffB);
        PG8_WAIT_V(6); PG8_BAR;
    }
    for (;;) {
        const bool has_next = S.next(ui + 1, nxt);
        const char* nA = has_next ? (const char*)g.A + (size_t)nxt.pm * tstepA : cA; const char* nB = has_next ? (const char*)g.Bt + (size_t)nxt.pn * tstepB : cB;
        for (int t = 0; t < nt; t += 2) {
            const bool last = (t == nt - 2);
            const char* a1 = cA + (size_t)(t + 1) * kstep;
            const char* a2 = last ? nA : cA + (size_t)(t + 2) * kstep; const char* b2 = last ? nB : cB + (size_t)(t + 2) * kstep;
            const char* a3 = a2 + kstep; const char* b3 = b2 + kstep;
            if (last && has_next) S.a_ready(nxt);
            if constexpr (SP2) {
            PG8_LDB(B0, 0, 0); PG8_LDB(B1, 0, 1); PG8_SCHED; PG8_LDA(At, 0, 0); PG8_STAGE(PG8_SA(1, 1), a1 + hstepA, voffA);
            PG8_WAIT_V(8); PG8_WAIT_L(0); PG8_BAR; PG8_MMA(0, 0, At, B0); PG8_MMA(0, 1, At, B1); PG8_BAR; PG8_SCHED;
            PG8_LDA(At, 0, 1); PG8_STAGE(PG8_SB(0, 0), b2, voffB); PG8_STAGE(PG8_SB(0, 1), b2 + hstepB, voffB); PG8_STAGE(PG8_SA(0, 0), a2, voffA);
            PG8_WAIT_V(8); PG8_WAIT_L(0); PG8_BAR; PG8_MMA(1, 0, At, B0); PG8_MMA(1, 1, At, B1); PG8_BAR; PG8_SCHED;
            PG8_LDB(B0, 1, 0); PG8_LDB(B1, 1, 1); PG8_SCHED; PG8_LDA(At, 1, 0); PG8_STAGE(PG8_SA(0, 1), a2 + hstepA, voffA);
            PG8_WAIT_V(8); PG8_WAIT_L(0); PG8_BAR; PG8_MMA(0, 0, At, B0); PG8_MMA(0, 1, At, B1); PG8_BAR; PG8_SCHED;
            PG8_LDA(At, 1, 1); PG8_STAGE(PG8_SB(1, 0), b3, voffB); PG8_STAGE(PG8_SB(1, 1), b3 + hstepB, voffB); PG8_STAGE(PG8_SA(1, 0), a3, voffA);
            PG8_WAIT_V(8); PG8_WAIT_L(0); PG8_BAR; PG8_MMA(1, 0, At, B0); PG8_MMA(1, 1, At, B1); PG8_BAR; PG8_SCHED;
            } else {
            PG8_LDB(B0, 0, 0); PG8_SCHED; PG8_LDA(At, 0, 0); PG8_STAGE(PG8_SA(1, 1), a1 + hstepA, voffA);
            PG8_WAIT_L(8); PG8_BAR; PG8_WAIT_L(0); PG8_MMA(0, 0, At, B0); PG8_BAR; PG8_SCHED;
            PG8_LDB(B1, 0, 1); PG8_STAGE(PG8_SB(0, 0), b2, voffB);
            PG8_BAR; PG8_WAIT_L(0); PG8_MMA(0, 1, At, B1); PG8_BAR;
            PG8_LDA(At, 0, 1); PG8_STAGE(PG8_SA(0, 0), a2, voffA);
            PG8_BAR; PG8_WAIT_L(0); PG8_MMA(1, 0, At, B0); PG8_BAR; PG8_SCHED;
            PG8_STAGE(PG8_SB(0, 1), b2 + hstepB, voffB);
            PG8_WAIT_V(6); PG8_BAR; PG8_MMA(1, 1, At, B1); PG8_BAR;
            PG8_LDB(B0, 1, 0); PG8_SCHED; PG8_LDA(At, 1, 0); PG8_STAGE(PG8_SA(0, 1), a2 + hstepA, voffA);
            PG8_WAIT_L(8); PG8_BAR; PG8_WAIT_L(0); PG8_MMA(0, 0, At, B0); PG8_BAR; PG8_SCHED;
            PG8_LDB(B1, 1, 1); PG8_STAGE(PG8_SB(1, 0), b3, voffB);
            PG8_BAR; PG8_WAIT_L(0); PG8_MMA(0, 1, At, B1); PG8_BAR;
            PG8_LDA(At, 1, 1); PG8_STAGE(PG8_SA(1, 0), a3, voffA);
            PG8_BAR; PG8_WAIT_L(0); PG8_MMA(1, 0, At, B0); PG8_BAR; PG8_SCHED;
            PG8_STAGE(PG8_SB(1, 1), b3 + hstepB, voffB);
            PG8_WAIT_V(6); PG8_BAR; PG8_MMA(1, 1, At, B1); PG8_BAR;
            }
        }
        if constexpr (ALIGN_EPI) { if (wr == 0) PG8_BAR; }
        if constexpr (!Epi::AFTER_DRAIN) { E(acc, cur, wr, wc, fr, fq); S.done(cur); }
        if (!has_next) break;
#pragma unroll
        for (int a = 0; a < 2; ++a)
#pragma unroll
            for (int b = 0; b < 2; ++b)
#pragma unroll
                for (int m = 0; m < 4; ++m)
#pragma unroll
                    for (int n = 0; n < 2; ++n) acc[a][b][m][n] = (f32x4){0.f, 0.f, 0.f, 0.f};
        cur = nxt; cA = nA; cB = nB; ++ui;
        if constexpr (ALIGN_EPI) { if (wr == 1) PG8_BAR; }
    }
    PG8_WAIT_V(0);
    if constexpr (!ALIGN_EPI) { if (wr == 0) PG8_BAR; }
    PG8_BAR;
#undef PG8_SA
#undef PG8_SB
#undef PG8_STAGE
#undef PG8_LDA
#undef PG8_LDB
#undef PG8_MMA
#undef PG8_WAIT_V
#undef PG8_WAIT_L
#undef PG8_BAR
#undef PG8_SCHED
}
}

constexpr int NWAVES = 8, NTHREADS = 512;
constexpr int RING_BYTES = 131072;
constexpr int LDSCTL_OFF = RING_BYTES, MISC_OFF = LDSCTL_OFF + 320;
constexpr int LDS_BYTES = 147456;

typedef GAS unsigned gu32;
#define RLX_AGENT __ATOMIC_RELAXED, __HIP_MEMORY_SCOPE_AGENT
#define LDS_WAIT() asm volatile("s_waitcnt lgkmcnt(0)" ::: "memory")
#define VM_WAIT() asm volatile("s_waitcnt vmcnt(0)" ::: "memory")

#define XB_TMO      128
#define XB_XCNT(j)  (256  + 64 * (j))
#define XB_XSUB(j)  (1280 + 64 * (j))
#define XB_XGEN(j)  (2304 + 64 * (j))
#define XB_TOP      3328
#define XB_TOPGEN   3392
#define XCD_BAR_WORDS 3456
#define XB_SPIN_CAP (1u << 18)
__device__ __forceinline__ unsigned xb_ld(unsigned* p)              { return __hip_atomic_load(p, __ATOMIC_RELAXED, __HIP_MEMORY_SCOPE_AGENT); }
__device__ __forceinline__ unsigned xb_add(unsigned* p, unsigned v) { return __hip_atomic_fetch_add(p, v, __ATOMIC_RELAXED, __HIP_MEMORY_SCOPE_AGENT); }
__device__ __forceinline__ unsigned xb_xcc_id() { return (unsigned)__builtin_amdgcn_s_getreg((3 << 11) | 20) & 0xFu; }
#define XB_SPIN(cond, bar) do { unsigned _sp = 0; while (cond) { __builtin_amdgcn_s_sleep(1); \
    if ((++_sp & 255u) == 0u) { if (xb_ld(&(bar)[XB_TMO])) break; if (_sp > XB_SPIN_CAP) { atomicAdd(&(bar)[XB_TMO], 1u); break; } } } } while (0)
struct XcdBarrier { unsigned* bar; unsigned x; volatile LAS unsigned* st; };
__device__ __forceinline__ XcdBarrier xcd_barrier_post(unsigned* bar, volatile LAS unsigned* st) {
    XcdBarrier b; b.bar = bar; b.x = xb_xcc_id(); b.st = st;
    if (threadIdx.x == 0) (void)xb_add(&bar[XB_XCNT(b.x)], 1u);
    return b;
}
__device__ __forceinline__ void xcd_barrier_complete(unsigned* bar, unsigned x, unsigned& nloc, unsigned& nx) {
    const unsigned G = gridDim.x * gridDim.y * gridDim.z;
    unsigned sum, cnt, mine, sp = 0u;
    for (;;) {
        sum = 0u; cnt = 0u; mine = 0u;
#pragma unroll
        for (unsigned j = 0; j < 16; ++j) { const unsigned c = xb_ld(&bar[XB_XCNT(j)]); sum += c; cnt += (c > 0u) ? 1u : 0u; mine = (j == x) ? c : mine; }
        if (sum == G) break;
        __builtin_amdgcn_s_sleep(1);
        if ((++sp & 255u) == 0u) { if (xb_ld(&bar[XB_TMO])) break; if (sp > XB_SPIN_CAP) { atomicAdd(&bar[XB_TMO], 1u); break; } }
    }
    nloc = mine > 0u ? mine : 1u; nx = cnt > 0u ? cnt : 1u;
}
__device__ __forceinline__ void xcd_barrier(const XcdBarrier& b) {
    asm volatile("s_waitcnt vmcnt(0)" ::: "memory");
    __syncthreads();
    if (threadIdx.x == 0) {
        unsigned* bar = b.bar;
        __builtin_amdgcn_s_waitcnt(0);
        unsigned nloc = b.st[0], nx = b.st[1];
        if (nloc == 0u) { xcd_barrier_complete(bar, b.x, nloc, nx); b.st[0] = nloc; b.st[1] = nx; }
        const unsigned old = xb_add(&bar[XB_XSUB(b.x)], 1u);
        const unsigned gen = old / nloc;
        if (old + 1u == (gen + 1u) * nloc) {
            __builtin_amdgcn_fence(__ATOMIC_RELEASE, "agent");
            asm volatile("s_waitcnt vmcnt(0)" ::: "memory");
            const unsigned og = xb_add(&bar[XB_TOP], 1u);
            const unsigned tg = og / nx;
            if (og + 1u == (tg + 1u) * nx) xb_add(&bar[XB_TOPGEN], 1u);
            else XB_SPIN(xb_ld(&bar[XB_TOPGEN]) == tg, bar);
            __builtin_amdgcn_fence(__ATOMIC_ACQUIRE, "agent");
            xb_add(&bar[XB_XGEN(b.x)], 1u);
            asm volatile("s_waitcnt vmcnt(0)" ::: "memory");
        } else {
            XB_SPIN(xb_ld(&bar[XB_XGEN(b.x)]) == gen, bar);
            __builtin_amdgcn_fence(__ATOMIC_ACQUIRE, "agent");
            asm volatile("s_waitcnt vmcnt(0)" ::: "memory");
        }
    }
    __syncthreads();
}
constexpr int CW_BAR = 4096;
static_assert((CW_BAR + XCD_BAR_WORDS) * 4 <= (int)CTL_ZERO_BYTES, "ctl");

struct Args {
    const float* in[33]; float* out; unsigned char* ws; int ph_lo, ph_hi;
};
typedef const float* cfp_t;
struct Frame {
    LAS unsigned char* lds;
    int tid, lane, wave, vcu, G;
    const __attribute__((address_space(4))) cfp_t* in; float* out; unsigned char* ws; float* out0; unsigned char* ws0;
    __device__ __forceinline__ void refresh() { int t = threadIdx.x; asm volatile("" : "+v"(t)); tid = t; lane = t & 63; wave = __builtin_amdgcn_readfirstlane(t >> 6);
        const __attribute__((address_space(4))) cfp_t* p = (const __attribute__((address_space(4))) cfp_t*)__builtin_amdgcn_kernarg_segment_ptr(); asm volatile("" : "+s"(p)); in = p;
        float* o_ = out0; unsigned char* w_ = ws0; asm volatile("" : "+s"(o_), "+s"(w_)); out = o_; ws = w_; }
};
enum { I_XP = 0, I_XS, I_C, I_CKB, I_CVB, I_CKC, I_CVC, I_STATE, I_CCTX, I_N1G, I_N2G, I_WMOD, I_BMOD, I_WIN, I_LCW, I_LCB, I_LWA, I_LBA, I_LWX, I_LBX, I_LAM,
       I_QNG, I_KNG, I_SINK, I_WOA, I_WOB, I_WOC, I_WOUT, I_WUP, I_FCW, I_FCB, I_WDOWN, I_FING };

__device__ __forceinline__ void transpose_item(const float* W, int K, int N, h16* WT, LAS float* scr, int item, int lane) {
    const int nblk = N / 32, kb = item / nblk, nb = item % nblk, k0 = 64 * kb, n0 = 32 * nb;
#pragma unroll 8
    for (int i = 0; i < 32; ++i) { const int kk = 2 * i + (lane >> 5); scr[kk * 33 + (lane & 31)] = W[(size_t)(k0 + kk) * N + n0 + (lane & 31)]; }
    LDS_WAIT(); asm volatile("" ::: "memory");
    const int c = lane & 7;
#pragma unroll
    for (int j = 0; j < 4; ++j) { const int n = (lane >> 3) + 8 * j; const LAS float* s = scr + (8 * c) * 33 + n;
        u32x4 o; o.x = pk_h2(s[0 * 33], s[1 * 33]); o.y = pk_h2(s[2 * 33], s[3 * 33]); o.z = pk_h2(s[4 * 33], s[5 * 33]); o.w = pk_h2(s[6 * 33], s[7 * 33]);
        *(u32x4*)(WT + (size_t)(n0 + n) * K + k0 + 8 * c) = o; }
    LDS_WAIT(); asm volatile("" ::: "memory");
}
__device__ __forceinline__ void phase_convert_weights(Frame& F, int l) {
    LAS float* scr = (LAS float*)(F.lds + F.wave * 16384);
    const int gw = F.vcu * NWAVES + F.wave, NGW = F.G * NWAVES;
    unsigned char* wb = F.ws + WS_W;
    constexpr int IT_IN = (DM / 64) * (DIN / 32), IT_OA = (1024 / 64) * (DM / 32), IT_OB = (512 / 64) * (DM / 32), IT_OUT = (DM / 64) * (DM / 32),
                  IT_UP = (DM / 64) * (DUP / 32), IT_DOWN = (DFF / 64) * (DM / 32), IT_LRU1 = (128 / 64) * (128 / 32), IT_LRU = 32 * IT_LRU1;
    constexpr int NITEMS = IT_IN + IT_OA + 2 * IT_OB + IT_OUT + IT_UP + IT_DOWN + IT_LRU;
    for (int it = gw; it < NITEMS; it += NGW) {
        int r = it;
        if (r < IT_IN) { transpose_item(F.in[I_WIN] + (size_t)l * DM * DIN, DM, DIN, (h16*)(wb + W_IN), scr, r, F.lane); continue; } r -= IT_IN;
        if (r < IT_OA) { transpose_item(F.in[I_WOA] + (size_t)l * 1024 * DM, 1024, DM, (h16*)(wb + W_OA), scr, r, F.lane); continue; } r -= IT_OA;
        if (r < IT_OB) { transpose_item(F.in[I_WOB] + (size_t)l * 512 * DM, 512, DM, (h16*)(wb + W_OB), scr, r, F.lane); continue; } r -= IT_OB;
        if (r < IT_OB) { transpose_item(F.in[I_WOC] + (size_t)l * 512 * DM, 512, DM, (h16*)(wb + W_OC), scr, r, F.lane); continue; } r -= IT_OB;
        if (r < IT_OUT) { transpose_item(F.in[I_WOUT] + (size_t)l * DM * DM, DM, DM, (h16*)(wb + W_OUT), scr, r, F.lane); continue; } r -= IT_OUT;
        if (r < IT_UP) { transpose_item(F.in[I_WUP] + (size_t)l * DM * DUP, DM, DUP, (h16*)(wb + W_UP), scr, r, F.lane); continue; } r -= IT_UP;
        if (r < IT_DOWN) { transpose_item(F.in[I_WDOWN] + (size_t)l * DFF * DM, DFF, DM, (h16*)(wb + W_DOWN), scr, r, F.lane); continue; } r -= IT_DOWN;
        {
            const int mi = r / IT_LRU1, sub = r % IT_LRU1, dir = mi >> 4, gate = (mi >> 3) & 1, n = mi & 7;
            const float* src = (gate ? F.in[I_LWX] : F.in[I_LWA]) + ((size_t)((l * 2 + dir) * 8 + n)) * 128 * 128;
            transpose_item(src, 128, 128, (h16*)(wb + W_LRU) + (size_t)mi * 128 * 128, scr, sub, F.lane);
        }
    }
}
__device__ __forceinline__ void phase_prep_misc(Frame& F) {
    LAS float* sil = (LAS float*)F.lds;
    LAS float* part = (LAS float*)(F.lds + 16384);
    float* mod = (float*)(F.ws + WS_MOD);
    for (int item = F.vcu; item < 192; item += F.G) {
        const int l = item / 96, n0 = (item % 96) * 64;
        __syncthreads();
        for (int i = F.tid; i < 3 * 1024; i += NTHREADS) { const int j = i >> 10, k = i & 1023;
            const float v = j == 0 ? F.in[I_CCTX][k] : F.in[I_C][(j - 1) * 1024 + k]; sil[i] = v * sigmoidf_(v); }
        __syncthreads();
        const float* wp = F.in[I_WMOD] + (size_t)l * DM * 6144 + n0 + F.lane;
        float a0 = 0.f, a1 = 0.f, a2 = 0.f;
        const int kb = F.wave * 128;
#pragma unroll 8
        for (int k = 0; k < 128; ++k) { const float w = wp[(size_t)(kb + k) * 6144]; a0 += w * sil[kb + k]; a1 += w * sil[1024 + kb + k]; a2 += w * sil[2048 + kb + k]; }
        part[(F.wave * 3 + 0) * 64 + F.lane] = a0; part[(F.wave * 3 + 1) * 64 + F.lane] = a1; part[(F.wave * 3 + 2) * 64 + F.lane] = a2;
        __syncthreads();
        if (F.tid < 192) { const int j = F.tid >> 6, c = F.tid & 63; float s = F.in[I_BMOD][l * 6144 + n0 + c];
#pragma unroll
            for (int w = 0; w < 8; ++w) s += part[(w * 3 + j) * 64 + c];
            mod[((size_t)l * 3 + j) * 6144 + n0 + c] = s; }
    }
    __syncthreads();
    const int gt = F.vcu * NTHREADS + F.tid, NGT = F.G * NTHREADS;
    float* rope = (float*)(F.ws + WS_ROPE);
    for (int i = gt; i < 64 * 16; i += NGT) { const int pos = i >> 4, fi = i & 15; const float inv = expf(-(float)fi * (1.0f / 16.0f) * 9.210340371976184f);
        const float ang = (float)pos * inv; rope[2 * i] = cosf(ang); rope[2 * i + 1] = sinf(ang); }
    h16* cache = (h16*)(F.ws + WS_CACHE);
    for (int i = gt; i < 4 * 131072 / 4; i += NGT) { const int kind = i / 32768, e = (i % 32768) * 4;
        const float* src = kind == 0 ? F.in[I_CKB] : kind == 1 ? F.in[I_CVB] : kind == 2 ? F.in[I_CKC] : F.in[I_CVC];
        const f32x4 v = *(const f32x4*)(src + e); u32x2 w; w.x = pk_h2(v[0], v[1]); w.y = pk_h2(v[2], v[3]); *(u32x2*)(cache + (size_t)kind * 131072 + e) = w; }
}

__device__ __forceinline__ const float* xrow_ptr(const Frame& F, int layer_src_is_input, int row) {
    if (layer_src_is_input) return row < NCTX ? F.in[I_XP] + (size_t)row * DM : F.in[I_XS] + (size_t)(row - NCTX) * DM;
    return F.out + O_Y + (size_t)row * DM;
}
__device__ __forceinline__ void phase_norm_mod(Frame& F, int from_input, const float* g, const float* mod_l, int shift_chunk) {
    const int gw = F.vcu * NWAVES + F.wave, NGW = F.G * NWAVES;
    h16* H = (h16*)(F.ws + WS_H);
    int cur_cond = -1; f32x4 gs[4], sh[4];
    for (int row = gw; row < NTOK; row += NGW) {
        const int cond = row < NCTX ? 0 : (row < NCTX + LSEQ ? 1 : 2);
        if (cond != cur_cond) { cur_cond = cond; const float* mp = mod_l + (size_t)cond * 6144;
#pragma unroll
            for (int j = 0; j < 4; ++j) { const int c = F.lane * 4 + 256 * j; const f32x4 gg = *(const f32x4*)(g + c); const f32x4 sc = *(const f32x4*)(mp + (shift_chunk + 1) * 1024 + c);
                gs[j] = gg * (sc + 1.0f); sh[j] = *(const f32x4*)(mp + shift_chunk * 1024 + c); } }
        const f32x4* xr = (const f32x4*)xrow_ptr(F, from_input, row) + F.lane;
        f32x4 v[4]; float s = 0.f;
#pragma unroll
        for (int j = 0; j < 4; ++j) { v[j] = xr[64 * j]; s += (v[j].x * v[j].x + v[j].y * v[j].y) + (v[j].z * v[j].z + v[j].w * v[j].w); }
        const float rstd = 1.0f / sqrtf(wave_sum(s) * (1.0f / DM) + NORM_EPS);
        u32x2* o8 = (u32x2*)(H + (size_t)row * DM) + F.lane;
#pragma unroll
        for (int j = 0; j < 4; ++j) { const f32x4 y = v[j] * rstd * gs[j] + sh[j]; u32x2 w; w.x = pk_h2(y.x, y.y); w.y = pk_h2(y.z, y.w); o8[64 * j] = w; }
    }
}
__device__ __forceinline__ void phase_final_norm(Frame& F) {
    const int gw = F.vcu * NWAVES + F.wave, NGW = F.G * NWAVES;
    f32x4 gg[4];
#pragma unroll
    for (int j = 0; j < 4; ++j) gg[j] = *(const f32x4*)(F.in[I_FING] + F.lane * 4 + 256 * j);
    for (int row = gw; row < NTOK; row += NGW) {
        f32x4* xr = (f32x4*)(F.out + O_Y + (size_t)row * DM) + F.lane;
        f32x4 v[4]; float s = 0.f;
#pragma unroll
        for (int j = 0; j < 4; ++j) { v[j] = xr[64 * j]; s += (v[j].x * v[j].x + v[j].y * v[j].y) + (v[j].z * v[j].z + v[j].w * v[j].w); }
        const float rstd = 1.0f / sqrtf(wave_sum(s) * (1.0f / DM) + NORM_EPS);
#pragma unroll
        for (int j = 0; j < 4; ++j) xr[64 * j] = v[j] * rstd * gg[j];
    }
}

__device__ __forceinline__ void phase_qk(Frame& F, int l) {
    const int gw = F.vcu * NWAVES + F.wave, NGW = F.G * NWAVES, lane = F.lane;
    h16* Z = (h16*)(F.ws + WS_ZU);
    const float* rope = (const float*)(F.ws + WS_ROPE);
    const float* qg = F.in[I_QNG] + l * 64; const float* kg = F.in[I_KNG] + l * 64;
    const int hl = lane & 7, hc0 = hl * 8;
    float qgv[8], kgv[8];
#pragma unroll
    for (int j = 0; j < 8; ++j) { qgv[j] = qg[hc0 + j]; kgv[j] = kg[hc0 + j]; }
    for (int row = gw; row < NTOK; row += NGW) {
        const bool is_ctx = row < NCTX;
        int rpos = 0, cpos = 0, b = 0, t = 0;
        if (is_ctx) { b = row >> 8; t = row & 255; } else { const int tt = (row - NCTX) & (LSEQ - 1); rpos = tt >> 6; cpos = tt & 63; }
        h16* zr = Z + (size_t)row * NMAIN;
#pragma unroll
        for (int pass = 0; pass < 3; ++pass) {
            const int col = C_QB + pass * 512 + lane * 8;
            int kind;
            if (pass == 0) kind = 0; else if (pass == 1) kind = lane < 8 * 2 ? 1 : (lane < 8 * 4 ? 2 : 3); else kind = lane < 32 ? 3 : (lane < 48 ? 4 : 5);
            const u32x4 w = *(const u32x4*)(zr + col);
            float x[8]; unpack8(w, x);
            if (kind <= 1) {
                float s = 0.f;
#pragma unroll
                for (int j = 0; j < 8; ++j) s += x[j] * x[j];
                s += __shfl_xor(s, 1); s += __shfl_xor(s, 2); s += __shfl_xor(s, 4);
                const float rstd = 1.0f / sqrtf(s * (1.0f / 64.0f) + NORM_EPS);
#pragma unroll
                for (int j = 0; j < 8; ++j) x[j] = x[j] * rstd * (kind == 0 ? qgv[j] : kgv[j]);
            }
            if (!is_ctx) {
                float p[8];
#pragma unroll
                for (int j = 0; j < 8; ++j) p[j] = __shfl_xor(x[j], 2);
                if (kind == 0 || kind == 1 || kind == 3 || kind == 4) {
                    const int half = hl >> 2, second = (hl >> 1) & 1, f0 = (hl & 1) * 8, pos = half ? cpos : rpos;
                    const float* tp = rope + ((size_t)pos * 16 + f0) * 2;
#pragma unroll
                    for (int j = 0; j < 8; ++j) { const float cs = tp[2 * j], sn = tp[2 * j + 1]; x[j] = second ? (p[j] * sn + x[j] * cs) : (x[j] * cs - p[j] * sn); }
                }
            }
            if (kind == 0 || kind == 3) {
#pragma unroll
                for (int j = 0; j < 8; ++j) x[j] *= QSCALE;
            }
            if (kind != 2 && kind != 5) *(u32x4*)(zr + col) = pack8(x);
            if (is_ctx && (kind == 1 || kind == 2 || kind == 4 || kind == 5)) {
                const size_t ob = kind == 1 ? O_KB : kind == 2 ? O_VB : kind == 4 ? O_KC : O_VC;
                const int c128 = (kind == 1 || kind == 2) ? (col - (kind == 1 ? C_KB : C_VB)) : (col - (kind == 4 ? C_KC : C_VC));
                float* op = F.out + ob + ((size_t)((b * 2 + l) * 256 + t)) * 128 + c128;
                *(f32x4*)op = (f32x4){x[0], x[1], x[2], x[3]}; *(f32x4*)(op + 4) = (f32x4){x[4], x[5], x[6], x[7]};
            }
        }
    }
}

__device__ __forceinline__ int img_off(int row, int ch) { return row * 256 + ((((ch >> 3) ^ (row & 15)) << 4) | ((ch & 7) << 1)); }
template <int MODE>
__device__ __forceinline__ void lru_unit(Frame& F, int l, int row0, int n, int seq_first, int seq_last, int lat_b, int lat_chunk, int ctx_b) {
    LAS unsigned char* img = F.lds; LAS unsigned char* hx = F.lds + 65536;
    const h16* Z = (const h16*)(F.ws + WS_ZU);
    const int tid = F.tid, lane = F.lane, wave = F.wave;
    __syncthreads();
    {
        const int cc = tid & 15, tg = tid >> 4; const int ch0 = n * 128 + cc * 8;
        float w0[8], w1[8], w2[8], w3[8], bb[8];
        const float* cw = F.in[I_LCW] + (size_t)l * 4 * DLRU + ch0; const float* cb = F.in[I_LCB] + (size_t)l * DLRU + ch0;
#pragma unroll
        for (int j = 0; j < 8; ++j) { w0[j] = cw[j]; w1[j] = cw[DLRU + j]; w2[j] = cw[2 * DLRU + j]; w3[j] = cw[3 * DLRU + j]; bb[j] = cb[j]; }
        float xm2[8], xm1[8], x0[8], xp1[8];
        const int t0 = tg * 8;
        auto ldrow = [&](int t, float* dst) {
            const bool ok = (t >= 0 || !seq_first) && (t < 256 || !seq_last);
            if (ok) { const u32x4 w = *(const u32x4*)(Z + (size_t)(row0 + t) * NMAIN + C_XA + ch0); unpack8(w, dst); }
            else {
#pragma unroll
                for (int j = 0; j < 8; ++j) dst[j] = 0.f; }
        };
        ldrow(t0 - 2, xm2); ldrow(t0 - 1, xm1); ldrow(t0, x0);
#pragma unroll
        for (int i = 0; i < 8; ++i) {
            ldrow(t0 + i + 1, xp1);
            float y[8];
#pragma unroll
            for (int j = 0; j < 8; ++j) y[j] = bb[j] + w0[j] * xm2[j] + w1[j] * xm1[j] + w2[j] * x0[j] + w3[j] * xp1[j];
            *(LAS u32x4*)(img + img_off(t0 + i, cc * 8)) = pack8(y);
#pragma unroll
            for (int j = 0; j < 8; ++j) { xm2[j] = xm1[j]; xm1[j] = x0[j]; x0[j] = xp1[j]; }
        }
    }
    __syncthreads();
    const int dir = wave >> 2, cb = wave & 3, r32 = lane & 31, hi = lane >> 5;
    const int C = n * 128 + cb * 32 + r32;
    const h16* wr_ = (const h16*)(F.ws + WS_W + W_LRU) + ((size_t)((dir * 2 + 0) * 8 + n) * 128 + cb * 32 + r32) * 128 + 8 * hi;
    const h16* wi_ = (const h16*)(F.ws + WS_W + W_LRU) + ((size_t)((dir * 2 + 1) * 8 + n) * 128 + cb * 32 + r32) * 128 + 8 * hi;
    const float ba = F.in[I_LBA][(size_t)(l * 2 + dir) * DLRU + C], bx = F.in[I_LBX][(size_t)(l * 2 + dir) * DLRU + C];
    const float lam = F.in[I_LAM][(size_t)(l * 2 + dir) * DLRU + C];
    const float sp = (-lam > 20.f) ? -lam : log1pf(expf(-lam));
    const float k8 = -8.0f * sp * LOG2E;
    float H = 0.f;
    float aggP = 1.f;
    if (MODE == 2) {
        const float* agg = (const float*)(F.ws + WS_AGG);
        H = F.in[I_STATE][(size_t)((lat_b * 2 + l) * 2 + dir) * DLRU + C];
        float ap[15], au[15];
#pragma unroll
        for (int k = 0; k < 15; ++k) { const int ch = dir == 0 ? k : 15 - k; const bool use = dir == 0 ? (ch < lat_chunk) : (ch > lat_chunk);
            const float* p = agg + ((size_t)((lat_b * 16 + (use ? ch : 0)) * 2 + dir) * DLRU + C) * 2; ap[k] = use ? p[0] : 1.f; au[k] = use ? p[1] : 0.f; }
#pragma unroll
        for (int k = 0; k < 15; ++k) H = ap[k] * H + au[k];
    }
    const int ya_col = C_YA + C;
    h16* OA = (h16*)(F.ws + WS_ZU + ZU_OA);
#pragma unroll 1
    for (int step = 0; step < 8; ++step) {
        if (step == 4) __syncthreads();
        const int rb = dir == 0 ? step : 7 - step;
        f32x16 ar = {}, ai = {};
#pragma unroll
        for (int ks = 0; ks < 8; ++ks) {
            const h16x8 af = *(const LAS h16x8*)(img + (rb * 32 + r32) * 256 + (((2 * ks + hi) ^ (r32 & 15)) << 4));
            const h16x8 br = *(const h16x8*)(wr_ + 16 * ks), bi = *(const h16x8*)(wi_ + 16 * ks);
            ar = __builtin_amdgcn_mfma_f32_32x32x16_f16(af, br, ar, 0, 0, 0);
            ai = __builtin_amdgcn_mfma_f32_32x32x16_f16(af, bi, ai, 0, 0, 0);
        }
        float an[16], un[16];
#pragma unroll
        for (int r = 0; r < 16; ++r) {
            const int tk = rb * 32 + 8 * (r >> 2) + 4 * hi + (r & 3);
            const float xv = (float)*(const LAS h16*)(img + img_off(tk, cb * 32 + r32));
            const float rr = sigmoidf_(ar[r] + ba), ii = sigmoidf_(ai[r] + bx);
            const float e2 = k8 * rr;
            an[r] = fast_exp2(e2);
            const float y = 2.0f * e2 * 0.6931471805599453f;
            const float em1 = (y > -0.25f) ? y * (1.f + y * (0.5f + y * ((1.f / 6.f) + y * ((1.f / 24.f) + y * ((1.f / 120.f) + y * (1.f / 720.f)))))) : (fast_exp2(2.0f * e2) - 1.0f);
            un[r] = sqrtf(-em1) * (ii * xv);
        }
        float a[16], u[16];
#pragma unroll
        for (int r = 0; r < 16; ++r) { a[r] = dir ? an[15 - r] : an[r]; u[r] = dir ? un[15 - r] : un[r]; }
        const int hm = hi ^ dir;
        float P[4], U[4];
#pragma unroll
        for (int g = 0; g < 4; ++g) {
            float p = 1.f, uu = 0.f;
#pragma unroll
            for (int i = 0; i < 4; ++i) { uu = a[4 * g + i] * uu + u[4 * g + i]; p *= a[4 * g + i]; }
            P[g] = p; U[g] = uu;
        }
        float PP[4], UP[4];
#pragma unroll
        for (int g = 0; g < 4; ++g) { PP[g] = __shfl_xor(P[g], 32); UP[g] = __shfl_xor(U[g], 32); }
        float Hs[4];
        {
            float h = H;
#pragma unroll
            for (int s = 0; s < 8; ++s) {
                const int g = s >> 1; const int sh = s & 1;
                const float p = (sh == hm) ? P[g] : PP[g], uu = (sh == hm) ? U[g] : UP[g];
                if (sh == hm) Hs[g] = h;
                h = p * h + uu;
            }
            H = h;
        }
        if (MODE == 1) { float p = 1.f;
#pragma unroll
            for (int g = 0; g < 4; ++g) p *= P[g] * PP[g];
            aggP *= p; }
        if (MODE != 1) {
            float hv[16];
#pragma unroll
            for (int g = 0; g < 4; ++g) { float h = Hs[g];
#pragma unroll
                for (int i = 0; i < 4; ++i) { h = a[4 * g + i] * h + u[4 * g + i]; hv[4 * g + i] = h; } }
            if (step < 4) {
#pragma unroll
                for (int r = 0; r < 16; ++r) { const int tau = 8 * (r >> 2) + 4 * hm + (r & 3); const int tk = rb * 32 + (dir ? 31 - tau : tau);
                    *(LAS h16*)(hx + img_off(tk, cb * 32 + r32)) = (h16)hv[r]; }
            } else {
#pragma unroll
                for (int r = 0; r < 16; ++r) { const int tau = 8 * (r >> 2) + 4 * hm + (r & 3); const int tk = rb * 32 + (dir ? 31 - tau : tau);
                    const float other = (float)*(const LAS h16*)(hx + img_off(tk, cb * 32 + r32));
                    const float ya = (float)Z[(size_t)(row0 + tk) * NMAIN + ya_col];
                    OA[(size_t)(row0 + tk) * 1024 + C] = (h16)((hv[r] + other) * gelu_tanh(ya)); }
            }
        }
    }
    if (MODE == 0 && hi == 0) F.out[O_LRU + (size_t)((ctx_b * 2 + l) * 2 + dir) * DLRU + C] = H;
    if (MODE == 1 && hi == 0) { float* agg = (float*)(F.ws + WS_AGG) + ((size_t)((lat_b * 16 + lat_chunk) * 2 + dir) * DLRU + C) * 2; agg[0] = aggP; agg[1] = H; }
}

struct AttnDesc {
    const h16* Qz; h16* O;
    const h16* Kc; const h16* Vc;
    const h16* Kz; const h16* Vz;
    int nc, zt0, nz;
    int windowed;
    const float* sink;
    int kvh, q0;
};
__device__ __forceinline__ void attn_unit(Frame& F, const AttnDesc& D, const h16* Qrow0  , h16* Orow0  ) {
    LAS unsigned char* lds = F.lds;
    const int tid = F.tid, lane = F.lane, wave = F.wave, r32 = lane & 31, hi = lane >> 5;
    const int head = D.kvh * 4 + (wave >> 1);
    const int qpos = D.q0 + (wave & 1) * 32 + r32;
    const int NT = D.nc + D.nz;
    h16x8 qr[4];
    { const h16* qp = Qrow0 + (size_t)qpos * NMAIN + head * 64 + 8 * hi;
#pragma unroll
      for (int d0 = 0; d0 < 4; ++d0) qr[d0] = *(const h16x8*)(qp + 16 * d0); }
    const int krow = tid >> 3, kch = tid & 7; const int kdst = krow * 128 + ((kch ^ ((krow >> 1) & 7)) << 4);
    const int vrow = 16 * (wave & 3) + (lane >> 2), vcol = (wave >> 2) * 32 + (lane & 3) * 8; const int vdst = wave * 1024 + lane * 16;
    auto ktile_ptr = [&](int j, int row, int col, bool isV) -> const h16* {
        if (j < D.nc) return (isV ? D.Vc : D.Kc) + (size_t)(64 * j + row) * 128 + col;
        return (isV ? D.Vz : D.Kz) + (size_t)((D.zt0 + (j - D.nc)) * 64 + row) * NMAIN + col;
    };
    u32x4 kreg, vreg;
    kreg = *(const u32x4*)ktile_ptr(0, krow, kch * 8, false); vreg = *(const u32x4*)ktile_ptr(0, vrow, vcol, true);
    __syncthreads();
    *(LAS u32x4*)(lds + kdst) = kreg; *(LAS u32x4*)(lds + 16384 + vdst) = vreg;
    __syncthreads();
    float m_run, l_run;
    if (D.sink) { m_run = D.sink[head] * LOG2E; l_run = hi == 0 ? 1.f : 0.f; } else { m_run = -1e30f; l_run = 0.f; }
    f32x16 o0 = {}, o1 = {};
    LAS float* wsf = (LAS float*)(lds + 32768) + wave * 64;
    const int kfoff = r32 * 128;
    const int ksw = (r32 >> 1) & 7;
    const int vp0 = ((lane >> 4) & 1) * 32 + (lane & 3) * 8 + (4 * hi + ((lane & 15) >> 2)) * 64;
#pragma unroll 1
    for (int j = 0; j < NT; ++j) {
        const int buf = j & 1;
        if (j + 1 < NT) { kreg = *(const u32x4*)ktile_ptr(j + 1, krow, kch * 8, false); vreg = *(const u32x4*)ktile_ptr(j + 1, vrow, vcol, true); }
        LAS unsigned char* Kb = lds + buf * 8192; LAS unsigned char* Vb = lds + 16384 + buf * 8192;
        f32x16 p0 = {}, p1 = {};
#pragma unroll
        for (int d0 = 0; d0 < 4; ++d0) {
            const int co = ((2 * d0 + hi) ^ ksw) << 4;
            const h16x8 k0 = *(const LAS h16x8*)(Kb + kfoff + co);
            const h16x8 k1 = *(const LAS h16x8*)(Kb + 4096 + kfoff + co);
            p0 = __builtin_amdgcn_mfma_f32_32x32x16_f16(k0, qr[d0], p0, 0, 0, 0);
            p1 = __builtin_amdgcn_mfma_f32_32x32x16_f16(k1, qr[d0], p1, 0, 0, 0);
        }
        if (D.windowed && j >= D.nc) {
            const int kb0 = (D.zt0 + (j - D.nc)) * 64 + 4 * hi;
#pragma unroll
            for (int r = 0; r < 16; ++r) { const int kp = kb0 + (r & 3) + 8 * (r >> 2);
                const int d0_ = qpos - kp, d1_ = qpos - (kp + 32);
                if (d0_ > 128 || d0_ < -128) p0[r] = -1e30f;
                if (d1_ > 128 || d1_ < -128) p1[r] = -1e30f; }
        }
        float mx = fmaxf(p0[0], p1[0]);
#pragma unroll
        for (int r = 1; r < 16; ++r) mx = fmaxf(mx, fmaxf(p0[r], p1[r]));
        mx = fmaxf(mx, __shfl_xor(mx, 32));
        const float m_new = fmaxf(m_run, mx);
        const float alpha = fast_exp2(m_run - m_new);
        m_run = m_new;
        float rs = 0.f;
#pragma unroll
        for (int r = 0; r < 16; ++r) { p0[r] = fast_exp2(p0[r] - m_new); p1[r] = fast_exp2(p1[r] - m_new); rs += p0[r] + p1[r]; }
        l_run = l_run * alpha + rs;
        if (hi == 0) wsf[r32] = alpha;
        LDS_WAIT();
#pragma unroll
        for (int r = 0; r < 16; ++r) { const float f = wsf[(r & 3) + 8 * (r >> 2) + 4 * hi]; o0[r] *= f; o1[r] *= f; }
        u32x4 pw[4];
        pw[0] = (u32x4){pk_h2(p0[0], p0[1]), pk_h2(p0[2], p0[3]), pk_h2(p0[4], p0[5]), pk_h2(p0[6], p0[7])};
        pw[1] = (u32x4){pk_h2(p0[8], p0[9]), pk_h2(p0[10], p0[11]), pk_h2(p0[12], p0[13]), pk_h2(p0[14], p0[15])};
        pw[2] = (u32x4){pk_h2(p1[0], p1[1]), pk_h2(p1[2], p1[3]), pk_h2(p1[4], p1[5]), pk_h2(p1[6], p1[7])};
        pw[3] = (u32x4){pk_h2(p1[8], p1[9]), pk_h2(p1[10], p1[11]), pk_h2(p1[12], p1[13]), pk_h2(p1[14], p1[15])};
#pragma unroll
        for (int ks = 0; ks < 4; ++ks) {
            const h16x8 pa = __builtin_bit_cast(h16x8, pw[ks]);
#pragma unroll
            for (int d0 = 0; d0 < 2; ++d0) {
                const s16x4 lo = __builtin_amdgcn_ds_read_tr16_b64_v4i16((LAS s16x4*)(Vb + vp0 + d0 * 4096 + ks * 1024));
                const s16x4 hh = __builtin_amdgcn_ds_read_tr16_b64_v4i16((LAS s16x4*)(Vb + vp0 + d0 * 4096 + ks * 1024 + 512));
                typedef short s16x8 __attribute__((ext_vector_type(8)));
                const s16x8 vv = {lo[0], lo[1], lo[2], lo[3], hh[0], hh[1], hh[2], hh[3]};
                const h16x8 vf = __builtin_bit_cast(h16x8, vv);
                if (d0 == 0) o0 = __builtin_amdgcn_mfma_f32_32x32x16_f16(pa, vf, o0, 0, 0, 0);
                else         o1 = __builtin_amdgcn_mfma_f32_32x32x16_f16(pa, vf, o1, 0, 0, 0);
            }
        }
        if (j + 1 < NT) { *(LAS u32x4*)(lds + (buf ^ 1) * 8192 + kdst) = kreg; *(LAS u32x4*)(lds + 16384 + (buf ^ 1) * 8192 + vdst) = vreg; }
        __syncthreads();
    }
    l_run += __shfl_xor(l_run, 32);
    if (hi == 0) wsf[32 + r32] = l_run;
    LDS_WAIT();
    h16* op = Orow0 + (size_t)(D.q0 + (wave & 1) * 32) * 512 + head * 64 + r32;
#pragma unroll
    for (int r = 0; r < 16; ++r) { const int q = (r & 3) + 8 * (r >> 2) + 4 * hi; const float rl = fast_rcp(wsf[32 + q]);
        op[(size_t)q * 512] = (h16)(o0[r] * rl); op[(size_t)q * 512 + 32] = (h16)(o1[r] * rl); }
}
__device__ __forceinline__ void attn_dispatch(Frame& F, int l, int type, int u) {
    const h16* Z = (const h16*)(F.ws + WS_ZU);
    const h16* cache = (const h16*)(F.ws + WS_CACHE);
    AttnDesc D; D.sink = nullptr; D.windowed = 0; D.Kc = nullptr; D.Vc = nullptr; D.nc = 0;
    const bool isC = type & 1;
    const int qcol = isC ? C_QC : C_QB, kcol = isC ? C_KC : C_KB, vcol = isC ? C_VC : C_VB;
    h16* Obase = (h16*)(F.ws + WS_ZU + (isC ? ZU_OC : ZU_OB));
    size_t row_seq0;
    if (type < 2) {
        const int b = u >> 7, kvh = (u >> 6) & 1, qb = u & 63;
        row_seq0 = (size_t)NCTX + (size_t)b * LSEQ; D.kvh = kvh; D.q0 = qb * 64;
        D.Kc = cache + ((size_t)(isC ? 2 : 0) * 131072) + (size_t)((b * 2 + l) * 256) * 128 + kvh * 64;
        D.Vc = cache + ((size_t)(isC ? 3 : 1) * 131072) + (size_t)((b * 2 + l) * 256) * 128 + kvh * 64;
        D.nc = 4;
        if (!isC) { D.zt0 = 0; D.nz = 64; }
        else { int lo = qb - 2; if (lo < 0) lo = 0; int hi_ = qb + 2; if (hi_ > 63) hi_ = 63; D.zt0 = lo; D.nz = hi_ - lo + 1; D.windowed = 1; }
    } else {
        const int b = u >> 3, kvh = (u >> 2) & 1, qb = u & 3;
        row_seq0 = (size_t)b * SEQ; D.kvh = kvh; D.q0 = qb * 64; D.zt0 = 0; D.nz = 4;
    }
    if (isC) D.sink = F.in[I_SINK] + l * 8;
    D.Kz = Z + row_seq0 * NMAIN + kcol + D.kvh * 64; D.Vz = Z + row_seq0 * NMAIN + vcol + D.kvh * 64;
    attn_unit(F, D, Z + row_seq0 * NMAIN + qcol, Obase + row_seq0 * 512);
}

__device__ __forceinline__ void phase_ffn_act(Frame& F, int l) {
    h16* U = (h16*)(F.ws + WS_ZU);
    const int gt = F.vcu * NTHREADS + F.tid, NGT = F.G * NTHREADS;
    constexpr int NCC = DFF / 8, NRUN = NTOK / 64;
    for (int it = gt; it < NCC * NRUN; it += NGT) {
        const int cc = it % NCC, run = it / NCC; const int c0 = cc * 8, r0 = run * 64;
        const bool first = (r0 < NCTX) ? ((r0 & 255) == 0) : (((r0 - NCTX) & (LSEQ - 1)) == 0);
        const bool last = (r0 < NCTX) ? (((r0 + 64) & 255) == 0) : ((((r0 + 64) - NCTX) & (LSEQ - 1)) == 0);
        float w0[8], w1[8], w2[8], bb[8];
        const float* cw = F.in[I_FCW] + (size_t)l * 3 * DFF + c0; const float* cb = F.in[I_FCB] + (size_t)l * DFF + c0;
#pragma unroll
        for (int j = 0; j < 8; ++j) { w0[j] = cw[j]; w1[j] = cw[DFF + j]; w2[j] = cw[2 * DFF + j]; bb[j] = cb[j]; }
        float gp[8], gc[8], gn[8];
        if (first) {
#pragma unroll
            for (int j = 0; j < 8; ++j) gp[j] = 0.f; } else unpack8(*(const u32x4*)(U + (size_t)(r0 - 1) * DUP + c0), gp);
        unpack8(*(const u32x4*)(U + (size_t)r0 * DUP + c0), gc);
#pragma unroll 4
        for (int i = 0; i < 64; ++i) {
            const int r = r0 + i;
            if (i == 63 && last) {
#pragma unroll
                for (int j = 0; j < 8; ++j) gn[j] = 0.f; } else unpack8(*(const u32x4*)(U + (size_t)(r + 1) * DUP + c0), gn);
            float v[8]; unpack8(*(const u32x4*)(U + (size_t)r * DUP + DFF + c0), v);
            float o[8];
#pragma unroll
            for (int j = 0; j < 8; ++j) { const float g = bb[j] + w0[j] * gp[j] + w1[j] * gc[j] + w2[j] * gn[j]; o[j] = gelu_tanh(g) * v[j]; gp[j] = gc[j]; gc[j] = gn[j]; }
            *(u32x4*)(U + (size_t)r * DUP + DFF + c0) = pack8(o);
        }
    }
}

constexpr int N_PHASES = 25;
__global__ void __launch_bounds__(NTHREADS, 2) fwd_kernel(Args args) {
    extern __shared__ __attribute__((aligned(16))) unsigned char lds_raw[];
    Frame F;
    F.lds = (LAS unsigned char*)lds_raw;
    F.tid = threadIdx.x; F.lane = F.tid & 63; F.wave = __builtin_amdgcn_readfirstlane(F.tid >> 6);
    F.G = gridDim.x; { const int bx = blockIdx.x; F.vcu = (F.G % 8 == 0) ? (bx % 8) * (F.G / 8) + bx / 8 : bx; }
    F.out0 = args.out; F.ws0 = args.ws; F.refresh();
    volatile LAS unsigned* MISC = (volatile LAS unsigned*)(F.lds + MISC_OFF);
    for (int u = F.tid; u < (LDS_BYTES - LDSCTL_OFF) / 4; u += NTHREADS) ((LAS unsigned*)(F.lds + LDSCTL_OFF))[u] = 0u;
    __syncthreads();
#if !MK_PER_PHASE
    XcdBarrier bar = xcd_barrier_post((unsigned*)(F.ws + WS_CTL) + CW_BAR, MISC + 8);
#define GRID_BAR() xcd_barrier(bar)
#else
    (void)MISC;
#define GRID_BAR() do { } while (0)
#endif
    const int lo = args.ph_lo, hi_ph = args.ph_hi;
#define IN(k) (lo <= (k) && (k) < hi_ph)
#define SEAM(k) do { if (IN((k) + 1)) GRID_BAR(); } while (0)
#pragma unroll
    for (int l = 0; l < DEPTH; ++l) {
        const int pb = 12 * l;
        if (IN(pb + 0)) { F.refresh(); phase_convert_weights(F, l); if (l == 0) phase_prep_misc(F); SEAM(pb + 0); }
        if (IN(pb + 1)) { F.refresh(); phase_norm_mod(F, l == 0, F.in[I_N1G] + l * DM, (const float*)(F.ws + WS_MOD) + (size_t)l * 3 * 6144, 0); SEAM(pb + 1); }
        if (IN(pb + 2)) { F.refresh();
            pg8::Gemm g{(const h16*)(F.ws + WS_H), (const h16*)(F.ws + WS_W + W_IN), NTOK, NMAIN, DM, DM}; pg8::StaticOrder S; S.init(NTOK, NMAIN, F.G, (int)blockIdx.x);
            pg8::EpiF16<0> E{(h16*)(F.ws + WS_ZU), NMAIN};
            pg8::gemm_phase<pg8::EpiF16<0>, pg8::StaticOrder, true, true>(F.lds, g, S, E);
            SEAM(pb + 2); }
        if (IN(pb + 3)) { F.refresh();
            phase_qk(F, l);
            for (int u = F.vcu; u < 512; u += F.G) {
                if (u < 256) lru_unit<0>(F, l, (u >> 3) * 256, u & 7, 1, 1, 0, 0, u >> 3);
                else { const int v = u - 256, b = v >> 7, ch = (v >> 3) & 15; lru_unit<1>(F, l, NCTX + b * LSEQ + ch * 256, v & 7, ch == 0, ch == 15, b, ch, 0); }
            }
            SEAM(pb + 3); }
        if (IN(pb + 4)) { F.refresh();
            for (int type = 0; type < 4; ++type) for (int u = F.vcu; u < 256; u += F.G) attn_dispatch(F, l, type, u);
            for (int v = F.vcu; v < 256; v += F.G) { const int b = v >> 7, ch = (v >> 3) & 15; lru_unit<2>(F, l, NCTX + b * LSEQ + ch * 256, v & 7, ch == 0, ch == 15, b, ch, 0); }
            SEAM(pb + 4); }
        if (IN(pb + 5)) { F.refresh();
            pg8::Gemm g{(const h16*)(F.ws + WS_H), (const h16*)(F.ws + WS_W + W_IN) + (size_t)NMAIN * DM, NTOK, NGATE, DM, DM}; pg8::StaticOrder S; S.init(NTOK, NGATE, F.G, (int)blockIdx.x);
            pg8::EpiF16<1> E{(h16*)(F.ws + WS_ZU), NGATE};
            pg8::gemm_phase<pg8::EpiF16<1>, pg8::StaticOrder, true, true>(F.lds, g, S, E);
            SEAM(pb + 5); }
        if (IN(pb + 6)) { F.refresh();
            pg8::StaticOrder S; S.init(NTOK, DM, F.G, (int)blockIdx.x);
            h16* Hb = (h16*)(F.ws + WS_H); const h16* Gb = (const h16*)(F.ws + WS_ZU);
            { pg8::Gemm g{(const h16*)(F.ws + WS_ZU + ZU_OA), (const h16*)(F.ws + WS_W + W_OA), NTOK, DM, 1024, 1024}; pg8::EpiGateMul<0> E{Hb, Gb, 0};
              pg8::gemm_phase<pg8::EpiGateMul<0>, pg8::StaticOrder, true, true>(F.lds, g, S, E); }
            { pg8::Gemm g{(const h16*)(F.ws + WS_ZU + ZU_OB), (const h16*)(F.ws + WS_W + W_OB), NTOK, DM, 512, 512}; pg8::EpiGateMul<1> E{Hb, Gb, 1024};
              pg8::gemm_phase<pg8::EpiGateMul<1>, pg8::StaticOrder, true, true>(F.lds, g, S, E); }
            { pg8::Gemm g{(const h16*)(F.ws + WS_ZU + ZU_OC), (const h16*)(F.ws + WS_W + W_OC), NTOK, DM, 512, 512}; pg8::EpiGateMul<1> E{Hb, Gb, 2048};
              pg8::gemm_phase<pg8::EpiGateMul<1>, pg8::StaticOrder, true, true>(F.lds, g, S, E); }
            SEAM(pb + 6); }
        if (IN(pb + 7)) { F.refresh();
            pg8::Gemm g{(const h16*)(F.ws + WS_H), (const h16*)(F.ws + WS_W + W_OUT), NTOK, DM, DM, DM}; pg8::StaticOrder S; S.init(NTOK, DM, F.G, (int)blockIdx.x);
            pg8::EpiRes E{l == 0 ? F.in[I_XP] : F.out + O_Y, l == 0 ? F.in[I_XS] : F.out + O_Y + (size_t)NCTX * DM, F.out + O_Y, (const float*)(F.ws + WS_MOD) + (size_t)l * 3 * 6144 + 2 * 1024};
            pg8::gemm_phase<pg8::EpiRes, pg8::StaticOrder, true, true>(F.lds, g, S, E);
            SEAM(pb + 7); }
        if (IN(pb + 8)) { F.refresh(); phase_norm_mod(F, 0, F.in[I_N2G] + l * DM, (const float*)(F.ws + WS_MOD) + (size_t)l * 3 * 6144, 3); SEAM(pb + 8); }
        if (IN(pb + 9)) { F.refresh();
            pg8::Gemm g{(const h16*)(F.ws + WS_H), (const h16*)(F.ws + WS_W + W_UP), NTOK, DUP, DM, DM}; pg8::StaticOrder S; S.init(NTOK, DUP, F.G, (int)blockIdx.x);
            pg8::EpiF16<0> E{(h16*)(F.ws + WS_ZU), DUP};
            pg8::gemm_phase<pg8::EpiF16<0>, pg8::StaticOrder, true, true>(F.lds, g, S, E);
            SEAM(pb + 9); }
        if (IN(pb + 10)) { F.refresh(); phase_ffn_act(F, l); SEAM(pb + 10); }
        if (IN(pb + 11)) { F.refresh();
            pg8::Gemm g{(const h16*)(F.ws + WS_ZU) + DFF, (const h16*)(F.ws + WS_W + W_DOWN), NTOK, DM, DFF, DUP}; pg8::StaticOrder S; S.init(NTOK, DM, F.G, (int)blockIdx.x);
            pg8::EpiRes E{F.out + O_Y, F.out + O_Y + (size_t)NCTX * DM, F.out + O_Y, (const float*)(F.ws + WS_MOD) + (size_t)l * 3 * 6144 + 5 * 1024};
            pg8::gemm_phase<pg8::EpiRes, pg8::StaticOrder, true, true>(F.lds, g, S, E);
            SEAM(pb + 11); }
    }
    if (IN(24)) { F.refresh(); phase_final_norm(F); }
#undef IN
#undef SEAM
}

extern "C" void kernel_launch(void* const* d_in, const int* in_sizes, int n_in, void* d_out, int out_size, void* d_ws, size_t ws_size, hipStream_t stream) {
    static int grid = 0;
    if (grid == 0) {
        if (n_in != 33 || out_size != (int)O_END || ws_size < WS_END) { fprintf(stderr, "kernel_launch: unexpected shapes: n_in %d out %d ws %zu (need %zu)\n", n_in, out_size, ws_size, (size_t)WS_END); grid = -1; return; }
        int dev = 0, cus = 0;
        if (hipGetDevice(&dev) != hipSuccess || hipDeviceGetAttribute(&cus, hipDeviceAttributeMultiprocessorCount, dev) != hipSuccess) { grid = -1; return; }
        if (hipFuncSetAttribute((const void*)fwd_kernel, hipFuncAttributeMaxDynamicSharedMemorySize, LDS_BYTES) != hipSuccess) { fprintf(stderr, "kernel_launch: hipFuncSetAttribute failed\n"); grid = -1; return; }
        (void)hipGetLastError();
        grid = cus;
    }
    if (grid < 0) return;
    (void)hipMemsetAsync((char*)d_ws + WS_CTL, 0, CTL_ZERO_BYTES, stream);
    Args a{};
    for (int i = 0; i < 33; ++i) a.in[i] = (const float*)d_in[i];
    a.out = (float*)d_out; a.ws = (unsigned char*)d_ws;
#if MK_PER_PHASE
    for (int ph = 0; ph < N_PHASES; ++ph) { a.ph_lo = ph; a.ph_hi = ph + 1; hipLaunchKernelGGL(fwd_kernel, dim3(grid), dim3(NTHREADS), LDS_BYTES, stream, a); }
#else
    a.ph_lo = 0; a.ph_hi = N_PHASES;
    hipLaunchKernelGGL(fwd_kernel, dim3(grid), dim3(NTHREADS), LDS_BYTES, stream, a);
#endif
}
```

```cpp
#include <hip/hip_runtime.h>
#include <cstdio>
#include <cstdint>
#include <cmath>

#ifndef MK_PER_PHASE
#define MK_PER_PHASE 0
#endif

#define LAS __attribute__((address_space(3)))
#define GAS __attribute__((address_space(1)))
typedef _Float16 h16;
typedef _Float16 h16x8 __attribute__((ext_vector_type(8)));
typedef _Float16 h16x4 __attribute__((ext_vector_type(4)));
typedef _Float16 h16x2 __attribute__((ext_vector_type(2)));
typedef short s16x4 __attribute__((ext_vector_type(4)));
typedef float f32x2 __attribute__((ext_vector_type(2)));
typedef float f32x4 __attribute__((ext_vector_type(4)));
typedef float f32x16 __attribute__((ext_vector_type(16)));
typedef unsigned u32x2 __attribute__((ext_vector_type(2)));
typedef unsigned u32x4 __attribute__((ext_vector_type(4)));

constexpr int DM = 1024, NTOK = 16384, NCTX = 8192, SEQ = 256, LSEQ = 4096, NB_CTX = 32, NB_LAT = 2, DEPTH = 2;
constexpr int DIN = 6656, NMAIN = 3584, NGATE = 3072, DFF = 2816, DUP = 5632, DLRU = 1024;
constexpr int C_XA = 0, C_YA = 1024, C_QB = 2048, C_KB = 2560, C_VB = 2688, C_QC = 2816, C_KC = 3328, C_VC = 3456;
constexpr float NORM_EPS = 1e-6f;
constexpr float LOG2E = 1.4426950408889634f;
constexpr float QSCALE = 0.125f * LOG2E;
constexpr size_t O_Y = 0, O_KB = 16777216, O_VB = 18874368, O_KC = 20971520, O_VC = 23068672, O_LRU = 25165824, O_END = 25296896;
constexpr size_t MiB = 1u << 20;
constexpr size_t WS_CTL = 0, CTL_ZERO_BYTES = 64 * 1024;
constexpr size_t WS_MOD = 1 * MiB;
constexpr size_t WS_ROPE = 1 * MiB + 256 * 1024;
constexpr size_t WS_AGG = 1 * MiB + 320 * 1024;
constexpr size_t WS_CACHE = 2 * MiB;
constexpr size_t WS_W = 3 * MiB;
constexpr size_t W_IN = 0, W_OA = W_IN + (size_t)DIN * DM * 2, W_OB = W_OA + (size_t)DM * 1024 * 2, W_OC = W_OB + (size_t)DM * 512 * 2,
                 W_OUT = W_OC + (size_t)DM * 512 * 2, W_UP = W_OUT + (size_t)DM * DM * 2, W_DOWN = W_UP + (size_t)DUP * DM * 2,
                 W_LRU = W_DOWN + (size_t)DM * DFF * 2, W_END = W_LRU + (size_t)2 * 2 * 8 * 128 * 128 * 2;
static_assert(W_END <= 37 * MiB, "weights region");
constexpr size_t WS_H = 40 * MiB;
constexpr size_t WS_ZU = 72 * MiB;
constexpr size_t ZU_OA = (size_t)NTOK * NMAIN * 2, ZU_OB = ZU_OA + (size_t)NTOK * 1024 * 2, ZU_OC = ZU_OB + (size_t)NTOK * 512 * 2;
constexpr size_t WS_END = WS_ZU + (size_t)NTOK * DUP * 2;
static_assert(WS_END == 248 * MiB, "ws map");

__device__ __forceinline__ unsigned pk_h2(float lo, float hi) { f32x2 v = {lo, hi}; h16x2 h = __builtin_convertvector(v, h16x2); return __builtin_bit_cast(unsigned, h); }
__device__ __forceinline__ void unpack8(u32x4 w, float* x) { h16x8 h = __builtin_bit_cast(h16x8, w);
#pragma unroll
    for (int j = 0; j < 8; ++j) x[j] = (float)h[j]; }
__device__ __forceinline__ u32x4 pack8(const float* x) { u32x4 w; w.x = pk_h2(x[0], x[1]); w.y = pk_h2(x[2], x[3]); w.z = pk_h2(x[4], x[5]); w.w = pk_h2(x[6], x[7]); return w; }
__device__ __forceinline__ float fast_exp2(float x) { return __builtin_amdgcn_exp2f(x); }
__device__ __forceinline__ float fast_rcp(float x) { return __builtin_amdgcn_rcpf(x); }
__device__ __forceinline__ float sigmoidf_(float x) { return fast_rcp(1.0f + fast_exp2(-LOG2E * x)); }
__device__ __forceinline__ float gelu_tanh(float x) { const float t = x + 0.044715f * x * x * x; return x * fast_rcp(1.0f + fast_exp2(-2.0f * 0.7978845608028654f * LOG2E * t)); }
__device__ __forceinline__ float wave_sum(float v) {
#pragma unroll
    for (int o = 1; o < 64; o <<= 1) v += __shfl_xor(v, o);
    return v;
}

namespace pg8 {
constexpr int BM = 256, BK = 64, HALF = 128, HTB = HALF * BK * 2, STAGE_BYTES = 8 * HTB, NXCD = 8, WGM = 8;
__host__ __device__ __forceinline__ int lds_byte(int r, int c) { const int st = (r >> 4) * 2 + (c >> 5), rr = r & 15, cc = c & 31, ob = rr * 64 + cc * 2; return st * 1024 + (ob ^ (((ob >> 9) & 1) << 5)); }
__host__ __device__ __forceinline__ void stage_rc(int b, int& R, int& C) { const int st = b / 1024, sb = b % 1024, swz = sb ^ (((sb >> 9) & 1) << 5); R = (st >> 1) * 16 + swz / 64; C = (st & 1) * 32 + (swz % 64) / 2; }
__host__ __device__ __forceinline__ int perm32(int rho) { const int n = rho >> 4, i = rho & 15; return 8 * (i >> 2) + 4 * n + (i & 3); }
struct Unit { int pm, pn; };
struct Gemm { const h16* A; const h16* Bt; int M, N, K, lda; };
struct StaticOrder {
    int nM, nN, nwg, G, c;
    __host__ __device__ void init(int M, int N, int G_, int c_) { nM = M / BM; nN = N / BM; nwg = nM * nN; G = G_; c = c_; }
    __host__ __device__ bool next(int i, Unit& u) const {
        const long L = (long)i * G + c; if (L >= nwg) return false;
        int wgid = (int)L; { const int q = nwg / NXCD, r = nwg % NXCD, xcd = wgid % NXCD, off = wgid / NXCD; wgid = (xcd < r ? xcd * (q + 1) : r * (q + 1) + (xcd - r) * q) + off; }
        const int nig = WGM * nN, gid = wgid / nig, fm = gid * WGM, gsz = (nM - fm) < WGM ? (nM - fm) : WGM;
        u.pm = fm + ((wgid % nig) % gsz); u.pn = (wgid % nig) / gsz; return true;
    }
    __device__ __forceinline__ void a_ready(const Unit&) const {}
    __device__ __forceinline__ void done(const Unit&) const {}
};

template <int ACT> struct EpiF16 {
    static constexpr bool PERM = true, AFTER_DRAIN = false;
    h16* O; int ldc;
    __device__ __forceinline__ void operator()(const f32x4 (&acc)[2][2][4][2], const Unit& u, int wr, int wc, int fr, int fq) const {
        const int row0 = u.pm * BM + wr * 64 + fr, col0 = u.pn * BM + wc * 32 + 8 * fq;
#pragma unroll
        for (int ai = 0; ai < 2; ++ai)
#pragma unroll
            for (int m = 0; m < 4; ++m) { h16* rowp = O + (size_t)(row0 + ai * HALF + m * 16) * ldc + col0;
#pragma unroll
                for (int bj = 0; bj < 2; ++bj) { f32x4 v0 = acc[ai][bj][m][0], v1 = acc[ai][bj][m][1];
                    if (ACT == 1) {
#pragma unroll
                        for (int j = 0; j < 4; ++j) { v0[j] = sigmoidf_(v0[j]); v1[j] = sigmoidf_(v1[j]); } }
                    u32x4 w; w.x = pk_h2(v0[0], v0[1]); w.y = pk_h2(v0[2], v0[3]); w.z = pk_h2(v1[0], v1[1]); w.w = pk_h2(v1[2], v1[3]);
                    *(u32x4*)(rowp + bj * HALF) = w; } }
    }
};
template <int ACCUM> struct EpiGateMul {
    static constexpr bool PERM = true, AFTER_DRAIN = false;
    h16* Mg; const h16* G; int gcol0;
    __device__ __forceinline__ void operator()(const f32x4 (&acc)[2][2][4][2], const Unit& u, int wr, int wc, int fr, int fq) const {
        const int row0 = u.pm * BM + wr * 64 + fr, col0 = u.pn * BM + wc * 32 + 8 * fq;
#pragma unroll
        for (int ai = 0; ai < 2; ++ai)
#pragma unroll
            for (int m = 0; m < 4; ++m) { const size_t row = (size_t)(row0 + ai * HALF + m * 16);
#pragma unroll
                for (int bj = 0; bj < 2; ++bj) {
                    const u32x4 gw = *(const u32x4*)(G + row * NGATE + gcol0 + col0 + bj * HALF);
                    float g[8]; unpack8(gw, g);
                    float o[8];
                    if (ACCUM) { const u32x4 mw = *(const u32x4*)(Mg + row * DM + col0 + bj * HALF); unpack8(mw, o); }
                    else {
#pragma unroll
                        for (int j = 0; j < 8; ++j) o[j] = 0.f; }
                    const f32x4 v0 = acc[ai][bj][m][0], v1 = acc[ai][bj][m][1];
#pragma unroll
                    for (int j = 0; j < 4; ++j) { o[j] += g[j] * v0[j]; o[4 + j] += g[4 + j] * v1[j]; }
                    *(u32x4*)(Mg + row * DM + col0 + bj * HALF) = pack8(o); }
                asm volatile("" ::: "memory"); }
    }
};
struct EpiRes {
    static constexpr bool PERM = false, AFTER_DRAIN = false;
    const float* base_ctx; const float* base_lat; float* X; const float* gate;
    __device__ __forceinline__ void operator()(const f32x4 (&acc)[2][2][4][2], const Unit& u, int wr, int wc, int fr, int fq) const {
        const int cond = u.pm < 32 ? 0 : (u.pm < 48 ? 1 : 2);
        const float* gp = gate + (size_t)cond * 6144;
        const float* bp = u.pm < 32 ? base_ctx + (size_t)u.pm * BM * DM : base_lat + (size_t)(u.pm - 32) * BM * DM;
        float* xp = X + (size_t)u.pm * BM * DM;
        const int r0 = wr * 64 + fr, col0 = u.pn * BM + wc * 32 + 4 * fq;
#pragma unroll
        for (int ai = 0; ai < 2; ++ai)
#pragma unroll
            for (int m = 0; m < 4; ++m) { const size_t off = (size_t)(r0 + ai * HALF + m * 16) * DM + col0;
#pragma unroll
                for (int bj = 0; bj < 2; ++bj)
#pragma unroll
                    for (int n = 0; n < 2; ++n) { const f32x4 b = *(const f32x4*)(bp + off + bj * HALF + n * 16); const f32x4 gvv = *(const f32x4*)(gp + col0 + bj * HALF + n * 16);
                        *(f32x4*)(xp + off + bj * HALF + n * 16) = b + gvv * acc[ai][bj][m][n]; }
                asm volatile("" ::: "memory"); }
    }
};

template <class Epi, class Sched, bool ALIGN_EPI = false, bool SP2 = false>
__device__ __forceinline__ void gemm_phase(LAS unsigned char* lds, const Gemm g, const Sched& S, const Epi& E) {
    int tid_ = threadIdx.x; asm volatile("" : "+v"(tid_));
    const int tid = tid_, wid = __builtin_amdgcn_readfirstlane(tid >> 6), lane = tid & 63, wr = wid >> 2, wc = wid & 3, fr = lane & 15, fq = lane >> 4;
    const int K = g.K, nt = K / BK, lda = g.lda;
    unsigned voffA[2], voffB[2];
#pragma unroll
    for (int i = 0; i < 2; ++i) { int R, C; stage_rc(tid * 16 + i * 8192, R, C); const int Rb = Epi::PERM ? ((R & ~31) + perm32(R & 31)) : R;
        voffA[i] = (unsigned)(R * lda + C) * 2u; voffB[i] = (unsigned)(Rb * K + C) * 2u; }
    const size_t kstep = (size_t)(BK * 2);
    const size_t hstepA = (size_t)HALF * lda * 2, hstepB = (size_t)HALF * K * 2;
    const size_t tstepA = 2 * hstepA, tstepB = 2 * hstepB;
    const unsigned ldsw = (unsigned)wid * 1024u;
    const int aoff = lds_byte(wr * 64 + fr, fq * 8), boff = lds_byte(wc * 32 + fr, fq * 8);
#define PG8_SA(b, h) (((b) * 2 + (h)) * HTB)
#define PG8_SB(b, h) ((4 + (b) * 2 + (h)) * HTB)
#define PG8_STAGE(bufoff, gbase, voff) do { _Pragma("unroll") for (int _i = 0; _i < 2; ++_i) \
        __builtin_amdgcn_global_load_lds((const unsigned*)((const char*)(gbase) + (voff)[_i]), (LAS unsigned*)(lds + (bufoff) + ldsw + _i * 8192), 16, 0, 0); } while (0)
#define PG8_LDA(dst, b, h) do { _Pragma("unroll") for (int m = 0; m < 4; ++m) _Pragma("unroll") for (int k = 0; k < 2; ++k) dst[m][k] = *(const LAS h16x8*)(lds + PG8_SA(b, h) + aoff + m * 2048 + k * 1024); } while (0)
#define PG8_LDB(dst, b, h) do { _Pragma("unroll") for (int n = 0; n < 2; ++n) _Pragma("unroll") for (int k = 0; k < 2; ++k) dst[n][k] = *(const LAS h16x8*)(lds + PG8_SB(b, h) + boff + n * 2048 + k * 1024); } while (0)
#define PG8_MMA(ai, bj, At, Bt) do { __builtin_amdgcn_s_setprio(1); _Pragma("unroll") for (int m = 0; m < 4; ++m) _Pragma("unroll") for (int n = 0; n < 2; ++n) _Pragma("unroll") for (int k = 0; k < 2; ++k) \
        acc[ai][bj][m][n] = __builtin_amdgcn_mfma_f32_16x16x32_f16(Bt[n][k], At[m][k], acc[ai][bj][m][n], 0, 0, 0); __builtin_amdgcn_s_setprio(0); } while (0)
#define PG8_WAIT_V(n) asm volatile("s_waitcnt vmcnt(" #n ")" ::: "memory")
#define PG8_WAIT_L(n) asm volatile("s_waitcnt lgkmcnt(" #n ")" ::: "memory")
#define PG8_BAR __builtin_amdgcn_s_barrier()
#define PG8_SCHED __builtin_amdgcn_sched_barrier(0)
    Unit cur, nxt; int ui = 0;
    if (!S.next(0, cur)) return;
    f32x4 acc[2][2][4][2];
#pragma unroll
    for (int a = 0; a < 2; ++a)
#pragma unroll
        for (int b = 0; b < 2; ++b)
#pragma unroll
            for (int m = 0; m < 4; ++m)
#pragma unroll
                for (int n = 0; n < 2; ++n) acc[a][b][m][n] = (f32x4){0.f, 0.f, 0.f, 0.f};
    h16x8 At[4][2], B0[2][2], B1[2][2];
    const char* cA = (const char*)g.A + (size_t)cur.pm * tstepA; const char* cB = (const char*)g.Bt + (size_t)cur.pn * tstepB;
    S.a_ready(cur);
    if constexpr (SP2) {
        PG8_STAGE(PG8_SB(0, 0), cB, voffB); PG8_STAGE(PG8_SB(0, 1), cB + hstepB, voffB); PG8_STAGE(PG8_SA(0, 0), cA, voffA); PG8_STAGE(PG8_SA(0, 1), cA + hstepA, voffA);
        if (wr == 1) PG8_BAR;
        PG8_WAIT_V(2); PG8_BAR;
        PG8_STAGE(PG8_SB(1, 0), cB + kstep, voffB); PG8_STAGE(PG8_SA(1, 0), cA + kstep, voffA); PG8_STAGE(PG8_SB(1, 1), cB + hstepB + kstep, voffB);
        PG8_WAIT_V(6); PG8_BAR;
    } else {
        PG8_STAGE(PG8_SB(0, 0), cB, voffB); PG8_STAGE(PG8_SA(0, 0), cA, voffA); PG8_STAGE(PG8_SB(0, 1), cB + hstepB, voffB); PG8_STAGE(PG8_SA(0, 1), cA + hstepA, voffA);
        if (wr == 1) PG8_BAR;
        PG8_WAIT_V(4); PG8_BAR;
        PG8_STAGE(PG8_SB(1, 0), cB + kstep, voffB); PG8_STAGE(PG8_SA(1, 0), cA + kstep, voffA); PG8_STAGE(PG8_SB(1, 1), cB + hstepB + kstep, voffB);
        PG8_WAIT_V(6); PG8_BAR;
    }
    for (;;) {
        const bool has_next = S.next(ui + 1, nxt);
        const char* nA = has_next ? (const char*)g.A + (size_t)nxt.pm * tstepA : cA; const char* nB = has_next ? (const char*)g.Bt + (size_t)nxt.pn * tstepB : cB;
        for (int t = 0; t < nt; t += 2) {
            const bool last = (t == nt - 2);
            const char* a1 = cA + (size_t)(t + 1) * kstep;
            const char* a2 = last ? nA : cA + (size_t)(t + 2) * kstep; const char* b2 = last ? nB : cB + (size_t)(t + 2) * kstep;
            const char* a3 = a2 + kstep; const char* b3 = b2 + kstep;
            if (last && has_next) S.a_ready(nxt);
            if constexpr (SP2) {
            PG8_LDB(B0, 0, 0); PG8_LDB(B1, 0, 1); PG8_SCHED; PG8_LDA(At, 0, 0); PG8_STAGE(PG8_SA(1, 1), a1 + hstepA, voffA);
            PG8_WAIT_V(8); PG8_WAIT_L(0); PG8_BAR; PG8_MMA(0, 0, At, B0); PG8_MMA(0, 1, At, B1); PG8_BAR; PG8_SCHED;
            PG8_LDA(At, 0, 1); PG8_STAGE(PG8_SB(0, 0), b2, voffB); PG8_STAGE(PG8_SB(0, 1), b2 + hstepB, voffB); PG8_STAGE(PG8_SA(0, 0), a2, voffA);
            PG8_WAIT_V(8); PG8_WAIT_L(0); PG8_BAR; PG8_MMA(1, 0, At, B0); PG8_MMA(1, 1, At, B1); PG8_BAR; PG8_SCHED;
            PG8_LDB(B0, 1, 0); PG8_LDB(B1, 1, 1); PG8_SCHED; PG8_LDA(At, 1, 0); PG8_STAGE(PG8_SA(0, 1), a2 + hstepA, voffA);
            PG8_WAIT_V(8); PG8_WAIT_L(0); PG8_BAR; PG8_MMA(0, 0, At, B0); PG8_MMA(0, 1, At, B1); PG8_BAR; PG8_SCHED;
            PG8_LDA(At, 1, 1); PG8_STAGE(PG8_SB(1, 0), b3, voffB); PG8_STAGE(PG8_SB(1, 1), b3 + hstepB, voffB); PG8_STAGE(PG8_SA(1, 0), a3, voffA);
            PG8_WAIT_V(8); PG8_WAIT_L(0); PG8_BAR; PG8_MMA(1, 0, At, B0); PG8_MMA(1, 1, At, B1); PG8_BAR; PG8_SCHED;
            } else {
            PG8_LDB(B0, 0, 0); PG8_SCHED; PG8_LDA(At, 0, 0); PG8_STAGE(PG8_SA(1, 1), a1 + hstepA, voffA);
            PG8_WAIT_L(8); PG8_BAR; PG8_WAIT_L(0); PG8_MMA(0, 0, At, B0); PG8_BAR; PG8_SCHED;
            PG8_LDB(B1, 0, 1); PG8_STAGE(PG8_SB(0, 0), b2, voffB);
            PG8_BAR; PG8_WAIT_L(0); PG8_MMA(0, 1, At, B1); PG8_BAR;
            PG8_LDA(At, 0, 1); PG8_STAGE(PG8_SA(0, 0), a2, voffA);
            PG8_BAR; PG8_WAIT_L(0); PG8_MMA(1, 0, At, B0); PG8_BAR; PG8_SCHED;
            PG8_STAGE(PG8_SB(0, 1), b2 + hstepB, voffB);
            PG8_WAIT_V(6); PG8_BAR; PG8_MMA(1, 1, At, B1); PG8_BAR;
            PG8_LDB(B0, 1, 0); PG8_SCHED; PG8_LDA(At, 1, 0); PG8_STAGE(PG8_SA(0, 1), a2 + hstepA, voffA);
            PG8_WAIT_L(8); PG8_BAR; PG8_WAIT_L(0); PG8_MMA(0, 0, At, B0); PG8_BAR; PG8_SCHED;
            PG8_LDB(B1, 1, 1); PG8_STAGE(PG8_SB(1, 0), b3, voffB);
            PG8_BAR; PG8_WAIT_L(0); PG8_MMA(0, 1, At, B1); PG8_BAR;
            PG8_LDA(At, 1, 1); PG8_STAGE(PG8_SA(1, 0), a3, voffA);
            PG8_BAR; PG8_WAIT_L(0); PG8_MMA(1, 0, At, B0); PG8_BAR; PG8_SCHED;
            PG8_STAGE(PG8_SB(1, 1), b3 + hstepB, voffB);
            PG8_WAIT_V(6); PG8_BAR; PG8_MMA(1, 1, At, B1); PG8_BAR;
            }
        }
        if constexpr (ALIGN_EPI) { if (wr == 0) PG8_BAR; }
        if constexpr (!Epi::AFTER_DRAIN) { E(acc, cur, wr, wc, fr, fq); S.done(cur); }
        if (!has_next) break;
#pragma unroll
        for (int a = 0; a < 2; ++a)
#pragma unroll
            for (int b = 0; b < 2; ++b)
#pragma unroll
                for (int m = 0; m < 4; ++m)
#pragma unroll
                    for (int n = 0; n < 2; ++n) acc[a][b][m][n] = (f32x4){0.f, 0.f, 0.f, 0.f};
        cur = nxt; cA = nA; cB = nB; ++ui;
        if constexpr (ALIGN_EPI) { if (wr == 1) PG8_BAR; }
    }
    PG8_WAIT_V(0);
    if constexpr (!ALIGN_EPI) { if (wr == 0) PG8_BAR; }
    PG8_BAR;
#undef PG8_SA
#undef PG8_SB
#undef PG8_STAGE
#undef PG8_LDA
#undef PG8_LDB
#undef PG8_MMA
#undef PG8_WAIT_V
#undef PG8_WAIT_L
#undef PG8_BAR
#undef PG8_SCHED
}
}

constexpr int NWAVES = 8, NTHREADS = 512;
constexpr int RING_BYTES = 131072;
constexpr int LDSCTL_OFF = RING_BYTES, MISC_OFF = LDSCTL_OFF + 320;
constexpr int LDS_BYTES = 147456;

typedef GAS unsigned gu32;
#define RLX_AGENT __ATOMIC_RELAXED, __HIP_MEMORY_SCOPE_AGENT
#define LDS_WAIT() asm volatile("s_waitcnt lgkmcnt(0)" ::: "memory")
#define VM_WAIT() asm volatile("s_waitcnt vmcnt(0)" ::: "memory")

#define XB_TMO      128
#define XB_XCNT(j)  (256  + 64 * (j))
#define XB_XSUB(j)  (1280 + 64 * (j))
#define XB_XGEN(j)  (2304 + 64 * (j))
#define XB_TOP      3328
#define XB_TOPGEN   3392
#define XCD_BAR_WORDS 3456
#define XB_SPIN_CAP (1u << 18)
__device__ __forceinline__ unsigned xb_ld(unsigned* p)              { return __hip_atomic_load(p, __ATOMIC_RELAXED, __HIP_MEMORY_SCOPE_AGENT); }
__device__ __forceinline__ unsigned xb_add(unsigned* p, unsigned v) { return __hip_atomic_fetch_add(p, v, __ATOMIC_RELAXED, __HIP_MEMORY_SCOPE_AGENT); }
__device__ __forceinline__ unsigned xb_xcc_id() { return (unsigned)__builtin_amdgcn_s_getreg((3 << 11) | 20) & 0xFu; }
#define XB_SPIN(cond, bar) do { unsigned _sp = 0; while (cond) { __builtin_amdgcn_s_sleep(1); \
    if ((++_sp & 255u) == 0u) { if (xb_ld(&(bar)[XB_TMO])) break; if (_sp > XB_SPIN_CAP) { atomicAdd(&(bar)[XB_TMO], 1u); break; } } } } while (0)
struct XcdBarrier { unsigned* bar; unsigned x; volatile LAS unsigned* st; };
__device__ __forceinline__ XcdBarrier xcd_barrier_post(unsigned* bar, volatile LAS unsigned* st) {
    XcdBarrier b; b.bar = bar; b.x = xb_xcc_id(); b.st = st;
    if (threadIdx.x == 0) (void)xb_add(&bar[XB_XCNT(b.x)], 1u);
    return b;
}
__device__ __forceinline__ void xcd_barrier_complete(unsigned* bar, unsigned x, unsigned& nloc, unsigned& nx) {
    const unsigned G = gridDim.x * gridDim.y * gridDim.z;
    unsigned sum, cnt, mine, sp = 0u;
    for (;;) {
        sum = 0u; cnt = 0u; mine = 0u;
#pragma unroll
        for (unsigned j = 0; j < 16; ++j) { const unsigned c = xb_ld(&bar[XB_XCNT(j)]); sum += c; cnt += (c > 0u) ? 1u : 0u; mine = (j == x) ? c : mine; }
        if (sum == G) break;
        __builtin_amdgcn_s_sleep(1);
        if ((++sp & 255u) == 0u) { if (xb_ld(&bar[XB_TMO])) break; if (sp > XB_SPIN_CAP) { atomicAdd(&bar[XB_TMO], 1u); break; } }
    }
    nloc = mine > 0u ? mine : 1u; nx = cnt > 0u ? cnt : 1u;
}
__device__ __forceinline__ void xcd_barrier(const XcdBarrier& b) {
    asm volatile("s_waitcnt vmcnt(0)" ::: "memory");
    __syncthreads();
    if (threadIdx.x == 0) {
        unsigned* bar = b.bar;
        __builtin_amdgcn_s_waitcnt(0);
        unsigned nloc = b.st[0], nx = b.st[1];
        if (nloc == 0u) { xcd_barrier_complete(bar, b.x, nloc, nx); b.st[0] = nloc; b.st[1] = nx; }
        const unsigned old = xb_add(&bar[XB_XSUB(b.x)], 1u);
        const unsigned gen = old / nloc;
        if (old + 1u == (gen + 1u) * nloc) {
            __builtin_amdgcn_fence(__ATOMIC_RELEASE, "agent");
            asm volatile("s_waitcnt vmcnt(0)" ::: "memory");
            const unsigned og = xb_add(&bar[XB_TOP], 1u);
            const unsigned tg = og / nx;
            if (og + 1u == (tg + 1u) * nx) xb_add(&bar[XB_TOPGEN], 1u);
            else XB_SPIN(xb_ld(&bar[XB_TOPGEN]) == tg, bar);
            __builtin_amdgcn_fence(__ATOMIC_ACQUIRE, "agent");
            xb_add(&bar[XB_XGEN(b.x)], 1u);
            asm volatile("s_waitcnt vmcnt(0)" ::: "memory");
        } else {
            XB_SPIN(xb_ld(&bar[XB_XGEN(b.x)]) == gen, bar);
            __builtin_amdgcn_fence(__ATOMIC_ACQUIRE, "agent");
            asm volatile("s_waitcnt vmcnt(0)" ::: "memory");
        }
    }
    __syncthreads();
}
constexpr int CW_BAR = 4096;
static_assert((CW_BAR + XCD_BAR_WORDS) * 4 <= (int)CTL_ZERO_BYTES, "ctl");

struct Args {
    const float* in[33]; float* out; unsigned char* ws; int ph_lo, ph_hi;
};
typedef const float* cfp_t;
struct Frame {
    LAS unsigned char* lds;
    int tid, lane, wave, vcu, G;
    const __attribute__((address_space(4))) cfp_t* in; float* out; unsigned char* ws; float* out0; unsigned char* ws0;
    __device__ __forceinline__ void refresh() { int t = threadIdx.x; asm volatile("" : "+v"(t)); tid = t; lane = t & 63; wave = __builtin_amdgcn_readfirstlane(t >> 6);
        const __attribute__((address_space(4))) cfp_t* p = (const __attribute__((address_space(4))) cfp_t*)__builtin_amdgcn_kernarg_segment_ptr(); asm volatile("" : "+s"(p)); in = p;
        float* o_ = out0; unsigned char* w_ = ws0; asm volatile("" : "+s"(o_), "+s"(w_)); out = o_; ws = w_; }
};
enum { I_XP = 0, I_XS, I_C, I_CKB, I_CVB, I_CKC, I_CVC, I_STATE, I_CCTX, I_N1G, I_N2G, I_WMOD, I_BMOD, I_WIN, I_LCW, I_LCB, I_LWA, I_LBA, I_LWX, I_LBX, I_LAM,
       I_QNG, I_KNG, I_SINK, I_WOA, I_WOB, I_WOC, I_WOUT, I_WUP, I_FCW, I_FCB, I_WDOWN, I_FING };

__device__ __forceinline__ void transpose_item(const float* W, int K, int N, h16* WT, LAS float* scr, int item, int lane) {
    const int nblk = N / 32, kb = item / nblk, nb = item % nblk, k0 = 64 * kb, n0 = 32 * nb;
#pragma unroll 8
    for (int i = 0; i < 32; ++i) { const int kk = 2 * i + (lane >> 5); scr[kk * 33 + (lane & 31)] = W[(size_t)(k0 + kk) * N + n0 + (lane & 31)]; }
    LDS_WAIT(); asm volatile("" ::: "memory");
    const int c = lane & 7;
#pragma unroll
    for (int j = 0; j < 4; ++j) { const int n = (lane >> 3) + 8 * j; const LAS float* s = scr + (8 * c) * 33 + n;
        u32x4 o; o.x = pk_h2(s[0 * 33], s[1 * 33]); o.y = pk_h2(s[2 * 33], s[3 * 33]); o.z = pk_h2(s[4 * 33], s[5 * 33]); o.w = pk_h2(s[6 * 33], s[7 * 33]);
        *(u32x4*)(WT + (size_t)(n0 + n) * K + k0 + 8 * c) = o; }
    LDS_WAIT(); asm volatile("" ::: "memory");
}
__device__ __forceinline__ void phase_convert_weights(Frame& F, int l) {
    LAS float* scr = (LAS float*)(F.lds + F.wave * 16384);
    const int gw = F.vcu * NWAVES + F.wave, NGW = F.G * NWAVES;
    unsigned char* wb = F.ws + WS_W;
    constexpr int IT_IN = (DM / 64) * (DIN / 32), IT_OA = (1024 / 64) * (DM / 32), IT_OB = (512 / 64) * (DM / 32), IT_OUT = (DM / 64) * (DM / 32),
                  IT_UP = (DM / 64) * (DUP / 32), IT_DOWN = (DFF / 64) * (DM / 32), IT_LRU1 = (128 / 64) * (128 / 32), IT_LRU = 32 * IT_LRU1;
    constexpr int NITEMS = IT_IN + IT_OA + 2 * IT_OB + IT_OUT + IT_UP + IT_DOWN + IT_LRU;
    for (int it = gw; it < NITEMS; it += NGW) {
        int r = it;
        if (r < IT_IN) { transpose_item(F.in[I_WIN] + (size_t)l * DM * DIN, DM, DIN, (h16*)(wb + W_IN), scr, r, F.lane); continue; } r -= IT_IN;
        if (r < IT_OA) { transpose_item(F.in[I_WOA] + (size_t)l * 1024 * DM, 1024, DM, (h16*)(wb + W_OA), scr, r, F.lane); continue; } r -= IT_OA;
        if (r < IT_OB) { transpose_item(F.in[I_WOB] + (size_t)l * 512 * DM, 512, DM, (h16*)(wb + W_OB), scr, r, F.lane); continue; } r -= IT_OB;
        if (r < IT_OB) { transpose_item(F.in[I_WOC] + (size_t)l * 512 * DM, 512, DM, (h16*)(wb + W_OC), scr, r, F.lane); continue; } r -= IT_OB;
        if (r < IT_OUT) { transpose_item(F.in[I_WOUT] + (size_t)l * DM * DM, DM, DM, (h16*)(wb + W_OUT), scr, r, F.lane); continue; } r -= IT_OUT;
        if (r < IT_UP) { transpose_item(F.in[I_WUP] + (size_t)l * DM * DUP, DM, DUP, (h16*)(wb + W_UP), scr, r, F.lane); continue; } r -= IT_UP;
        if (r < IT_DOWN) { transpose_item(F.in[I_WDOWN] + (size_t)l * DFF * DM, DFF, DM, (h16*)(wb + W_DOWN), scr, r, F.lane); continue; } r -= IT_DOWN;
        {
            const int mi = r / IT_LRU1, sub = r % IT_LRU1, dir = mi >> 4, gate = (mi >> 3) & 1, n = mi & 7;
            const float* src = (gate ? F.in[I_LWX] : F.in[I_LWA]) + ((size_t)((l * 2 + dir) * 8 + n)) * 128 * 128;
            transpose_item(src, 128, 128, (h16*)(wb + W_LRU) + (size_t)mi * 128 * 128, scr, sub, F.lane);
        }
    }
}
__device__ __forceinline__ void phase_prep_misc(Frame& F) {
    LAS float* sil = (LAS float*)F.lds;
    LAS float* part = (LAS float*)(F.lds + 16384);
    float* mod = (float*)(F.ws + WS_MOD);
    for (int item = F.vcu; item < 192; item += F.G) {
        const int l = item / 96, n0 = (item % 96) * 64;
        __syncthreads();
        for (int i = F.tid; i < 3 * 1024; i += NTHREADS) { const int j = i >> 10, k = i & 1023;
            const float v = j == 0 ? F.in[I_CCTX][k] : F.in[I_C][(j - 1) * 1024 + k]; sil[i] = v * sigmoidf_(v); }
        __syncthreads();
        const float* wp = F.in[I_WMOD] + (size_t)l * DM * 6144 + n0 + F.lane;
        float a0 = 0.f, a1 = 0.f, a2 = 0.f;
        const int kb = F.wave * 128;
#pragma unroll 8
        for (int k = 0; k < 128; ++k) { const float w = wp[(size_t)(kb + k) * 6144]; a0 += w * sil[kb + k]; a1 += w * sil[1024 + kb + k]; a2 += w * sil[2048 + kb + k]; }
        part[(F.wave * 3 + 0) * 64 + F.lane] = a0; part[(F.wave * 3 + 1) * 64 + F.lane] = a1; part[(F.wave * 3 + 2) * 64 + F.lane] = a2;
        __syncthreads();
        if (F.tid < 192) { const int j = F.tid >> 6, c = F.tid & 63; float s = F.in[I_BMOD][l * 6144 + n0 + c];
#pragma unroll
            for (int w = 0; w < 8; ++w) s += part[(w * 3 + j) * 64 + c];
            mod[((size_t)l * 3 + j) * 6144 + n0 + c] = s; }
    }
    __syncthreads();
    const int gt = F.vcu * NTHREADS + F.tid, NGT = F.G * NTHREADS;
    float* rope = (float*)(F.ws + WS_ROPE);
    for (int i = gt; i < 64 * 16; i += NGT) { const int pos = i >> 4, fi = i & 15; const float inv = expf(-(float)fi * (1.0f / 16.0f) * 9.210340371976184f);
        const float ang = (float)pos * inv; rope[2 * i] = cosf(ang); rope[2 * i + 1] = sinf(ang); }
    h16* cache = (h16*)(F.ws + WS_CACHE);
    for (int i = gt; i < 4 * 131072 / 4; i += NGT) { const int kind = i / 32768, e = (i % 32768) * 4;
        const float* src = kind == 0 ? F.in[I_CKB] : kind == 1 ? F.in[I_CVB] : kind == 2 ? F.in[I_CKC] : F.in[I_CVC];
        const f32x4 v = *(const f32x4*)(src + e); u32x2 w; w.x = pk_h2(v[0], v[1]); w.y = pk_h2(v[2], v[3]); *(u32x2*)(cache + (size_t)kind * 131072 + e) = w; }
}

__device__ __forceinline__ const float* xrow_ptr(const Frame& F, int layer_src_is_input, int row) {
    if (layer_src_is_input) return row < NCTX ? F.in[I_XP] + (size_t)row * DM : F.in[I_XS] + (size_t)(row - NCTX) * DM;
    return F.out + O_Y + (size_t)row * DM;
}
__device__ __forceinline__ void phase_norm_mod(Frame& F, int from_input, const float* g, const float* mod_l, int shift_chunk) {
    const int gw = F.vcu * NWAVES + F.wave, NGW = F.G * NWAVES;
    h16* H = (h16*)(F.ws + WS_H);
    int cur_cond = -1; f32x4 gs[4], sh[4];
    for (int row = gw; row < NTOK; row += NGW) {
        const int cond = row < NCTX ? 0 : (row < NCTX + LSEQ ? 1 : 2);
        if (cond != cur_cond) { cur_cond = cond; const float* mp = mod_l + (size_t)cond * 6144;
#pragma unroll
            for (int j = 0; j < 4; ++j) { const int c = F.lane * 4 + 256 * j; const f32x4 gg = *(const f32x4*)(g + c); const f32x4 sc = *(const f32x4*)(mp + (shift_chunk + 1) * 1024 + c);
                gs[j] = gg * (sc + 1.0f); sh[j] = *(const f32x4*)(mp + shift_chunk * 1024 + c); } }
        const f32x4* xr = (const f32x4*)xrow_ptr(F, from_input, row) + F.lane;
        f32x4 v[4]; float s = 0.f;
#pragma unroll
        for (int j = 0; j < 4; ++j) { v[j] = xr[64 * j]; s += (v[j].x * v[j].x + v[j].y * v[j].y) + (v[j].z * v[j].z + v[j].w * v[j].w); }
        const float rstd = 1.0f / sqrtf(wave_sum(s) * (1.0f / DM) + NORM_EPS);
        u32x2* o8 = (u32x2*)(H + (size_t)row * DM) + F.lane;
#pragma unroll
        for (int j = 0; j < 4; ++j) { const f32x4 y = v[j] * rstd * gs[j] + sh[j]; u32x2 w; w.x = pk_h2(y.x, y.y); w.y = pk_h2(y.z, y.w); o8[64 * j] = w; }
    }
}
__device__ __forceinline__ void phase_final_norm(Frame& F) {
    const int gw = F.vcu * NWAVES + F.wave, NGW = F.G * NWAVES;
    f32x4 gg[4];
#pragma unroll
    for (int j = 0; j < 4; ++j) gg[j] = *(const f32x4*)(F.in[I_FING] + F.lane * 4 + 256 * j);
    for (int row = gw; row < NTOK; row += NGW) {
        f32x4* xr = (f32x4*)(F.out + O_Y + (size_t)row * DM) + F.lane;
        f32x4 v[4]; float s = 0.f;
#pragma unroll
        for (int j = 0; j < 4; ++j) { v[j] = xr[64 * j]; s += (v[j].x * v[j].x + v[j].y * v[j].y) + (v[j].z * v[j].z + v[j].w * v[j].w); }
        const float rstd = 1.0f / sqrtf(wave_sum(s) * (1.0f / DM) + NORM_EPS);
#pragma unroll
        for (int j = 0; j < 4; ++j) xr[64 * j] = v[j] * rstd * gg[j];
    }
}

__device__ __forceinline__ void phase_qk(Frame& F, int l, bool write_out = true) {
    const int gw = F.vcu * NWAVES + F.wave, NGW = F.G * NWAVES, lane = F.lane;
    h16* Z = (h16*)(F.ws + WS_ZU);
    const float* rope = (const float*)(F.ws + WS_ROPE);
    const float* qg = F.in[I_QNG] + l * 64; const float* kg = F.in[I_KNG] + l * 64;
    const int hl = lane & 7, hc0 = hl * 8;
    float qgv[8], kgv[8];
#pragma unroll
    for (int j = 0; j < 8; ++j) { qgv[j] = qg[hc0 + j]; kgv[j] = kg[hc0 + j]; }
    for (int row = gw; row < NTOK; row += NGW) {
        const bool is_ctx = row < NCTX;
        int rpos = 0, cpos = 0, b = 0, t = 0;
        if (is_ctx) { b = row >> 8; t = row & 255; } else { const int tt = (row - NCTX) & (LSEQ - 1); rpos = tt >> 6; cpos = tt & 63; }
        h16* zr = Z + (size_t)row * NMAIN;
#pragma unroll
        for (int pass = 0; pass < 3; ++pass) {
            const int col = C_QB + pass * 512 + lane * 8;
            int kind;
            if (pass == 0) kind = 0; else if (pass == 1) kind = lane < 8 * 2 ? 1 : (lane < 8 * 4 ? 2 : 3); else kind = lane < 32 ? 3 : (lane < 48 ? 4 : 5);
            const u32x4 w = *(const u32x4*)(zr + col);
            float x[8]; unpack8(w, x);
            if (kind <= 1) {
                float s = 0.f;
#pragma unroll
                for (int j = 0; j < 8; ++j) s += x[j] * x[j];
                s += __shfl_xor(s, 1); s += __shfl_xor(s, 2); s += __shfl_xor(s, 4);
                const float rstd = 1.0f / sqrtf(s * (1.0f / 64.0f) + NORM_EPS);
#pragma unroll
                for (int j = 0; j < 8; ++j) x[j] = x[j] * rstd * (kind == 0 ? qgv[j] : kgv[j]);
            }
            if (!is_ctx) {
                float p[8];
#pragma unroll
                for (int j = 0; j < 8; ++j) p[j] = __shfl_xor(x[j], 2);
                if (kind == 0 || kind == 1 || kind == 3 || kind == 4) {
                    const int half = hl >> 2, second = (hl >> 1) & 1, f0 = (hl & 1) * 8, pos = half ? cpos : rpos;
                    const float* tp = rope + ((size_t)pos * 16 + f0) * 2;
#pragma unroll
                    for (int j = 0; j < 8; ++j) { const float cs = tp[2 * j], sn = tp[2 * j + 1]; x[j] = second ? (p[j] * sn + x[j] * cs) : (x[j] * cs - p[j] * sn); }
                }
            }
            if (kind == 0 || kind == 3) {
#pragma unroll
                for (int j = 0; j < 8; ++j) x[j] *= QSCALE;
            }
            if (kind != 2 && kind != 5) *(u32x4*)(zr + col) = pack8(x);
            if (write_out && is_ctx && (kind == 1 || kind == 2 || kind == 4 || kind == 5)) {
                const size_t ob = kind == 1 ? O_KB : kind == 2 ? O_VB : kind == 4 ? O_KC : O_VC;
                const int c128 = (kind == 1 || kind == 2) ? (col - (kind == 1 ? C_KB : C_VB)) : (col - (kind == 4 ? C_KC : C_VC));
                float* op = F.out + ob + ((size_t)((b * 2 + l) * 256 + t)) * 128 + c128;
                *(f32x4*)op = (f32x4){x[0], x[1], x[2], x[3]}; *(f32x4*)(op + 4) = (f32x4){x[4], x[5], x[6], x[7]};
            }
        }
    }
}

__device__ __forceinline__ int img_off(int row, int ch) { return row * 256 + ((((ch >> 3) ^ (row & 15)) << 4) | ((ch & 7) << 1)); }
template <int MODE, int DIR>
__device__ __forceinline__ void lru_scan(Frame& F, int l, int row0, int n, int lat_b, int lat_chunk, int ctx_b, bool write_out, int cb) {
    LAS unsigned char* img = F.lds; LAS unsigned char* hx = F.lds + 65536;
    const int lane = F.lane, r32 = lane & 31, hi = lane >> 5, hm = hi ^ DIR;
    const int C = n * 128 + cb * 32 + r32;
    h16x8 Br[8], Bi[8];
    {
        const h16* wr_ = (const h16*)(F.ws + WS_W + W_LRU) + ((size_t)((DIR * 2 + 0) * 8 + n) * 128 + cb * 32 + r32) * 128 + 8 * hi;
        const h16* wi_ = (const h16*)(F.ws + WS_W + W_LRU) + ((size_t)((DIR * 2 + 1) * 8 + n) * 128 + cb * 32 + r32) * 128 + 8 * hi;
#pragma unroll
        for (int ks = 0; ks < 8; ++ks) { Br[ks] = *(const h16x8*)(wr_ + 16 * ks); Bi[ks] = *(const h16x8*)(wi_ + 16 * ks); }
    }
    const float ba = F.in[I_LBA][(size_t)(l * 2 + DIR) * DLRU + C], bx = F.in[I_LBX][(size_t)(l * 2 + DIR) * DLRU + C];
    const float lam = F.in[I_LAM][(size_t)(l * 2 + DIR) * DLRU + C];
    const float sp = (-lam > 20.f) ? -lam : log1pf(expf(-lam));
    const float k8 = -8.0f * sp * LOG2E;
    const float nba = -LOG2E * ba, nbx = -LOG2E * bx;
    float H = 0.f, aggP = 1.f;
    if (MODE == 2) {
        const float* agg = (const float*)(F.ws + WS_AGG);
        H = F.in[I_STATE][(size_t)((lat_b * 2 + l) * 2 + DIR) * DLRU + C];
        float ap[15], au[15];
#pragma unroll
        for (int k = 0; k < 15; ++k) { const int ch = DIR == 0 ? k : 15 - k; const bool use = DIR == 0 ? (ch < lat_chunk) : (ch > lat_chunk);
            const float* p = agg + ((size_t)((lat_b * 16 + (use ? ch : 0)) * 2 + DIR) * DLRU + C) * 2; ap[k] = use ? p[0] : 1.f; au[k] = use ? p[1] : 0.f; }
#pragma unroll
        for (int k = 0; k < 15; ++k) H = ap[k] * H + au[k];
    }
    const int xoff = (cb * 32 + r32) * 2;
    const int xch = cb * 4 + (r32 >> 3), xel = (r32 & 7) * 2; (void)xoff;
#pragma unroll 1
    for (int step = 0; step < 8; ++step) {
        if (step == 4) __syncthreads();
        const int rb = DIR == 0 ? step : 7 - step;
        f32x16 ar = {}, ai = {};
#pragma unroll
        for (int ks = 0; ks < 8; ++ks) {
            const h16x8 af = *(const LAS h16x8*)(img + (rb * 32 + r32) * 256 + (((2 * ks + hi) ^ (r32 & 15)) << 4));
            ar = __builtin_amdgcn_mfma_f32_32x32x16_f16(af, Br[ks], ar, 0, 0, 0);
            ai = __builtin_amdgcn_mfma_f32_32x32x16_f16(af, Bi[ks], ai, 0, 0, 0);
        }
        float an[16], un[16];
#pragma unroll
        for (int r = 0; r < 16; ++r) {
            const int tk = rb * 32 + 8 * (r >> 2) + 4 * hi + (r & 3);
            const float xv = (float)*(const LAS h16*)(img + tk * 256 + ((xch ^ (tk & 15)) << 4) + xel);
            const float rr = fast_rcp(1.0f + fast_exp2(__builtin_fmaf(ar[r], -LOG2E, nba)));
            const float ii = fast_rcp(1.0f + fast_exp2(__builtin_fmaf(ai[r], -LOG2E, nbx)));
            const float av = fast_exp2(k8 * rr);
            an[r] = av;
            un[r] = __builtin_amdgcn_sqrtf(__builtin_fmaf(-av, av, 1.0f)) * (ii * xv);
        }
#define SA(r) (DIR ? an[15 - (r)] : an[(r)])
#define SU(r) (DIR ? un[15 - (r)] : un[(r)])
        float P[4], U[4];
#pragma unroll
        for (int g = 0; g < 4; ++g) {
            float p = 1.f, uu = 0.f;
#pragma unroll
            for (int i = 0; i < 4; ++i) { uu = SA(4 * g + i) * uu + SU(4 * g + i); p *= SA(4 * g + i); }
            P[g] = p; U[g] = uu;
        }
        float PP[4], UP[4];
#pragma unroll
        for (int g = 0; g < 4; ++g) { PP[g] = __shfl_xor(P[g], 32); UP[g] = __shfl_xor(U[g], 32); }
        float Hs[4];
        {
            float h = H;
#pragma unroll
            for (int s2 = 0; s2 < 8; ++s2) {
                const int g = s2 >> 1; const int sh = s2 & 1;
                const float p = (sh == hm) ? P[g] : PP[g], uu = (sh == hm) ? U[g] : UP[g];
                if (sh == hm) Hs[g] = h;
                h = p * h + uu;
            }
            H = h;
        }
        if (MODE == 1) { float p = 1.f;
#pragma unroll
            for (int g = 0; g < 4; ++g) p *= P[g] * PP[g];
            aggP *= p; }
        if (MODE != 1) {
#pragma unroll
            for (int g = 0; g < 4; ++g) { float h = Hs[g];
#pragma unroll
                for (int i = 0; i < 4; ++i) { const int r = 4 * g + i; h = SA(r) * h + SU(r);
                    const int rn = DIR ? 15 - r : r;
                    const int tk = rb * 32 + 8 * (rn >> 2) + 4 * hi + (rn & 3);
                    LAS h16* hp = (LAS h16*)(hx + tk * 256 + ((xch ^ (tk & 15)) << 4) + xel);
                    if (step < 4) *hp = (h16)h; else *hp = (h16)(h + (float)*hp); } }
        }
#undef SA
#undef SU
    }
    if (MODE == 0 && hi == 0 && write_out) F.out[O_LRU + (size_t)((ctx_b * 2 + l) * 2 + DIR) * DLRU + C] = H;
    if (MODE == 1 && hi == 0) { float* agg = (float*)(F.ws + WS_AGG) + ((size_t)((lat_b * 16 + lat_chunk) * 2 + DIR) * DLRU + C) * 2; agg[0] = aggP; agg[1] = H; }
}
template <int MODE>
__device__ __forceinline__ void lru_unit(Frame& F, int l, int row0, int n, int seq_first, int seq_last, int lat_b, int lat_chunk, int ctx_b, bool write_out = true) {
    LAS unsigned char* img = F.lds; LAS unsigned char* hx = F.lds + 65536;
    const h16* Z = (const h16*)(F.ws + WS_ZU);
    const int tid = F.tid;
    __syncthreads();
    {
        const int cc = tid & 15, tg = tid >> 4; const int ch0 = n * 128 + cc * 8;
        float w0[8], w1[8], w2[8], w3[8], bb[8];
        const float* cw = F.in[I_LCW] + (size_t)l * 4 * DLRU + ch0; const float* cb = F.in[I_LCB] + (size_t)l * DLRU + ch0;
#pragma unroll
        for (int j = 0; j < 8; ++j) { w0[j] = cw[j]; w1[j] = cw[DLRU + j]; w2[j] = cw[2 * DLRU + j]; w3[j] = cw[3 * DLRU + j]; bb[j] = cb[j]; }
        const int t0 = tg * 8;
        u32x4 raw[11];
#pragma unroll
        for (int i = 0; i < 11; ++i) { const int t = t0 - 2 + i; const bool ok = (t >= 0 || !seq_first) && (t < 256 || !seq_last);
            raw[i] = ok ? *(const u32x4*)(Z + (size_t)(row0 + t) * NMAIN + C_XA + ch0) : (u32x4){0u, 0u, 0u, 0u}; }
        float xm2[8], xm1[8], x0[8], xp1[8];
        unpack8(raw[0], xm2); unpack8(raw[1], xm1); unpack8(raw[2], x0);
#pragma unroll
        for (int i = 0; i < 8; ++i) {
            unpack8(raw[3 + i], xp1);
            float y[8];
#pragma unroll
            for (int j = 0; j < 8; ++j) y[j] = bb[j] + w0[j] * xm2[j] + w1[j] * xm1[j] + w2[j] * x0[j] + w3[j] * xp1[j];
            *(LAS u32x4*)(img + img_off(t0 + i, cc * 8)) = pack8(y);
#pragma unroll
            for (int j = 0; j < 8; ++j) { xm2[j] = xm1[j]; xm1[j] = x0[j]; x0[j] = xp1[j]; }
        }
    }
    __syncthreads();
    const int dir = F.wave >> 2, cb = F.wave & 3;
    if (dir == 0) lru_scan<MODE, 0>(F, l, row0, n, lat_b, lat_chunk, ctx_b, write_out, cb);
    else          lru_scan<MODE, 1>(F, l, row0, n, lat_b, lat_chunk, ctx_b, write_out, cb);
    if (MODE != 1) {
        __syncthreads();
        h16* OA = (h16*)(F.ws + WS_ZU + ZU_OA);
#pragma unroll
        for (int k = 0; k < 8; ++k) { const int i = tid + NTHREADS * k, tk = i >> 4, cc = i & 15;
            float hs[8], ya[8], o[8];
            unpack8(*(const LAS u32x4*)(hx + img_off(tk, cc * 8)), hs);
            unpack8(*(const u32x4*)(Z + (size_t)(row0 + tk) * NMAIN + C_YA + n * 128 + cc * 8), ya);
#pragma unroll
            for (int j = 0; j < 8; ++j) o[j] = hs[j] * gelu_tanh(ya[j]);
            *(u32x4*)(OA + (size_t)(row0 + tk) * 1024 + n * 128 + cc * 8) = pack8(o); }
    }
}

struct AttnDesc {
    const h16* Qz; h16* O;
    const h16* Kc; const h16* Vc;
    const h16* Kz; const h16* Vz;
    int nc, zt0, nz;
    int windowed;
    const float* sink;
    int kvh, q0;
};
__device__ __forceinline__ void attn_unit(Frame& F, const AttnDesc& D, const h16* Qrow0  , h16* Orow0  ) {
    LAS unsigned char* lds = F.lds;
    const int tid = F.tid, lane = F.lane, wave = F.wave, r32 = lane & 31, hi = lane >> 5;
    const int head = D.kvh * 4 + (wave >> 1);
    const int qpos = D.q0 + (wave & 1) * 32 + r32;
    const int NT = D.nc + D.nz;
    h16x8 qr[4];
    { const h16* qp = Qrow0 + (size_t)qpos * NMAIN + head * 64 + 8 * hi;
#pragma unroll
      for (int d0 = 0; d0 < 4; ++d0) qr[d0] = *(const h16x8*)(qp + 16 * d0); }
    const int krow = tid >> 3, kch = tid & 7; const int kdst = krow * 128 + ((kch ^ ((krow >> 1) & 7)) << 4);
    const int vrow = 16 * (wave & 3) + (lane >> 2), vcol = (wave >> 2) * 32 + (lane & 3) * 8; const int vdst = wave * 1024 + lane * 16;
    auto ktile_ptr = [&](int j, int row, int col, bool isV) -> const h16* {
        if (j < D.nc) return (isV ? D.Vc : D.Kc) + (size_t)(64 * j + row) * 128 + col;
        return (isV ? D.Vz : D.Kz) + (size_t)((D.zt0 + (j - D.nc)) * 64 + row) * NMAIN + col;
    };
    u32x4 kreg, vreg;
    kreg = *(const u32x4*)ktile_ptr(0, krow, kch * 8, false); vreg = *(const u32x4*)ktile_ptr(0, vrow, vcol, true);
    __syncthreads();
    *(LAS u32x4*)(lds + kdst) = kreg; *(LAS u32x4*)(lds + 16384 + vdst) = vreg;
    __syncthreads();
    float m_run, l_run;
    if (D.sink) { m_run = D.sink[head] * LOG2E; l_run = hi == 0 ? 1.f : 0.f; } else { m_run = -1e30f; l_run = 0.f; }
    f32x16 o0 = {}, o1 = {};
    LAS float* wsf = (LAS float*)(lds + 32768) + wave * 64;
    const int kfoff = r32 * 128;
    const int ksw = (r32 >> 1) & 7;
    const int vp0 = ((lane >> 4) & 1) * 32 + (lane & 3) * 8 + (4 * hi + ((lane & 15) >> 2)) * 64;
#pragma unroll 1
    for (int j = 0; j < NT; ++j) {
        const int buf = j & 1;
        if (j + 1 < NT) { kreg = *(const u32x4*)ktile_ptr(j + 1, krow, kch * 8, false); vreg = *(const u32x4*)ktile_ptr(j + 1, vrow, vcol, true); }
        LAS unsigned char* Kb = lds + buf * 8192; LAS unsigned char* Vb = lds + 16384 + buf * 8192;
        f32x16 p0 = {}, p1 = {};
#pragma unroll
        for (int d0 = 0; d0 < 4; ++d0) {
            const int co = ((2 * d0 + hi) ^ ksw) << 4;
            const h16x8 k0 = *(const LAS h16x8*)(Kb + kfoff + co);
            const h16x8 k1 = *(const LAS h16x8*)(Kb + 4096 + kfoff + co);
            p0 = __builtin_amdgcn_mfma_f32_32x32x16_f16(k0, qr[d0], p0, 0, 0, 0);
            p1 = __builtin_amdgcn_mfma_f32_32x32x16_f16(k1, qr[d0], p1, 0, 0, 0);
        }
        if (D.windowed && j >= D.nc) {
            const int kb0 = (D.zt0 + (j - D.nc)) * 64 + 4 * hi;
#pragma unroll
            for (int r = 0; r < 16; ++r) { const int kp = kb0 + (r & 3) + 8 * (r >> 2);
                const int d0_ = qpos - kp, d1_ = qpos - (kp + 32);
                if (d0_ > 128 || d0_ < -128) p0[r] = -1e30f;
                if (d1_ > 128 || d1_ < -128) p1[r] = -1e30f; }
        }
        float mx = fmaxf(p0[0], p1[0]);
#pragma unroll
        for (int r = 1; r < 16; ++r) mx = fmaxf(mx, fmaxf(p0[r], p1[r]));
        mx = fmaxf(mx, __shfl_xor(mx, 32));
        const float m_new = fmaxf(m_run, mx);
        const float alpha = fast_exp2(m_run - m_new);
        m_run = m_new;
        float rs = 0.f;
#pragma unroll
        for (int r = 0; r < 16; ++r) { p0[r] = fast_exp2(p0[r] - m_new); p1[r] = fast_exp2(p1[r] - m_new); rs += p0[r] + p1[r]; }
        l_run = l_run * alpha + rs;
        if (hi == 0) wsf[r32] = alpha;
        LDS_WAIT();
#pragma unroll
        for (int r = 0; r < 16; ++r) { const float f = wsf[(r & 3) + 8 * (r >> 2) + 4 * hi]; o0[r] *= f; o1[r] *= f; }
        u32x4 pw[4];
        pw[0] = (u32x4){pk_h2(p0[0], p0[1]), pk_h2(p0[2], p0[3]), pk_h2(p0[4], p0[5]), pk_h2(p0[6], p0[7])};
        pw[1] = (u32x4){pk_h2(p0[8], p0[9]), pk_h2(p0[10], p0[11]), pk_h2(p0[12], p0[13]), pk_h2(p0[14], p0[15])};
        pw[2] = (u32x4){pk_h2(p1[0], p1[1]), pk_h2(p1[2], p1[3]), pk_h2(p1[4], p1[5]), pk_h2(p1[6], p1[7])};
        pw[3] = (u32x4){pk_h2(p1[8], p1[9]), pk_h2(p1[10], p1[11]), pk_h2(p1[12], p1[13]), pk_h2(p1[14], p1[15])};
#pragma unroll
        for (int ks = 0; ks < 4; ++ks) {
            const h16x8 pa = __builtin_bit_cast(h16x8, pw[ks]);
#pragma unroll
            for (int d0 = 0; d0 < 2; ++d0) {
                const s16x4 lo = __builtin_amdgcn_ds_read_tr16_b64_v4i16((LAS s16x4*)(Vb + vp0 + d0 * 4096 + ks * 1024));
                const s16x4 hh = __builtin_amdgcn_ds_read_tr16_b64_v4i16((LAS s16x4*)(Vb + vp0 + d0 * 4096 + ks * 1024 + 512));
                typedef short s16x8 __attribute__((ext_vector_type(8)));
                const s16x8 vv = {lo[0], lo[1], lo[2], lo[3], hh[0], hh[1], hh[2], hh[3]};
                const h16x8 vf = __builtin_bit_cast(h16x8, vv);
                if (d0 == 0) o0 = __builtin_amdgcn_mfma_f32_32x32x16_f16(pa, vf, o0, 0, 0, 0);
                else         o1 = __builtin_amdgcn_mfma_f32_32x32x16_f16(pa, vf, o1, 0, 0, 0);
            }
        }
        if (j + 1 < NT) { *(LAS u32x4*)(lds + (buf ^ 1) * 8192 + kdst) = kreg; *(LAS u32x4*)(lds + 16384 + (buf ^ 1) * 8192 + vdst) = vreg; }
        __syncthreads();
    }
    l_run += __shfl_xor(l_run, 32);
    if (hi == 0) wsf[32 + r32] = l_run;
    LDS_WAIT();
    h16* op = Orow0 + (size_t)(D.q0 + (wave & 1) * 32) * 512 + head * 64 + r32;
#pragma unroll
    for (int r = 0; r < 16; ++r) { const int q = (r & 3) + 8 * (r >> 2) + 4 * hi; const float rl = fast_rcp(wsf[32 + q]);
        op[(size_t)q * 512] = (h16)(o0[r] * rl); op[(size_t)q * 512 + 32] = (h16)(o1[r] * rl); }
}
__device__ __forceinline__ void attn_dispatch(Frame& F, int l, int type, int u) {
    const h16* Z = (const h16*)(F.ws + WS_ZU);
    const h16* cache = (const h16*)(F.ws + WS_CACHE);
    AttnDesc D; D.sink = nullptr; D.windowed = 0; D.Kc = nullptr; D.Vc = nullptr; D.nc = 0;
    const bool isC = type & 1;
    const int qcol = isC ? C_QC : C_QB, kcol = isC ? C_KC : C_KB, vcol = isC ? C_VC : C_VB;
    h16* Obase = (h16*)(F.ws + WS_ZU + (isC ? ZU_OC : ZU_OB));
    size_t row_seq0;
    if (type < 2) {
        const int b = u >> 7, kvh = (u >> 6) & 1, qb = u & 63;
        row_seq0 = (size_t)NCTX + (size_t)b * LSEQ; D.kvh = kvh; D.q0 = qb * 64;
        D.Kc = cache + ((size_t)(isC ? 2 : 0) * 131072) + (size_t)((b * 2 + l) * 256) * 128 + kvh * 64;
        D.Vc = cache + ((size_t)(isC ? 3 : 1) * 131072) + (size_t)((b * 2 + l) * 256) * 128 + kvh * 64;
        D.nc = 4;
        if (!isC) { D.zt0 = 0; D.nz = 64; }
        else { int lo = qb - 2; if (lo < 0) lo = 0; int hi_ = qb + 2; if (hi_ > 63) hi_ = 63; D.zt0 = lo; D.nz = hi_ - lo + 1; D.windowed = 1; }
    } else {
        const int b = u >> 3, kvh = (u >> 2) & 1, qb = u & 3;
        row_seq0 = (size_t)b * SEQ; D.kvh = kvh; D.q0 = qb * 64; D.zt0 = 0; D.nz = 4;
    }
    if (isC) D.sink = F.in[I_SINK] + l * 8;
    D.Kz = Z + row_seq0 * NMAIN + kcol + D.kvh * 64; D.Vz = Z + row_seq0 * NMAIN + vcol + D.kvh * 64;
    attn_unit(F, D, Z + row_seq0 * NMAIN + qcol, Obase + row_seq0 * 512);
}

__device__ __forceinline__ void phase_ffn_act(Frame& F, int l) {
    h16* U = (h16*)(F.ws + WS_ZU);
    const int gt = F.vcu * NTHREADS + F.tid, NGT = F.G * NTHREADS;
    constexpr int NCC = DFF / 8, NRUN = NTOK / 64;
    for (int it = gt; it < NCC * NRUN; it += NGT) {
        const int cc = it % NCC, run = it / NCC; const int c0 = cc * 8, r0 = run * 64;
        const bool first = (r0 < NCTX) ? ((r0 & 255) == 0) : (((r0 - NCTX) & (LSEQ - 1)) == 0);
        const bool last = (r0 < NCTX) ? (((r0 + 64) & 255) == 0) : ((((r0 + 64) - NCTX) & (LSEQ - 1)) == 0);
        float w0[8], w1[8], w2[8], bb[8];
        const float* cw = F.in[I_FCW] + (size_t)l * 3 * DFF + c0; const float* cb = F.in[I_FCB] + (size_t)l * DFF + c0;
#pragma unroll
        for (int j = 0; j < 8; ++j) { w0[j] = cw[j]; w1[j] = cw[DFF + j]; w2[j] = cw[2 * DFF + j]; bb[j] = cb[j]; }
        float gp[8], gc[8], gn[8];
        if (first) {
#pragma unroll
            for (int j = 0; j < 8; ++j) gp[j] = 0.f; } else unpack8(*(const u32x4*)(U + (size_t)(r0 - 1) * DUP + c0), gp);
        unpack8(*(const u32x4*)(U + (size_t)r0 * DUP + c0), gc);
#pragma unroll 4
        for (int i = 0; i < 64; ++i) {
            const int r = r0 + i;
            if (i == 63 && last) {
#pragma unroll
                for (int j = 0; j < 8; ++j) gn[j] = 0.f; } else unpack8(*(const u32x4*)(U + (size_t)(r + 1) * DUP + c0), gn);
            float v[8]; unpack8(*(const u32x4*)(U + (size_t)r * DUP + DFF + c0), v);
            float o[8];
#pragma unroll
            for (int j = 0; j < 8; ++j) { const float g = bb[j] + w0[j] * gp[j] + w1[j] * gc[j] + w2[j] * gn[j]; o[j] = gelu_tanh(g) * v[j]; gp[j] = gc[j]; gc[j] = gn[j]; }
            *(u32x4*)(U + (size_t)r * DUP + DFF + c0) = pack8(o);
        }
    }
}

constexpr int N_PHASES = 25;
__global__ void __launch_bounds__(NTHREADS, 2) fwd_kernel(Args args) {
    extern __shared__ __attribute__((aligned(16))) unsigned char lds_raw[];
    Frame F;
    F.lds = (LAS unsigned char*)lds_raw;
    F.tid = threadIdx.x; F.lane = F.tid & 63; F.wave = __builtin_amdgcn_readfirstlane(F.tid >> 6);
    F.G = gridDim.x; { const int bx = blockIdx.x; F.vcu = (F.G % 8 == 0) ? (bx % 8) * (F.G / 8) + bx / 8 : bx; }
    F.out0 = args.out; F.ws0 = args.ws; F.refresh();
    volatile LAS unsigned* MISC = (volatile LAS unsigned*)(F.lds + MISC_OFF);
    for (int u = F.tid; u < (LDS_BYTES - LDSCTL_OFF) / 4; u += NTHREADS) ((LAS unsigned*)(F.lds + LDSCTL_OFF))[u] = 0u;
    __syncthreads();
#if !MK_PER_PHASE
    XcdBarrier bar = xcd_barrier_post((unsigned*)(F.ws + WS_CTL) + CW_BAR, MISC + 8);
#define GRID_BAR() xcd_barrier(bar)
#else
    (void)MISC;
#define GRID_BAR() do { } while (0)
#endif
    const int lo = args.ph_lo, hi_ph = args.ph_hi;
#define IN(k) (lo <= (k) && (k) < hi_ph)
#define SEAM(k) do { if (IN((k) + 1)) GRID_BAR(); } while (0)
#pragma unroll
    for (int l = 0; l < DEPTH; ++l) {
        const int pb = 12 * l;
        if (IN(pb + 0)) { F.refresh(); phase_convert_weights(F, l); if (l == 0) phase_prep_misc(F); SEAM(pb + 0); }
        if (IN(pb + 1)) { F.refresh(); phase_norm_mod(F, l == 0, F.in[I_N1G] + l * DM, (const float*)(F.ws + WS_MOD) + (size_t)l * 3 * 6144, 0); SEAM(pb + 1); }
        if (IN(pb + 2)) { F.refresh();
            pg8::Gemm g{(const h16*)(F.ws + WS_H), (const h16*)(F.ws + WS_W + W_IN), NTOK, NMAIN, DM, DM}; pg8::StaticOrder S; S.init(NTOK, NMAIN, F.G, (int)blockIdx.x);
            pg8::EpiF16<0> E{(h16*)(F.ws + WS_ZU), NMAIN};
            pg8::gemm_phase<pg8::EpiF16<0>, pg8::StaticOrder, true, true>(F.lds, g, S, E);
            SEAM(pb + 2); }
        if (IN(pb + 3)) { F.refresh();
            phase_qk(F, l);
            for (int u = F.vcu; u < 512; u += F.G) {
                if (u < 256) lru_unit<0>(F, l, (u >> 3) * 256, u & 7, 1, 1, 0, 0, u >> 3);
                else { const int v = u - 256, b = v >> 7, ch = (v >> 3) & 15; lru_unit<1>(F, l, NCTX + b * LSEQ + ch * 256, v & 7, ch == 0, ch == 15, b, ch, 0); }
            }
            SEAM(pb + 3); }
        if (IN(pb + 4)) { F.refresh();
            for (int type = 0; type < 4; ++type) for (int u = F.vcu; u < 256; u += F.G) attn_dispatch(F, l, type, u);
            for (int v = F.vcu; v < 256; v += F.G) { const int b = v >> 7, ch = (v >> 3) & 15; lru_unit<2>(F, l, NCTX + b * LSEQ + ch * 256, v & 7, ch == 0, ch == 15, b, ch, 0); }
            SEAM(pb + 4); }
        if (IN(pb + 5)) { F.refresh();
            pg8::Gemm g{(const h16*)(F.ws + WS_H), (const h16*)(F.ws + WS_W + W_IN) + (size_t)NMAIN * DM, NTOK, NGATE, DM, DM}; pg8::StaticOrder S; S.init(NTOK, NGATE, F.G, (int)blockIdx.x);
            pg8::EpiF16<1> E{(h16*)(F.ws + WS_ZU), NGATE};
            pg8::gemm_phase<pg8::EpiF16<1>, pg8::StaticOrder, true, true>(F.lds, g, S, E);
            SEAM(pb + 5); }
        if (IN(pb + 6)) { F.refresh();
            pg8::StaticOrder S; S.init(NTOK, DM, F.G, (int)blockIdx.x);
            h16* Hb = (h16*)(F.ws + WS_H); const h16* Gb = (const h16*)(F.ws + WS_ZU);
            { pg8::Gemm g{(const h16*)(F.ws + WS_ZU + ZU_OA), (const h16*)(F.ws + WS_W + W_OA), NTOK, DM, 1024, 1024}; pg8::EpiGateMul<0> E{Hb, Gb, 0};
              pg8::gemm_phase<pg8::EpiGateMul<0>, pg8::StaticOrder, true, true>(F.lds, g, S, E); }
            { pg8::Gemm g{(const h16*)(F.ws + WS_ZU + ZU_OB), (const h16*)(F.ws + WS_W + W_OB), NTOK, DM, 512, 512}; pg8::EpiGateMul<1> E{Hb, Gb, 1024};
              pg8::gemm_phase<pg8::EpiGateMul<1>, pg8::StaticOrder, true, true>(F.lds, g, S, E); }
            { pg8::Gemm g{(const h16*)(F.ws + WS_ZU + ZU_OC), (const h16*)(F.ws + WS_W + W_OC), NTOK, DM, 512, 512}; pg8::EpiGateMul<1> E{Hb, Gb, 2048};
              pg8::gemm_phase<pg8::EpiGateMul<1>, pg8::StaticOrder, true, true>(F.lds, g, S, E); }
            SEAM(pb + 6); }
        if (IN(pb + 7)) { F.refresh();
            pg8::Gemm g{(const h16*)(F.ws + WS_H), (const h16*)(F.ws + WS_W + W_OUT), NTOK, DM, DM, DM}; pg8::StaticOrder S; S.init(NTOK, DM, F.G, (int)blockIdx.x);
            pg8::EpiRes E{l == 0 ? F.in[I_XP] : F.out + O_Y, l == 0 ? F.in[I_XS] : F.out + O_Y + (size_t)NCTX * DM, F.out + O_Y, (const float*)(F.ws + WS_MOD) + (size_t)l * 3 * 6144 + 2 * 1024};
            pg8::gemm_phase<pg8::EpiRes, pg8::StaticOrder, true, true>(F.lds, g, S, E);
            SEAM(pb + 7); }
        if (IN(pb + 8)) { F.refresh(); phase_norm_mod(F, 0, F.in[I_N2G] + l * DM, (const float*)(F.ws + WS_MOD) + (size_t)l * 3 * 6144, 3); SEAM(pb + 8); }
        if (IN(pb + 9)) { F.refresh();
            pg8::Gemm g{(const h16*)(F.ws + WS_H), (const h16*)(F.ws + WS_W + W_UP), NTOK, DUP, DM, DM}; pg8::StaticOrder S; S.init(NTOK, DUP, F.G, (int)blockIdx.x);
            pg8::EpiF16<0> E{(h16*)(F.ws + WS_ZU), DUP};
            pg8::gemm_phase<pg8::EpiF16<0>, pg8::StaticOrder, true, true>(F.lds, g, S, E);
            SEAM(pb + 9); }
        if (IN(pb + 10)) { F.refresh(); phase_ffn_act(F, l); SEAM(pb + 10); }
        if (IN(pb + 11)) { F.refresh();
            pg8::Gemm g{(const h16*)(F.ws + WS_ZU) + DFF, (const h16*)(F.ws + WS_W + W_DOWN), NTOK, DM, DFF, DUP}; pg8::StaticOrder S; S.init(NTOK, DM, F.G, (int)blockIdx.x);
            pg8::EpiRes E{F.out + O_Y, F.out + O_Y + (size_t)NCTX * DM, F.out + O_Y, (const float*)(F.ws + WS_MOD) + (size_t)l * 3 * 6144 + 5 * 1024};
            pg8::gemm_phase<pg8::EpiRes, pg8::StaticOrder, true, true>(F.lds, g, S, E);
            SEAM(pb + 11); }
    }
    if (IN(24)) { F.refresh(); phase_final_norm(F); }
#if defined(PROBE_PH)
#ifndef PROBE_N
#define PROBE_N 4
#endif
#ifndef PROBE_SUB
#define PROBE_SUB 0xFF
#endif
    if (IN(24)) {
        const int l = 1;
        for (int rep = 0; rep < PROBE_N; ++rep) {
            GRID_BAR(); F.refresh();
            if (PROBE_PH == 0) { phase_convert_weights(F, l); }
            if (PROBE_PH == 12) { phase_prep_misc(F); }
            if (PROBE_PH == 1) { phase_norm_mod(F, 0, F.in[I_N1G] + l * DM, (const float*)(F.ws + WS_MOD) + (size_t)l * 3 * 6144, 0); }
            if (PROBE_PH == 2) { pg8::Gemm g{(const h16*)(F.ws + WS_H), (const h16*)(F.ws + WS_W + W_IN), NTOK, NMAIN, DM, DM}; pg8::StaticOrder S; S.init(NTOK, NMAIN, F.G, (int)blockIdx.x);
                pg8::EpiF16<0> E{(h16*)(F.ws + WS_ZU), NMAIN}; pg8::gemm_phase<pg8::EpiF16<0>, pg8::StaticOrder, true, true>(F.lds, g, S, E); }
            if (PROBE_PH == 3) {
                if (PROBE_SUB & 1) phase_qk(F, l, false);
                for (int u = F.vcu; u < 512; u += F.G) {
                    if (u < 256) { if (PROBE_SUB & 2) lru_unit<0>(F, l, (u >> 3) * 256, u & 7, 1, 1, 0, 0, u >> 3, false); }
                    else if (PROBE_SUB & 4) { const int v = u - 256, b = v >> 7, ch = (v >> 3) & 15; lru_unit<1>(F, l, NCTX + b * LSEQ + ch * 256, v & 7, ch == 0, ch == 15, b, ch, 0); }
                } }
            if (PROBE_PH == 4) {
                for (int type = 0; type < 4; ++type) if ((PROBE_SUB >> type) & 1) for (int u = F.vcu; u < 256; u += F.G) attn_dispatch(F, l, type, u);
                if (PROBE_SUB & 16) for (int v = F.vcu; v < 256; v += F.G) { const int b = v >> 7, ch = (v >> 3) & 15; lru_unit<2>(F, l, NCTX + b * LSEQ + ch * 256, v & 7, ch == 0, ch == 15, b, ch, 0); } }
            if (PROBE_PH == 5) { pg8::Gemm g{(const h16*)(F.ws + WS_H), (const h16*)(F.ws + WS_W + W_IN) + (size_t)NMAIN * DM, NTOK, NGATE, DM, DM}; pg8::StaticOrder S; S.init(NTOK, NGATE, F.G, (int)blockIdx.x);
                pg8::EpiF16<1> E{(h16*)(F.ws + WS_ZU), NGATE}; pg8::gemm_phase<pg8::EpiF16<1>, pg8::StaticOrder, true, true>(F.lds, g, S, E); }
            if (PROBE_PH == 6) { pg8::StaticOrder S; S.init(NTOK, DM, F.G, (int)blockIdx.x);
                h16* Hb = (h16*)(F.ws + WS_H); const h16* Gb = (const h16*)(F.ws + WS_ZU);
                { pg8::Gemm g{(const h16*)(F.ws + WS_ZU + ZU_OA), (const h16*)(F.ws + WS_W + W_OA), NTOK, DM, 1024, 1024}; pg8::EpiGateMul<0> E{Hb, Gb, 0};
                  pg8::gemm_phase<pg8::EpiGateMul<0>, pg8::StaticOrder, true, true>(F.lds, g, S, E); }
                { pg8::Gemm g{(const h16*)(F.ws + WS_ZU + ZU_OB), (const h16*)(F.ws + WS_W + W_OB), NTOK, DM, 512, 512}; pg8::EpiGateMul<1> E{Hb, Gb, 1024};
                  pg8::gemm_phase<pg8::EpiGateMul<1>, pg8::StaticOrder, true, true>(F.lds, g, S, E); }
                { pg8::Gemm g{(const h16*)(F.ws + WS_ZU + ZU_OC), (const h16*)(F.ws + WS_W + W_OC), NTOK, DM, 512, 512}; pg8::EpiGateMul<1> E{Hb, Gb, 2048};
                  pg8::gemm_phase<pg8::EpiGateMul<1>, pg8::StaticOrder, true, true>(F.lds, g, S, E); } }
            if (PROBE_PH == 7) { pg8::Gemm g{(const h16*)(F.ws + WS_H), (const h16*)(F.ws + WS_W + W_OUT), NTOK, DM, DM, DM}; pg8::StaticOrder S; S.init(NTOK, DM, F.G, (int)blockIdx.x);
                pg8::EpiRes E{F.out + O_Y, F.out + O_Y + (size_t)NCTX * DM, (float*)(F.ws + WS_ZU), (const float*)(F.ws + WS_MOD) + (size_t)l * 3 * 6144 + 2 * 1024};
                pg8::gemm_phase<pg8::EpiRes, pg8::StaticOrder, true, true>(F.lds, g, S, E); }
            if (PROBE_PH == 9) { pg8::Gemm g{(const h16*)(F.ws + WS_H), (const h16*)(F.ws + WS_W + W_UP), NTOK, DUP, DM, DM}; pg8::StaticOrder S; S.init(NTOK, DUP, F.G, (int)blockIdx.x);
                pg8::EpiF16<0> E{(h16*)(F.ws + WS_ZU), DUP}; pg8::gemm_phase<pg8::EpiF16<0>, pg8::StaticOrder, true, true>(F.lds, g, S, E); }
            if (PROBE_PH == 10) { phase_ffn_act(F, l); }
            if (PROBE_PH == 11) { pg8::Gemm g{(const h16*)(F.ws + WS_ZU) + DFF, (const h16*)(F.ws + WS_W + W_DOWN), NTOK, DM, DFF, DUP}; pg8::StaticOrder S; S.init(NTOK, DM, F.G, (int)blockIdx.x);
                pg8::EpiRes E{F.out + O_Y, F.out + O_Y + (size_t)NCTX * DM, (float*)(F.ws + WS_H), (const float*)(F.ws + WS_MOD) + (size_t)l * 3 * 6144 + 5 * 1024};
                pg8::gemm_phase<pg8::EpiRes, pg8::StaticOrder, true, true>(F.lds, g, S, E); }
            if (PROBE_PH == 13) { }
        }
    }
#endif
#undef IN
#undef SEAM
}

extern "C" void kernel_launch(void* const* d_in, const int* in_sizes, int n_in, void* d_out, int out_size, void* d_ws, size_t ws_size, hipStream_t stream) {
    static int grid = 0;
    if (grid == 0) {
        if (n_in != 33 || out_size != (int)O_END || ws_size < WS_END) { fprintf(stderr, "kernel_launch: unexpected shapes: n_in %d out %d ws %zu (need %zu)\n", n_in, out_size, ws_size, (size_t)WS_END); grid = -1; return; }
        int dev = 0, cus = 0;
        if (hipGetDevice(&dev) != hipSuccess || hipDeviceGetAttribute(&cus, hipDeviceAttributeMultiprocessorCount, dev) != hipSuccess) { grid = -1; return; }
        if (hipFuncSetAttribute((const void*)fwd_kernel, hipFuncAttributeMaxDynamicSharedMemorySize, LDS_BYTES) != hipSuccess) { fprintf(stderr, "kernel_launch: hipFuncSetAttribute failed\n"); grid = -1; return; }
        (void)hipGetLastError();
        grid = cus;
    }
    if (grid < 0) return;
    (void)hipMemsetAsync((char*)d_ws + WS_CTL, 0, CTL_ZERO_BYTES, stream);
    Args a{};
    for (int i = 0; i < 33; ++i) a.in[i] = (const float*)d_in[i];
    a.out = (float*)d_out; a.ws = (unsigned char*)d_ws;
#if MK_PER_PHASE
    for (int ph = 0; ph < N_PHASES; ++ph) { a.ph_lo = ph; a.ph_hi = ph + 1; hipLaunchKernelGGL(fwd_kernel, dim3(grid), dim3(NTHREADS), LDS_BYTES, stream, a); }
#else
    a.ph_lo = 0; a.ph_hi = N_PHASES;
    hipLaunchKernelGGL(fwd_kernel, dim3(grid), dim3(NTHREADS), LDS_BYTES, stream, a);
#endif
}
```

```cpp
#include <hip/hip_runtime.h>
#include <cstdio>
#include <cstdint>
#include <cmath>

#ifndef MK_PER_PHASE
#define MK_PER_PHASE 0
#endif

#define LAS __attribute__((address_space(3)))
#define GAS __attribute__((address_space(1)))
typedef _Float16 h16;
typedef _Float16 h16x8 __attribute__((ext_vector_type(8)));
typedef _Float16 h16x4 __attribute__((ext_vector_type(4)));
typedef _Float16 h16x2 __attribute__((ext_vector_type(2)));
typedef short s16x4 __attribute__((ext_vector_type(4)));
typedef float f32x2 __attribute__((ext_vector_type(2)));
typedef float f32x4 __attribute__((ext_vector_type(4)));
typedef float f32x16 __attribute__((ext_vector_type(16)));
typedef unsigned u32x2 __attribute__((ext_vector_type(2)));
typedef unsigned u32x4 __attribute__((ext_vector_type(4)));

constexpr int DM = 1024, NTOK = 16384, NCTX = 8192, SEQ = 256, LSEQ = 4096, NB_CTX = 32, NB_LAT = 2, DEPTH = 2;
constexpr int DIN = 6656, NMAIN = 3584, NGATE = 3072, DFF = 2816, DUP = 5632, DLRU = 1024;
constexpr int C_XA = 0, C_YA = 1024, C_QB = 2048, C_KB = 2560, C_VB = 2688, C_QC = 2816, C_KC = 3328, C_VC = 3456;
constexpr float NORM_EPS = 1e-6f;
constexpr float LOG2E = 1.4426950408889634f;
constexpr float QSCALE = 0.125f * LOG2E;
constexpr size_t O_Y = 0, O_KB = 16777216, O_VB = 18874368, O_KC = 20971520, O_VC = 23068672, O_LRU = 25165824, O_END = 25296896;
constexpr size_t MiB = 1u << 20;
constexpr size_t WS_CTL = 0, CTL_ZERO_BYTES = 64 * 1024;
constexpr size_t WS_MOD = 1 * MiB;
constexpr size_t WS_ROPE = 1 * MiB + 256 * 1024;
constexpr size_t WS_AGG = 1 * MiB + 320 * 1024;
constexpr size_t WS_CACHE = 2 * MiB;
constexpr size_t WS_W = 3 * MiB;
constexpr size_t W_IN = 0, W_OA = W_IN + (size_t)DIN * DM * 2, W_OB = W_OA + (size_t)DM * 1024 * 2, W_OC = W_OB + (size_t)DM * 512 * 2,
                 W_OUT = W_OC + (size_t)DM * 512 * 2, W_UP = W_OUT + (size_t)DM * DM * 2, W_DOWN = W_UP + (size_t)DUP * DM * 2,
                 W_LRU = W_DOWN + (size_t)DM * DFF * 2, W_END = W_LRU + (size_t)2 * 2 * 8 * 128 * 128 * 2;
static_assert(W_END <= 37 * MiB, "weights region");
constexpr size_t WS_H = 40 * MiB;
constexpr size_t WS_ZU = 72 * MiB;
constexpr size_t ZU_OA = (size_t)NTOK * NMAIN * 2, ZU_OB = ZU_OA + (size_t)NTOK * 1024 * 2, ZU_OC = ZU_OB + (size_t)NTOK * 512 * 2;
constexpr size_t WS_END = WS_ZU + (size_t)NTOK * DUP * 2;
static_assert(WS_END == 248 * MiB, "ws map");

__device__ __forceinline__ unsigned pk_h2(float lo, float hi) { f32x2 v = {lo, hi}; h16x2 h = __builtin_convertvector(v, h16x2); return __builtin_bit_cast(unsigned, h); }
__device__ __forceinline__ void unpack8(u32x4 w, float* x) { h16x8 h = __builtin_bit_cast(h16x8, w);
#pragma unroll
    for (int j = 0; j < 8; ++j) x[j] = (float)h[j]; }
__device__ __forceinline__ u32x4 pack8(const float* x) { u32x4 w; w.x = pk_h2(x[0], x[1]); w.y = pk_h2(x[2], x[3]); w.z = pk_h2(x[4], x[5]); w.w = pk_h2(x[6], x[7]); return w; }
__device__ __forceinline__ float fast_exp2(float x) { return __builtin_amdgcn_exp2f(x); }
__device__ __forceinline__ float fast_rcp(float x) { return __builtin_amdgcn_rcpf(x); }
__device__ __forceinline__ float sigmoidf_(float x) { return fast_rcp(1.0f + fast_exp2(-LOG2E * x)); }
__device__ __forceinline__ float gelu_tanh(float x) { const float t = x + 0.044715f * x * x * x; return x * fast_rcp(1.0f + fast_exp2(-2.0f * 0.7978845608028654f * LOG2E * t)); }
__device__ __forceinline__ float wave_sum(float v) {
#pragma unroll
    for (int o = 1; o < 64; o <<= 1) v += __shfl_xor(v, o);
    return v;
}

namespace pg8 {
constexpr int BM = 256, BK = 64, HALF = 128, HTB = HALF * BK * 2, STAGE_BYTES = 8 * HTB, NXCD = 8, WGM = 8;
__host__ __device__ __forceinline__ int lds_byte(int r, int c) { const int st = (r >> 4) * 2 + (c >> 5), rr = r & 15, cc = c & 31, ob = rr * 64 + cc * 2; return st * 1024 + (ob ^ (((ob >> 9) & 1) << 5)); }
__host__ __device__ __forceinline__ void stage_rc(int b, int& R, int& C) { const int st = b / 1024, sb = b % 1024, swz = sb ^ (((sb >> 9) & 1) << 5); R = (st >> 1) * 16 + swz / 64; C = (st & 1) * 32 + (swz % 64) / 2; }
__host__ __device__ __forceinline__ int perm32(int rho) { const int n = rho >> 4, i = rho & 15; return 8 * (i >> 2) + 4 * n + (i & 3); }
struct Unit { int pm, pn; };
struct Gemm { const h16* A; const h16* Bt; int M, N, K, lda; };
struct StaticOrder {
    int nM, nN, nwg, G, c;
    __host__ __device__ void init(int M, int N, int G_, int c_) { nM = M / BM; nN = N / BM; nwg = nM * nN; G = G_; c = c_; }
    __host__ __device__ bool next(int i, Unit& u) const {
        const long L = (long)i * G + c; if (L >= nwg) return false;
        int wgid = (int)L; { const int q = nwg / NXCD, r = nwg % NXCD, xcd = wgid % NXCD, off = wgid / NXCD; wgid = (xcd < r ? xcd * (q + 1) : r * (q + 1) + (xcd - r) * q) + off; }
        const int nig = WGM * nN, gid = wgid / nig, fm = gid * WGM, gsz = (nM - fm) < WGM ? (nM - fm) : WGM;
        u.pm = fm + ((wgid % nig) % gsz); u.pn = (wgid % nig) / gsz; return true;
    }
    __device__ __forceinline__ void a_ready(const Unit&) const {}
    __device__ __forceinline__ void done(const Unit&) const {}
};

template <int ACT> struct EpiF16 {
    static constexpr bool PERM = true, AFTER_DRAIN = false;
    h16* O; int ldc;
    __device__ __forceinline__ void operator()(const f32x4 (&acc)[2][2][4][2], const Unit& u, int wr, int wc, int fr, int fq) const {
        const int row0 = u.pm * BM + wr * 64 + fr, col0 = u.pn * BM + wc * 32 + 8 * fq;
#pragma unroll
        for (int ai = 0; ai < 2; ++ai)
#pragma unroll
            for (int m = 0; m < 4; ++m) { h16* rowp = O + (size_t)(row0 + ai * HALF + m * 16) * ldc + col0;
#pragma unroll
                for (int bj = 0; bj < 2; ++bj) { f32x4 v0 = acc[ai][bj][m][0], v1 = acc[ai][bj][m][1];
                    if (ACT == 1) {
#pragma unroll
                        for (int j = 0; j < 4; ++j) { v0[j] = sigmoidf_(v0[j]); v1[j] = sigmoidf_(v1[j]); } }
                    u32x4 w; w.x = pk_h2(v0[0], v0[1]); w.y = pk_h2(v0[2], v0[3]); w.z = pk_h2(v1[0], v1[1]); w.w = pk_h2(v1[2], v1[3]);
                    *(u32x4*)(rowp + bj * HALF) = w; } }
    }
};
template <int ACCUM> struct EpiGateMul {
    static constexpr bool PERM = true, AFTER_DRAIN = false;
    h16* Mg; const h16* G; int gcol0;
    __device__ __forceinline__ void operator()(const f32x4 (&acc)[2][2][4][2], const Unit& u, int wr, int wc, int fr, int fq) const {
        const int row0 = u.pm * BM + wr * 64 + fr, col0 = u.pn * BM + wc * 32 + 8 * fq;
#pragma unroll
        for (int ai = 0; ai < 2; ++ai)
#pragma unroll
            for (int m = 0; m < 4; ++m) { const size_t row = (size_t)(row0 + ai * HALF + m * 16);
#pragma unroll
                for (int bj = 0; bj < 2; ++bj) {
                    const u32x4 gw = *(const u32x4*)(G + row * NGATE + gcol0 + col0 + bj * HALF);
                    float g[8]; unpack8(gw, g);
                    float o[8];
                    if (ACCUM) { const u32x4 mw = *(const u32x4*)(Mg + row * DM + col0 + bj * HALF); unpack8(mw, o); }
                    else {
#pragma unroll
                        for (int j = 0; j < 8; ++j) o[j] = 0.f; }
                    const f32x4 v0 = acc[ai][bj][m][0], v1 = acc[ai][bj][m][1];
#pragma unroll
                    for (int j = 0; j < 4; ++j) { o[j] += g[j] * v0[j]; o[4 + j] += g[4 + j] * v1[j]; }
                    *(u32x4*)(Mg + row * DM + col0 + bj * HALF) = pack8(o); }
                asm volatile("" ::: "memory"); }
    }
};
struct EpiRes {
    static constexpr bool PERM = false, AFTER_DRAIN = false;
    const float* base_ctx; const float* base_lat; float* X; const float* gate;
    __device__ __forceinline__ void operator()(const f32x4 (&acc)[2][2][4][2], const Unit& u, int wr, int wc, int fr, int fq) const {
        const int cond = u.pm < 32 ? 0 : (u.pm < 48 ? 1 : 2);
        const float* gp = gate + (size_t)cond * 6144;
        const float* bp = u.pm < 32 ? base_ctx + (size_t)u.pm * BM * DM : base_lat + (size_t)(u.pm - 32) * BM * DM;
        float* xp = X + (size_t)u.pm * BM * DM;
        const int r0 = wr * 64 + fr, col0 = u.pn * BM + wc * 32 + 4 * fq;
#pragma unroll
        for (int ai = 0; ai < 2; ++ai)
#pragma unroll
            for (int m = 0; m < 4; ++m) { const size_t off = (size_t)(r0 + ai * HALF + m * 16) * DM + col0;
#pragma unroll
                for (int bj = 0; bj < 2; ++bj)
#pragma unroll
                    for (int n = 0; n < 2; ++n) { const f32x4 b = *(const f32x4*)(bp + off + bj * HALF + n * 16); const f32x4 gvv = *(const f32x4*)(gp + col0 + bj * HALF + n * 16);
                        *(f32x4*)(xp + off + bj * HALF + n * 16) = b + gvv * acc[ai][bj][m][n]; }
                asm volatile("" ::: "memory"); }
    }
};

template <class Epi, class Sched, bool ALIGN_EPI = false, bool SP2 = false>
__device__ __forceinline__ void gemm_phase(LAS unsigned char* lds, const Gemm g, const Sched& S, const Epi& E) {
    int tid_ = threadIdx.x; asm volatile("" : "+v"(tid_));
    const int tid = tid_, wid = __builtin_amdgcn_readfirstlane(tid >> 6), lane = tid & 63, wr = wid >> 2, wc = wid & 3, fr = lane & 15, fq = lane >> 4;
    const int K = g.K, nt = K / BK, lda = g.lda;
    unsigned voffA[2], voffB[2];
#pragma unroll
    for (int i = 0; i < 2; ++i) { int R, C; stage_rc(tid * 16 + i * 8192, R, C); const int Rb = Epi::PERM ? ((R & ~31) + perm32(R & 31)) : R;
        voffA[i] = (unsigned)(R * lda + C) * 2u; voffB[i] = (unsigned)(Rb * K + C) * 2u; }
    const size_t kstep = (size_t)(BK * 2);
    const size_t hstepA = (size_t)HALF * lda * 2, hstepB = (size_t)HALF * K * 2;
    const size_t tstepA = 2 * hstepA, tstepB = 2 * hstepB;
    const unsigned ldsw = (unsigned)wid * 1024u;
    const int aoff = lds_byte(wr * 64 + fr, fq * 8), boff = lds_byte(wc * 32 + fr, fq * 8);
#define PG8_SA(b, h) (((b) * 2 + (h)) * HTB)
#define PG8_SB(b, h) ((4 + (b) * 2 + (h)) * HTB)
#define PG8_STAGE(bufoff, gbase, voff) do { _Pragma("unroll") for (int _i = 0; _i < 2; ++_i) \
        __builtin_amdgcn_global_load_lds((const unsigned*)((const char*)(gbase) + (voff)[_i]), (LAS unsigned*)(lds + (bufoff) + ldsw + _i * 8192), 16, 0, 0); } while (0)
#define PG8_LDA(dst, b, h) do { _Pragma("unroll") for (int m = 0; m < 4; ++m) _Pragma("unroll") for (int k = 0; k < 2; ++k) dst[m][k] = *(const LAS h16x8*)(lds + PG8_SA(b, h) + aoff + m * 2048 + k * 1024); } while (0)
#define PG8_LDB(dst, b, h) do { _Pragma("unroll") for (int n = 0; n < 2; ++n) _Pragma("unroll") for (int k = 0; k < 2; ++k) dst[n][k] = *(const LAS h16x8*)(lds + PG8_SB(b, h) + boff + n * 2048 + k * 1024); } while (0)
#define PG8_MMA(ai, bj, At, Bt) do { __builtin_amdgcn_s_setprio(1); _Pragma("unroll") for (int m = 0; m < 4; ++m) _Pragma("unroll") for (int n = 0; n < 2; ++n) _Pragma("unroll") for (int k = 0; k < 2; ++k) \
        acc[ai][bj][m][n] = __builtin_amdgcn_mfma_f32_16x16x32_f16(Bt[n][k], At[m][k], acc[ai][bj][m][n], 0, 0, 0); __builtin_amdgcn_s_setprio(0); } while (0)
#define PG8_WAIT_V(n) asm volatile("s_waitcnt vmcnt(" #n ")" ::: "memory")
#define PG8_WAIT_L(n) asm volatile("s_waitcnt lgkmcnt(" #n ")" ::: "memory")
#define PG8_BAR __builtin_amdgcn_s_barrier()
#define PG8_SCHED __builtin_amdgcn_sched_barrier(0)
    Unit cur, nxt; int ui = 0;
    if (!S.next(0, cur)) return;
    f32x4 acc[2][2][4][2];
#pragma unroll
    for (int a = 0; a < 2; ++a)
#pragma unroll
        for (int b = 0; b < 2; ++b)
#pragma unroll
            for (int m = 0; m < 4; ++m)
#pragma unroll
                for (int n = 0; n < 2; ++n) acc[a][b][m][n] = (f32x4){0.f, 0.f, 0.f, 0.f};
    h16x8 At[4][2], B0[2][2], B1[2][2];
    const char* cA = (const char*)g.A + (size_t)cur.pm * tstepA; const char* cB = (const char*)g.Bt + (size_t)cur.pn * tstepB;
    S.a_ready(cur);
    if constexpr (SP2) {
        PG8_STAGE(PG8_SB(0, 0), cB, voffB); PG8_STAGE(PG8_SB(0, 1), cB + hstepB, voffB); PG8_STAGE(PG8_SA(0, 0), cA, voffA); PG8_STAGE(PG8_SA(0, 1), cA + hstepA, voffA);
        if (wr == 1) PG8_BAR;
        PG8_WAIT_V(2); PG8_BAR;
        PG8_STAGE(PG8_SB(1, 0), cB + kstep, voffB); PG8_STAGE(PG8_SA(1, 0), cA + kstep, voffA); PG8_STAGE(PG8_SB(1, 1), cB + hstepB + kstep, voffB);
        PG8_WAIT_V(6); PG8_BAR;
    } else {
        PG8_STAGE(PG8_SB(0, 0), cB, voffB); PG8_STAGE(PG8_SA(0, 0), cA, voffA); PG8_STAGE(PG8_SB(0, 1), cB + hstepB, voffB); PG8_STAGE(PG8_SA(0, 1), cA + hstepA, voffA);
        if (wr == 1) PG8_BAR;
        PG8_WAIT_V(4); PG8_BAR;
        PG8_STAGE(PG8_SB(1, 0), cB + kstep, voffB); PG8_STAGE(PG8_SA(1, 0), cA + kstep, voffA); PG8_STAGE(PG8_SB(1, 1), cB + hstepB + kstep, voffB);
        PG8_WAIT_V(6); PG8_BAR;
    }
    for (;;) {
        const bool has_next = S.next(ui + 1, nxt);
        const char* nA = has_next ? (const char*)g.A + (size_t)nxt.pm * tstepA : cA; const char* nB = has_next ? (const char*)g.Bt + (size_t)nxt.pn * tstepB : cB;
        for (int t = 0; t < nt; t += 2) {
            const bool last = (t == nt - 2);
            const char* a1 = cA + (size_t)(t + 1) * kstep;
            const char* a2 = last ? nA : cA + (size_t)(t + 2) * kstep; const char* b2 = last ? nB : cB + (size_t)(t + 2) * kstep;
            const char* a3 = a2 + kstep; const char* b3 = b2 + kstep;
            if (last && has_next) S.a_ready(nxt);
            if constexpr (SP2) {
            PG8_LDB(B0, 0, 0); PG8_LDB(B1, 0, 1); PG8_SCHED; PG8_LDA(At, 0, 0); PG8_STAGE(PG8_SA(1, 1), a1 + hstepA, voffA);
            PG8_WAIT_V(8); PG8_WAIT_L(0); PG8_BAR; PG8_MMA(0, 0, At, B0); PG8_MMA(0, 1, At, B1); PG8_BAR; PG8_SCHED;
            PG8_LDA(At, 0, 1); PG8_STAGE(PG8_SB(0, 0), b2, voffB); PG8_STAGE(PG8_SB(0, 1), b2 + hstepB, voffB); PG8_STAGE(PG8_SA(0, 0), a2, voffA);
            PG8_WAIT_V(8); PG8_WAIT_L(0); PG8_BAR; PG8_MMA(1, 0, At, B0); PG8_MMA(1, 1, At, B1); PG8_BAR; PG8_SCHED;
            PG8_LDB(B0, 1, 0); PG8_LDB(B1, 1, 1); PG8_SCHED; PG8_LDA(At, 1, 0); PG8_STAGE(PG8_SA(0, 1), a2 + hstepA, voffA);
            PG8_WAIT_V(8); PG8_WAIT_L(0); PG8_BAR; PG8_MMA(0, 0, At, B0); PG8_MMA(0, 1, At, B1); PG8_BAR; PG8_SCHED;
            PG8_LDA(At, 1, 1); PG8_STAGE(PG8_SB(1, 0), b3, voffB); PG8_STAGE(PG8_SB(1, 1), b3 + hstepB, voffB); PG8_STAGE(PG8_SA(1, 0), a3, voffA);
            PG8_WAIT_V(8); PG8_WAIT_L(0); PG8_BAR; PG8_MMA(1, 0, At, B0); PG8_MMA(1, 1, At, B1); PG8_BAR; PG8_SCHED;
            } else {
            PG8_LDB(B0, 0, 0); PG8_SCHED; PG8_LDA(At, 0, 0); PG8_STAGE(PG8_SA(1, 1), a1 + hstepA, voffA);
            PG8_WAIT_L(8); PG8_BAR; PG8_WAIT_L(0); PG8_MMA(0, 0, At, B0); PG8_BAR; PG8_SCHED;
            PG8_LDB(B1, 0, 1); PG8_STAGE(PG8_SB(0, 0), b2, voffB);
            PG8_BAR; PG8_WAIT_L(0); PG8_MMA(0, 1, At, B1); PG8_BAR;
            PG8_LDA(At, 0, 1); PG8_STAGE(PG8_SA(0, 0), a2, voffA);
            PG8_BAR; PG8_WAIT_L(0); PG8_MMA(1, 0, At, B0); PG8_BAR; PG8_SCHED;
            PG8_STAGE(PG8_SB(0, 1), b2 + hstepB, voffB);
            PG8_WAIT_V(6); PG8_BAR; PG8_MMA(1, 1, At, B1); PG8_BAR;
            PG8_LDB(B0, 1, 0); PG8_SCHED; PG8_LDA(At, 1, 0); PG8_STAGE(PG8_SA(0, 1), a2 + hstepA, voffA);
            PG8_WAIT_L(8); PG8_BAR; PG8_WAIT_L(0); PG8_MMA(0, 0, At, B0); PG8_BAR; PG8_SCHED;
            PG8_LDB(B1, 1, 1); PG8_STAGE(PG8_SB(1, 0), b3, voffB);
            PG8_BAR; PG8_WAIT_L(0); PG8_MMA(0, 1, At, B1); PG8_BAR;
            PG8_LDA(At, 1, 1); PG8_STAGE(PG8_SA(1, 0), a3, voffA);
            PG8_BAR; PG8_WAIT_L(0); PG8_MMA(1, 0, At, B0); PG8_BAR; PG8_SCHED;
            PG8_STAGE(PG8_SB(1, 1), b3 + hstepB, voffB);
            PG8_WAIT_V(6); PG8_BAR; PG8_MMA(1, 1, At, B1); PG8_BAR;
            }
        }
        if constexpr (ALIGN_EPI) { if (wr == 0) PG8_BAR; }
        if constexpr (!Epi::AFTER_DRAIN) { E(acc, cur, wr, wc, fr, fq); S.done(cur); }
        if (!has_next) break;
#pragma unroll
        for (int a = 0; a < 2; ++a)
#pragma unroll
            for (int b = 0; b < 2; ++b)
#pragma unroll
                for (int m = 0; m < 4; ++m)
#pragma unroll
                    for (int n = 0; n < 2; ++n) acc[a][b][m][n] = (f32x4){0.f, 0.f, 0.f, 0.f};
        cur = nxt; cA = nA; cB = nB; ++ui;
        if constexpr (ALIGN_EPI) { if (wr == 1) PG8_BAR; }
    }
    PG8_WAIT_V(0);
    if constexpr (!ALIGN_EPI) { if (wr == 0) PG8_BAR; }
    PG8_BAR;
#undef PG8_SA
#undef PG8_SB
#undef PG8_STAGE
#undef PG8_LDA
#undef PG8_LDB
#undef PG8_MMA
#undef PG8_WAIT_V
#undef PG8_WAIT_L
#undef PG8_BAR
#undef PG8_SCHED
}
}

constexpr int NWAVES = 8, NTHREADS = 512;
constexpr int RING_BYTES = 131072;
constexpr int LDSCTL_OFF = RING_BYTES, MISC_OFF = LDSCTL_OFF + 320;
constexpr int LDS_BYTES = 147456;

typedef GAS unsigned gu32;
#define RLX_AGENT __ATOMIC_RELAXED, __HIP_MEMORY_SCOPE_AGENT
#define LDS_WAIT() asm volatile("s_waitcnt lgkmcnt(0)" ::: "memory")
#define VM_WAIT() asm volatile("s_waitcnt vmcnt(0)" ::: "memory")

#define XB_TMO      128
#define XB_XCNT(j)  (256  + 64 * (j))
#define XB_XSUB(j)  (1280 + 64 * (j))
#define XB_XGEN(j)  (2304 + 64 * (j))
#define XB_TOP      3328
#define XB_TOPGEN   3392
#define XCD_BAR_WORDS 3456
#define XB_SPIN_CAP (1u << 18)
__device__ __forceinline__ unsigned xb_ld(unsigned* p)              { return __hip_atomic_load(p, __ATOMIC_RELAXED, __HIP_MEMORY_SCOPE_AGENT); }
__device__ __forceinline__ unsigned xb_add(unsigned* p, unsigned v) { return __hip_atomic_fetch_add(p, v, __ATOMIC_RELAXED, __HIP_MEMORY_SCOPE_AGENT); }
__device__ __forceinline__ unsigned xb_xcc_id() { return (unsigned)__builtin_amdgcn_s_getreg((3 << 11) | 20) & 0xFu; }
#define XB_SPIN(cond, bar) do { unsigned _sp = 0; while (cond) { __builtin_amdgcn_s_sleep(1); \
    if ((++_sp & 255u) == 0u) { if (xb_ld(&(bar)[XB_TMO])) break; if (_sp > XB_SPIN_CAP) { atomicAdd(&(bar)[XB_TMO], 1u); break; } } } } while (0)
struct XcdBarrier { unsigned* bar; unsigned x; volatile LAS unsigned* st; };
__device__ __forceinline__ XcdBarrier xcd_barrier_post(unsigned* bar, volatile LAS unsigned* st) {
    XcdBarrier b; b.bar = bar; b.x = xb_xcc_id(); b.st = st;
    if (threadIdx.x == 0) (void)xb_add(&bar[XB_XCNT(b.x)], 1u);
    return b;
}
__device__ __forceinline__ void xcd_barrier_complete(unsigned* bar, unsigned x, unsigned& nloc, unsigned& nx) {
    const unsigned G = gridDim.x * gridDim.y * gridDim.z;
    unsigned sum, cnt, mine, sp = 0u;
    for (;;) {
        sum = 0u; cnt = 0u; mine = 0u;
#pragma unroll
        for (unsigned j = 0; j < 16; ++j) { const unsigned c = xb_ld(&bar[XB_XCNT(j)]); sum += c; cnt += (c > 0u) ? 1u : 0u; mine = (j == x) ? c : mine; }
        if (sum == G) break;
        __builtin_amdgcn_s_sleep(1);
        if ((++sp & 255u) == 0u) { if (xb_ld(&bar[XB_TMO])) break; if (sp > XB_SPIN_CAP) { atomicAdd(&bar[XB_TMO], 1u); break; } }
    }
    nloc = mine > 0u ? mine : 1u; nx = cnt > 0u ? cnt : 1u;
}
__device__ __forceinline__ void xcd_barrier(const XcdBarrier& b) {
    asm volatile("s_waitcnt vmcnt(0)" ::: "memory");
    __syncthreads();
    if (threadIdx.x == 0) {
        unsigned* bar = b.bar;
        __builtin_amdgcn_s_waitcnt(0);
        unsigned nloc = b.st[0], nx = b.st[1];
        if (nloc == 0u) { xcd_barrier_complete(bar, b.x, nloc, nx); b.st[0] = nloc; b.st[1] = nx; }
        const unsigned old = xb_add(&bar[XB_XSUB(b.x)], 1u);
        const unsigned gen = old / nloc;
        if (old + 1u == (gen + 1u) * nloc) {
            __builtin_amdgcn_fence(__ATOMIC_RELEASE, "agent");
            asm volatile("s_waitcnt vmcnt(0)" ::: "memory");
            const unsigned og = xb_add(&bar[XB_TOP], 1u);
            const unsigned tg = og / nx;
            if (og + 1u == (tg + 1u) * nx) xb_add(&bar[XB_TOPGEN], 1u);
            else XB_SPIN(xb_ld(&bar[XB_TOPGEN]) == tg, bar);
            __builtin_amdgcn_fence(__ATOMIC_ACQUIRE, "agent");
            xb_add(&bar[XB_XGEN(b.x)], 1u);
            asm volatile("s_waitcnt vmcnt(0)" ::: "memory");
        } else {
            XB_SPIN(xb_ld(&bar[XB_XGEN(b.x)]) == gen, bar);
            __builtin_amdgcn_fence(__ATOMIC_ACQUIRE, "agent");
            asm volatile("s_waitcnt vmcnt(0)" ::: "memory");
        }
    }
    __syncthreads();
}
constexpr int CW_BAR = 4096;
static_assert((CW_BAR + XCD_BAR_WORDS) * 4 <= (int)CTL_ZERO_BYTES, "ctl");

struct Args {
    const float* in[33]; float* out; unsigned char* ws; int ph_lo, ph_hi;
};
typedef const GAS float* cfp_t;
struct Frame {
    LAS unsigned char* lds;
    int tid, lane, wave, vcu, G;
    const __attribute__((address_space(4))) cfp_t* in; float* out; unsigned char* ws; float* out0; unsigned char* ws0;
    __device__ __forceinline__ const float* inp(int i) const { return (const float*)in[i]; }
    __device__ __forceinline__ void refresh() { int t = threadIdx.x; asm volatile("" : "+v"(t)); tid = t; lane = t & 63; wave = __builtin_amdgcn_readfirstlane(t >> 6);
        const __attribute__((address_space(4))) cfp_t* p = (const __attribute__((address_space(4))) cfp_t*)__builtin_amdgcn_kernarg_segment_ptr(); asm volatile("" : "+s"(p)); in = p;
        GAS float* o_ = (GAS float*)out0; GAS unsigned char* w_ = (GAS unsigned char*)ws0; asm volatile("" : "+s"(o_), "+s"(w_)); out = (float*)o_; ws = (unsigned char*)w_; }
};
enum { I_XP = 0, I_XS, I_C, I_CKB, I_CVB, I_CKC, I_CVC, I_STATE, I_CCTX, I_N1G, I_N2G, I_WMOD, I_BMOD, I_WIN, I_LCW, I_LCB, I_LWA, I_LBA, I_LWX, I_LBX, I_LAM,
       I_QNG, I_KNG, I_SINK, I_WOA, I_WOB, I_WOC, I_WOUT, I_WUP, I_FCW, I_FCB, I_WDOWN, I_FING };

__device__ __forceinline__ void transpose_item(const float* W, int K, int N, h16* WT, LAS float* scr, int item, int lane) {
    const int nblk = N / 32, kb = item / nblk, nb = item % nblk, k0 = 64 * kb, n0 = 32 * nb;
#pragma unroll 8
    for (int i = 0; i < 32; ++i) { const int kk = 2 * i + (lane >> 5); scr[kk * 33 + (lane & 31)] = W[(size_t)(k0 + kk) * N + n0 + (lane & 31)]; }
    LDS_WAIT(); asm volatile("" ::: "memory");
    const int c = lane & 7;
#pragma unroll
    for (int j = 0; j < 4; ++j) { const int n = (lane >> 3) + 8 * j; const LAS float* s = scr + (8 * c) * 33 + n;
        u32x4 o; o.x = pk_h2(s[0 * 33], s[1 * 33]); o.y = pk_h2(s[2 * 33], s[3 * 33]); o.z = pk_h2(s[4 * 33], s[5 * 33]); o.w = pk_h2(s[6 * 33], s[7 * 33]);
        *(u32x4*)(WT + (size_t)(n0 + n) * K + k0 + 8 * c) = o; }
    LDS_WAIT(); asm volatile("" ::: "memory");
}
__device__ __forceinline__ void phase_convert_weights(Frame& F, int l) {
    LAS float* scr = (LAS float*)(F.lds + F.wave * 16384);
    const int gw = F.vcu * NWAVES + F.wave, NGW = F.G * NWAVES;
    unsigned char* wb = F.ws + WS_W;
    constexpr int IT_IN = (DM / 64) * (DIN / 32), IT_OA = (1024 / 64) * (DM / 32), IT_OB = (512 / 64) * (DM / 32), IT_OUT = (DM / 64) * (DM / 32),
                  IT_UP = (DM / 64) * (DUP / 32), IT_DOWN = (DFF / 64) * (DM / 32), IT_LRU1 = (128 / 64) * (128 / 32), IT_LRU = 32 * IT_LRU1;
    constexpr int NITEMS = IT_IN + IT_OA + 2 * IT_OB + IT_OUT + IT_UP + IT_DOWN + IT_LRU;
    for (int it = gw; it < NITEMS; it += NGW) {
        int r = it;
        if (r < IT_IN) { transpose_item(F.inp(I_WIN) + (size_t)l * DM * DIN, DM, DIN, (h16*)(wb + W_IN), scr, r, F.lane); continue; } r -= IT_IN;
        if (r < IT_OA) { transpose_item(F.inp(I_WOA) + (size_t)l * 1024 * DM, 1024, DM, (h16*)(wb + W_OA), scr, r, F.lane); continue; } r -= IT_OA;
        if (r < IT_OB) { transpose_item(F.inp(I_WOB) + (size_t)l * 512 * DM, 512, DM, (h16*)(wb + W_OB), scr, r, F.lane); continue; } r -= IT_OB;
        if (r < IT_OB) { transpose_item(F.inp(I_WOC) + (size_t)l * 512 * DM, 512, DM, (h16*)(wb + W_OC), scr, r, F.lane); continue; } r -= IT_OB;
        if (r < IT_OUT) { transpose_item(F.inp(I_WOUT) + (size_t)l * DM * DM, DM, DM, (h16*)(wb + W_OUT), scr, r, F.lane); continue; } r -= IT_OUT;
        if (r < IT_UP) { transpose_item(F.inp(I_WUP) + (size_t)l * DM * DUP, DM, DUP, (h16*)(wb + W_UP), scr, r, F.lane); continue; } r -= IT_UP;
        if (r < IT_DOWN) { transpose_item(F.inp(I_WDOWN) + (size_t)l * DFF * DM, DFF, DM, (h16*)(wb + W_DOWN), scr, r, F.lane); continue; } r -= IT_DOWN;
        {
            const int mi = r / IT_LRU1, sub = r % IT_LRU1, dir = mi >> 4, gate = (mi >> 3) & 1, n = mi & 7;
            const float* src = (gate ? F.inp(I_LWX) : F.inp(I_LWA)) + ((size_t)((l * 2 + dir) * 8 + n)) * 128 * 128;
            transpose_item(src, 128, 128, (h16*)(wb + W_LRU) + (size_t)mi * 128 * 128, scr, sub, F.lane);
        }
    }
}
__device__ __forceinline__ void phase_prep_misc(Frame& F) {
    LAS float* sil = (LAS float*)F.lds;
    LAS float* part = (LAS float*)(F.lds + 16384);
    float* mod = (float*)(F.ws + WS_MOD);
    for (int item = F.vcu; item < 192; item += F.G) {
        const int l = item / 96, n0 = (item % 96) * 64;
        __syncthreads();
        for (int i = F.tid; i < 3 * 1024; i += NTHREADS) { const int j = i >> 10, k = i & 1023;
            const float v = j == 0 ? F.inp(I_CCTX)[k] : F.inp(I_C)[(j - 1) * 1024 + k]; sil[i] = v * sigmoidf_(v); }
        __syncthreads();
        const float* wp = F.inp(I_WMOD) + (size_t)l * DM * 6144 + n0 + F.lane;
        float a0 = 0.f, a1 = 0.f, a2 = 0.f;
        const int kb = F.wave * 128;
#pragma unroll 8
        for (int k = 0; k < 128; ++k) { const float w = wp[(size_t)(kb + k) * 6144]; a0 += w * sil[kb + k]; a1 += w * sil[1024 + kb + k]; a2 += w * sil[2048 + kb + k]; }
        part[(F.wave * 3 + 0) * 64 + F.lane] = a0; part[(F.wave * 3 + 1) * 64 + F.lane] = a1; part[(F.wave * 3 + 2) * 64 + F.lane] = a2;
        __syncthreads();
        if (F.tid < 192) { const int j = F.tid >> 6, c = F.tid & 63; float s = F.inp(I_BMOD)[l * 6144 + n0 + c];
#pragma unroll
            for (int w = 0; w < 8; ++w) s += part[(w * 3 + j) * 64 + c];
            mod[((size_t)l * 3 + j) * 6144 + n0 + c] = s; }
    }
    __syncthreads();
    const int gt = F.vcu * NTHREADS + F.tid, NGT = F.G * NTHREADS;
    float* rope = (float*)(F.ws + WS_ROPE);
    for (int i = gt; i < 64 * 16; i += NGT) { const int pos = i >> 4, fi = i & 15; const float inv = expf(-(float)fi * (1.0f / 16.0f) * 9.210340371976184f);
        const float ang = (float)pos * inv; rope[2 * i] = cosf(ang); rope[2 * i + 1] = sinf(ang); }
    h16* cache = (h16*)(F.ws + WS_CACHE);
    for (int i = gt; i < 4 * 131072 / 4; i += NGT) { const int kind = i / 32768, e = (i % 32768) * 4;
        const float* src = kind == 0 ? F.inp(I_CKB) : kind == 1 ? F.inp(I_CVB) : kind == 2 ? F.inp(I_CKC) : F.inp(I_CVC);
        const f32x4 v = *(const f32x4*)(src + e); u32x2 w; w.x = pk_h2(v[0], v[1]); w.y = pk_h2(v[2], v[3]); *(u32x2*)(cache + (size_t)kind * 131072 + e) = w; }
}

__device__ __forceinline__ const float* xrow_ptr(const Frame& F, int layer_src_is_input, int row) {
    if (layer_src_is_input) return row < NCTX ? F.inp(I_XP) + (size_t)row * DM : F.inp(I_XS) + (size_t)(row - NCTX) * DM;
    return F.out + O_Y + (size_t)row * DM;
}
__device__ __forceinline__ void phase_norm_mod(Frame& F, int from_input, const float* g, const float* mod_l, int shift_chunk) {
    const int gw = F.vcu * NWAVES + F.wave, NGW = F.G * NWAVES;
    h16* H = (h16*)(F.ws + WS_H);
    int cur_cond = -1; f32x4 gs[4], sh[4];
    for (int row = gw; row < NTOK; row += NGW) {
        const int cond = row < NCTX ? 0 : (row < NCTX + LSEQ ? 1 : 2);
        if (cond != cur_cond) { cur_cond = cond; const float* mp = mod_l + (size_t)cond * 6144;
#pragma unroll
            for (int j = 0; j < 4; ++j) { const int c = F.lane * 4 + 256 * j; const f32x4 gg = *(const f32x4*)(g + c); const f32x4 sc = *(const f32x4*)(mp + (shift_chunk + 1) * 1024 + c);
                gs[j] = gg * (sc + 1.0f); sh[j] = *(const f32x4*)(mp + shift_chunk * 1024 + c); } }
        const f32x4* xr = (const f32x4*)xrow_ptr(F, from_input, row) + F.lane;
        f32x4 v[4]; float s = 0.f;
#pragma unroll
        for (int j = 0; j < 4; ++j) { v[j] = xr[64 * j]; s += (v[j].x * v[j].x + v[j].y * v[j].y) + (v[j].z * v[j].z + v[j].w * v[j].w); }
        const float rstd = 1.0f / sqrtf(wave_sum(s) * (1.0f / DM) + NORM_EPS);
        u32x2* o8 = (u32x2*)(H + (size_t)row * DM) + F.lane;
#pragma unroll
        for (int j = 0; j < 4; ++j) { const f32x4 y = v[j] * rstd * gs[j] + sh[j]; u32x2 w; w.x = pk_h2(y.x, y.y); w.y = pk_h2(y.z, y.w); o8[64 * j] = w; }
    }
}
__device__ __forceinline__ void phase_final_norm(Frame& F) {
    const int gw = F.vcu * NWAVES + F.wave, NGW = F.G * NWAVES;
    f32x4 gg[4];
#pragma unroll
    for (int j = 0; j < 4; ++j) gg[j] = *(const f32x4*)(F.inp(I_FING) + F.lane * 4 + 256 * j);
    for (int row = gw; row < NTOK; row += NGW) {
        f32x4* xr = (f32x4*)(F.out + O_Y + (size_t)row * DM) + F.lane;
        f32x4 v[4]; float s = 0.f;
#pragma unroll
        for (int j = 0; j < 4; ++j) { v[j] = xr[64 * j]; s += (v[j].x * v[j].x + v[j].y * v[j].y) + (v[j].z * v[j].z + v[j].w * v[j].w); }
        const float rstd = 1.0f / sqrtf(wave_sum(s) * (1.0f / DM) + NORM_EPS);
#pragma unroll
        for (int j = 0; j < 4; ++j) xr[64 * j] = v[j] * rstd * gg[j];
    }
}

__device__ __forceinline__ void phase_qk(Frame& F, int l, bool write_out = true) {
    const int gw = F.vcu * NWAVES + F.wave, NGW = F.G * NWAVES, lane = F.lane;
    h16* Z = (h16*)(F.ws + WS_ZU);
    const float* rope = (const float*)(F.ws + WS_ROPE);
    const float* qg = F.inp(I_QNG) + l * 64; const float* kg = F.inp(I_KNG) + l * 64;
    const int hl = lane & 7, hc0 = hl * 8;
    float qgv[8], kgv[8];
#pragma unroll
    for (int j = 0; j < 8; ++j) { qgv[j] = qg[hc0 + j]; kgv[j] = kg[hc0 + j]; }
    for (int row = gw; row < NTOK; row += NGW) {
        const bool is_ctx = row < NCTX;
        int rpos = 0, cpos = 0, b = 0, t = 0;
        if (is_ctx) { b = row >> 8; t = row & 255; } else { const int tt = (row - NCTX) & (LSEQ - 1); rpos = tt >> 6; cpos = tt & 63; }
        h16* zr = Z + (size_t)row * NMAIN;
#pragma unroll
        for (int pass = 0; pass < 3; ++pass) {
            const int col = C_QB + pass * 512 + lane * 8;
            int kind;
            if (pass == 0) kind = 0; else if (pass == 1) kind = lane < 8 * 2 ? 1 : (lane < 8 * 4 ? 2 : 3); else kind = lane < 32 ? 3 : (lane < 48 ? 4 : 5);
            const u32x4 w = *(const u32x4*)(zr + col);
            float x[8]; unpack8(w, x);
            if (kind <= 1) {
                float s = 0.f;
#pragma unroll
                for (int j = 0; j < 8; ++j) s += x[j] * x[j];
                s += __shfl_xor(s, 1); s += __shfl_xor(s, 2); s += __shfl_xor(s, 4);
                const float rstd = 1.0f / sqrtf(s * (1.0f / 64.0f) + NORM_EPS);
#pragma unroll
                for (int j = 0; j < 8; ++j) x[j] = x[j] * rstd * (kind == 0 ? qgv[j] : kgv[j]);
            }
            if (!is_ctx) {
                float p[8];
#pragma unroll
                for (int j = 0; j < 8; ++j) p[j] = __shfl_xor(x[j], 2);
                if (kind == 0 || kind == 1 || kind == 3 || kind == 4) {
                    const int half = hl >> 2, second = (hl >> 1) & 1, f0 = (hl & 1) * 8, pos = half ? cpos : rpos;
                    const float* tp = rope + ((size_t)pos * 16 + f0) * 2;
#pragma unroll
                    for (int j = 0; j < 8; ++j) { const float cs = tp[2 * j], sn = tp[2 * j + 1]; x[j] = second ? (p[j] * sn + x[j] * cs) : (x[j] * cs - p[j] * sn); }
                }
            }
            if (kind == 0 || kind == 3) {
#pragma unroll
                for (int j = 0; j < 8; ++j) x[j] *= QSCALE;
            }
            if (kind != 2 && kind != 5) *(u32x4*)(zr + col) = pack8(x);
            if (write_out && is_ctx && (kind == 1 || kind == 2 || kind == 4 || kind == 5)) {
                const size_t ob = kind == 1 ? O_KB : kind == 2 ? O_VB : kind == 4 ? O_KC : O_VC;
                const int c128 = (kind == 1 || kind == 2) ? (col - (kind == 1 ? C_KB : C_VB)) : (col - (kind == 4 ? C_KC : C_VC));
                float* op = F.out + ob + ((size_t)((b * 2 + l) * 256 + t)) * 128 + c128;
                *(f32x4*)op = (f32x4){x[0], x[1], x[2], x[3]}; *(f32x4*)(op + 4) = (f32x4){x[4], x[5], x[6], x[7]};
            }
        }
    }
}

__device__ __forceinline__ int img_off(int row, int ch) { return row * 256 + ((((ch >> 3) ^ (row & 15)) << 4) | ((ch & 7) << 1)); }
template <int MODE, int DIR>
__device__ __forceinline__ void lru_scan(Frame& F, int l, int row0, int n, int lat_b, int lat_chunk, int ctx_b, bool write_out, int cb) {
    LAS unsigned char* img = F.lds; LAS unsigned char* hx = F.lds + 65536;
    const int lane = F.lane, r32 = lane & 31, hi = lane >> 5, hm = hi ^ DIR;
    const int C = n * 128 + cb * 32 + r32;
    h16x8 Br[8], Bi[8];
    {
        const h16* wr_ = (const h16*)(F.ws + WS_W + W_LRU) + ((size_t)((DIR * 2 + 0) * 8 + n) * 128 + cb * 32 + r32) * 128 + 8 * hi;
        const h16* wi_ = (const h16*)(F.ws + WS_W + W_LRU) + ((size_t)((DIR * 2 + 1) * 8 + n) * 128 + cb * 32 + r32) * 128 + 8 * hi;
#pragma unroll
        for (int ks = 0; ks < 8; ++ks) { Br[ks] = *(const h16x8*)(wr_ + 16 * ks); Bi[ks] = *(const h16x8*)(wi_ + 16 * ks); }
    }
    const float ba = F.inp(I_LBA)[(size_t)(l * 2 + DIR) * DLRU + C], bx = F.inp(I_LBX)[(size_t)(l * 2 + DIR) * DLRU + C];
    const float lam = F.inp(I_LAM)[(size_t)(l * 2 + DIR) * DLRU + C];
    const float sp = (-lam > 20.f) ? -lam : log1pf(expf(-lam));
    const float k8 = -8.0f * sp * LOG2E;
    const float nba = -LOG2E * ba, nbx = -LOG2E * bx;
    float H = 0.f, aggP = 1.f;
    if (MODE == 2) {
        const float* agg = (const float*)(F.ws + WS_AGG);
        H = F.inp(I_STATE)[(size_t)((lat_b * 2 + l) * 2 + DIR) * DLRU + C];
        float ap[15], au[15];
#pragma unroll
        for (int k = 0; k < 15; ++k) { const int ch = DIR == 0 ? k : 15 - k; const bool use = DIR == 0 ? (ch < lat_chunk) : (ch > lat_chunk);
            const float* p = agg + ((size_t)((lat_b * 16 + (use ? ch : 0)) * 2 + DIR) * DLRU + C) * 2; ap[k] = use ? p[0] : 1.f; au[k] = use ? p[1] : 0.f; }
#pragma unroll
        for (int k = 0; k < 15; ++k) H = ap[k] * H + au[k];
    }
    const int xch = cb * 4 + (r32 >> 3), xel = (r32 & 7) * 2;
    int lo8[8];
#pragma unroll
    for (int ci = 0; ci < 8; ++ci) { const int c = (ci & 3) + 8 * (ci >> 2); lo8[ci] = (((xch ^ (4 * hi)) ^ c) << 4) + xel + (4 * hi) * 256; }
#define LOFF(rn) (lo8s[((rn) & 3) + 4 * (((rn) >> 2) & 1)] + (8 * ((rn) >> 2) + ((rn) & 3)) * 256)
#pragma unroll 1
    for (int step = 0; step < 8; ++step) {
        if (step == 4) __syncthreads();
        const int rb = DIR == 0 ? step : 7 - step;
        int lo8s[8];
#pragma unroll
        for (int ci = 0; ci < 8; ++ci) lo8s[ci] = lo8[ci] + rb * 8192;
        f32x16 ar = {}, ai = {};
#pragma unroll
        for (int ks = 0; ks < 8; ++ks) {
            const h16x8 af = *(const LAS h16x8*)(img + (rb * 32 + r32) * 256 + (((2 * ks + hi) ^ (r32 & 15)) << 4));
            ar = __builtin_amdgcn_mfma_f32_32x32x16_f16(af, Br[ks], ar, 0, 0, 0);
            ai = __builtin_amdgcn_mfma_f32_32x32x16_f16(af, Bi[ks], ai, 0, 0, 0);
        }
        float an[16], un[16];
#pragma unroll
        for (int r = 0; r < 16; ++r) {
            const float xv = (float)*(const LAS h16*)(img + LOFF(r));
            const float rr = fast_rcp(1.0f + fast_exp2(__builtin_fmaf(ar[r], -LOG2E, nba)));
            const float ii = fast_rcp(1.0f + fast_exp2(__builtin_fmaf(ai[r], -LOG2E, nbx)));
            const float av = fast_exp2(k8 * rr);
            an[r] = av;
            un[r] = __builtin_amdgcn_sqrtf(__builtin_fmaf(-av, av, 1.0f)) * (ii * xv);
        }
#define SA(r) (DIR ? an[15 - (r)] : an[(r)])
#define SU(r) (DIR ? un[15 - (r)] : un[(r)])
        float Pe[4], Ue[4], Po[4], Uo[4];
#pragma unroll
        for (int g = 0; g < 4; ++g) {
            float p = 1.f, uu = 0.f;
#pragma unroll
            for (int i = 0; i < 4; ++i) { uu = SA(4 * g + i) * uu + SU(4 * g + i); p *= SA(4 * g + i); }
            const auto sp_ = __builtin_amdgcn_permlane32_swap(__float_as_uint(p), __float_as_uint(p), false, false);
            const auto su_ = __builtin_amdgcn_permlane32_swap(__float_as_uint(uu), __float_as_uint(uu), false, false);
            Pe[g] = __uint_as_float(sp_[DIR]); Po[g] = __uint_as_float(sp_[1 - DIR]); Ue[g] = __uint_as_float(su_[DIR]); Uo[g] = __uint_as_float(su_[1 - DIR]);
        }
        float Hs[4];
        {
            float h = H;
#pragma unroll
            for (int g = 0; g < 4; ++g) { const float he = h; h = Pe[g] * h + Ue[g]; const float ho = h; h = Po[g] * h + Uo[g]; Hs[g] = hm ? ho : he; }
            H = h;
        }
        if (MODE == 1) { float p = 1.f;
#pragma unroll
            for (int g = 0; g < 4; ++g) p *= Pe[g] * Po[g];
            aggP *= p; }
        if (MODE != 1) {
#pragma unroll
            for (int g = 0; g < 4; ++g) { float h = Hs[g];
                float old[4];
#pragma unroll
                for (int i = 0; i < 4; ++i) old[i] = (float)*(const LAS h16*)(hx + LOFF(DIR ? 15 - (4 * g + i) : (4 * g + i)));
#pragma unroll
                for (int i = 0; i < 4; ++i) { const int r = 4 * g + i; h = SA(r) * h + SU(r);
                    const float o = step < 4 ? 0.f : old[i];
                    *(LAS h16*)(hx + LOFF(DIR ? 15 - r : r)) = (h16)(h + o); } }
        }
#undef SA
#undef SU
    }
#undef LOFF
    if (MODE == 0 && hi == 0 && write_out) F.out[O_LRU + (size_t)((ctx_b * 2 + l) * 2 + DIR) * DLRU + C] = H;
    if (MODE == 1 && hi == 0) { float* agg = (float*)(F.ws + WS_AGG) + ((size_t)((lat_b * 16 + lat_chunk) * 2 + DIR) * DLRU + C) * 2; agg[0] = aggP; agg[1] = H; }
}
template <int MODE>
__device__ __forceinline__ void lru_unit(Frame& F, int l, int row0, int n, int seq_first, int seq_last, int lat_b, int lat_chunk, int ctx_b, bool write_out = true, int pv = 0) {
    LAS unsigned char* img = F.lds; LAS unsigned char* hx = F.lds + 65536;
    const h16* Z = (const h16*)(F.ws + WS_ZU);
    const int tid = F.tid;
    __syncthreads();
    if (!(pv & 1)) {
        const int cc = tid & 15, tg = tid >> 4; const int ch0 = n * 128 + cc * 8;
        float w0[8], w1[8], w2[8], w3[8], bb[8];
        const float* cw = F.inp(I_LCW) + (size_t)l * 4 * DLRU + ch0; const float* cb = F.inp(I_LCB) + (size_t)l * DLRU + ch0;
#pragma unroll
        for (int j = 0; j < 8; ++j) { w0[j] = cw[j]; w1[j] = cw[DLRU + j]; w2[j] = cw[2 * DLRU + j]; w3[j] = cw[3 * DLRU + j]; bb[j] = cb[j]; }
        const int t0 = tg * 8;
        u32x4 raw[11];
#pragma unroll
        for (int i = 0; i < 11; ++i) { const int t = t0 - 2 + i; const bool ok = (t >= 0 || !seq_first) && (t < 256 || !seq_last);
            const int tc = ok ? t : (t < 0 ? 0 : 255);
            const u32x4 v = *(const u32x4*)(Z + (size_t)(row0 + tc) * NMAIN + C_XA + ch0);
            raw[i].x = ok ? v.x : 0u; raw[i].y = ok ? v.y : 0u; raw[i].z = ok ? v.z : 0u; raw[i].w = ok ? v.w : 0u; }
        float xm2[8], xm1[8], x0[8], xp1[8];
        unpack8(raw[0], xm2); unpack8(raw[1], xm1); unpack8(raw[2], x0);
#pragma unroll
        for (int i = 0; i < 8; ++i) {
            unpack8(raw[3 + i], xp1);
            float y[8];
#pragma unroll
            for (int j = 0; j < 8; ++j) y[j] = bb[j] + w0[j] * xm2[j] + w1[j] * xm1[j] + w2[j] * x0[j] + w3[j] * xp1[j];
            *(LAS u32x4*)(img + img_off(t0 + i, cc * 8)) = pack8(y);
#pragma unroll
            for (int j = 0; j < 8; ++j) { xm2[j] = xm1[j]; xm1[j] = x0[j]; x0[j] = xp1[j]; }
        }
    }
    __syncthreads();
    const int dir = F.wave >> 2, cb = F.wave & 3;
    if (!(pv & 2)) {
    if (dir == 0) lru_scan<MODE, 0>(F, l, row0, n, lat_b, lat_chunk, ctx_b, write_out, cb);
    else          lru_scan<MODE, 1>(F, l, row0, n, lat_b, lat_chunk, ctx_b, write_out, cb);
    }
    if (MODE != 1 && !(pv & 4)) {
        __syncthreads();
        h16* OA = (h16*)(F.ws + WS_ZU + ZU_OA);
#pragma unroll
        for (int k = 0; k < 8; ++k) { const int i = tid + NTHREADS * k, tk = i >> 4, cc = i & 15;
            float hs[8], ya[8], o[8];
            unpack8(*(const LAS u32x4*)(hx + img_off(tk, cc * 8)), hs);
            unpack8(*(const u32x4*)(Z + (size_t)(row0 + tk) * NMAIN + C_YA + n * 128 + cc * 8), ya);
#pragma unroll
            for (int j = 0; j < 8; ++j) o[j] = hs[j] * gelu_tanh(ya[j]);
            *(u32x4*)(OA + (size_t)(row0 + tk) * 1024 + n * 128 + cc * 8) = pack8(o); }
    }
}

struct AttnDesc {
    const h16* Qz; h16* O;
    const h16* Kc; const h16* Vc;
    const h16* Kz; const h16* Vz;
    int nc, zt0, nz;
    int windowed;
    const float* sink;
    int kvh, q0;
};
__device__ __forceinline__ void attn_unit(Frame& F, const AttnDesc& D, const h16* Qrow0  , h16* Orow0  ) {
    LAS unsigned char* lds = F.lds;
    const int tid = F.tid, lane = F.lane, wave = F.wave, r32 = lane & 31, hi = lane >> 5;
    const int head = D.kvh * 4 + (wave >> 1);
    const int qpos = D.q0 + (wave & 1) * 32 + r32;
    const int NT = D.nc + D.nz;
    h16x8 qr[4];
    { const h16* qp = Qrow0 + (size_t)qpos * NMAIN + head * 64 + 8 * hi;
#pragma unroll
      for (int d0 = 0; d0 < 4; ++d0) qr[d0] = *(const h16x8*)(qp + 16 * d0); }
    const int krow = tid >> 3, kch = tid & 7; const int kdst = krow * 128 + ((kch ^ ((krow >> 1) & 7)) << 4);
    const int vrow = 16 * (wave & 3) + (lane >> 2), vcol = (wave >> 2) * 32 + (lane & 3) * 8; const int vdst = wave * 1024 + lane * 16;
    auto ktile_ptr = [&](int j, int row, int col, bool isV) -> const h16* {
        if (j < D.nc) return (isV ? D.Vc : D.Kc) + (size_t)(64 * j + row) * 128 + col;
        return (isV ? D.Vz : D.Kz) + (size_t)((D.zt0 + (j - D.nc)) * 64 + row) * NMAIN + col;
    };
    u32x4 kreg, vreg;
    kreg = *(const u32x4*)ktile_ptr(0, krow, kch * 8, false); vreg = *(const u32x4*)ktile_ptr(0, vrow, vcol, true);
    __syncthreads();
    *(LAS u32x4*)(lds + kdst) = kreg; *(LAS u32x4*)(lds + 16384 + vdst) = vreg;
    __syncthreads();
    float mhat, l_run;
    const bool has_sink = D.sink != nullptr;
    if (has_sink) { mhat = D.sink[head] * LOG2E; l_run = hi == 0 ? 1.f : 0.f; } else { mhat = 0.f; l_run = 0.f; }
    f32x16 negm;
#pragma unroll
    for (int r = 0; r < 16; ++r) negm[r] = -mhat;
    f32x16 o0 = {}, o1 = {};
    LAS float* wsf = (LAS float*)(lds + 32768) + wave * 64;
    const int kfoff = r32 * 128;
    const int ksw = (r32 >> 1) & 7;
    const int vp0 = ((lane >> 4) & 1) * 32 + (lane & 3) * 8 + (4 * hi + ((lane & 15) >> 2)) * 64;
#pragma unroll 1
    for (int j = 0; j < NT; ++j) {
        const int buf = j & 1;
        if (j + 1 < NT) { kreg = *(const u32x4*)ktile_ptr(j + 1, krow, kch * 8, false); vreg = *(const u32x4*)ktile_ptr(j + 1, vrow, vcol, true); }
        LAS unsigned char* Kb = lds + buf * 8192; LAS unsigned char* Vb = lds + 16384 + buf * 8192;
        f32x16 p0, p1;
#pragma unroll
        for (int d0 = 0; d0 < 4; ++d0) {
            const int co = ((2 * d0 + hi) ^ ksw) << 4;
            const h16x8 k0 = *(const LAS h16x8*)(Kb + kfoff + co);
            const h16x8 k1 = *(const LAS h16x8*)(Kb + 4096 + kfoff + co);
            p0 = __builtin_amdgcn_mfma_f32_32x32x16_f16(k0, qr[d0], d0 == 0 ? negm : p0, 0, 0, 0);
            p1 = __builtin_amdgcn_mfma_f32_32x32x16_f16(k1, qr[d0], d0 == 0 ? negm : p1, 0, 0, 0);
        }
        if (D.windowed && j >= D.nc) {
            const int kb0 = (D.zt0 + (j - D.nc)) * 64 + 4 * hi;
#pragma unroll
            for (int r = 0; r < 16; ++r) { const int kp = kb0 + (r & 3) + 8 * (r >> 2);
                const int d0_ = qpos - kp, d1_ = qpos - (kp + 32);
                if (d0_ > 128 || d0_ < -128) p0[r] = -1e30f;
                if (d1_ > 128 || d1_ < -128) p1[r] = -1e30f; }
        }
        if (j == 0) {
            float mx = fmaxf(p0[0], p1[0]);
#pragma unroll
            for (int r = 1; r < 16; ++r) mx = fmaxf(mx, fmaxf(p0[r], p1[r]));
            mx = fmaxf(mx, __shfl_xor(mx, 32));
            const float dl = has_sink ? fmaxf(mx, 0.f) : mx;
#pragma unroll
            for (int r = 0; r < 16; ++r) { p0[r] -= dl; p1[r] -= dl; }
            mhat += dl; if (has_sink) l_run *= fast_exp2(-dl);
#pragma unroll
            for (int r = 0; r < 16; ++r) negm[r] = -mhat;
        }
        float rs = 0.f;
#pragma unroll
        for (int r = 0; r < 16; ++r) { p0[r] = fast_exp2(p0[r]); p1[r] = fast_exp2(p1[r]); rs += p0[r] + p1[r]; }
        if (__builtin_expect(__any(rs > 256.f), 0)) {
            const float rsm = fmaxf(rs, __shfl_xor(rs, 32));
            const float dl = rsm > 256.f ? ceilf(__builtin_log2f(rsm)) : 0.f;
            const float f = fast_exp2(-dl);
#pragma unroll
            for (int r = 0; r < 16; ++r) { p0[r] *= f; p1[r] *= f; }
            rs *= f; l_run *= f; mhat += dl;
#pragma unroll
            for (int r = 0; r < 16; ++r) negm[r] = -mhat;
            if (hi == 0) wsf[r32] = f;
            LDS_WAIT();
#pragma unroll
            for (int r = 0; r < 16; ++r) { const float g = wsf[(r & 3) + 8 * (r >> 2) + 4 * hi]; o0[r] *= g; o1[r] *= g; }
        }
        l_run += rs;
        u32x4 pw[4];
        pw[0] = (u32x4){pk_h2(p0[0], p0[1]), pk_h2(p0[2], p0[3]), pk_h2(p0[4], p0[5]), pk_h2(p0[6], p0[7])};
        pw[1] = (u32x4){pk_h2(p0[8], p0[9]), pk_h2(p0[10], p0[11]), pk_h2(p0[12], p0[13]), pk_h2(p0[14], p0[15])};
        pw[2] = (u32x4){pk_h2(p1[0], p1[1]), pk_h2(p1[2], p1[3]), pk_h2(p1[4], p1[5]), pk_h2(p1[6], p1[7])};
        pw[3] = (u32x4){pk_h2(p1[8], p1[9]), pk_h2(p1[10], p1[11]), pk_h2(p1[12], p1[13]), pk_h2(p1[14], p1[15])};
#pragma unroll
        for (int ks = 0; ks < 4; ++ks) {
            const h16x8 pa = __builtin_bit_cast(h16x8, pw[ks]);
#pragma unroll
            for (int d0 = 0; d0 < 2; ++d0) {
                const s16x4 lo = __builtin_amdgcn_ds_read_tr16_b64_v4i16((LAS s16x4*)(Vb + vp0 + d0 * 4096 + ks * 1024));
                const s16x4 hh = __builtin_amdgcn_ds_read_tr16_b64_v4i16((LAS s16x4*)(Vb + vp0 + d0 * 4096 + ks * 1024 + 512));
                typedef short s16x8 __attribute__((ext_vector_type(8)));
                const s16x8 vv = {lo[0], lo[1], lo[2], lo[3], hh[0], hh[1], hh[2], hh[3]};
                const h16x8 vf = __builtin_bit_cast(h16x8, vv);
                if (d0 == 0) o0 = __builtin_amdgcn_mfma_f32_32x32x16_f16(pa, vf, o0, 0, 0, 0);
                else         o1 = __builtin_amdgcn_mfma_f32_32x32x16_f16(pa, vf, o1, 0, 0, 0);
            }
        }
        if (j + 1 < NT) { *(LAS u32x4*)(lds + (buf ^ 1) * 8192 + kdst) = kreg; *(LAS u32x4*)(lds + 16384 + (buf ^ 1) * 8192 + vdst) = vreg; }
        __syncthreads();
    }
    l_run += __shfl_xor(l_run, 32);
    if (hi == 0) wsf[32 + r32] = l_run;
    LDS_WAIT();
    h16* op = Orow0 + (size_t)(D.q0 + (wave & 1) * 32) * 512 + head * 64 + r32;
#pragma unroll
    for (int r = 0; r < 16; ++r) { const int q = (r & 3) + 8 * (r >> 2) + 4 * hi; const float rl = fast_rcp(wsf[32 + q]);
        op[(size_t)q * 512] = (h16)(o0[r] * rl); op[(size_t)q * 512 + 32] = (h16)(o1[r] * rl); }
}
__device__ __forceinline__ void attn_dispatch(Frame& F, int l, int type, int u) {
    const h16* Z = (const h16*)(F.ws + WS_ZU);
    const h16* cache = (const h16*)(F.ws + WS_CACHE);
    AttnDesc D; D.sink = nullptr; D.windowed = 0; D.Kc = nullptr; D.Vc = nullptr; D.nc = 0;
    const bool isC = type & 1;
    const int qcol = isC ? C_QC : C_QB, kcol = isC ? C_KC : C_KB, vcol = isC ? C_VC : C_VB;
    h16* Obase = (h16*)(F.ws + WS_ZU + (isC ? ZU_OC : ZU_OB));
    size_t row_seq0;
    if (type < 2) {
        const int b = u >> 7, kvh = (u >> 6) & 1, qb = u & 63;
        row_seq0 = (size_t)NCTX + (size_t)b * LSEQ; D.kvh = kvh; D.q0 = qb * 64;
        D.Kc = cache + ((size_t)(isC ? 2 : 0) * 131072) + (size_t)((b * 2 + l) * 256) * 128 + kvh * 64;
        D.Vc = cache + ((size_t)(isC ? 3 : 1) * 131072) + (size_t)((b * 2 + l) * 256) * 128 + kvh * 64;
        D.nc = 4;
        if (!isC) { D.zt0 = 0; D.nz = 64; }
        else { int lo = qb - 2; if (lo < 0) lo = 0; int hi_ = qb + 2; if (hi_ > 63) hi_ = 63; D.zt0 = lo; D.nz = hi_ - lo + 1; D.windowed = 1; }
    } else {
        const int b = u >> 3, kvh = (u >> 2) & 1, qb = u & 3;
        row_seq0 = (size_t)b * SEQ; D.kvh = kvh; D.q0 = qb * 64; D.zt0 = 0; D.nz = 4;
    }
    if (isC) D.sink = F.inp(I_SINK) + l * 8;
    D.Kz = Z + row_seq0 * NMAIN + kcol + D.kvh * 64; D.Vz = Z + row_seq0 * NMAIN + vcol + D.kvh * 64;
    attn_unit(F, D, Z + row_seq0 * NMAIN + qcol, Obase + row_seq0 * 512);
}

__device__ __forceinline__ void phase_ffn_act(Frame& F, int l) {
    h16* U = (h16*)(F.ws + WS_ZU);
    const int gt = F.vcu * NTHREADS + F.tid, NGT = F.G * NTHREADS;
    constexpr int NCC = DFF / 8, NRUN = NTOK / 64;
    for (int it = gt; it < NCC * NRUN; it += NGT) {
        const int cc = it % NCC, run = it / NCC; const int c0 = cc * 8, r0 = run * 64;
        const bool first = (r0 < NCTX) ? ((r0 & 255) == 0) : (((r0 - NCTX) & (LSEQ - 1)) == 0);
        const bool last = (r0 < NCTX) ? (((r0 + 64) & 255) == 0) : ((((r0 + 64) - NCTX) & (LSEQ - 1)) == 0);
        float w0[8], w1[8], w2[8], bb[8];
        const float* cw = F.inp(I_FCW) + (size_t)l * 3 * DFF + c0; const float* cb = F.inp(I_FCB) + (size_t)l * DFF + c0;
#pragma unroll
        for (int j = 0; j < 8; ++j) { w0[j] = cw[j]; w1[j] = cw[DFF + j]; w2[j] = cw[2 * DFF + j]; bb[j] = cb[j]; }
        float gp[8], gc[8], gn[8];
        if (first) {
#pragma unroll
            for (int j = 0; j < 8; ++j) gp[j] = 0.f; } else unpack8(*(const u32x4*)(U + (size_t)(r0 - 1) * DUP + c0), gp);
        unpack8(*(const u32x4*)(U + (size_t)r0 * DUP + c0), gc);
#pragma unroll 4
        for (int i = 0; i < 64; ++i) {
            const int r = r0 + i;
            if (i == 63 && last) {
#pragma unroll
                for (int j = 0; j < 8; ++j) gn[j] = 0.f; } else unpack8(*(const u32x4*)(U + (size_t)(r + 1) * DUP + c0), gn);
            float v[8]; unpack8(*(const u32x4*)(U + (size_t)r * DUP + DFF + c0), v);
            float o[8];
#pragma unroll
            for (int j = 0; j < 8; ++j) { const float g = bb[j] + w0[j] * gp[j] + w1[j] * gc[j] + w2[j] * gn[j]; o[j] = gelu_tanh(g) * v[j]; gp[j] = gc[j]; gc[j] = gn[j]; }
            *(u32x4*)(U + (size_t)r * DUP + DFF + c0) = pack8(o);
        }
    }
}

constexpr int N_PHASES = 25;
__global__ void __launch_bounds__(NTHREADS, 2) fwd_kernel(Args args) {
    extern __shared__ __attribute__((aligned(16))) unsigned char lds_raw[];
    Frame F;
    F.lds = (LAS unsigned char*)lds_raw;
    F.tid = threadIdx.x; F.lane = F.tid & 63; F.wave = __builtin_amdgcn_readfirstlane(F.tid >> 6);
    F.G = gridDim.x; { const int bx = blockIdx.x; F.vcu = (F.G % 8 == 0) ? (bx % 8) * (F.G / 8) + bx / 8 : bx; }
    F.out0 = args.out; F.ws0 = args.ws; F.refresh();
    volatile LAS unsigned* MISC = (volatile LAS unsigned*)(F.lds + MISC_OFF);
    for (int u = F.tid; u < (LDS_BYTES - LDSCTL_OFF) / 4; u += NTHREADS) ((LAS unsigned*)(F.lds + LDSCTL_OFF))[u] = 0u;
    __syncthreads();
#if !MK_PER_PHASE
    XcdBarrier bar = xcd_barrier_post((unsigned*)(F.ws + WS_CTL) + CW_BAR, MISC + 8);
#define GRID_BAR() xcd_barrier(bar)
#else
    (void)MISC;
#define GRID_BAR() do { } while (0)
#endif
    const int lo = args.ph_lo, hi_ph = args.ph_hi;
#define IN(k) (lo <= (k) && (k) < hi_ph)
#define SEAM(k) do { if (IN((k) + 1)) GRID_BAR(); } while (0)
#pragma unroll
    for (int l = 0; l < DEPTH; ++l) {
        const int pb = 12 * l;
        if (IN(pb + 0)) { F.refresh(); phase_convert_weights(F, l); if (l == 0) phase_prep_misc(F); SEAM(pb + 0); }
        if (IN(pb + 1)) { F.refresh(); phase_norm_mod(F, l == 0, F.inp(I_N1G) + l * DM, (const float*)(F.ws + WS_MOD) + (size_t)l * 3 * 6144, 0); SEAM(pb + 1); }
        if (IN(pb + 2)) { F.refresh();
            pg8::Gemm g{(const h16*)(F.ws + WS_H), (const h16*)(F.ws + WS_W + W_IN), NTOK, NMAIN, DM, DM}; pg8::StaticOrder S; S.init(NTOK, NMAIN, F.G, (int)blockIdx.x);
            pg8::EpiF16<0> E{(h16*)(F.ws + WS_ZU), NMAIN};
            pg8::gemm_phase<pg8::EpiF16<0>, pg8::StaticOrder, true, true>(F.lds, g, S, E);
            SEAM(pb + 2); }
        if (IN(pb + 3)) { F.refresh();
            phase_qk(F, l);
            for (int u = F.vcu; u < 512; u += F.G) {
                if (u < 256) lru_unit<0>(F, l, (u >> 3) * 256, u & 7, 1, 1, 0, 0, u >> 3);
                else { const int v = u - 256, b = v >> 7, ch = (v >> 3) & 15; lru_unit<1>(F, l, NCTX + b * LSEQ + ch * 256, v & 7, ch == 0, ch == 15, b, ch, 0); }
            }
            SEAM(pb + 3); }
        if (IN(pb + 4)) { F.refresh();
            for (int type = 0; type < 4; ++type) for (int u = F.vcu; u < 256; u += F.G) attn_dispatch(F, l, type, u);
            for (int v = F.vcu; v < 256; v += F.G) { const int b = v >> 7, ch = (v >> 3) & 15; lru_unit<2>(F, l, NCTX + b * LSEQ + ch * 256, v & 7, ch == 0, ch == 15, b, ch, 0); }
            SEAM(pb + 4); }
        if (IN(pb + 5)) { F.refresh();
            pg8::Gemm g{(const h16*)(F.ws + WS_H), (const h16*)(F.ws + WS_W + W_IN) + (size_t)NMAIN * DM, NTOK, NGATE, DM, DM}; pg8::StaticOrder S; S.init(NTOK, NGATE, F.G, (int)blockIdx.x);
            pg8::EpiF16<1> E{(h16*)(F.ws + WS_ZU), NGATE};
            pg8::gemm_phase<pg8::EpiF16<1>, pg8::StaticOrder, true, true>(F.lds, g, S, E);
            SEAM(pb + 5); }
        if (IN(pb + 6)) { F.refresh();
            pg8::StaticOrder S; S.init(NTOK, DM, F.G, (int)blockIdx.x);
            h16* Hb = (h16*)(F.ws + WS_H); const h16* Gb = (const h16*)(F.ws + WS_ZU);
            { pg8::Gemm g{(const h16*)(F.ws + WS_ZU + ZU_OA), (const h16*)(F.ws + WS_W + W_OA), NTOK, DM, 1024, 1024}; pg8::EpiGateMul<0> E{Hb, Gb, 0};
              pg8::gemm_phase<pg8::EpiGateMul<0>, pg8::StaticOrder, true, true>(F.lds, g, S, E); }
            { pg8::Gemm g{(const h16*)(F.ws + WS_ZU + ZU_OB), (const h16*)(F.ws + WS_W + W_OB), NTOK, DM, 512, 512}; pg8::EpiGateMul<1> E{Hb, Gb, 1024};
              pg8::gemm_phase<pg8::EpiGateMul<1>, pg8::StaticOrder, true, true>(F.lds, g, S, E); }
            { pg8::Gemm g{(const h16*)(F.ws + WS_ZU + ZU_OC), (const h16*)(F.ws + WS_W + W_OC), NTOK, DM, 512, 512}; pg8::EpiGateMul<1> E{Hb, Gb, 2048};
              pg8::gemm_phase<pg8::EpiGateMul<1>, pg8::StaticOrder, true, true>(F.lds, g, S, E); }
            SEAM(pb + 6); }
        if (IN(pb + 7)) { F.refresh();
            pg8::Gemm g{(const h16*)(F.ws + WS_H), (const h16*)(F.ws + WS_W + W_OUT), NTOK, DM, DM, DM}; pg8::StaticOrder S; S.init(NTOK, DM, F.G, (int)blockIdx.x);
            pg8::EpiRes E{l == 0 ? F.inp(I_XP) : F.out + O_Y, l == 0 ? F.inp(I_XS) : F.out + O_Y + (size_t)NCTX * DM, F.out + O_Y, (const float*)(F.ws + WS_MOD) + (size_t)l * 3 * 6144 + 2 * 1024};
            pg8::gemm_phase<pg8::EpiRes, pg8::StaticOrder, true, true>(F.lds, g, S, E);
            SEAM(pb + 7); }
        if (IN(pb + 8)) { F.refresh(); phase_norm_mod(F, 0, F.inp(I_N2G) + l * DM, (const float*)(F.ws + WS_MOD) + (size_t)l * 3 * 6144, 3); SEAM(pb + 8); }
        if (IN(pb + 9)) { F.refresh();
            pg8::Gemm g{(const h16*)(F.ws + WS_H), (const h16*)(F.ws + WS_W + W_UP), NTOK, DUP, DM, DM}; pg8::StaticOrder S; S.init(NTOK, DUP, F.G, (int)blockIdx.x);
            pg8::EpiF16<0> E{(h16*)(F.ws + WS_ZU), DUP};
            pg8::gemm_phase<pg8::EpiF16<0>, pg8::StaticOrder, true, true>(F.lds, g, S, E);
            SEAM(pb + 9); }
        if (IN(pb + 10)) { F.refresh(); phase_ffn_act(F, l); SEAM(pb + 10); }
        if (IN(pb + 11)) { F.refresh();
            pg8::Gemm g{(const h16*)(F.ws + WS_ZU) + DFF, (const h16*)(F.ws + WS_W + W_DOWN), NTOK, DM, DFF, DUP}; pg8::StaticOrder S; S.init(NTOK, DM, F.G, (int)blockIdx.x);
            pg8::EpiRes E{F.out + O_Y, F.out + O_Y + (size_t)NCTX * DM, F.out + O_Y, (const float*)(F.ws + WS_MOD) + (size_t)l * 3 * 6144 + 5 * 1024};
            pg8::gemm_phase<pg8::EpiRes, pg8::StaticOrder, true, true>(F.lds, g, S, E);
            SEAM(pb + 11); }
    }
    if (IN(24)) { F.refresh(); phase_final_norm(F); }
#if defined(PROBE_PH)
#ifndef PROBE_N
#define PROBE_N 4
#endif
#ifndef PROBE_SUB
#define PROBE_SUB 0xFF
#endif
#ifndef PROBE_VAR
#define PROBE_VAR 0
#endif
    if (IN(24)) {
        const int l = 1;
        for (int rep = 0; rep < PROBE_N; ++rep) {
            GRID_BAR(); F.refresh();
            if (PROBE_PH == 0) { phase_convert_weights(F, l); }
            if (PROBE_PH == 12) { phase_prep_misc(F); }
            if (PROBE_PH == 1) { phase_norm_mod(F, 0, F.inp(I_N1G) + l * DM, (const float*)(F.ws + WS_MOD) + (size_t)l * 3 * 6144, 0); }
            if (PROBE_PH == 2) { pg8::Gemm g{(const h16*)(F.ws + WS_H), (const h16*)(F.ws + WS_W + W_IN), NTOK, NMAIN, DM, DM}; pg8::StaticOrder S; S.init(NTOK, NMAIN, F.G, (int)blockIdx.x);
                pg8::EpiF16<0> E{(h16*)(F.ws + WS_ZU), NMAIN}; pg8::gemm_phase<pg8::EpiF16<0>, pg8::StaticOrder, true, true>(F.lds, g, S, E); }
            if (PROBE_PH == 3) {
                if (PROBE_SUB & 1) phase_qk(F, l, false);
                for (int u = F.vcu; u < 512; u += F.G) {
                    if (u < 256) { if (PROBE_SUB & 2) lru_unit<0>(F, l, (u >> 3) * 256, u & 7, 1, 1, 0, 0, u >> 3, false); }
                    else if (PROBE_SUB & 4) { const int v = u - 256, b = v >> 7, ch = (v >> 3) & 15; lru_unit<1>(F, l, NCTX + b * LSEQ + ch * 256, v & 7, ch == 0, ch == 15, b, ch, 0); }
                } }
            if (PROBE_PH == 4) {
                for (int type = 0; type < 4; ++type) if ((PROBE_SUB >> type) & 1) for (int u = F.vcu; u < 256; u += F.G) attn_dispatch(F, l, type, u);
                if (PROBE_SUB & 16) for (int v = F.vcu; v < 256; v += F.G) { const int b = v >> 7, ch = (v >> 3) & 15; lru_unit<2>(F, l, NCTX + b * LSEQ + ch * 256, v & 7, ch == 0, ch == 15, b, ch, 0, true, PROBE_VAR); } }
            if (PROBE_PH == 5) { pg8::Gemm g{(const h16*)(F.ws + WS_H), (const h16*)(F.ws + WS_W + W_IN) + (size_t)NMAIN * DM, NTOK, NGATE, DM, DM}; pg8::StaticOrder S; S.init(NTOK, NGATE, F.G, (int)blockIdx.x);
                pg8::EpiF16<1> E{(h16*)(F.ws + WS_ZU), NGATE}; pg8::gemm_phase<pg8::EpiF16<1>, pg8::StaticOrder, true, true>(F.lds, g, S, E); }
            if (PROBE_PH == 6) { pg8::StaticOrder S; S.init(NTOK, DM, F.G, (int)blockIdx.x);
                h16* Hb = (h16*)(F.ws + WS_H); const h16* Gb = (const h16*)(F.ws + WS_ZU);
                { pg8::Gemm g{(const h16*)(F.ws + WS_ZU + ZU_OA), (const h16*)(F.ws + WS_W + W_OA), NTOK, DM, 1024, 1024}; pg8::EpiGateMul<0> E{Hb, Gb, 0};
                  pg8::gemm_phase<pg8::EpiGateMul<0>, pg8::StaticOrder, true, true>(F.lds, g, S, E); }
                { pg8::Gemm g{(const h16*)(F.ws + WS_ZU + ZU_OB), (const h16*)(F.ws + WS_W + W_OB), NTOK, DM, 512, 512}; pg8::EpiGateMul<1> E{Hb, Gb, 1024};
                  pg8::gemm_phase<pg8::EpiGateMul<1>, pg8::StaticOrder, true, true>(F.lds, g, S, E); }
                { pg8::Gemm g{(const h16*)(F.ws + WS_ZU + ZU_OC), (const h16*)(F.ws + WS_W + W_OC), NTOK, DM, 512, 512}; pg8::EpiGateMul<1> E{Hb, Gb, 2048};
                  pg8::gemm_phase<pg8::EpiGateMul<1>, pg8::StaticOrder, true, true>(F.lds, g, S, E); } }
            if (PROBE_PH == 7) { pg8::Gemm g{(const h16*)(F.ws + WS_H), (const h16*)(F.ws + WS_W + W_OUT), NTOK, DM, DM, DM}; pg8::StaticOrder S; S.init(NTOK, DM, F.G, (int)blockIdx.x);
                pg8::EpiRes E{F.out + O_Y, F.out + O_Y + (size_t)NCTX * DM, (float*)(F.ws + WS_ZU), (const float*)(F.ws + WS_MOD) + (size_t)l * 3 * 6144 + 2 * 1024};
                pg8::gemm_phase<pg8::EpiRes, pg8::StaticOrder, true, true>(F.lds, g, S, E); }
            if (PROBE_PH == 9) { pg8::Gemm g{(const h16*)(F.ws + WS_H), (const h16*)(F.ws + WS_W + W_UP), NTOK, DUP, DM, DM}; pg8::StaticOrder S; S.init(NTOK, DUP, F.G, (int)blockIdx.x);
                pg8::EpiF16<0> E{(h16*)(F.ws + WS_ZU), DUP}; pg8::gemm_phase<pg8::EpiF16<0>, pg8::StaticOrder, true, true>(F.lds, g, S, E); }
            if (PROBE_PH == 10) { phase_ffn_act(F, l); }
            if (PROBE_PH == 11) { pg8::Gemm g{(const h16*)(F.ws + WS_ZU) + DFF, (const h16*)(F.ws + WS_W + W_DOWN), NTOK, DM, DFF, DUP}; pg8::StaticOrder S; S.init(NTOK, DM, F.G, (int)blockIdx.x);
                pg8::EpiRes E{F.out + O_Y, F.out + O_Y + (size_t)NCTX * DM, (float*)(F.ws + WS_H), (const float*)(F.ws + WS_MOD) + (size_t)l * 3 * 6144 + 5 * 1024};
                pg8::gemm_phase<pg8::EpiRes, pg8::StaticOrder, true, true>(F.lds, g, S, E); }
            if (PROBE_PH == 13) { }
        }
    }
#endif
#undef IN
#undef SEAM
}

extern "C" void kernel_launch(void* const* d_in, const int* in_sizes, int n_in, void* d_out, int out_size, void* d_ws, size_t ws_size, hipStream_t stream) {
    static int grid = 0;
    if (grid == 0) {
        if (n_in != 33 || out_size != (int)O_END || ws_size < WS_END) { fprintf(stderr, "kernel_launch: unexpected shapes: n_in %d out %d ws %zu (need %zu)\n", n_in, out_size, ws_size, (size_t)WS_END); grid = -1; return; }
        int dev = 0, cus = 0;
        if (hipGetDevice(&dev) != hipSuccess || hipDeviceGetAttribute(&cus, hipDeviceAttributeMultiprocessorCount, dev) != hipSuccess) { grid = -1; return; }
        if (hipFuncSetAttribute((const void*)fwd_kernel, hipFuncAttributeMaxDynamicSharedMemorySize, LDS_BYTES) != hipSuccess) { fprintf(stderr, "kernel_launch: hipFuncSetAttribute failed\n"); grid = -1; return; }
        (void)hipGetLastError();
        grid = cus;
    }
    if (grid < 0) return;
    (void)hipMemsetAsync((char*)d_ws + WS_CTL, 0, CTL_ZERO_BYTES, stream);
    Args a{};
    for (int i = 0; i < 33; ++i) a.in[i] = (const float*)d_in[i];
    a.out = (float*)d_out; a.ws = (unsigned char*)d_ws;
#if MK_PER_PHASE
    for (int ph = 0; ph < N_PHASES; ++ph) { a.ph_lo = ph; a.ph_hi = ph + 1; hipLaunchKernelGGL(fwd_kernel, dim3(grid), dim3(NTHREADS), LDS_BYTES, stream, a); }
#else
    a.ph_lo = 0; a.ph_hi = N_PHASES;
    hipLaunchKernelGGL(fwd_kernel, dim3(grid), dim3(NTHREADS), LDS_BYTES, stream, a);
#endif
}
```

```cpp
#include <hip/hip_runtime.h>
#include <cstdio>
#include <cstdint>
#include <cmath>

#ifndef MK_PER_PHASE
#define MK_PER_PHASE 0
#endif

#define LAS __attribute__((address_space(3)))
#define GAS __attribute__((address_space(1)))
typedef _Float16 h16;
typedef _Float16 h16x8 __attribute__((ext_vector_type(8)));
typedef _Float16 h16x4 __attribute__((ext_vector_type(4)));
typedef _Float16 h16x2 __attribute__((ext_vector_type(2)));
typedef short s16x4 __attribute__((ext_vector_type(4)));
typedef float f32x2 __attribute__((ext_vector_type(2)));
typedef float f32x4 __attribute__((ext_vector_type(4)));
typedef float f32x16 __attribute__((ext_vector_type(16)));
typedef unsigned u32x2 __attribute__((ext_vector_type(2)));
typedef unsigned u32x4 __attribute__((ext_vector_type(4)));

constexpr int DM = 1024, NTOK = 16384, NCTX = 8192, SEQ = 256, LSEQ = 4096, NB_CTX = 32, NB_LAT = 2, DEPTH = 2;
constexpr int DIN = 6656, NMAIN = 3584, NGATE = 3072, DFF = 2816, DUP = 5632, DLRU = 1024;
constexpr int C_XA = 0, C_YA = 1024, C_QB = 2048, C_KB = 2560, C_VB = 2688, C_QC = 2816, C_KC = 3328, C_VC = 3456;
constexpr float NORM_EPS = 1e-6f;
constexpr float LOG2E = 1.4426950408889634f;
constexpr float QSCALE = 0.125f * LOG2E;
constexpr size_t O_Y = 0, O_KB = 16777216, O_VB = 18874368, O_KC = 20971520, O_VC = 23068672, O_LRU = 25165824, O_END = 25296896;
constexpr size_t MiB = 1u << 20;
constexpr size_t WS_CTL = 0, CTL_ZERO_BYTES = 64 * 1024;
constexpr size_t WS_MOD = 1 * MiB;
constexpr size_t WS_ROPE = 1 * MiB + 256 * 1024;
constexpr size_t WS_AGG = 1 * MiB + 320 * 1024;
constexpr size_t WS_CACHE = 2 * MiB;
constexpr size_t WS_W = 3 * MiB;
constexpr size_t W_IN = 0, W_OA = W_IN + (size_t)DIN * DM * 2, W_OB = W_OA + (size_t)DM * 1024 * 2, W_OC = W_OB + (size_t)DM * 512 * 2,
                 W_OUT = W_OC + (size_t)DM * 512 * 2, W_UP = W_OUT + (size_t)DM * DM * 2, W_DOWN = W_UP + (size_t)DUP * DM * 2,
                 W_LRU = W_DOWN + (size_t)DM * DFF * 2, W_END = W_LRU + (size_t)2 * 2 * 8 * 128 * 128 * 2;
static_assert(W_END <= 37 * MiB, "weights region");
constexpr size_t WS_H = 40 * MiB;
constexpr size_t WS_ZU = 72 * MiB;
constexpr size_t ZU_OA = (size_t)NTOK * NMAIN * 2, ZU_OB = ZU_OA + (size_t)NTOK * 1024 * 2, ZU_OC = ZU_OB + (size_t)NTOK * 512 * 2;
constexpr size_t WS_END = WS_ZU + (size_t)NTOK * DUP * 2;
static_assert(WS_END == 248 * MiB, "ws map");

__device__ __forceinline__ unsigned pk_h2(float lo, float hi) { f32x2 v = {lo, hi}; h16x2 h = __builtin_convertvector(v, h16x2); return __builtin_bit_cast(unsigned, h); }
__device__ __forceinline__ void unpack8(u32x4 w, float* x) { h16x8 h = __builtin_bit_cast(h16x8, w);
#pragma unroll
    for (int j = 0; j < 8; ++j) x[j] = (float)h[j]; }
__device__ __forceinline__ u32x4 pack8(const float* x) { u32x4 w; w.x = pk_h2(x[0], x[1]); w.y = pk_h2(x[2], x[3]); w.z = pk_h2(x[4], x[5]); w.w = pk_h2(x[6], x[7]); return w; }
__device__ __forceinline__ float fast_exp2(float x) { return __builtin_amdgcn_exp2f(x); }
__device__ __forceinline__ float fast_rcp(float x) { return __builtin_amdgcn_rcpf(x); }
__device__ __forceinline__ float sigmoidf_(float x) { return fast_rcp(1.0f + fast_exp2(-LOG2E * x)); }
__device__ __forceinline__ float gelu_tanh(float x) { const float t = x + 0.044715f * x * x * x; return x * fast_rcp(1.0f + fast_exp2(-2.0f * 0.7978845608028654f * LOG2E * t)); }
__device__ __forceinline__ float wave_sum(float v) {
#pragma unroll
    for (int o = 1; o < 64; o <<= 1) v += __shfl_xor(v, o);
    return v;
}

namespace pg8 {
constexpr int BM = 256, BK = 64, HALF = 128, HTB = HALF * BK * 2, STAGE_BYTES = 8 * HTB, NXCD = 8, WGM = 8;
__host__ __device__ __forceinline__ int lds_byte(int r, int c) { const int st = (r >> 4) * 2 + (c >> 5), rr = r & 15, cc = c & 31, ob = rr * 64 + cc * 2; return st * 1024 + (ob ^ (((ob >> 9) & 1) << 5)); }
__host__ __device__ __forceinline__ void stage_rc(int b, int& R, int& C) { const int st = b / 1024, sb = b % 1024, swz = sb ^ (((sb >> 9) & 1) << 5); R = (st >> 1) * 16 + swz / 64; C = (st & 1) * 32 + (swz % 64) / 2; }
__host__ __device__ __forceinline__ int perm32(int rho) { const int n = rho >> 4, i = rho & 15; return 8 * (i >> 2) + 4 * n + (i & 3); }
struct Unit { int pm, pn; };
struct Gemm { const h16* A; const h16* Bt; int M, N, K, lda; };
struct StaticOrder {
    int nM, nN, nwg, G, c;
    __host__ __device__ void init(int M, int N, int G_, int c_) { nM = M / BM; nN = N / BM; nwg = nM * nN; G = G_; c = c_; }
    __host__ __device__ bool next(int i, Unit& u) const {
        const long L = (long)i * G + c; if (L >= nwg) return false;
        int wgid = (int)L; { const int q = nwg / NXCD, r = nwg % NXCD, xcd = wgid % NXCD, off = wgid / NXCD; wgid = (xcd < r ? xcd * (q + 1) : r * (q + 1) + (xcd - r) * q) + off; }
        const int nig = WGM * nN, gid = wgid / nig, fm = gid * WGM, gsz = (nM - fm) < WGM ? (nM - fm) : WGM;
        u.pm = fm + ((wgid % nig) % gsz); u.pn = (wgid % nig) / gsz; return true;
    }
    __device__ __forceinline__ void a_ready(const Unit&) const {}
    __device__ __forceinline__ void done(const Unit&) const {}
};

template <int ACT> struct EpiF16 {
    static constexpr bool PERM = true, AFTER_DRAIN = false;
    h16* O; int ldc;
    __device__ __forceinline__ void operator()(const f32x4 (&acc)[2][2][4][2], const Unit& u, int wr, int wc, int fr, int fq) const {
        const int row0 = u.pm * BM + wr * 64 + fr, col0 = u.pn * BM + wc * 32 + 8 * fq;
#pragma unroll
        for (int ai = 0; ai < 2; ++ai)
#pragma unroll
            for (int m = 0; m < 4; ++m) { h16* rowp = O + (size_t)(row0 + ai * HALF + m * 16) * ldc + col0;
#pragma unroll
                for (int bj = 0; bj < 2; ++bj) { f32x4 v0 = acc[ai][bj][m][0], v1 = acc[ai][bj][m][1];
                    if (ACT == 1) {
#pragma unroll
                        for (int j = 0; j < 4; ++j) { v0[j] = sigmoidf_(v0[j]); v1[j] = sigmoidf_(v1[j]); } }
                    u32x4 w; w.x = pk_h2(v0[0], v0[1]); w.y = pk_h2(v0[2], v0[3]); w.z = pk_h2(v1[0], v1[1]); w.w = pk_h2(v1[2], v1[3]);
                    *(u32x4*)(rowp + bj * HALF) = w; } }
    }
};
template <int ACCUM> struct EpiGateMul {
    static constexpr bool PERM = true, AFTER_DRAIN = false;
    h16* Mg; const h16* G; int gcol0;
    __device__ __forceinline__ void operator()(const f32x4 (&acc)[2][2][4][2], const Unit& u, int wr, int wc, int fr, int fq) const {
        const int row0 = u.pm * BM + wr * 64 + fr, col0 = u.pn * BM + wc * 32 + 8 * fq;
#pragma unroll
        for (int ai = 0; ai < 2; ++ai)
#pragma unroll
            for (int m = 0; m < 4; ++m) { const size_t row = (size_t)(row0 + ai * HALF + m * 16);
#pragma unroll
                for (int bj = 0; bj < 2; ++bj) {
                    const u32x4 gw = *(const u32x4*)(G + row * NGATE + gcol0 + col0 + bj * HALF);
                    float g[8]; unpack8(gw, g);
                    float o[8];
                    if (ACCUM) { const u32x4 mw = *(const u32x4*)(Mg + row * DM + col0 + bj * HALF); unpack8(mw, o); }
                    else {
#pragma unroll
                        for (int j = 0; j < 8; ++j) o[j] = 0.f; }
                    const f32x4 v0 = acc[ai][bj][m][0], v1 = acc[ai][bj][m][1];
#pragma unroll
                    for (int j = 0; j < 4; ++j) { o[j] += g[j] * v0[j]; o[4 + j] += g[4 + j] * v1[j]; }
                    *(u32x4*)(Mg + row * DM + col0 + bj * HALF) = pack8(o); }
                asm volatile("" ::: "memory"); }
    }
};
struct EpiRes {
    static constexpr bool PERM = false, AFTER_DRAIN = false;
    const float* base_ctx; const float* base_lat; float* X; const float* gate;
    __device__ __forceinline__ void operator()(const f32x4 (&acc)[2][2][4][2], const Unit& u, int wr, int wc, int fr, int fq) const {
        const int cond = u.pm < 32 ? 0 : (u.pm < 48 ? 1 : 2);
        const float* gp = gate + (size_t)cond * 6144;
        const float* bp = u.pm < 32 ? base_ctx + (size_t)u.pm * BM * DM : base_lat + (size_t)(u.pm - 32) * BM * DM;
        float* xp = X + (size_t)u.pm * BM * DM;
        const int r0 = wr * 64 + fr, col0 = u.pn * BM + wc * 32 + 4 * fq;
#pragma unroll
        for (int ai = 0; ai < 2; ++ai)
#pragma unroll
            for (int m = 0; m < 4; ++m) { const size_t off = (size_t)(r0 + ai * HALF + m * 16) * DM + col0;
#pragma unroll
                for (int bj = 0; bj < 2; ++bj)
#pragma unroll
                    for (int n = 0; n < 2; ++n) { const f32x4 b = *(const f32x4*)(bp + off + bj * HALF + n * 16); const f32x4 gvv = *(const f32x4*)(gp + col0 + bj * HALF + n * 16);
                        *(f32x4*)(xp + off + bj * HALF + n * 16) = b + gvv * acc[ai][bj][m][n]; }
                asm volatile("" ::: "memory"); }
    }
};

template <class Epi, class Sched, bool ALIGN_EPI = false, bool SP2 = false>
__device__ __forceinline__ void gemm_phase(LAS unsigned char* lds, const Gemm g, const Sched& S, const Epi& E) {
    int tid_ = threadIdx.x; asm volatile("" : "+v"(tid_));
    const int tid = tid_, wid = __builtin_amdgcn_readfirstlane(tid >> 6), lane = tid & 63, wr = wid >> 2, wc = wid & 3, fr = lane & 15, fq = lane >> 4;
    const int K = g.K, nt = K / BK, lda = g.lda;
    unsigned voffA[2], voffB[2];
#pragma unroll
    for (int i = 0; i < 2; ++i) { int R, C; stage_rc(tid * 16 + i * 8192, R, C); const int Rb = Epi::PERM ? ((R & ~31) + perm32(R & 31)) : R;
        voffA[i] = (unsigned)(R * lda + C) * 2u; voffB[i] = (unsigned)(Rb * K + C) * 2u; }
    const size_t kstep = (size_t)(BK * 2);
    const size_t hstepA = (size_t)HALF * lda * 2, hstepB = (size_t)HALF * K * 2;
    const size_t tstepA = 2 * hstepA, tstepB = 2 * hstepB;
    const unsigned ldsw = (unsigned)wid * 1024u;
    const int aoff = lds_byte(wr * 64 + fr, fq * 8), boff = lds_byte(wc * 32 + fr, fq * 8);
#define PG8_SA(b, h) (((b) * 2 + (h)) * HTB)
#define PG8_SB(b, h) ((4 + (b) * 2 + (h)) * HTB)
#define PG8_STAGE(bufoff, gbase, voff) do { _Pragma("unroll") for (int _i = 0; _i < 2; ++_i) \
        __builtin_amdgcn_global_load_lds((const unsigned*)((const char*)(gbase) + (voff)[_i]), (LAS unsigned*)(lds + (bufoff) + ldsw + _i * 8192), 16, 0, 0); } while (0)
#define PG8_LDA(dst, b, h) do { _Pragma("unroll") for (int m = 0; m < 4; ++m) _Pragma("unroll") for (int k = 0; k < 2; ++k) dst[m][k] = *(const LAS h16x8*)(lds + PG8_SA(b, h) + aoff + m * 2048 + k * 1024); } while (0)
#define PG8_LDB(dst, b, h) do { _Pragma("unroll") for (int n = 0; n < 2; ++n) _Pragma("unroll") for (int k = 0; k < 2; ++k) dst[n][k] = *(const LAS h16x8*)(lds + PG8_SB(b, h) + boff + n * 2048 + k * 1024); } while (0)
#define PG8_MMA(ai, bj, At, Bt) do { __builtin_amdgcn_s_setprio(1); _Pragma("unroll") for (int m = 0; m < 4; ++m) _Pragma("unroll") for (int n = 0; n < 2; ++n) _Pragma("unroll") for (int k = 0; k < 2; ++k) \
        acc[ai][bj][m][n] = __builtin_amdgcn_mfma_f32_16x16x32_f16(Bt[n][k], At[m][k], acc[ai][bj][m][n], 0, 0, 0); __builtin_amdgcn_s_setprio(0); } while (0)
#define PG8_WAIT_V(n) asm volatile("s_waitcnt vmcnt(" #n ")" ::: "memory")
#define PG8_WAIT_L(n) asm volatile("s_waitcnt lgkmcnt(" #n ")" ::: "memory")
#define PG8_BAR __builtin_amdgcn_s_barrier()
#define PG8_SCHED __builtin_amdgcn_sched_barrier(0)
    Unit cur, nxt; int ui = 0;
    if (!S.next(0, cur)) return;
    f32x4 acc[2][2][4][2];
#pragma unroll
    for (int a = 0; a < 2; ++a)
#pragma unroll
        for (int b = 0; b < 2; ++b)
#pragma unroll
            for (int m = 0; m < 4; ++m)
#pragma unroll
                for (int n = 0; n < 2; ++n) acc[a][b][m][n] = (f32x4){0.f, 0.f, 0.f, 0.f};
    h16x8 At[4][2], B0[2][2], B1[2][2];
    const char* cA = (const char*)g.A + (size_t)cur.pm * tstepA; const char* cB = (const char*)g.Bt + (size_t)cur.pn * tstepB;
    S.a_ready(cur);
    if constexpr (SP2) {
        PG8_STAGE(PG8_SB(0, 0), cB, voffB); PG8_STAGE(PG8_SB(0, 1), cB + hstepB, voffB); PG8_STAGE(PG8_SA(0, 0), cA, voffA); PG8_STAGE(PG8_SA(0, 1), cA + hstepA, voffA);
        if (wr == 1) PG8_BAR;
        PG8_WAIT_V(2); PG8_BAR;
        PG8_STAGE(PG8_SB(1, 0), cB + kstep, voffB); PG8_STAGE(PG8_SA(1, 0), cA + kstep, voffA); PG8_STAGE(PG8_SB(1, 1), cB + hstepB + kstep, voffB);
        PG8_WAIT_V(6); PG8_BAR;
    } else {
        PG8_STAGE(PG8_SB(0, 0), cB, voffB); PG8_STAGE(PG8_SA(0, 0), cA, voffA); PG8_STAGE(PG8_SB(0, 1), cB + hstepB, voffB); PG8_STAGE(PG8_SA(0, 1), cA + hstepA, voffA);
        if (wr == 1) PG8_BAR;
        PG8_WAIT_V(4); PG8_BAR;
        PG8_STAGE(PG8_SB(1, 0), cB + kstep, voffB); PG8_STAGE(PG8_SA(1, 0), cA + kstep, voffA); PG8_STAGE(PG8_SB(1, 1), cB + hstepB + kstep, voffB);
        PG8_WAIT_V(6); PG8_BAR;
    }
    for (;;) {
        const bool has_next = S.next(ui + 1, nxt);
        const char* nA = has_next ? (const char*)g.A + (size_t)nxt.pm * tstepA : cA; const char* nB = has_next ? (const char*)g.Bt + (size_t)nxt.pn * tstepB : cB;
        for (int t = 0; t < nt; t += 2) {
            const bool last = (t == nt - 2);
            const char* a1 = cA + (size_t)(t + 1) * kstep;
            const char* a2 = last ? nA : cA + (size_t)(t + 2) * kstep; const char* b2 = last ? nB : cB + (size_t)(t + 2) * kstep;
            const char* a3 = a2 + kstep; const char* b3 = b2 + kstep;
            if (last && has_next) S.a_ready(nxt);
            if constexpr (SP2) {
            PG8_LDB(B0, 0, 0); PG8_LDB(B1, 0, 1); PG8_SCHED; PG8_LDA(At, 0, 0); PG8_STAGE(PG8_SA(1, 1), a1 + hstepA, voffA);
            PG8_WAIT_V(8); PG8_WAIT_L(0); PG8_BAR; PG8_MMA(0, 0, At, B0); PG8_MMA(0, 1, At, B1); PG8_BAR; PG8_SCHED;
            PG8_LDA(At, 0, 1); PG8_STAGE(PG8_SB(0, 0), b2, voffB); PG8_STAGE(PG8_SB(0, 1), b2 + hstepB, voffB); PG8_STAGE(PG8_SA(0, 0), a2, voffA);
            PG8_WAIT_V(8); PG8_WAIT_L(0); PG8_BAR; PG8_MMA(1, 0, At, B0); PG8_MMA(1, 1, At, B1); PG8_BAR; PG8_SCHED;
            PG8_LDB(B0, 1, 0); PG8_LDB(B1, 1, 1); PG8_SCHED; PG8_LDA(At, 1, 0); PG8_STAGE(PG8_SA(0, 1), a2 + hstepA, voffA);
            PG8_WAIT_V(8); PG8_WAIT_L(0); PG8_BAR; PG8_MMA(0, 0, At, B0); PG8_MMA(0, 1, At, B1); PG8_BAR; PG8_SCHED;
            PG8_LDA(At, 1, 1); PG8_STAGE(PG8_SB(1, 0), b3, voffB); PG8_STAGE(PG8_SB(1, 1), b3 + hstepB, voffB); PG8_STAGE(PG8_SA(1, 0), a3, voffA);
            PG8_WAIT_V(8); PG8_WAIT_L(0); PG8_BAR; PG8_MMA(1, 0, At, B0); PG8_MMA(1, 1, At, B1); PG8_BAR; PG8_SCHED;
            } else {
            PG8_LDB(B0, 0, 0); PG8_SCHED; PG8_LDA(At, 0, 0); PG8_STAGE(PG8_SA(1, 1), a1 + hstepA, voffA);
            PG8_WAIT_L(8); PG8_BAR; PG8_WAIT_L(0); PG8_MMA(0, 0, At, B0); PG8_BAR; PG8_SCHED;
            PG8_LDB(B1, 0, 1); PG8_STAGE(PG8_SB(0, 0), b2, voffB);
            PG8_BAR; PG8_WAIT_L(0); PG8_MMA(0, 1, At, B1); PG8_BAR;
            PG8_LDA(At, 0, 1); PG8_STAGE(PG8_SA(0, 0), a2, voffA);
            PG8_BAR; PG8_WAIT_L(0); PG8_MMA(1, 0, At, B0); PG8_BAR; PG8_SCHED;
            PG8_STAGE(PG8_SB(0, 1), b2 + hstepB, voffB);
            PG8_WAIT_V(6); PG8_BAR; PG8_MMA(1, 1, At, B1); PG8_BAR;
            PG8_LDB(B0, 1, 0); PG8_SCHED; PG8_LDA(At, 1, 0); PG8_STAGE(PG8_SA(0, 1), a2 + hstepA, voffA);
            PG8_WAIT_L(8); PG8_BAR; PG8_WAIT_L(0); PG8_MMA(0, 0, At, B0); PG8_BAR; PG8_SCHED;
            PG8_LDB(B1, 1, 1); PG8_STAGE(PG8_SB(1, 0), b3, voffB);
            PG8_BAR; PG8_WAIT_L(0); PG8_MMA(0, 1, At, B1); PG8_BAR;
            PG8_LDA(At, 1, 1); PG8_STAGE(PG8_SA(1, 0), a3, voffA);
            PG8_BAR; PG8_WAIT_L(0); PG8_MMA(1, 0, At, B0); PG8_BAR; PG8_SCHED;
            PG8_STAGE(PG8_SB(1, 1), b3 + hstepB, voffB);
            PG8_WAIT_V(6); PG8_BAR; PG8_MMA(1, 1, At, B1); PG8_BAR;
            }
        }
        if constexpr (ALIGN_EPI) { if (wr == 0) PG8_BAR; }
        if constexpr (!Epi::AFTER_DRAIN) { E(acc, cur, wr, wc, fr, fq); S.done(cur); }
        if (!has_next) break;
#pragma unroll
        for (int a = 0; a < 2; ++a)
#pragma unroll
            for (int b = 0; b < 2; ++b)
#pragma unroll
                for (int m = 0; m < 4; ++m)
#pragma unroll
                    for (int n = 0; n < 2; ++n) acc[a][b][m][n] = (f32x4){0.f, 0.f, 0.f, 0.f};
        cur = nxt; cA = nA; cB = nB; ++ui;
        if constexpr (ALIGN_EPI) { if (wr == 1) PG8_BAR; }
    }
    PG8_WAIT_V(0);
    if constexpr (!ALIGN_EPI) { if (wr == 0) PG8_BAR; }
    PG8_BAR;
#undef PG8_SA
#undef PG8_SB
#undef PG8_STAGE
#undef PG8_LDA
#undef PG8_LDB
#undef PG8_MMA
#undef PG8_WAIT_V
#undef PG8_WAIT_L
#undef PG8_BAR
#undef PG8_SCHED
}
}

constexpr int NWAVES = 8, NTHREADS = 512;
constexpr int RING_BYTES = 131072;
constexpr int LDSCTL_OFF = RING_BYTES, MISC_OFF = LDSCTL_OFF + 320;
constexpr int LDS_BYTES = 147456;

typedef GAS unsigned gu32;
#define RLX_AGENT __ATOMIC_RELAXED, __HIP_MEMORY_SCOPE_AGENT
#define LDS_WAIT() asm volatile("s_waitcnt lgkmcnt(0)" ::: "memory")
#define VM_WAIT() asm volatile("s_waitcnt vmcnt(0)" ::: "memory")

#define XB_TMO      128
#define XB_XCNT(j)  (256  + 64 * (j))
#define XB_XSUB(j)  (1280 + 64 * (j))
#define XB_XGEN(j)  (2304 + 64 * (j))
#define XB_TOP      3328
#define XB_TOPGEN   3392
#define XCD_BAR_WORDS 3456
#define XB_SPIN_CAP (1u << 18)
__device__ __forceinline__ unsigned xb_ld(unsigned* p)              { return __hip_atomic_load(p, __ATOMIC_RELAXED, __HIP_MEMORY_SCOPE_AGENT); }
__device__ __forceinline__ unsigned xb_add(unsigned* p, unsigned v) { return __hip_atomic_fetch_add(p, v, __ATOMIC_RELAXED, __HIP_MEMORY_SCOPE_AGENT); }
__device__ __forceinline__ unsigned xb_xcc_id() { return (unsigned)__builtin_amdgcn_s_getreg((3 << 11) | 20) & 0xFu; }
#define XB_SPIN(cond, bar) do { unsigned _sp = 0; while (cond) { __builtin_amdgcn_s_sleep(1); \
    if ((++_sp & 255u) == 0u) { if (xb_ld(&(bar)[XB_TMO])) break; if (_sp > XB_SPIN_CAP) { atomicAdd(&(bar)[XB_TMO], 1u); break; } } } } while (0)
struct XcdBarrier { unsigned* bar; unsigned x; volatile LAS unsigned* st; };
__device__ __forceinline__ XcdBarrier xcd_barrier_post(unsigned* bar, volatile LAS unsigned* st) {
    XcdBarrier b; b.bar = bar; b.x = xb_xcc_id(); b.st = st;
    if (threadIdx.x == 0) (void)xb_add(&bar[XB_XCNT(b.x)], 1u);
    return b;
}
__device__ __forceinline__ void xcd_barrier_complete(unsigned* bar, unsigned x, unsigned& nloc, unsigned& nx) {
    const unsigned G = gridDim.x * gridDim.y * gridDim.z;
    unsigned sum, cnt, mine, sp = 0u;
    for (;;) {
        sum = 0u; cnt = 0u; mine = 0u;
#pragma unroll
        for (unsigned j = 0; j < 16; ++j) { const unsigned c = xb_ld(&bar[XB_XCNT(j)]); sum += c; cnt += (c > 0u) ? 1u : 0u; mine = (j == x) ? c : mine; }
        if (sum == G) break;
        __builtin_amdgcn_s_sleep(1);
        if ((++sp & 255u) == 0u) { if (xb_ld(&bar[XB_TMO])) break; if (sp > XB_SPIN_CAP) { atomicAdd(&bar[XB_TMO], 1u); break; } }
    }
    nloc = mine > 0u ? mine : 1u; nx = cnt > 0u ? cnt : 1u;
}
__device__ __forceinline__ void xcd_barrier(const XcdBarrier& b) {
    asm volatile("s_waitcnt vmcnt(0)" ::: "memory");
    __syncthreads();
    if (threadIdx.x == 0) {
        unsigned* bar = b.bar;
        __builtin_amdgcn_s_waitcnt(0);
        unsigned nloc = b.st[0], nx = b.st[1];
        if (nloc == 0u) { xcd_barrier_complete(bar, b.x, nloc, nx); b.st[0] = nloc; b.st[1] = nx; }
        const unsigned old = xb_add(&bar[XB_XSUB(b.x)], 1u);
        const unsigned gen = old / nloc;
        if (old + 1u == (gen + 1u) * nloc) {
            __builtin_amdgcn_fence(__ATOMIC_RELEASE, "agent");
            asm volatile("s_waitcnt vmcnt(0)" ::: "memory");
            const unsigned og = xb_add(&bar[XB_TOP], 1u);
            const unsigned tg = og / nx;
            if (og + 1u == (tg + 1u) * nx) xb_add(&bar[XB_TOPGEN], 1u);
            else XB_SPIN(xb_ld(&bar[XB_TOPGEN]) == tg, bar);
            __builtin_amdgcn_fence(__ATOMIC_ACQUIRE, "agent");
            xb_add(&bar[XB_XGEN(b.x)], 1u);
            asm volatile("s_waitcnt vmcnt(0)" ::: "memory");
        } else {
            XB_SPIN(xb_ld(&bar[XB_XGEN(b.x)]) == gen, bar);
            __builtin_amdgcn_fence(__ATOMIC_ACQUIRE, "agent");
            asm volatile("s_waitcnt vmcnt(0)" ::: "memory");
        }
    }
    __syncthreads();
}
constexpr int CW_BAR = 4096;
static_assert((CW_BAR + XCD_BAR_WORDS) * 4 <= (int)CTL_ZERO_BYTES, "ctl");

struct Args {
    const float* in[33]; float* out; unsigned char* ws; int ph_lo, ph_hi;
};
typedef const GAS float* cfp_t;
struct Frame {
    LAS unsigned char* lds;
    int tid, lane, wave, vcu, G;
    const __attribute__((address_space(4))) cfp_t* in; float* out; unsigned char* ws; float* out0; unsigned char* ws0;
    __device__ __forceinline__ const float* inp(int i) const { return (const float*)in[i]; }
    __device__ __forceinline__ void refresh() { int t = threadIdx.x; asm volatile("" : "+v"(t)); tid = t; lane = t & 63; wave = __builtin_amdgcn_readfirstlane(t >> 6);
        const __attribute__((address_space(4))) cfp_t* p = (const __attribute__((address_space(4))) cfp_t*)__builtin_amdgcn_kernarg_segment_ptr(); asm volatile("" : "+s"(p)); in = p;
        GAS float* o_ = (GAS float*)out0; GAS unsigned char* w_ = (GAS unsigned char*)ws0; asm volatile("" : "+s"(o_), "+s"(w_)); out = (float*)o_; ws = (unsigned char*)w_; }
};
enum { I_XP = 0, I_XS, I_C, I_CKB, I_CVB, I_CKC, I_CVC, I_STATE, I_CCTX, I_N1G, I_N2G, I_WMOD, I_BMOD, I_WIN, I_LCW, I_LCB, I_LWA, I_LBA, I_LWX, I_LBX, I_LAM,
       I_QNG, I_KNG, I_SINK, I_WOA, I_WOB, I_WOC, I_WOUT, I_WUP, I_FCW, I_FCB, I_WDOWN, I_FING };

__device__ __forceinline__ void transpose_item(const float* W, int K, int N, h16* WT, LAS float* scr, int item, int lane) {
    const int nblk = N / 32, kb = item / nblk, nb = item % nblk, k0 = 64 * kb, n0 = 32 * nb;
#pragma unroll 8
    for (int i = 0; i < 32; ++i) { const int kk = 2 * i + (lane >> 5); scr[kk * 33 + (lane & 31)] = W[(size_t)(k0 + kk) * N + n0 + (lane & 31)]; }
    LDS_WAIT(); asm volatile("" ::: "memory");
    const int c = lane & 7;
#pragma unroll
    for (int j = 0; j < 4; ++j) { const int n = (lane >> 3) + 8 * j; const LAS float* s = scr + (8 * c) * 33 + n;
        u32x4 o; o.x = pk_h2(s[0 * 33], s[1 * 33]); o.y = pk_h2(s[2 * 33], s[3 * 33]); o.z = pk_h2(s[4 * 33], s[5 * 33]); o.w = pk_h2(s[6 * 33], s[7 * 33]);
        *(u32x4*)(WT + (size_t)(n0 + n) * K + k0 + 8 * c) = o; }
    LDS_WAIT(); asm volatile("" ::: "memory");
}
__device__ __forceinline__ void phase_convert_weights(Frame& F, int l) {
    LAS float* scr = (LAS float*)(F.lds + F.wave * 16384);
    const int gw = F.vcu * NWAVES + F.wave, NGW = F.G * NWAVES;
    unsigned char* wb = F.ws + WS_W;
    constexpr int IT_IN = (DM / 64) * (DIN / 32), IT_OA = (1024 / 64) * (DM / 32), IT_OB = (512 / 64) * (DM / 32), IT_OUT = (DM / 64) * (DM / 32),
                  IT_UP = (DM / 64) * (DUP / 32), IT_DOWN = (DFF / 64) * (DM / 32), IT_LRU1 = (128 / 64) * (128 / 32), IT_LRU = 32 * IT_LRU1;
    constexpr int NITEMS = IT_IN + IT_OA + 2 * IT_OB + IT_OUT + IT_UP + IT_DOWN + IT_LRU;
    for (int it = gw; it < NITEMS; it += NGW) {
        int r = it;
        if (r < IT_IN) { transpose_item(F.inp(I_WIN) + (size_t)l * DM * DIN, DM, DIN, (h16*)(wb + W_IN), scr, r, F.lane); continue; } r -= IT_IN;
        if (r < IT_OA) { transpose_item(F.inp(I_WOA) + (size_t)l * 1024 * DM, 1024, DM, (h16*)(wb + W_OA), scr, r, F.lane); continue; } r -= IT_OA;
        if (r < IT_OB) { transpose_item(F.inp(I_WOB) + (size_t)l * 512 * DM, 512, DM, (h16*)(wb + W_OB), scr, r, F.lane); continue; } r -= IT_OB;
        if (r < IT_OB) { transpose_item(F.inp(I_WOC) + (size_t)l * 512 * DM, 512, DM, (h16*)(wb + W_OC), scr, r, F.lane); continue; } r -= IT_OB;
        if (r < IT_OUT) { transpose_item(F.inp(I_WOUT) + (size_t)l * DM * DM, DM, DM, (h16*)(wb + W_OUT), scr, r, F.lane); continue; } r -= IT_OUT;
        if (r < IT_UP) { transpose_item(F.inp(I_WUP) + (size_t)l * DM * DUP, DM, DUP, (h16*)(wb + W_UP), scr, r, F.lane); continue; } r -= IT_UP;
        if (r < IT_DOWN) { transpose_item(F.inp(I_WDOWN) + (size_t)l * DFF * DM, DFF, DM, (h16*)(wb + W_DOWN), scr, r, F.lane); continue; } r -= IT_DOWN;
        {
            const int mi = r / IT_LRU1, sub = r % IT_LRU1, dir = mi >> 4, gate = (mi >> 3) & 1, n = mi & 7;
            const float* src = (gate ? F.inp(I_LWX) : F.inp(I_LWA)) + ((size_t)((l * 2 + dir) * 8 + n)) * 128 * 128;
            transpose_item(src, 128, 128, (h16*)(wb + W_LRU) + (size_t)mi * 128 * 128, scr, sub, F.lane);
        }
    }
}
__device__ __forceinline__ void phase_prep_misc(Frame& F) {
    LAS float* sil = (LAS float*)F.lds;
    LAS float* part = (LAS float*)(F.lds + 16384);
    float* mod = (float*)(F.ws + WS_MOD);
    for (int item = F.vcu; item < 192; item += F.G) {
        const int l = item / 96, n0 = (item % 96) * 64;
        __syncthreads();
        for (int i = F.tid; i < 3 * 1024; i += NTHREADS) { const int j = i >> 10, k = i & 1023;
            const float v = j == 0 ? F.inp(I_CCTX)[k] : F.inp(I_C)[(j - 1) * 1024 + k]; sil[i] = v * sigmoidf_(v); }
        __syncthreads();
        const float* wp = F.inp(I_WMOD) + (size_t)l * DM * 6144 + n0 + F.lane;
        float a0 = 0.f, a1 = 0.f, a2 = 0.f;
        const int kb = F.wave * 128;
#pragma unroll 8
        for (int k = 0; k < 128; ++k) { const float w = wp[(size_t)(kb + k) * 6144]; a0 += w * sil[kb + k]; a1 += w * sil[1024 + kb + k]; a2 += w * sil[2048 + kb + k]; }
        part[(F.wave * 3 + 0) * 64 + F.lane] = a0; part[(F.wave * 3 + 1) * 64 + F.lane] = a1; part[(F.wave * 3 + 2) * 64 + F.lane] = a2;
        __syncthreads();
        if (F.tid < 192) { const int j = F.tid >> 6, c = F.tid & 63; float s = F.inp(I_BMOD)[l * 6144 + n0 + c];
#pragma unroll
            for (int w = 0; w < 8; ++w) s += part[(w * 3 + j) * 64 + c];
            mod[((size_t)l * 3 + j) * 6144 + n0 + c] = s; }
    }
    __syncthreads();
    const int gt = F.vcu * NTHREADS + F.tid, NGT = F.G * NTHREADS;
    float* rope = (float*)(F.ws + WS_ROPE);
    for (int i = gt; i < 64 * 16; i += NGT) { const int pos = i >> 4, fi = i & 15; const float inv = expf(-(float)fi * (1.0f / 16.0f) * 9.210340371976184f);
        const float ang = (float)pos * inv; rope[2 * i] = cosf(ang); rope[2 * i + 1] = sinf(ang); }
    h16* cache = (h16*)(F.ws + WS_CACHE);
    for (int i = gt; i < 4 * 131072 / 4; i += NGT) { const int kind = i / 32768, e = (i % 32768) * 4;
        const float* src = kind == 0 ? F.inp(I_CKB) : kind == 1 ? F.inp(I_CVB) : kind == 2 ? F.inp(I_CKC) : F.inp(I_CVC);
        const f32x4 v = *(const f32x4*)(src + e); u32x2 w; w.x = pk_h2(v[0], v[1]); w.y = pk_h2(v[2], v[3]); *(u32x2*)(cache + (size_t)kind * 131072 + e) = w; }
}

__device__ __forceinline__ const float* xrow_ptr(const Frame& F, int layer_src_is_input, int row) {
    if (layer_src_is_input) return row < NCTX ? F.inp(I_XP) + (size_t)row * DM : F.inp(I_XS) + (size_t)(row - NCTX) * DM;
    return F.out + O_Y + (size_t)row * DM;
}
__device__ __forceinline__ void phase_norm_mod(Frame& F, int from_input, const float* g, const float* mod_l, int shift_chunk) {
    const int gw = F.vcu * NWAVES + F.wave, NGW = F.G * NWAVES;
    h16* H = (h16*)(F.ws + WS_H);
    int cur_cond = -1; f32x4 gs[4], sh[4];
    for (int row = gw; row < NTOK; row += NGW) {
        const int cond = row < NCTX ? 0 : (row < NCTX + LSEQ ? 1 : 2);
        if (cond != cur_cond) { cur_cond = cond; const float* mp = mod_l + (size_t)cond * 6144;
#pragma unroll
            for (int j = 0; j < 4; ++j) { const int c = F.lane * 4 + 256 * j; const f32x4 gg = *(const f32x4*)(g + c); const f32x4 sc = *(const f32x4*)(mp + (shift_chunk + 1) * 1024 + c);
                gs[j] = gg * (sc + 1.0f); sh[j] = *(const f32x4*)(mp + shift_chunk * 1024 + c); } }
        const f32x4* xr = (const f32x4*)xrow_ptr(F, from_input, row) + F.lane;
        f32x4 v[4]; float s = 0.f;
#pragma unroll
        for (int j = 0; j < 4; ++j) { v[j] = xr[64 * j]; s += (v[j].x * v[j].x + v[j].y * v[j].y) + (v[j].z * v[j].z + v[j].w * v[j].w); }
        const float rstd = 1.0f / sqrtf(wave_sum(s) * (1.0f / DM) + NORM_EPS);
        u32x2* o8 = (u32x2*)(H + (size_t)row * DM) + F.lane;
#pragma unroll
        for (int j = 0; j < 4; ++j) { const f32x4 y = v[j] * rstd * gs[j] + sh[j]; u32x2 w; w.x = pk_h2(y.x, y.y); w.y = pk_h2(y.z, y.w); o8[64 * j] = w; }
    }
}
__device__ __forceinline__ void phase_final_norm(Frame& F) {
    const int gw = F.vcu * NWAVES + F.wave, NGW = F.G * NWAVES;
    f32x4 gg[4];
#pragma unroll
    for (int j = 0; j < 4; ++j) gg[j] = *(const f32x4*)(F.inp(I_FING) + F.lane * 4 + 256 * j);
    for (int row = gw; row < NTOK; row += NGW) {
        f32x4* xr = (f32x4*)(F.out + O_Y + (size_t)row * DM) + F.lane;
        f32x4 v[4]; float s = 0.f;
#pragma unroll
        for (int j = 0; j < 4; ++j) { v[j] = xr[64 * j]; s += (v[j].x * v[j].x + v[j].y * v[j].y) + (v[j].z * v[j].z + v[j].w * v[j].w); }
        const float rstd = 1.0f / sqrtf(wave_sum(s) * (1.0f / DM) + NORM_EPS);
#pragma unroll
        for (int j = 0; j < 4; ++j) xr[64 * j] = v[j] * rstd * gg[j];
    }
}

__device__ __forceinline__ void phase_qk(Frame& F, int l, bool write_out = true) {
    const int gw = F.vcu * NWAVES + F.wave, NGW = F.G * NWAVES, lane = F.lane;
    h16* Z = (h16*)(F.ws + WS_ZU);
    const float* rope = (const float*)(F.ws + WS_ROPE);
    const float* qg = F.inp(I_QNG) + l * 64; const float* kg = F.inp(I_KNG) + l * 64;
    const int hl = lane & 7, hc0 = hl * 8;
    float qgv[8], kgv[8];
#pragma unroll
    for (int j = 0; j < 8; ++j) { qgv[j] = qg[hc0 + j]; kgv[j] = kg[hc0 + j]; }
    for (int row = gw; row < NTOK; row += NGW) {
        const bool is_ctx = row < NCTX;
        int rpos = 0, cpos = 0, b = 0, t = 0;
        if (is_ctx) { b = row >> 8; t = row & 255; } else { const int tt = (row - NCTX) & (LSEQ - 1); rpos = tt >> 6; cpos = tt & 63; }
        h16* zr = Z + (size_t)row * NMAIN;
#pragma unroll
        for (int pass = 0; pass < 3; ++pass) {
            const int col = C_QB + pass * 512 + lane * 8;
            int kind;
            if (pass == 0) kind = 0; else if (pass == 1) kind = lane < 8 * 2 ? 1 : (lane < 8 * 4 ? 2 : 3); else kind = lane < 32 ? 3 : (lane < 48 ? 4 : 5);
            const u32x4 w = *(const u32x4*)(zr + col);
            float x[8]; unpack8(w, x);
            if (kind <= 1) {
                float s = 0.f;
#pragma unroll
                for (int j = 0; j < 8; ++j) s += x[j] * x[j];
                s += __shfl_xor(s, 1); s += __shfl_xor(s, 2); s += __shfl_xor(s, 4);
                const float rstd = 1.0f / sqrtf(s * (1.0f / 64.0f) + NORM_EPS);
#pragma unroll
                for (int j = 0; j < 8; ++j) x[j] = x[j] * rstd * (kind == 0 ? qgv[j] : kgv[j]);
            }
            if (!is_ctx) {
                float p[8];
#pragma unroll
                for (int j = 0; j < 8; ++j) p[j] = __shfl_xor(x[j], 2);
                if (kind == 0 || kind == 1 || kind == 3 || kind == 4) {
                    const int half = hl >> 2, second = (hl >> 1) & 1, f0 = (hl & 1) * 8, pos = half ? cpos : rpos;
                    const float* tp = rope + ((size_t)pos * 16 + f0) * 2;
#pragma unroll
                    for (int j = 0; j < 8; ++j) { const float cs = tp[2 * j], sn = tp[2 * j + 1]; x[j] = second ? (p[j] * sn + x[j] * cs) : (x[j] * cs - p[j] * sn); }
                }
            }
            if (kind == 0 || kind == 3) {
#pragma unroll
                for (int j = 0; j < 8; ++j) x[j] *= QSCALE;
            }
            if (kind != 2 && kind != 5) *(u32x4*)(zr + col) = pack8(x);
            if (write_out && is_ctx && (kind == 1 || kind == 2 || kind == 4 || kind == 5)) {
                const size_t ob = kind == 1 ? O_KB : kind == 2 ? O_VB : kind == 4 ? O_KC : O_VC;
                const int c128 = (kind == 1 || kind == 2) ? (col - (kind == 1 ? C_KB : C_VB)) : (col - (kind == 4 ? C_KC : C_VC));
                float* op = F.out + ob + ((size_t)((b * 2 + l) * 256 + t)) * 128 + c128;
                *(f32x4*)op = (f32x4){x[0], x[1], x[2], x[3]}; *(f32x4*)(op + 4) = (f32x4){x[4], x[5], x[6], x[7]};
            }
        }
    }
}

__device__ __forceinline__ int img_off(int row, int ch) { return row * 256 + ((((ch >> 3) ^ (row & 15)) << 4) | ((ch & 7) << 1)); }
template <int MODE, int DIR>
__device__ __forceinline__ void lru_scan(Frame& F, int l, int row0, int n, int lat_b, int lat_chunk, int ctx_b, bool write_out, int cb) {
    LAS unsigned char* img = F.lds; LAS unsigned char* hx = F.lds + 65536;
    const int lane = F.lane, r32 = lane & 31, hi = lane >> 5, hm = hi ^ DIR;
    const int C = n * 128 + cb * 32 + r32;
    h16x8 Br[8], Bi[8];
    {
        const h16* wr_ = (const h16*)(F.ws + WS_W + W_LRU) + ((size_t)((DIR * 2 + 0) * 8 + n) * 128 + cb * 32 + r32) * 128 + 8 * hi;
        const h16* wi_ = (const h16*)(F.ws + WS_W + W_LRU) + ((size_t)((DIR * 2 + 1) * 8 + n) * 128 + cb * 32 + r32) * 128 + 8 * hi;
#pragma unroll
        for (int ks = 0; ks < 8; ++ks) { Br[ks] = *(const h16x8*)(wr_ + 16 * ks); Bi[ks] = *(const h16x8*)(wi_ + 16 * ks); }
    }
    const float ba = F.inp(I_LBA)[(size_t)(l * 2 + DIR) * DLRU + C], bx = F.inp(I_LBX)[(size_t)(l * 2 + DIR) * DLRU + C];
    const float lam = F.inp(I_LAM)[(size_t)(l * 2 + DIR) * DLRU + C];
    const float sp = (-lam > 20.f) ? -lam : log1pf(expf(-lam));
    const float k8 = -8.0f * sp * LOG2E;
    const float nba = -LOG2E * ba, nbx = -LOG2E * bx;
    float H = 0.f, aggP = 1.f;
    if (MODE == 2) {
        const float* agg = (const float*)(F.ws + WS_AGG);
        H = F.inp(I_STATE)[(size_t)((lat_b * 2 + l) * 2 + DIR) * DLRU + C];
        float ap[15], au[15];
#pragma unroll
        for (int k = 0; k < 15; ++k) { const int ch = DIR == 0 ? k : 15 - k; const bool use = DIR == 0 ? (ch < lat_chunk) : (ch > lat_chunk);
            const float* p = agg + ((size_t)((lat_b * 16 + (use ? ch : 0)) * 2 + DIR) * DLRU + C) * 2; ap[k] = use ? p[0] : 1.f; au[k] = use ? p[1] : 0.f; }
#pragma unroll
        for (int k = 0; k < 15; ++k) H = ap[k] * H + au[k];
    }
    const int xch = cb * 4 + (r32 >> 3), xel = (r32 & 7) * 2;
    int lo8[8];
#pragma unroll
    for (int ci = 0; ci < 8; ++ci) { const int c = (ci & 3) + 8 * (ci >> 2); lo8[ci] = (((xch ^ (4 * hi)) ^ c) << 4) + xel + (4 * hi) * 256; }
#define LOFF(rn) (lo8s[((rn) & 3) + 4 * (((rn) >> 2) & 1)] + (8 * ((rn) >> 2) + ((rn) & 3)) * 256)
#pragma unroll 1
    for (int step = 0; step < 8; ++step) {
        if (step == 4) __syncthreads();
        const int rb = DIR == 0 ? step : 7 - step;
        int lo8s[8];
#pragma unroll
        for (int ci = 0; ci < 8; ++ci) lo8s[ci] = lo8[ci] + rb * 8192;
        f32x16 ar = {}, ai = {};
#pragma unroll
        for (int ks = 0; ks < 8; ++ks) {
            const h16x8 af = *(const LAS h16x8*)(img + (rb * 32 + r32) * 256 + (((2 * ks + hi) ^ (r32 & 15)) << 4));
            ar = __builtin_amdgcn_mfma_f32_32x32x16_f16(af, Br[ks], ar, 0, 0, 0);
            ai = __builtin_amdgcn_mfma_f32_32x32x16_f16(af, Bi[ks], ai, 0, 0, 0);
        }
        float an[16], un[16];
#pragma unroll
        for (int r = 0; r < 16; ++r) {
            const float xv = (float)*(const LAS h16*)(img + LOFF(r));
            const float rr = fast_rcp(1.0f + fast_exp2(__builtin_fmaf(ar[r], -LOG2E, nba)));
            const float ii = fast_rcp(1.0f + fast_exp2(__builtin_fmaf(ai[r], -LOG2E, nbx)));
            const float av = fast_exp2(k8 * rr);
            an[r] = av;
            un[r] = __builtin_amdgcn_sqrtf(__builtin_fmaf(-av, av, 1.0f)) * (ii * xv);
        }
#define SA(r) (DIR ? an[15 - (r)] : an[(r)])
#define SU(r) (DIR ? un[15 - (r)] : un[(r)])
        float Pe[4], Ue[4], Po[4], Uo[4];
#pragma unroll
        for (int g = 0; g < 4; ++g) {
            float p = 1.f, uu = 0.f;
#pragma unroll
            for (int i = 0; i < 4; ++i) { uu = SA(4 * g + i) * uu + SU(4 * g + i); p *= SA(4 * g + i); }
            const auto sp_ = __builtin_amdgcn_permlane32_swap(__float_as_uint(p), __float_as_uint(p), false, false);
            const auto su_ = __builtin_amdgcn_permlane32_swap(__float_as_uint(uu), __float_as_uint(uu), false, false);
            Pe[g] = __uint_as_float(sp_[DIR]); Po[g] = __uint_as_float(sp_[1 - DIR]); Ue[g] = __uint_as_float(su_[DIR]); Uo[g] = __uint_as_float(su_[1 - DIR]);
        }
        float Hs[4];
        {
            float h = H;
#pragma unroll
            for (int g = 0; g < 4; ++g) { const float he = h; h = Pe[g] * h + Ue[g]; const float ho = h; h = Po[g] * h + Uo[g]; Hs[g] = hm ? ho : he; }
            H = h;
        }
        if (MODE == 1) { float p = 1.f;
#pragma unroll
            for (int g = 0; g < 4; ++g) p *= Pe[g] * Po[g];
            aggP *= p; }
        if (MODE != 1) {
#pragma unroll
            for (int g = 0; g < 4; ++g) { float h = Hs[g];
                float old[4];
#pragma unroll
                for (int i = 0; i < 4; ++i) old[i] = (float)*(const LAS h16*)(hx + LOFF(DIR ? 15 - (4 * g + i) : (4 * g + i)));
#pragma unroll
                for (int i = 0; i < 4; ++i) { const int r = 4 * g + i; h = SA(r) * h + SU(r);
                    const float o = step < 4 ? 0.f : old[i];
                    *(LAS h16*)(hx + LOFF(DIR ? 15 - r : r)) = (h16)(h + o); } }
        }
#undef SA
#undef SU
    }
#undef LOFF
    if (MODE == 0 && hi == 0 && write_out) F.out[O_LRU + (size_t)((ctx_b * 2 + l) * 2 + DIR) * DLRU + C] = H;
    if (MODE == 1 && hi == 0) { float* agg = (float*)(F.ws + WS_AGG) + ((size_t)((lat_b * 16 + lat_chunk) * 2 + DIR) * DLRU + C) * 2; agg[0] = aggP; agg[1] = H; }
}
template <int MODE>
__device__ __forceinline__ void lru_unit(Frame& F, int l, int row0, int n, int seq_first, int seq_last, int lat_b, int lat_chunk, int ctx_b, bool write_out = true, int pv = 0) {
    LAS unsigned char* img = F.lds; LAS unsigned char* hx = F.lds + 65536;
    const h16* Z = (const h16*)(F.ws + WS_ZU);
    const int tid = F.tid;
    __syncthreads();
    if (!(pv & 1)) {
        const int cc = tid & 15, tg = tid >> 4; const int ch0 = n * 128 + cc * 8;
        float w0[8], w1[8], w2[8], w3[8], bb[8];
        const float* cw = F.inp(I_LCW) + (size_t)l * 4 * DLRU + ch0; const float* cb = F.inp(I_LCB) + (size_t)l * DLRU + ch0;
#pragma unroll
        for (int j = 0; j < 8; ++j) { w0[j] = cw[j]; w1[j] = cw[DLRU + j]; w2[j] = cw[2 * DLRU + j]; w3[j] = cw[3 * DLRU + j]; bb[j] = cb[j]; }
        const int t0 = tg * 8;
        u32x4 raw[11];
#pragma unroll
        for (int i = 0; i < 11; ++i) { const int t = t0 - 2 + i; const bool ok = (t >= 0 || !seq_first) && (t < 256 || !seq_last);
            const int tc = ok ? t : (t < 0 ? 0 : 255);
            const u32x4 v = *(const u32x4*)(Z + (size_t)(row0 + tc) * NMAIN + C_XA + ch0);
            raw[i].x = ok ? v.x : 0u; raw[i].y = ok ? v.y : 0u; raw[i].z = ok ? v.z : 0u; raw[i].w = ok ? v.w : 0u; }
        float xm2[8], xm1[8], x0[8], xp1[8];
        unpack8(raw[0], xm2); unpack8(raw[1], xm1); unpack8(raw[2], x0);
#pragma unroll
        for (int i = 0; i < 8; ++i) {
            unpack8(raw[3 + i], xp1);
            float y[8];
#pragma unroll
            for (int j = 0; j < 8; ++j) y[j] = bb[j] + w0[j] * xm2[j] + w1[j] * xm1[j] + w2[j] * x0[j] + w3[j] * xp1[j];
            *(LAS u32x4*)(img + img_off(t0 + i, cc * 8)) = pack8(y);
#pragma unroll
            for (int j = 0; j < 8; ++j) { xm2[j] = xm1[j]; xm1[j] = x0[j]; x0[j] = xp1[j]; }
        }
    }
    __syncthreads();
    const int dir = F.wave >> 2, cb = F.wave & 3;
    if (!(pv & 2)) {
    if (dir == 0) lru_scan<MODE, 0>(F, l, row0, n, lat_b, lat_chunk, ctx_b, write_out, cb);
    else          lru_scan<MODE, 1>(F, l, row0, n, lat_b, lat_chunk, ctx_b, write_out, cb);
    }
    if (MODE != 1 && !(pv & 4)) {
        __syncthreads();
        h16* OA = (h16*)(F.ws + WS_ZU + ZU_OA);
#pragma unroll
        for (int k = 0; k < 8; ++k) { const int i = tid + NTHREADS * k, tk = i >> 4, cc = i & 15;
            float hs[8], ya[8], o[8];
            unpack8(*(const LAS u32x4*)(hx + img_off(tk, cc * 8)), hs);
            unpack8(*(const u32x4*)(Z + (size_t)(row0 + tk) * NMAIN + C_YA + n * 128 + cc * 8), ya);
#pragma unroll
            for (int j = 0; j < 8; ++j) o[j] = hs[j] * gelu_tanh(ya[j]);
            *(u32x4*)(OA + (size_t)(row0 + tk) * 1024 + n * 128 + cc * 8) = pack8(o); }
    }
}

struct AttnDesc {
    const h16* Qz; h16* O;
    const h16* Kc; const h16* Vc;
    const h16* Kz; const h16* Vz;
    int nc, zt0, nz;
    int windowed;
    const float* sink;
    int kvh, q0;
};
__device__ __forceinline__ void attn_unit(Frame& F, const AttnDesc& D, const h16* Qrow0  , h16* Orow0  ) {
    LAS unsigned char* lds = F.lds;
    const int tid = F.tid, lane = F.lane, wave = F.wave, r32 = lane & 31, hi = lane >> 5;
    const int head = D.kvh * 4 + (wave >> 1);
    const int qpos = D.q0 + (wave & 1) * 32 + r32;
    const int NT = D.nc + D.nz;
    h16x8 qr[4];
    { const h16* qp = Qrow0 + (size_t)qpos * NMAIN + head * 64 + 8 * hi;
#pragma unroll
      for (int d0 = 0; d0 < 4; ++d0) qr[d0] = *(const h16x8*)(qp + 16 * d0); }
    const int krow = tid >> 3, kch = tid & 7; const int kdst = krow * 128 + ((kch ^ ((krow >> 1) & 7)) << 4);
    const int vrow = 16 * (wave & 3) + (lane >> 2), vcol = (wave >> 2) * 32 + (lane & 3) * 8; const int vdst = wave * 1024 + lane * 16;
    auto ktile_ptr = [&](int j, int row, int col, bool isV) -> const h16* {
        if (j < D.nc) return (isV ? D.Vc : D.Kc) + (size_t)(64 * j + row) * 128 + col;
        return (isV ? D.Vz : D.Kz) + (size_t)((D.zt0 + (j - D.nc)) * 64 + row) * NMAIN + col;
    };
    u32x4 kreg, vreg;
    kreg = *(const u32x4*)ktile_ptr(0, krow, kch * 8, false); vreg = *(const u32x4*)ktile_ptr(0, vrow, vcol, true);
    __syncthreads();
    *(LAS u32x4*)(lds + kdst) = kreg; *(LAS u32x4*)(lds + 16384 + vdst) = vreg;
    __syncthreads();
    float mhat, l_run;
    const bool has_sink = D.sink != nullptr;
    if (has_sink) { mhat = D.sink[head] * LOG2E; l_run = hi == 0 ? 1.f : 0.f; } else { mhat = 0.f; l_run = 0.f; }
    f32x16 negm;
#pragma unroll
    for (int r = 0; r < 16; ++r) negm[r] = -mhat;
    f32x16 o0 = {}, o1 = {};
    LAS float* wsf = (LAS float*)(lds + 32768) + wave * 64;
    const int kfoff = r32 * 128;
    const int ksw = (r32 >> 1) & 7;
    const int vp0 = ((lane >> 4) & 1) * 32 + (lane & 3) * 8 + (4 * hi + ((lane & 15) >> 2)) * 64;
#pragma unroll 1
    for (int j = 0; j < NT; ++j) {
        const int buf = j & 1;
        if (j + 1 < NT) { kreg = *(const u32x4*)ktile_ptr(j + 1, krow, kch * 8, false); vreg = *(const u32x4*)ktile_ptr(j + 1, vrow, vcol, true); }
        LAS unsigned char* Kb = lds + buf * 8192; LAS unsigned char* Vb = lds + 16384 + buf * 8192;
        f32x16 p0, p1;
#pragma unroll
        for (int d0 = 0; d0 < 4; ++d0) {
            const int co = ((2 * d0 + hi) ^ ksw) << 4;
            const h16x8 k0 = *(const LAS h16x8*)(Kb + kfoff + co);
            const h16x8 k1 = *(const LAS h16x8*)(Kb + 4096 + kfoff + co);
            p0 = __builtin_amdgcn_mfma_f32_32x32x16_f16(k0, qr[d0], d0 == 0 ? negm : p0, 0, 0, 0);
            p1 = __builtin_amdgcn_mfma_f32_32x32x16_f16(k1, qr[d0], d0 == 0 ? negm : p1, 0, 0, 0);
        }
        if (D.windowed && j >= D.nc) {
            const int kb0 = (D.zt0 + (j - D.nc)) * 64 + 4 * hi;
#pragma unroll
            for (int r = 0; r < 16; ++r) { const int kp = kb0 + (r & 3) + 8 * (r >> 2);
                const int d0_ = qpos - kp, d1_ = qpos - (kp + 32);
                if (d0_ > 128 || d0_ < -128) p0[r] = -1e30f;
                if (d1_ > 128 || d1_ < -128) p1[r] = -1e30f; }
        }
        if (j == 0) {
            float mx = fmaxf(p0[0], p1[0]);
#pragma unroll
            for (int r = 1; r < 16; ++r) mx = fmaxf(mx, fmaxf(p0[r], p1[r]));
            mx = fmaxf(mx, __shfl_xor(mx, 32));
            const float dl = has_sink ? fmaxf(mx, 0.f) : mx;
#pragma unroll
            for (int r = 0; r < 16; ++r) { p0[r] -= dl; p1[r] -= dl; }
            mhat += dl; if (has_sink) l_run *= fast_exp2(-dl);
#pragma unroll
            for (int r = 0; r < 16; ++r) negm[r] = -mhat;
        }
        float rs = 0.f;
#pragma unroll
        for (int r = 0; r < 16; ++r) { p0[r] = fast_exp2(p0[r]); p1[r] = fast_exp2(p1[r]); rs += p0[r] + p1[r]; }
        if (__builtin_expect(__any(rs > 256.f), 0)) {
            const float rsm = fmaxf(rs, __shfl_xor(rs, 32));
            const float dl = rsm > 256.f ? ceilf(__builtin_log2f(rsm)) : 0.f;
            const float f = fast_exp2(-dl);
#pragma unroll
            for (int r = 0; r < 16; ++r) { p0[r] *= f; p1[r] *= f; }
            rs *= f; l_run *= f; mhat += dl;
#pragma unroll
            for (int r = 0; r < 16; ++r) negm[r] = -mhat;
            if (hi == 0) wsf[r32] = f;
            LDS_WAIT();
#pragma unroll
            for (int r = 0; r < 16; ++r) { const float g = wsf[(r & 3) + 8 * (r >> 2) + 4 * hi]; o0[r] *= g; o1[r] *= g; }
        }
        l_run += rs;
        u32x4 pw[4];
        pw[0] = (u32x4){pk_h2(p0[0], p0[1]), pk_h2(p0[2], p0[3]), pk_h2(p0[4], p0[5]), pk_h2(p0[6], p0[7])};
        pw[1] = (u32x4){pk_h2(p0[8], p0[9]), pk_h2(p0[10], p0[11]), pk_h2(p0[12], p0[13]), pk_h2(p0[14], p0[15])};
        pw[2] = (u32x4){pk_h2(p1[0], p1[1]), pk_h2(p1[2], p1[3]), pk_h2(p1[4], p1[5]), pk_h2(p1[6], p1[7])};
        pw[3] = (u32x4){pk_h2(p1[8], p1[9]), pk_h2(p1[10], p1[11]), pk_h2(p1[12], p1[13]), pk_h2(p1[14], p1[15])};
#pragma unroll
        for (int ks = 0; ks < 4; ++ks) {
            const h16x8 pa = __builtin_bit_cast(h16x8, pw[ks]);
#pragma unroll
            for (int d0 = 0; d0 < 2; ++d0) {
                const s16x4 lo = __builtin_amdgcn_ds_read_tr16_b64_v4i16((LAS s16x4*)(Vb + vp0 + d0 * 4096 + ks * 1024));
                const s16x4 hh = __builtin_amdgcn_ds_read_tr16_b64_v4i16((LAS s16x4*)(Vb + vp0 + d0 * 4096 + ks * 1024 + 512));
                typedef short s16x8 __attribute__((ext_vector_type(8)));
                const s16x8 vv = {lo[0], lo[1], lo[2], lo[3], hh[0], hh[1], hh[2], hh[3]};
                const h16x8 vf = __builtin_bit_cast(h16x8, vv);
                if (d0 == 0) o0 = __builtin_amdgcn_mfma_f32_32x32x16_f16(pa, vf, o0, 0, 0, 0);
                else         o1 = __builtin_amdgcn_mfma_f32_32x32x16_f16(pa, vf, o1, 0, 0, 0);
            }
        }
        if (j + 1 < NT) { *(LAS u32x4*)(lds + (buf ^ 1) * 8192 + kdst) = kreg; *(LAS u32x4*)(lds + 16384 + (buf ^ 1) * 8192 + vdst) = vreg; }
        __syncthreads();
    }
    l_run += __shfl_xor(l_run, 32);
    if (hi == 0) wsf[32 + r32] = l_run;
    LDS_WAIT();
    h16* op = Orow0 + (size_t)(D.q0 + (wave & 1) * 32) * 512 + head * 64 + r32;
#pragma unroll
    for (int r = 0; r < 16; ++r) { const int q = (r & 3) + 8 * (r >> 2) + 4 * hi; const float rl = fast_rcp(wsf[32 + q]);
        op[(size_t)q * 512] = (h16)(o0[r] * rl); op[(size_t)q * 512 + 32] = (h16)(o1[r] * rl); }
}
__device__ __forceinline__ void attn_dispatch(Frame& F, int l, int type, int u) {
    const h16* Z = (const h16*)(F.ws + WS_ZU);
    const h16* cache = (const h16*)(F.ws + WS_CACHE);
    AttnDesc D; D.sink = nullptr; D.windowed = 0; D.Kc = nullptr; D.Vc = nullptr; D.nc = 0;
    const bool isC = type & 1;
    const int qcol = isC ? C_QC : C_QB, kcol = isC ? C_KC : C_KB, vcol = isC ? C_VC : C_VB;
    h16* Obase = (h16*)(F.ws + WS_ZU + (isC ? ZU_OC : ZU_OB));
    size_t row_seq0;
    if (type < 2) {
        const int b = u >> 7, kvh = (u >> 6) & 1, qb = u & 63;
        row_seq0 = (size_t)NCTX + (size_t)b * LSEQ; D.kvh = kvh; D.q0 = qb * 64;
        D.Kc = cache + ((size_t)(isC ? 2 : 0) * 131072) + (size_t)((b * 2 + l) * 256) * 128 + kvh * 64;
        D.Vc = cache + ((size_t)(isC ? 3 : 1) * 131072) + (size_t)((b * 2 + l) * 256) * 128 + kvh * 64;
        D.nc = 4;
        if (!isC) { D.zt0 = 0; D.nz = 64; }
        else { int lo = qb - 2; if (lo < 0) lo = 0; int hi_ = qb + 2; if (hi_ > 63) hi_ = 63; D.zt0 = lo; D.nz = hi_ - lo + 1; D.windowed = 1; }
    } else {
        const int b = u >> 3, kvh = (u >> 2) & 1, qb = u & 3;
        row_seq0 = (size_t)b * SEQ; D.kvh = kvh; D.q0 = qb * 64; D.zt0 = 0; D.nz = 4;
    }
    if (isC) D.sink = F.inp(I_SINK) + l * 8;
    D.Kz = Z + row_seq0 * NMAIN + kcol + D.kvh * 64; D.Vz = Z + row_seq0 * NMAIN + vcol + D.kvh * 64;
    attn_unit(F, D, Z + row_seq0 * NMAIN + qcol, Obase + row_seq0 * 512);
}

__device__ __forceinline__ void phase_ffn_act(Frame& F, int l) {
    h16* U = (h16*)(F.ws + WS_ZU);
    const int gt = F.vcu * NTHREADS + F.tid, NGT = F.G * NTHREADS;
    constexpr int NCC = DFF / 8, RUN = 16, NRUN = NTOK / RUN;
    for (int it = gt; it < NCC * NRUN; it += NGT) {
        const int cc = it % NCC, run = it / NCC; const int c0 = cc * 8, r0 = run * RUN;
        const bool first = (r0 < NCTX) ? ((r0 & 255) == 0) : (((r0 - NCTX) & (LSEQ - 1)) == 0);
        const bool last = (r0 < NCTX) ? (((r0 + RUN) & 255) == 0) : ((((r0 + RUN) - NCTX) & (LSEQ - 1)) == 0);
        float w0[8], w1[8], w2[8], bb[8];
        const float* cw = F.inp(I_FCW) + (size_t)l * 3 * DFF + c0; const float* cb = F.inp(I_FCB) + (size_t)l * DFF + c0;
#pragma unroll
        for (int j = 0; j < 8; ++j) { w0[j] = cw[j]; w1[j] = cw[DFF + j]; w2[j] = cw[2 * DFF + j]; bb[j] = cb[j]; }
        u32x4 gr[RUN + 2], vr[RUN];
#pragma unroll
        for (int i = 0; i < RUN + 2; ++i) { const int r = r0 - 1 + i; const bool ok = !((i == 0 && first) || (i == RUN + 1 && last));
            const int rc = ok ? r : r0; const u32x4 v = *(const u32x4*)(U + (size_t)rc * DUP + c0);
            gr[i].x = ok ? v.x : 0u; gr[i].y = ok ? v.y : 0u; gr[i].z = ok ? v.z : 0u; gr[i].w = ok ? v.w : 0u; }
#pragma unroll
        for (int i = 0; i < RUN; ++i) vr[i] = *(const u32x4*)(U + (size_t)(r0 + i) * DUP + DFF + c0);
        float gp[8], gc[8], gn[8];
        unpack8(gr[0], gp); unpack8(gr[1], gc);
#pragma unroll
        for (int i = 0; i < RUN; ++i) {
            unpack8(gr[i + 2], gn);
            float v[8]; unpack8(vr[i], v);
            float o[8];
#pragma unroll
            for (int j = 0; j < 8; ++j) { const float g = bb[j] + w0[j] * gp[j] + w1[j] * gc[j] + w2[j] * gn[j]; o[j] = gelu_tanh(g) * v[j]; gp[j] = gc[j]; gc[j] = gn[j]; }
            *(u32x4*)(U + (size_t)(r0 + i) * DUP + DFF + c0) = pack8(o);
        }
    }
}

constexpr int N_PHASES = 25;
__global__ void __launch_bounds__(NTHREADS, 2) fwd_kernel(Args args) {
    extern __shared__ __attribute__((aligned(16))) unsigned char lds_raw[];
    Frame F;
    F.lds = (LAS unsigned char*)lds_raw;
    F.tid = threadIdx.x; F.lane = F.tid & 63; F.wave = __builtin_amdgcn_readfirstlane(F.tid >> 6);
    F.G = gridDim.x; { const int bx = blockIdx.x; F.vcu = (F.G % 8 == 0) ? (bx % 8) * (F.G / 8) + bx / 8 : bx; }
    F.out0 = args.out; F.ws0 = args.ws; F.refresh();
    volatile LAS unsigned* MISC = (volatile LAS unsigned*)(F.lds + MISC_OFF);
    for (int u = F.tid; u < (LDS_BYTES - LDSCTL_OFF) / 4; u += NTHREADS) ((LAS unsigned*)(F.lds + LDSCTL_OFF))[u] = 0u;
    __syncthreads();
#if !MK_PER_PHASE
    XcdBarrier bar = xcd_barrier_post((unsigned*)(F.ws + WS_CTL) + CW_BAR, MISC + 8);
#define GRID_BAR() xcd_barrier(bar)
#else
    (void)MISC;
#define GRID_BAR() do { } while (0)
#endif
    const int lo = args.ph_lo, hi_ph = args.ph_hi;
#if defined(TIME_PH)
#ifndef TIME_AMP
#define TIME_AMP 8
#endif
    unsigned long long t_acc = 0, t_0 = 0;
#define TSTART(k) do { if ((k) == TIME_PH) t_0 = __builtin_amdgcn_s_memrealtime(); } while (0)
#define TSTOP(k) do { if ((k) == TIME_PH) t_acc += __builtin_amdgcn_s_memrealtime() - t_0; } while (0)
#else
#define TSTART(k) do { } while (0)
#define TSTOP(k) do { } while (0)
#endif
#define IN(k) (lo <= (k) && (k) < hi_ph)
#define SEAM(k) do { if (IN((k) + 1)) GRID_BAR(); } while (0)
#pragma unroll
    for (int l = 0; l < DEPTH; ++l) {
        const int pb = 12 * l;
        if (IN(pb + 0)) { TSTART(0); F.refresh(); phase_convert_weights(F, l); if (l == 0) phase_prep_misc(F); SEAM(pb + 0); TSTOP(0); }
        if (IN(pb + 1)) { TSTART(1); F.refresh(); phase_norm_mod(F, l == 0, F.inp(I_N1G) + l * DM, (const float*)(F.ws + WS_MOD) + (size_t)l * 3 * 6144, 0); SEAM(pb + 1); TSTOP(1); }
        if (IN(pb + 2)) { TSTART(2); F.refresh();
            pg8::Gemm g{(const h16*)(F.ws + WS_H), (const h16*)(F.ws + WS_W + W_IN), NTOK, NMAIN, DM, DM}; pg8::StaticOrder S; S.init(NTOK, NMAIN, F.G, (int)blockIdx.x);
            pg8::EpiF16<0> E{(h16*)(F.ws + WS_ZU), NMAIN};
            pg8::gemm_phase<pg8::EpiF16<0>, pg8::StaticOrder, true, true>(F.lds, g, S, E);
            SEAM(pb + 2); TSTOP(2); }
        if (IN(pb + 3)) { TSTART(3); F.refresh();
            phase_qk(F, l);
            for (int u = F.vcu; u < 512; u += F.G) {
                if (u < 256) lru_unit<0>(F, l, (u >> 3) * 256, u & 7, 1, 1, 0, 0, u >> 3);
                else { const int v = u - 256, b = v >> 7, ch = (v >> 3) & 15; lru_unit<1>(F, l, NCTX + b * LSEQ + ch * 256, v & 7, ch == 0, ch == 15, b, ch, 0); }
            }
            SEAM(pb + 3); TSTOP(3); }
        if (IN(pb + 4)) { TSTART(4); F.refresh();
            for (int type = 0; type < 4; ++type) for (int u = F.vcu; u < 256; u += F.G) attn_dispatch(F, l, type, u);
            for (int v = F.vcu; v < 256; v += F.G) { const int b = v >> 7, ch = (v >> 3) & 15; lru_unit<2>(F, l, NCTX + b * LSEQ + ch * 256, v & 7, ch == 0, ch == 15, b, ch, 0); }
            SEAM(pb + 4); TSTOP(4); }
        if (IN(pb + 5)) { TSTART(5); F.refresh();
            pg8::Gemm g{(const h16*)(F.ws + WS_H), (const h16*)(F.ws + WS_W + W_IN) + (size_t)NMAIN * DM, NTOK, NGATE, DM, DM}; pg8::StaticOrder S; S.init(NTOK, NGATE, F.G, (int)blockIdx.x);
            pg8::EpiF16<1> E{(h16*)(F.ws + WS_ZU), NGATE};
            pg8::gemm_phase<pg8::EpiF16<1>, pg8::StaticOrder, true, true>(F.lds, g, S, E);
            SEAM(pb + 5); TSTOP(5); }
        if (IN(pb + 6)) { TSTART(6); F.refresh();
            pg8::StaticOrder S; S.init(NTOK, DM, F.G, (int)blockIdx.x);
            h16* Hb = (h16*)(F.ws + WS_H); const h16* Gb = (const h16*)(F.ws + WS_ZU);
            { pg8::Gemm g{(const h16*)(F.ws + WS_ZU + ZU_OA), (const h16*)(F.ws + WS_W + W_OA), NTOK, DM, 1024, 1024}; pg8::EpiGateMul<0> E{Hb, Gb, 0};
              pg8::gemm_phase<pg8::EpiGateMul<0>, pg8::StaticOrder, true, true>(F.lds, g, S, E); }
            { pg8::Gemm g{(const h16*)(F.ws + WS_ZU + ZU_OB), (const h16*)(F.ws + WS_W + W_OB), NTOK, DM, 512, 512}; pg8::EpiGateMul<1> E{Hb, Gb, 1024};
              pg8::gemm_phase<pg8::EpiGateMul<1>, pg8::StaticOrder, true, true>(F.lds, g, S, E); }
            { pg8::Gemm g{(const h16*)(F.ws + WS_ZU + ZU_OC), (const h16*)(F.ws + WS_W + W_OC), NTOK, DM, 512, 512}; pg8::EpiGateMul<1> E{Hb, Gb, 2048};
              pg8::gemm_phase<pg8::EpiGateMul<1>, pg8::StaticOrder, true, true>(F.lds, g, S, E); }
            SEAM(pb + 6); TSTOP(6); }
        if (IN(pb + 7)) { TSTART(7); F.refresh();
            pg8::Gemm g{(const h16*)(F.ws + WS_H), (const h16*)(F.ws + WS_W + W_OUT), NTOK, DM, DM, DM}; pg8::StaticOrder S; S.init(NTOK, DM, F.G, (int)blockIdx.x);
            pg8::EpiRes E{l == 0 ? F.inp(I_XP) : F.out + O_Y, l == 0 ? F.inp(I_XS) : F.out + O_Y + (size_t)NCTX * DM, F.out + O_Y, (const float*)(F.ws + WS_MOD) + (size_t)l * 3 * 6144 + 2 * 1024};
            pg8::gemm_phase<pg8::EpiRes, pg8::StaticOrder, true, true>(F.lds, g, S, E);
            SEAM(pb + 7); TSTOP(7); }
        if (IN(pb + 8)) { TSTART(8); F.refresh(); phase_norm_mod(F, 0, F.inp(I_N2G) + l * DM, (const float*)(F.ws + WS_MOD) + (size_t)l * 3 * 6144, 3); SEAM(pb + 8); TSTOP(8); }
        if (IN(pb + 9)) { TSTART(9); F.refresh();
            pg8::Gemm g{(const h16*)(F.ws + WS_H), (const h16*)(F.ws + WS_W + W_UP), NTOK, DUP, DM, DM}; pg8::StaticOrder S; S.init(NTOK, DUP, F.G, (int)blockIdx.x);
            pg8::EpiF16<0> E{(h16*)(F.ws + WS_ZU), DUP};
            pg8::gemm_phase<pg8::EpiF16<0>, pg8::StaticOrder, true, true>(F.lds, g, S, E);
            SEAM(pb + 9); TSTOP(9); }
        if (IN(pb + 10)) { TSTART(10); F.refresh(); phase_ffn_act(F, l); SEAM(pb + 10); TSTOP(10); }
        if (IN(pb + 11)) { TSTART(11); F.refresh();
            pg8::Gemm g{(const h16*)(F.ws + WS_ZU) + DFF, (const h16*)(F.ws + WS_W + W_DOWN), NTOK, DM, DFF, DUP}; pg8::StaticOrder S; S.init(NTOK, DM, F.G, (int)blockIdx.x);
            pg8::EpiRes E{F.out + O_Y, F.out + O_Y + (size_t)NCTX * DM, F.out + O_Y, (const float*)(F.ws + WS_MOD) + (size_t)l * 3 * 6144 + 5 * 1024};
            pg8::gemm_phase<pg8::EpiRes, pg8::StaticOrder, true, true>(F.lds, g, S, E);
            SEAM(pb + 11); TSTOP(11); }
    }
    if (IN(24)) { TSTART(12); F.refresh(); phase_final_norm(F); TSTOP(12); }
#if defined(TIME_PH)
    if (blockIdx.x == 0 && threadIdx.x == 0) { const unsigned long long t1 = __builtin_amdgcn_s_memrealtime(); while (__builtin_amdgcn_s_memrealtime() - t1 < (unsigned long long)TIME_AMP * t_acc) __builtin_amdgcn_s_sleep(8); }
#endif
#if defined(PROBE_PH)
#ifndef PROBE_N
#define PROBE_N 4
#endif
#ifndef PROBE_SUB
#define PROBE_SUB 0xFF
#endif
#ifndef PROBE_VAR
#define PROBE_VAR 0
#endif
    if (IN(24)) {
        const int l = 1;
        for (int rep = 0; rep < PROBE_N; ++rep) {
            GRID_BAR(); F.refresh();
            if (PROBE_PH == 0) { phase_convert_weights(F, l); }
            if (PROBE_PH == 12) { phase_prep_misc(F); }
            if (PROBE_PH == 1) { phase_norm_mod(F, 0, F.inp(I_N1G) + l * DM, (const float*)(F.ws + WS_MOD) + (size_t)l * 3 * 6144, 0); }
            if (PROBE_PH == 2) { pg8::Gemm g{(const h16*)(F.ws + WS_H), (const h16*)(F.ws + WS_W + W_IN), NTOK, NMAIN, DM, DM}; pg8::StaticOrder S; S.init(NTOK, NMAIN, F.G, (int)blockIdx.x);
                pg8::EpiF16<0> E{(h16*)(F.ws + WS_ZU), NMAIN}; pg8::gemm_phase<pg8::EpiF16<0>, pg8::StaticOrder, true, true>(F.lds, g, S, E); }
            if (PROBE_PH == 3) {
                if (PROBE_SUB & 1) phase_qk(F, l, false);
                for (int u = F.vcu; u < 512; u += F.G) {
                    if (u < 256) { if (PROBE_SUB & 2) lru_unit<0>(F, l, (u >> 3) * 256, u & 7, 1, 1, 0, 0, u >> 3, false); }
                    else if (PROBE_SUB & 4) { const int v = u - 256, b = v >> 7, ch = (v >> 3) & 15; lru_unit<1>(F, l, NCTX + b * LSEQ + ch * 256, v & 7, ch == 0, ch == 15, b, ch, 0); }
                } }
            if (PROBE_PH == 4) {
                for (int type = 0; type < 4; ++type) if ((PROBE_SUB >> type) & 1) for (int u = F.vcu; u < 256; u += F.G) attn_dispatch(F, l, type, u);
                if (PROBE_SUB & 16) for (int v = F.vcu; v < 256; v += F.G) { const int b = v >> 7, ch = (v >> 3) & 15; lru_unit<2>(F, l, NCTX + b * LSEQ + ch * 256, v & 7, ch == 0, ch == 15, b, ch, 0, true, PROBE_VAR); } }
            if (PROBE_PH == 5) { pg8::Gemm g{(const h16*)(F.ws + WS_H), (const h16*)(F.ws + WS_W + W_IN) + (size_t)NMAIN * DM, NTOK, NGATE, DM, DM}; pg8::StaticOrder S; S.init(NTOK, NGATE, F.G, (int)blockIdx.x);
                pg8::EpiF16<1> E{(h16*)(F.ws + WS_ZU), NGATE}; pg8::gemm_phase<pg8::EpiF16<1>, pg8::StaticOrder, true, true>(F.lds, g, S, E); }
            if (PROBE_PH == 6) { pg8::StaticOrder S; S.init(NTOK, DM, F.G, (int)blockIdx.x);
                h16* Hb = (h16*)(F.ws + WS_H); const h16* Gb = (const h16*)(F.ws + WS_ZU);
                { pg8::Gemm g{(const h16*)(F.ws + WS_ZU + ZU_OA), (const h16*)(F.ws + WS_W + W_OA), NTOK, DM, 1024, 1024}; pg8::EpiGateMul<0> E{Hb, Gb, 0};
                  pg8::gemm_phase<pg8::EpiGateMul<0>, pg8::StaticOrder, true, true>(F.lds, g, S, E); }
                { pg8::Gemm g{(const h16*)(F.ws + WS_ZU + ZU_OB), (const h16*)(F.ws + WS_W + W_OB), NTOK, DM, 512, 512}; pg8::EpiGateMul<1> E{Hb, Gb, 1024};
                  pg8::gemm_phase<pg8::EpiGateMul<1>, pg8::StaticOrder, true, true>(F.lds, g, S, E); }
                { pg8::Gemm g{(const h16*)(F.ws + WS_ZU + ZU_OC), (const h16*)(F.ws + WS_W + W_OC), NTOK, DM, 512, 512}; pg8::EpiGateMul<1> E{Hb, Gb, 2048};
                  pg8::gemm_phase<pg8::EpiGateMul<1>, pg8::StaticOrder, true, true>(F.lds, g, S, E); } }
            if (PROBE_PH == 7) { pg8::Gemm g{(const h16*)(F.ws + WS_H), (const h16*)(F.ws + WS_W + W_OUT), NTOK, DM, DM, DM}; pg8::StaticOrder S; S.init(NTOK, DM, F.G, (int)blockIdx.x);
                pg8::EpiRes E{F.out + O_Y, F.out + O_Y + (size_t)NCTX * DM, (float*)(F.ws + WS_ZU), (const float*)(F.ws + WS_MOD) + (size_t)l * 3 * 6144 + 2 * 1024};
                pg8::gemm_phase<pg8::EpiRes, pg8::StaticOrder, true, true>(F.lds, g, S, E); }
            if (PROBE_PH == 9) { pg8::Gemm g{(const h16*)(F.ws + WS_H), (const h16*)(F.ws + WS_W + W_UP), NTOK, DUP, DM, DM}; pg8::StaticOrder S; S.init(NTOK, DUP, F.G, (int)blockIdx.x);
                pg8::EpiF16<0> E{(h16*)(F.ws + WS_ZU), DUP}; pg8::gemm_phase<pg8::EpiF16<0>, pg8::StaticOrder, true, true>(F.lds, g, S, E); }
            if (PROBE_PH == 10) { phase_ffn_act(F, l); }
            if (PROBE_PH == 11) { pg8::Gemm g{(const h16*)(F.ws + WS_ZU) + DFF, (const h16*)(F.ws + WS_W + W_DOWN), NTOK, DM, DFF, DUP}; pg8::StaticOrder S; S.init(NTOK, DM, F.G, (int)blockIdx.x);
                pg8::EpiRes E{F.out + O_Y, F.out + O_Y + (size_t)NCTX * DM, (float*)(F.ws + WS_H), (const float*)(F.ws + WS_MOD) + (size_t)l * 3 * 6144 + 5 * 1024};
                pg8::gemm_phase<pg8::EpiRes, pg8::StaticOrder, true, true>(F.lds, g, S, E); }
            if (PROBE_PH == 13) { }
        }
    }
#endif
#undef IN
#undef SEAM
}

extern "C" void kernel_launch(void* const* d_in, const int* in_sizes, int n_in, void* d_out, int out_size, void* d_ws, size_t ws_size, hipStream_t stream) {
    static int grid = 0;
    if (grid == 0) {
        if (n_in != 33 || out_size != (int)O_END || ws_size < WS_END) { fprintf(stderr, "kernel_launch: unexpected shapes: n_in %d out %d ws %zu (need %zu)\n", n_in, out_size, ws_size, (size_t)WS_END); grid = -1; return; }
        int dev = 0, cus = 0;
        if (hipGetDevice(&dev) != hipSuccess || hipDeviceGetAttribute(&cus, hipDeviceAttributeMultiprocessorCount, dev) != hipSuccess) { grid = -1; return; }
        if (hipFuncSetAttribute((const void*)fwd_kernel, hipFuncAttributeMaxDynamicSharedMemorySize, LDS_BYTES) != hipSuccess) { fprintf(stderr, "kernel_launch: hipFuncSetAttribute failed\n"); grid = -1; return; }
        (void)hipGetLastError();
        grid = cus;
    }
    if (grid < 0) return;
    (void)hipMemsetAsync((char*)d_ws + WS_CTL, 0, CTL_ZERO_BYTES, stream);
    Args a{};
    for (int i = 0; i < 33; ++i) a.in[i] = (const float*)d_in[i];
    a.out = (float*)d_out; a.ws = (unsigned char*)d_ws;
#if MK_PER_PHASE
    for (int ph = 0; ph < N_PHASES; ++ph) { a.ph_lo = ph; a.ph_hi = ph + 1; hipLaunchKernelGGL(fwd_kernel, dim3(grid), dim3(NTHREADS), LDS_BYTES, stream, a); }
#else
    a.ph_lo = 0; a.ph_hi = N_PHASES;
    hipLaunchKernelGGL(fwd_kernel, dim3(grid), dim3(NTHREADS), LDS_BYTES, stream, a);
#endif
}
```

```cpp
#include <hip/hip_runtime.h>
#include <cstdio>
#include <cstdint>
#include <cmath>

#ifndef MK_PER_PHASE
#define MK_PER_PHASE 0
#endif

#define LAS __attribute__((address_space(3)))
#define GAS __attribute__((address_space(1)))
typedef _Float16 h16;
typedef _Float16 h16x8 __attribute__((ext_vector_type(8)));
typedef _Float16 h16x4 __attribute__((ext_vector_type(4)));
typedef _Float16 h16x2 __attribute__((ext_vector_type(2)));
typedef short s16x4 __attribute__((ext_vector_type(4)));
typedef float f32x2 __attribute__((ext_vector_type(2)));
typedef float f32x4 __attribute__((ext_vector_type(4)));
typedef float f32x16 __attribute__((ext_vector_type(16)));
typedef unsigned u32x2 __attribute__((ext_vector_type(2)));
typedef unsigned u32x4 __attribute__((ext_vector_type(4)));

constexpr int DM = 1024, NTOK = 16384, NCTX = 8192, SEQ = 256, LSEQ = 4096, NB_CTX = 32, NB_LAT = 2, DEPTH = 2;
constexpr int DIN = 6656, NMAIN = 3584, NGATE = 3072, DFF = 2816, DUP = 5632, DLRU = 1024;
constexpr int C_XA = 0, C_YA = 1024, C_QB = 2048, C_KB = 2560, C_VB = 2688, C_QC = 2816, C_KC = 3328, C_VC = 3456;
constexpr float NORM_EPS = 1e-6f;
constexpr float LOG2E = 1.4426950408889634f;
constexpr float QSCALE = 0.125f * LOG2E;
constexpr size_t O_Y = 0, O_KB = 16777216, O_VB = 18874368, O_KC = 20971520, O_VC = 23068672, O_LRU = 25165824, O_END = 25296896;
constexpr size_t MiB = 1u << 20;
constexpr size_t WS_CTL = 0, WS_SS = 64 * 1024, CTL_ZERO_BYTES = 64 * 1024 + 4 * NTOK * 4;
constexpr size_t WS_MOD = 1 * MiB;
constexpr size_t WS_ROPE = 1 * MiB + 256 * 1024;
constexpr size_t WS_AGG = 1 * MiB + 320 * 1024;
constexpr size_t WS_CACHE = 2 * MiB;
constexpr size_t WS_W = 3 * MiB;
constexpr size_t W_IN = 0, W_OA = W_IN + (size_t)DIN * DM * 2, W_OB = W_OA + (size_t)DM * 1024 * 2, W_OC = W_OB + (size_t)DM * 512 * 2,
                 W_OUT = W_OC + (size_t)DM * 512 * 2, W_UP = W_OUT + (size_t)DM * DM * 2, W_DOWN = W_UP + (size_t)DUP * DM * 2,
                 W_LRU = W_DOWN + (size_t)DM * DFF * 2, W_END = W_LRU + (size_t)2 * 2 * 8 * 128 * 128 * 2;
static_assert(W_END <= 37 * MiB, "weights region");
constexpr size_t WS_H = 40 * MiB;
constexpr size_t WS_ZU = 72 * MiB;
constexpr size_t ZU_OA = (size_t)NTOK * NMAIN * 2, ZU_OB = ZU_OA + (size_t)NTOK * 1024 * 2, ZU_OC = ZU_OB + (size_t)NTOK * 512 * 2;
constexpr size_t WS_STASH = WS_ZU + (size_t)NTOK * DUP * 2;
static_assert(WS_STASH == 248 * MiB, "ws map");
constexpr size_t WS_H2 = WS_STASH + (size_t)NB_LAT * 2 * LSEQ * DLRU * 4;
constexpr size_t WS_CV = WS_H2 + (size_t)NTOK * DM * 2;
constexpr size_t WS_END = WS_CV + MiB;

__device__ __forceinline__ unsigned pk_h2(float lo, float hi) { f32x2 v = {lo, hi}; h16x2 h = __builtin_convertvector(v, h16x2); return __builtin_bit_cast(unsigned, h); }
__device__ __forceinline__ void unpack8(u32x4 w, float* x) { h16x8 h = __builtin_bit_cast(h16x8, w);
#pragma unroll
    for (int j = 0; j < 8; ++j) x[j] = (float)h[j]; }
__device__ __forceinline__ u32x4 pack8(const float* x) { u32x4 w; w.x = pk_h2(x[0], x[1]); w.y = pk_h2(x[2], x[3]); w.z = pk_h2(x[4], x[5]); w.w = pk_h2(x[6], x[7]); return w; }
__device__ __forceinline__ float fast_exp2(float x) { return __builtin_amdgcn_exp2f(x); }
__device__ __forceinline__ float fast_rcp(float x) { return __builtin_amdgcn_rcpf(x); }
__device__ __forceinline__ float sigmoidf_(float x) { return fast_rcp(1.0f + fast_exp2(-LOG2E * x)); }
__device__ __forceinline__ float gelu_tanh(float x) { const float t = x + 0.044715f * x * x * x; return x * fast_rcp(1.0f + fast_exp2(-2.0f * 0.7978845608028654f * LOG2E * t)); }
template <int CTRL> __device__ __forceinline__ float dpp_f(float v) { return __int_as_float(__builtin_amdgcn_update_dpp(0, __float_as_int(v), CTRL, 0xf, 0xf, true)); }
__device__ __forceinline__ float sum8(float v) { v += dpp_f<0xB1>(v); v += dpp_f<0x4E>(v); v += dpp_f<0x141>(v); return v; }
__device__ __forceinline__ float wave_sum(float v) { v = sum8(v); v += dpp_f<0x140>(v); v += __shfl_xor(v, 16); v += __shfl_xor(v, 32); return v; }

constexpr int RING_BYTES = 131072;
constexpr int LDSCTL_OFF = RING_BYTES, MISC_OFF = LDSCTL_OFF + 320;
constexpr int LDS_BYTES = 163840;
constexpr int EPI_SCR_OFF = RING_BYTES + 2048, EPI_SCR_WAVE = 2304;
#if defined(TIME_SUB)
#ifndef TIME_FILTER
#define TIME_FILTER -1
#endif
#define TSL_OK(l_) (blockIdx.x == 0 && threadIdx.x == 0 && (TIME_FILTER < 0 || *(volatile LAS int*)((l_) + MISC_OFF + 96) == TIME_FILTER))
#define TSL_START(l_, id) do { if ((id) == TIME_SUB && TSL_OK(l_)) *(volatile LAS unsigned long long*)((l_) + MISC_OFF + 72) = __builtin_amdgcn_s_memrealtime(); } while (0)
#define TSL_STOP(l_, id) do { if ((id) == TIME_SUB && TSL_OK(l_)) { volatile LAS unsigned long long* a_ = (volatile LAS unsigned long long*)((l_) + MISC_OFF + 64); a_[0] = a_[0] + (__builtin_amdgcn_s_memrealtime() - a_[1]); } } while (0)
#define TSL_PHASE(l_, k) do { if (blockIdx.x == 0 && threadIdx.x == 0) *(volatile LAS int*)((l_) + MISC_OFF + 96) = (k); } while (0)
#else
#define TSL_START(l_, id) do { } while (0)
#define TSL_STOP(l_, id) do { } while (0)
#define TSL_PHASE(l_, k) do { } while (0)
#endif
namespace pg8 {
constexpr int BM = 256, BK = 64, HALF = 128, HTB = HALF * BK * 2, STAGE_BYTES = 8 * HTB, NXCD = 8, WGM = 8;
__host__ __device__ __forceinline__ int lds_byte(int r, int c) { const int st = (r >> 4) * 2 + (c >> 5), rr = r & 15, cc = c & 31, ob = rr * 64 + cc * 2; return st * 1024 + (ob ^ (((ob >> 9) & 1) << 5)); }
__host__ __device__ __forceinline__ void stage_rc(int b, int& R, int& C) { const int st = b / 1024, sb = b % 1024, swz = sb ^ (((sb >> 9) & 1) << 5); R = (st >> 1) * 16 + swz / 64; C = (st & 1) * 32 + (swz % 64) / 2; }
__host__ __device__ __forceinline__ int perm32(int rho) { const int n = rho >> 4, i = rho & 15; return 8 * (i >> 2) + 4 * n + (i & 3); }
struct Unit { int pm, pn; };
struct Gemm { const h16* A; const h16* Bt; int M, N, K, lda; };
struct StaticOrder {
    int nM, nN, nwg, G, c;
    __host__ __device__ void init(int M, int N, int G_, int c_) { nM = M / BM; nN = N / BM; nwg = nM * nN; G = G_; c = c_; }
    __host__ __device__ bool next(int i, Unit& u) const {
        const long L = (long)i * G + c; if (L >= nwg) return false;
        int wgid = (int)L; { const int q = nwg / NXCD, r = nwg % NXCD, xcd = wgid % NXCD, off = wgid / NXCD; wgid = (xcd < r ? xcd * (q + 1) : r * (q + 1) + (xcd - r) * q) + off; }
        const int nig = WGM * nN, gid = wgid / nig, fm = gid * WGM, gsz = (nM - fm) < WGM ? (nM - fm) : WGM;
        u.pm = fm + ((wgid % nig) % gsz); u.pn = (wgid % nig) / gsz; return true;
    }
    __device__ __forceinline__ void a_ready(const Unit&) const {}
    __device__ __forceinline__ void done(const Unit&) const {}
};

template <int ACT> struct EpiF16 {
    static constexpr bool PERM = true, AFTER_DRAIN = false;
    h16* O; int ldc;
    const float* ss; const float* cv;
    int cvld;
    __device__ __forceinline__ void operator()(const f32x4 (&acc)[2][2][4][2], const Unit& u, int wr, int wc, int fr, int fq) const {
        const int row0 = u.pm * BM + wr * 64 + fr, col0 = u.pn * BM + wc * 32 + 8 * fq;
        const int cond = u.pm < 32 ? 0 : (u.pm < 48 ? 1 : 2);
        f32x4 c0[2], c1[2];
#pragma unroll
        for (int bj = 0; bj < 2; ++bj) { const float* cp = cv + (size_t)cond * cvld + col0 + bj * HALF; c0[bj] = *(const f32x4*)cp; c1[bj] = *(const f32x4*)(cp + 4); }
#pragma unroll
        for (int ai = 0; ai < 2; ++ai)
#pragma unroll
            for (int m = 0; m < 4; ++m) { const int row = row0 + ai * HALF + m * 16; h16* rowp = O + (size_t)row * ldc + col0;
                const float rstd = 1.0f / sqrtf(ss[row] * (1.0f / DM) + NORM_EPS);
#pragma unroll
                for (int bj = 0; bj < 2; ++bj) { f32x4 v0 = acc[ai][bj][m][0] * rstd + c0[bj], v1 = acc[ai][bj][m][1] * rstd + c1[bj];
                    if (ACT == 1) {
#pragma unroll
                        for (int j = 0; j < 4; ++j) { v0[j] = sigmoidf_(v0[j]); v1[j] = sigmoidf_(v1[j]); } }
                    u32x4 w; w.x = pk_h2(v0[0], v0[1]); w.y = pk_h2(v0[2], v0[3]); w.z = pk_h2(v1[0], v1[1]); w.w = pk_h2(v1[2], v1[3]);
                    *(u32x4*)(rowp + bj * HALF) = w; } }
    }
};
template <int ACCUM> struct EpiGateMul {
    static constexpr bool PERM = true, AFTER_DRAIN = false;
    h16* Mg; const h16* G; int gcol0;
    __device__ __forceinline__ void operator()(const f32x4 (&acc)[2][2][4][2], const Unit& u, int wr, int wc, int fr, int fq) const {
        const int row0 = u.pm * BM + wr * 64 + fr, col0 = u.pn * BM + wc * 32 + 8 * fq;
#pragma unroll
        for (int ai = 0; ai < 2; ++ai) {
            u32x4 gw[4][2], mw[4][2];
#pragma unroll
            for (int m = 0; m < 4; ++m) { const size_t row = (size_t)(row0 + ai * HALF + m * 16);
#pragma unroll
                for (int bj = 0; bj < 2; ++bj) { gw[m][bj] = *(const u32x4*)(G + row * NGATE + gcol0 + col0 + bj * HALF);
                    if (ACCUM) mw[m][bj] = *(const u32x4*)(Mg + row * DM + col0 + bj * HALF); } }
#pragma unroll
            for (int m = 0; m < 4; ++m) { const size_t row = (size_t)(row0 + ai * HALF + m * 16);
#pragma unroll
                for (int bj = 0; bj < 2; ++bj) {
                    float g[8]; unpack8(gw[m][bj], g);
                    float o[8];
                    if (ACCUM) unpack8(mw[m][bj], o);
                    else {
#pragma unroll
                        for (int j = 0; j < 8; ++j) o[j] = 0.f; }
                    const f32x4 v0 = acc[ai][bj][m][0], v1 = acc[ai][bj][m][1];
#pragma unroll
                    for (int j = 0; j < 4; ++j) { o[j] += g[j] * v0[j]; o[4 + j] += g[4 + j] * v1[j]; }
                    *(u32x4*)(Mg + row * DM + col0 + bj * HALF) = pack8(o); } }
            asm volatile("" ::: "memory"); }
    }
};
struct EpiRes {
    static constexpr bool PERM = false, AFTER_DRAIN = false;
    const float* base_ctx; const float* base_lat; float* X; const float* gate;
    h16* Hn; const float* gn; const float* scn; float* ssn;
    LAS unsigned char* scr;
    __device__ __forceinline__ void operator()(const f32x4 (&acc)[2][2][4][2], const Unit& u, int wr, int wc, int fr, int fq) const {
        const int cond = u.pm < 32 ? 0 : (u.pm < 48 ? 1 : 2);
        const float* gp = gate + (size_t)cond * 6144;
        const float* bp = u.pm < 32 ? base_ctx + (size_t)u.pm * BM * DM : base_lat + (size_t)(u.pm - 32) * BM * DM;
        float* xp = X + (size_t)u.pm * BM * DM;
        const int lane = fq * 16 + fr, wave = wr * 4 + wc;
        LAS unsigned char* my = scr + wave * EPI_SCR_WAVE;
        const int wofs = fr * 144 + fq * 16;
        const int rrow = lane >> 3, rc4 = (lane & 7) * 4;
        const int rofs = rrow * 144 + rc4 * 4;
        const int colw = u.pn * BM + wc * 32 + rc4;
        const unsigned loff = (unsigned)((wr * 64 + rrow) * DM + colw);
        f32x4 gv[2], gsn[2];
#pragma unroll
        for (int bj = 0; bj < 2; ++bj) { gv[bj] = *(const f32x4*)(gp + colw + bj * HALF);
            if (Hn) gsn[bj] = *(const f32x4*)(gn + colw + bj * HALF) * (*(const f32x4*)(scn + (size_t)cond * 6144 + colw + bj * HALF) + 1.0f); }
        h16* hp = Hn ? Hn + (size_t)u.pm * BM * DM : nullptr;
        float* sp = ssn ? ssn + u.pm * BM : nullptr;
#pragma unroll
        for (int ai = 0; ai < 2; ++ai)
#pragma unroll
        for (int mh = 0; mh < 2; ++mh) {
            f32x4 b[2][2][2];
#pragma unroll
            for (int m2 = 0; m2 < 2; ++m2)
#pragma unroll
                for (int k = 0; k < 2; ++k) { const float* rb = bp + (size_t)(ai * HALF + (2 * mh + m2) * 16 + 8 * k) * DM;
#pragma unroll
                    for (int bj = 0; bj < 2; ++bj) b[m2][bj][k] = *(const f32x4*)(rb + loff + bj * HALF); }
#pragma unroll
            for (int m2 = 0; m2 < 2; ++m2)
            { float q[2] = {0.f, 0.f};
#pragma unroll
                for (int bj = 0; bj < 2; ++bj) { const int m = 2 * mh + m2;
                    *(LAS f32x4*)(my + wofs) = acc[ai][bj][m][0]; *(LAS f32x4*)(my + wofs + 64) = acc[ai][bj][m][1];
#pragma unroll
                    for (int k = 0; k < 2; ++k) { const f32x4 a = *(const LAS f32x4*)(my + rofs + k * 8 * 144);
                        float* xb = xp + (size_t)(ai * HALF + m * 16 + 8 * k) * DM;
                        const f32x4 xn = b[m2][bj][k] + gv[bj] * a;
                        *(f32x4*)(xb + loff + bj * HALF) = xn;
                        if (Hn) { const f32x4 hv = xn * gsn[bj]; u32x2 w; w.x = pk_h2(hv[0], hv[1]); w.y = pk_h2(hv[2], hv[3]);
                            *(u32x2*)(hp + (size_t)(ai * HALF + m * 16 + 8 * k) * DM + loff + bj * HALF) = w;
                            q[k] += (xn[0] * xn[0] + xn[1] * xn[1]) + (xn[2] * xn[2] + xn[3] * xn[3]); } }
                }
                if (Hn) {
#pragma unroll
                    for (int k = 0; k < 2; ++k) { float t = sum8(q[k]);
                        if ((lane & 7) == 0) atomicAdd(sp + wr * 64 + ai * HALF + (2 * mh + m2) * 16 + 8 * k + rrow, t); } }
            }
            asm volatile("" ::: "memory"); }
    }
};

template <class Epi, class Sched, bool ALIGN_EPI = false, bool SP2 = false>
__device__ __forceinline__ void gemm_phase(LAS unsigned char* lds, const Gemm g, const Sched& S, const Epi& E) {
    int tid_ = threadIdx.x; asm volatile("" : "+v"(tid_));
    const int tid = tid_, wid = __builtin_amdgcn_readfirstlane(tid >> 6), lane = tid & 63, wr = wid >> 2, wc = wid & 3, fr = lane & 15, fq = lane >> 4;
    const int K = g.K, nt = K / BK, lda = g.lda;
    unsigned voffA[2], voffB[2];
#pragma unroll
    for (int i = 0; i < 2; ++i) { int R, C; stage_rc(tid * 16 + i * 8192, R, C); const int Rb = Epi::PERM ? ((R & ~31) + perm32(R & 31)) : R;
        voffA[i] = (unsigned)(R * lda + C) * 2u; voffB[i] = (unsigned)(Rb * K + C) * 2u; }
    const size_t kstep = (size_t)(BK * 2);
    const size_t hstepA = (size_t)HALF * lda * 2, hstepB = (size_t)HALF * K * 2;
    const size_t tstepA = 2 * hstepA, tstepB = 2 * hstepB;
    const unsigned ldsw = (unsigned)wid * 1024u;
    const int aoff = lds_byte(wr * 64 + fr, fq * 8), boff = lds_byte(wc * 32 + fr, fq * 8);
#define PG8_SA(b, h) (((b) * 2 + (h)) * HTB)
#define PG8_SB(b, h) ((4 + (b) * 2 + (h)) * HTB)
#define PG8_STAGE(bufoff, gbase, voff) do { _Pragma("unroll") for (int _i = 0; _i < 2; ++_i) \
        __builtin_amdgcn_global_load_lds((const unsigned*)((const char*)(gbase) + (voff)[_i]), (LAS unsigned*)(lds + (bufoff) + ldsw + _i * 8192), 16, 0, 0); } while (0)
#define PG8_LDA(dst, b, h) do { _Pragma("unroll") for (int m = 0; m < 4; ++m) _Pragma("unroll") for (int k = 0; k < 2; ++k) dst[m][k] = *(const LAS h16x8*)(lds + PG8_SA(b, h) + aoff + m * 2048 + k * 1024); } while (0)
#define PG8_LDB(dst, b, h) do { _Pragma("unroll") for (int n = 0; n < 2; ++n) _Pragma("unroll") for (int k = 0; k < 2; ++k) dst[n][k] = *(const LAS h16x8*)(lds + PG8_SB(b, h) + boff + n * 2048 + k * 1024); } while (0)
#define PG8_MMA(ai, bj, At, Bt) do { __builtin_amdgcn_s_setprio(1); _Pragma("unroll") for (int m = 0; m < 4; ++m) _Pragma("unroll") for (int n = 0; n < 2; ++n) _Pragma("unroll") for (int k = 0; k < 2; ++k) \
        acc[ai][bj][m][n] = __builtin_amdgcn_mfma_f32_16x16x32_f16(Bt[n][k], At[m][k], acc[ai][bj][m][n], 0, 0, 0); __builtin_amdgcn_s_setprio(0); } while (0)
#define PG8_WAIT_V(n) asm volatile("s_waitcnt vmcnt(" #n ")" ::: "memory")
#define PG8_WAIT_L(n) asm volatile("s_waitcnt lgkmcnt(" #n ")" ::: "memory")
#define PG8_BAR __builtin_amdgcn_s_barrier()
#define PG8_SCHED __builtin_amdgcn_sched_barrier(0)
    Unit cur, nxt; int ui = 0;
    if (!S.next(0, cur)) return;
    TSL_START(lds, 10);
    f32x4 acc[2][2][4][2];
#pragma unroll
    for (int a = 0; a < 2; ++a)
#pragma unroll
        for (int b = 0; b < 2; ++b)
#pragma unroll
            for (int m = 0; m < 4; ++m)
#pragma unroll
                for (int n = 0; n < 2; ++n) acc[a][b][m][n] = (f32x4){0.f, 0.f, 0.f, 0.f};
    h16x8 At[4][2], B0[2][2], B1[2][2];
    const char* cA = (const char*)g.A + (size_t)cur.pm * tstepA; const char* cB = (const char*)g.Bt + (size_t)cur.pn * tstepB;
    S.a_ready(cur);
    if constexpr (SP2) {
        PG8_STAGE(PG8_SB(0, 0), cB, voffB); PG8_STAGE(PG8_SB(0, 1), cB + hstepB, voffB); PG8_STAGE(PG8_SA(0, 0), cA, voffA); PG8_STAGE(PG8_SA(0, 1), cA + hstepA, voffA);
        if (wr == 1) PG8_BAR;
        PG8_WAIT_V(2); PG8_BAR;
        PG8_STAGE(PG8_SB(1, 0), cB + kstep, voffB); PG8_STAGE(PG8_SA(1, 0), cA + kstep, voffA); PG8_STAGE(PG8_SB(1, 1), cB + hstepB + kstep, voffB);
        PG8_WAIT_V(6); PG8_BAR;
    } else {
        PG8_STAGE(PG8_SB(0, 0), cB, voffB); PG8_STAGE(PG8_SA(0, 0), cA, voffA); PG8_STAGE(PG8_SB(0, 1), cB + hstepB, voffB); PG8_STAGE(PG8_SA(0, 1), cA + hstepA, voffA);
        if (wr == 1) PG8_BAR;
        PG8_WAIT_V(4); PG8_BAR;
        PG8_STAGE(PG8_SB(1, 0), cB + kstep, voffB); PG8_STAGE(PG8_SA(1, 0), cA + kstep, voffA); PG8_STAGE(PG8_SB(1, 1), cB + hstepB + kstep, voffB);
        PG8_WAIT_V(6); PG8_BAR;
    }
    for (;;) {
        const bool has_next = S.next(ui + 1, nxt);
        const char* nA = has_next ? (const char*)g.A + (size_t)nxt.pm * tstepA : cA; const char* nB = has_next ? (const char*)g.Bt + (size_t)nxt.pn * tstepB : cB;
        for (int t = 0; t < nt; t += 2) {
            const bool last = (t == nt - 2);
            const char* a1 = cA + (size_t)(t + 1) * kstep;
            const char* a2 = last ? nA : cA + (size_t)(t + 2) * kstep; const char* b2 = last ? nB : cB + (size_t)(t + 2) * kstep;
            const char* a3 = a2 + kstep; const char* b3 = b2 + kstep;
            if (last && has_next) S.a_ready(nxt);
            if constexpr (SP2) {
            PG8_LDB(B0, 0, 0); PG8_LDB(B1, 0, 1); PG8_SCHED; PG8_LDA(At, 0, 0); PG8_STAGE(PG8_SA(1, 1), a1 + hstepA, voffA);
            PG8_WAIT_V(8); PG8_WAIT_L(0); PG8_BAR; PG8_MMA(0, 0, At, B0); PG8_MMA(0, 1, At, B1); PG8_BAR; PG8_SCHED;
            PG8_LDA(At, 0, 1); PG8_STAGE(PG8_SB(0, 0), b2, voffB); PG8_STAGE(PG8_SB(0, 1), b2 + hstepB, voffB); PG8_STAGE(PG8_SA(0, 0), a2, voffA);
            PG8_WAIT_V(8); PG8_WAIT_L(0); PG8_BAR; PG8_MMA(1, 0, At, B0); PG8_MMA(1, 1, At, B1); PG8_BAR; PG8_SCHED;
            PG8_LDB(B0, 1, 0); PG8_LDB(B1, 1, 1); PG8_SCHED; PG8_LDA(At, 1, 0); PG8_STAGE(PG8_SA(0, 1), a2 + hstepA, voffA);
            PG8_WAIT_V(8); PG8_WAIT_L(0); PG8_BAR; PG8_MMA(0, 0, At, B0); PG8_MMA(0, 1, At, B1); PG8_BAR; PG8_SCHED;
            PG8_LDA(At, 1, 1); PG8_STAGE(PG8_SB(1, 0), b3, voffB); PG8_STAGE(PG8_SB(1, 1), b3 + hstepB, voffB); PG8_STAGE(PG8_SA(1, 0), a3, voffA);
            PG8_WAIT_V(8); PG8_WAIT_L(0); PG8_BAR; PG8_MMA(1, 0, At, B0); PG8_MMA(1, 1, At, B1); PG8_BAR; PG8_SCHED;
            } else {
            PG8_LDB(B0, 0, 0); PG8_SCHED; PG8_LDA(At, 0, 0); PG8_STAGE(PG8_SA(1, 1), a1 + hstepA, voffA);
            PG8_WAIT_L(8); PG8_BAR; PG8_WAIT_L(0); PG8_MMA(0, 0, At, B0); PG8_BAR; PG8_SCHED;
            PG8_LDB(B1, 0, 1); PG8_STAGE(PG8_SB(0, 0), b2, voffB);
            PG8_BAR; PG8_WAIT_L(0); PG8_MMA(0, 1, At, B1); PG8_BAR;
            PG8_LDA(At, 0, 1); PG8_STAGE(PG8_SA(0, 0), a2, voffA);
            PG8_BAR; PG8_WAIT_L(0); PG8_MMA(1, 0, At, B0); PG8_BAR; PG8_SCHED;
            PG8_STAGE(PG8_SB(0, 1), b2 + hstepB, voffB);
            PG8_WAIT_V(6); PG8_BAR; PG8_MMA(1, 1, At, B1); PG8_BAR;
            PG8_LDB(B0, 1, 0); PG8_SCHED; PG8_LDA(At, 1, 0); PG8_STAGE(PG8_SA(0, 1), a2 + hstepA, voffA);
            PG8_WAIT_L(8); PG8_BAR; PG8_WAIT_L(0); PG8_MMA(0, 0, At, B0); PG8_BAR; PG8_SCHED;
            PG8_LDB(B1, 1, 1); PG8_STAGE(PG8_SB(1, 0), b3, voffB);
            PG8_BAR; PG8_WAIT_L(0); PG8_MMA(0, 1, At, B1); PG8_BAR;
            PG8_LDA(At, 1, 1); PG8_STAGE(PG8_SA(1, 0), a3, voffA);
            PG8_BAR; PG8_WAIT_L(0); PG8_MMA(1, 0, At, B0); PG8_BAR; PG8_SCHED;
            PG8_STAGE(PG8_SB(1, 1), b3 + hstepB, voffB);
            PG8_WAIT_V(6); PG8_BAR; PG8_MMA(1, 1, At, B1); PG8_BAR;
            }
        }
        if constexpr (ALIGN_EPI) { if (wr == 0) PG8_BAR; }
        TSL_STOP(lds, 10); TSL_START(lds, 11);
        if constexpr (!Epi::AFTER_DRAIN) { E(acc, cur, wr, wc, fr, fq); S.done(cur); }
        TSL_STOP(lds, 11); TSL_START(lds, 10);
        if (!has_next) break;
#pragma unroll
        for (int a = 0; a < 2; ++a)
#pragma unroll
            for (int b = 0; b < 2; ++b)
#pragma unroll
                for (int m = 0; m < 4; ++m)
#pragma unroll
                    for (int n = 0; n < 2; ++n) acc[a][b][m][n] = (f32x4){0.f, 0.f, 0.f, 0.f};
        cur = nxt; cA = nA; cB = nB; ++ui;
        if constexpr (ALIGN_EPI) { if (wr == 1) PG8_BAR; }
    }
    PG8_WAIT_V(0);
    if constexpr (!ALIGN_EPI) { if (wr == 0) PG8_BAR; }
    PG8_BAR;
    TSL_STOP(lds, 10);
#undef PG8_SA
#undef PG8_SB
#undef PG8_STAGE
#undef PG8_LDA
#undef PG8_LDB
#undef PG8_MMA
#undef PG8_WAIT_V
#undef PG8_WAIT_L
#undef PG8_BAR
#undef PG8_SCHED
}
}

constexpr int NWAVES = 8, NTHREADS = 512;

typedef GAS unsigned gu32;
#define RLX_AGENT __ATOMIC_RELAXED, __HIP_MEMORY_SCOPE_AGENT
#define LDS_WAIT() asm volatile("s_waitcnt lgkmcnt(0)" ::: "memory")
#define VM_WAIT() asm volatile("s_waitcnt vmcnt(0)" ::: "memory")

#define XB_TMO      128
#define XB_XCNT(j)  (256  + 64 * (j))
#define XB_XSUB(j)  (1280 + 64 * (j))
#define XB_XGEN(j)  (2304 + 64 * (j))
#define XB_TOP      3328
#define XB_TOPGEN   3392
#define XCD_BAR_WORDS 3456
#define XB_SPIN_CAP (1u << 18)
__device__ __forceinline__ unsigned xb_ld(unsigned* p)              { return __hip_atomic_load(p, __ATOMIC_RELAXED, __HIP_MEMORY_SCOPE_AGENT); }
__device__ __forceinline__ unsigned xb_add(unsigned* p, unsigned v) { return __hip_atomic_fetch_add(p, v, __ATOMIC_RELAXED, __HIP_MEMORY_SCOPE_AGENT); }
__device__ __forceinline__ unsigned xb_xcc_id() { return (unsigned)__builtin_amdgcn_s_getreg((3 << 11) | 20) & 0xFu; }
#define XB_SPIN(cond, bar) do { unsigned _sp = 0; while (cond) { __builtin_amdgcn_s_sleep(1); \
    if ((++_sp & 255u) == 0u) { if (xb_ld(&(bar)[XB_TMO])) break; if (_sp > XB_SPIN_CAP) { atomicAdd(&(bar)[XB_TMO], 1u); break; } } } } while (0)
struct XcdBarrier { unsigned* bar; unsigned x; volatile LAS unsigned* st; };
__device__ __forceinline__ XcdBarrier xcd_barrier_post(unsigned* bar, volatile LAS unsigned* st) {
    XcdBarrier b; b.bar = bar; b.x = xb_xcc_id(); b.st = st;
    if (threadIdx.x == 0) (void)xb_add(&bar[XB_XCNT(b.x)], 1u);
    return b;
}
__device__ __forceinline__ void xcd_barrier_complete(unsigned* bar, unsigned x, unsigned& nloc, unsigned& nx) {
    const unsigned G = gridDim.x * gridDim.y * gridDim.z;
    unsigned sum, cnt, mine, sp = 0u;
    for (;;) {
        sum = 0u; cnt = 0u; mine = 0u;
#pragma unroll
        for (unsigned j = 0; j < 16; ++j) { const unsigned c = xb_ld(&bar[XB_XCNT(j)]); sum += c; cnt += (c > 0u) ? 1u : 0u; mine = (j == x) ? c : mine; }
        if (sum == G) break;
        __builtin_amdgcn_s_sleep(1);
        if ((++sp & 255u) == 0u) { if (xb_ld(&bar[XB_TMO])) break; if (sp > XB_SPIN_CAP) { atomicAdd(&bar[XB_TMO], 1u); break; } }
    }
    nloc = mine > 0u ? mine : 1u; nx = cnt > 0u ? cnt : 1u;
}
__device__ __forceinline__ void xcd_barrier(const XcdBarrier& b) {
    asm volatile("s_waitcnt vmcnt(0)" ::: "memory");
    __syncthreads();
    if (threadIdx.x == 0) {
        unsigned* bar = b.bar;
        __builtin_amdgcn_s_waitcnt(0);
        unsigned nloc = b.st[0], nx = b.st[1];
        if (nloc == 0u) { xcd_barrier_complete(bar, b.x, nloc, nx); b.st[0] = nloc; b.st[1] = nx; }
        const unsigned old = xb_add(&bar[XB_XSUB(b.x)], 1u);
        const unsigned gen = old / nloc;
        if (old + 1u == (gen + 1u) * nloc) {
            __builtin_amdgcn_fence(__ATOMIC_RELEASE, "agent");
            asm volatile("s_waitcnt vmcnt(0)" ::: "memory");
            const unsigned og = xb_add(&bar[XB_TOP], 1u);
            const unsigned tg = og / nx;
            if (og + 1u == (tg + 1u) * nx) xb_add(&bar[XB_TOPGEN], 1u);
            else XB_SPIN(xb_ld(&bar[XB_TOPGEN]) == tg, bar);
            __builtin_amdgcn_fence(__ATOMIC_ACQUIRE, "agent");
            xb_add(&bar[XB_XGEN(b.x)], 1u);
            asm volatile("s_waitcnt vmcnt(0)" ::: "memory");
        } else {
            XB_SPIN(xb_ld(&bar[XB_XGEN(b.x)]) == gen, bar);
            __builtin_amdgcn_fence(__ATOMIC_ACQUIRE, "agent");
            asm volatile("s_waitcnt vmcnt(0)" ::: "memory");
        }
    }
    __syncthreads();
}
constexpr int CW_BAR = 4096;
static_assert((CW_BAR + XCD_BAR_WORDS) * 4 <= (int)CTL_ZERO_BYTES, "ctl");

struct Args {
    const float* in[33]; float* out; unsigned char* ws; int ph_lo, ph_hi;
};
typedef const GAS float* cfp_t;
struct Frame {
    LAS unsigned char* lds;
    int tid, lane, wave, vcu, G;
    const __attribute__((address_space(4))) cfp_t* in; float* out; unsigned char* ws; float* out0; unsigned char* ws0;
    __device__ __forceinline__ const float* inp(int i) const { return (const float*)in[i]; }
    __device__ __forceinline__ void refresh() { int t = threadIdx.x; asm volatile("" : "+v"(t)); tid = t; lane = t & 63; wave = __builtin_amdgcn_readfirstlane(t >> 6);
        const __attribute__((address_space(4))) cfp_t* p = (const __attribute__((address_space(4))) cfp_t*)__builtin_amdgcn_kernarg_segment_ptr(); asm volatile("" : "+s"(p)); in = p;
        GAS float* o_ = (GAS float*)out0; GAS unsigned char* w_ = (GAS unsigned char*)ws0; asm volatile("" : "+s"(o_), "+s"(w_)); out = (float*)o_; ws = (unsigned char*)w_; }
};
enum { I_XP = 0, I_XS, I_C, I_CKB, I_CVB, I_CKC, I_CVC, I_STATE, I_CCTX, I_N1G, I_N2G, I_WMOD, I_BMOD, I_WIN, I_LCW, I_LCB, I_LWA, I_LBA, I_LWX, I_LBX, I_LAM,
       I_QNG, I_KNG, I_SINK, I_WOA, I_WOB, I_WOC, I_WOUT, I_WUP, I_FCW, I_FCB, I_WDOWN, I_FING };

__device__ __forceinline__ void transpose_item(const float* W, int K, int N, h16* WT, LAS float* scr, int item, int lane) {
    const int nblk = N / 32, kb = item / nblk, nb = item % nblk, k0 = 64 * kb, n0 = 32 * nb;
    f32x4 v[8];
#pragma unroll
    for (int i = 0; i < 8; ++i) v[i] = *(const f32x4*)(W + (size_t)(k0 + 8 * i + (lane >> 3)) * N + n0 + 4 * (lane & 7));
#pragma unroll
    for (int i = 0; i < 8; ++i) { LAS float* d = scr + (8 * i + (lane >> 3)) * 33 + 4 * (lane & 7); d[0] = v[i].x; d[1] = v[i].y; d[2] = v[i].z; d[3] = v[i].w; }
    LDS_WAIT(); asm volatile("" ::: "memory");
    const int c = lane & 7;
#pragma unroll
    for (int j = 0; j < 4; ++j) { const int n = (lane >> 3) + 8 * j; const LAS float* sp = scr + (8 * c) * 33 + n;
        u32x4 o; o.x = pk_h2(sp[0 * 33], sp[1 * 33]); o.y = pk_h2(sp[2 * 33], sp[3 * 33]); o.z = pk_h2(sp[4 * 33], sp[5 * 33]); o.w = pk_h2(sp[6 * 33], sp[7 * 33]);
        *(u32x4*)(WT + (size_t)(n0 + n) * K + k0 + 8 * c) = o; }
    LDS_WAIT(); asm volatile("" ::: "memory");
}
__device__ __forceinline__ void phase_convert_weights(Frame& F, int l) {
    LAS float* scr = (LAS float*)(F.lds + F.wave * 16384);
    const int gw = F.vcu * NWAVES + F.wave, NGW = F.G * NWAVES;
    unsigned char* wb = F.ws + WS_W;
    constexpr int IT_IN = (DM / 64) * (DIN / 32), IT_OA = (1024 / 64) * (DM / 32), IT_OB = (512 / 64) * (DM / 32), IT_OUT = (DM / 64) * (DM / 32),
                  IT_UP = (DM / 64) * (DUP / 32), IT_DOWN = (DFF / 64) * (DM / 32), IT_LRU1 = (128 / 64) * (128 / 32), IT_LRU = 32 * IT_LRU1;
    constexpr int NITEMS = IT_IN + IT_OA + 2 * IT_OB + IT_OUT + IT_UP + IT_DOWN + IT_LRU;
    for (int it = gw; it < NITEMS; it += NGW) {
        int r = it;
        if (r < IT_IN) { transpose_item(F.inp(I_WIN) + (size_t)l * DM * DIN, DM, DIN, (h16*)(wb + W_IN), scr, r, F.lane); continue; } r -= IT_IN;
        if (r < IT_OA) { transpose_item(F.inp(I_WOA) + (size_t)l * 1024 * DM, 1024, DM, (h16*)(wb + W_OA), scr, r, F.lane); continue; } r -= IT_OA;
        if (r < IT_OB) { transpose_item(F.inp(I_WOB) + (size_t)l * 512 * DM, 512, DM, (h16*)(wb + W_OB), scr, r, F.lane); continue; } r -= IT_OB;
        if (r < IT_OB) { transpose_item(F.inp(I_WOC) + (size_t)l * 512 * DM, 512, DM, (h16*)(wb + W_OC), scr, r, F.lane); continue; } r -= IT_OB;
        if (r < IT_OUT) { transpose_item(F.inp(I_WOUT) + (size_t)l * DM * DM, DM, DM, (h16*)(wb + W_OUT), scr, r, F.lane); continue; } r -= IT_OUT;
        if (r < IT_UP) { transpose_item(F.inp(I_WUP) + (size_t)l * DM * DUP, DM, DUP, (h16*)(wb + W_UP), scr, r, F.lane); continue; } r -= IT_UP;
        if (r < IT_DOWN) { transpose_item(F.inp(I_WDOWN) + (size_t)l * DFF * DM, DFF, DM, (h16*)(wb + W_DOWN), scr, r, F.lane); continue; } r -= IT_DOWN;
        {
            const int mi = r / IT_LRU1, sub = r % IT_LRU1, dir = mi >> 4, gate = (mi >> 3) & 1, n = mi & 7;
            const float* src = (gate ? F.inp(I_LWX) : F.inp(I_LWA)) + ((size_t)((l * 2 + dir) * 8 + n)) * 128 * 128;
            transpose_item(src, 128, 128, (h16*)(wb + W_LRU) + (size_t)mi * 128 * 128, scr, sub, F.lane);
        }
    }
}
__device__ __forceinline__ void phase_prep_misc(Frame& F) {
    LAS float* sil = (LAS float*)F.lds;
    LAS float* part = (LAS float*)(F.lds + 16384);
    float* mod = (float*)(F.ws + WS_MOD);
    for (int item = F.vcu; item < 192; item += F.G) {
        const int l = item / 96, n0 = (item % 96) * 64;
        __syncthreads();
        for (int i = F.tid; i < 3 * 1024; i += NTHREADS) { const int j = i >> 10, k = i & 1023;
            const float v = j == 0 ? F.inp(I_CCTX)[k] : F.inp(I_C)[(j - 1) * 1024 + k]; sil[i] = v * sigmoidf_(v); }
        __syncthreads();
        const float* wp = F.inp(I_WMOD) + (size_t)l * DM * 6144 + n0 + F.lane;
        float a0 = 0.f, a1 = 0.f, a2 = 0.f;
        const int kb = F.wave * 128;
#pragma unroll 8
        for (int k = 0; k < 128; ++k) { const float w = wp[(size_t)(kb + k) * 6144]; a0 += w * sil[kb + k]; a1 += w * sil[1024 + kb + k]; a2 += w * sil[2048 + kb + k]; }
        part[(F.wave * 3 + 0) * 64 + F.lane] = a0; part[(F.wave * 3 + 1) * 64 + F.lane] = a1; part[(F.wave * 3 + 2) * 64 + F.lane] = a2;
        __syncthreads();
        if (F.tid < 192) { const int j = F.tid >> 6, c = F.tid & 63; float s = F.inp(I_BMOD)[l * 6144 + n0 + c];
#pragma unroll
            for (int w = 0; w < 8; ++w) s += part[(w * 3 + j) * 64 + c];
            mod[((size_t)l * 3 + j) * 6144 + n0 + c] = s; }
    }
    __syncthreads();
    const int gt = F.vcu * NTHREADS + F.tid, NGT = F.G * NTHREADS;
    float* rope = (float*)(F.ws + WS_ROPE);
    for (int i = gt; i < 64 * 16; i += NGT) { const int pos = i >> 4, fi = i & 15; const float inv = expf(-(float)fi * (1.0f / 16.0f) * 9.210340371976184f);
        const float ang = (float)pos * inv; rope[2 * i] = cosf(ang); rope[2 * i + 1] = sinf(ang); }
    h16* cache = (h16*)(F.ws + WS_CACHE);
    for (int i = gt; i < 4 * 131072 / 4; i += NGT) { const int kind = i / 32768, e = (i % 32768) * 4;
        const float* src = kind == 0 ? F.inp(I_CKB) : kind == 1 ? F.inp(I_CVB) : kind == 2 ? F.inp(I_CKC) : F.inp(I_CVC);
        const f32x4 v = *(const f32x4*)(src + e); u32x2 w; w.x = pk_h2(v[0], v[1]); w.y = pk_h2(v[2], v[3]); *(u32x2*)(cache + (size_t)kind * 131072 + e) = w; }
}

__device__ __forceinline__ const float* xrow_ptr(const Frame& F, int layer_src_is_input, int row) {
    if (layer_src_is_input) return row < NCTX ? F.inp(I_XP) + (size_t)row * DM : F.inp(I_XS) + (size_t)(row - NCTX) * DM;
    return F.out + O_Y + (size_t)row * DM;
}
__device__ __forceinline__ void phase_norm0(Frame& F, const float* g, const float* mod_l, float* ss) {
    const int gw = F.vcu * NWAVES + F.wave, NGW = F.G * NWAVES;
    h16* H = (h16*)(F.ws + WS_H);
    for (int grp = gw; grp < NTOK / 4; grp += NGW) {
        const int row0 = grp * 4;
        const int cond = row0 < NCTX ? 0 : (row0 < NCTX + LSEQ ? 1 : 2);
        const float* mp = mod_l + (size_t)cond * 6144;
        f32x4 v[4][4];
#pragma unroll
        for (int i = 0; i < 4; ++i) { const f32x4* xr = (const f32x4*)xrow_ptr(F, 1, row0 + i) + F.lane;
#pragma unroll
            for (int j = 0; j < 4; ++j) v[i][j] = xr[64 * j]; }
        f32x4 gs[4];
#pragma unroll
        for (int j = 0; j < 4; ++j) { const int c = F.lane * 4 + 256 * j; gs[j] = *(const f32x4*)(g + c) * (*(const f32x4*)(mp + 1024 + c) + 1.0f); }
#pragma unroll
        for (int i = 0; i < 4; ++i) {
            float sq = 0.f;
#pragma unroll
            for (int j = 0; j < 4; ++j) sq += (v[i][j].x * v[i][j].x + v[i][j].y * v[i][j].y) + (v[i][j].z * v[i][j].z + v[i][j].w * v[i][j].w);
            sq = wave_sum(sq);
            if (F.lane == 0) ss[row0 + i] = sq;
            u32x2* o8 = (u32x2*)(H + (size_t)(row0 + i) * DM) + F.lane;
#pragma unroll
            for (int j = 0; j < 4; ++j) { const f32x4 y = v[i][j] * gs[j]; u32x2 w; w.x = pk_h2(y.x, y.y); w.y = pk_h2(y.z, y.w); o8[64 * j] = w; }
        }
    }
}
__device__ __forceinline__ void phase_cvec(Frame& F, int l) {
    const int gw = F.vcu * NWAVES + F.wave, NGW = F.G * NWAVES, lane = F.lane;
    const float* mod_l = (const float*)(F.ws + WS_MOD) + (size_t)l * 3 * 6144;
    float* cv = (float*)(F.ws + WS_CV) + (size_t)l * 3 * (DIN + DUP);
    for (int kind = 0; kind < 2; ++kind) {
        const int N = kind == 0 ? DIN : DUP, sc = kind == 0 ? 0 : 3;
        const h16* Wt = (const h16*)(F.ws + WS_W + (kind == 0 ? W_IN : W_UP));
        float sh[3][16];
#pragma unroll
        for (int c = 0; c < 3; ++c)
#pragma unroll
            for (int j = 0; j < 2; ++j)
#pragma unroll
                for (int e = 0; e < 8; ++e) sh[c][8 * j + e] = mod_l[(size_t)c * 6144 + sc * 1024 + 8 * lane + 512 * j + e];
        for (int n0 = gw * 4; n0 < N; n0 += NGW * 4) {
            u32x4 raw[4][2];
#pragma unroll
            for (int i = 0; i < 4; ++i) { raw[i][0] = *(const u32x4*)(Wt + (size_t)(n0 + i) * DM + 8 * lane); raw[i][1] = *(const u32x4*)(Wt + (size_t)(n0 + i) * DM + 512 + 8 * lane); }
#pragma unroll
            for (int i = 0; i < 4; ++i) {
                float w[16]; unpack8(raw[i][0], w); unpack8(raw[i][1], w + 8);
                float a0 = 0.f, a1 = 0.f, a2 = 0.f;
#pragma unroll
                for (int e = 0; e < 16; ++e) { a0 += w[e] * sh[0][e]; a1 += w[e] * sh[1][e]; a2 += w[e] * sh[2][e]; }
                a0 = wave_sum(a0); a1 = wave_sum(a1); a2 = wave_sum(a2);
                if (lane == 0) { float* o = cv + (kind == 0 ? 0 : DIN) + n0 + i; o[0] = a0; o[DIN + DUP] = a1; o[2 * (DIN + DUP)] = a2; }
            }
        }
    }
}
__device__ __forceinline__ void phase_final_norm(Frame& F) {
    const int gw = F.vcu * NWAVES + F.wave, NGW = F.G * NWAVES;
    f32x4 gg[4];
#pragma unroll
    for (int j = 0; j < 4; ++j) gg[j] = *(const f32x4*)(F.inp(I_FING) + F.lane * 4 + 256 * j);
    for (int grp = gw; grp < NTOK / 4; grp += NGW) {
        const int row0 = grp * 4;
        f32x4 v[4][4];
#pragma unroll
        for (int i = 0; i < 4; ++i) { const f32x4* xr = (const f32x4*)(F.out + O_Y + (size_t)(row0 + i) * DM) + F.lane;
#pragma unroll
            for (int j = 0; j < 4; ++j) v[i][j] = xr[64 * j]; }
#pragma unroll
        for (int i = 0; i < 4; ++i) {
            float s = 0.f;
#pragma unroll
            for (int j = 0; j < 4; ++j) s += (v[i][j].x * v[i][j].x + v[i][j].y * v[i][j].y) + (v[i][j].z * v[i][j].z + v[i][j].w * v[i][j].w);
            const float rstd = 1.0f / sqrtf(wave_sum(s) * (1.0f / DM) + NORM_EPS);
            f32x4* xo = (f32x4*)(F.out + O_Y + (size_t)(row0 + i) * DM) + F.lane;
#pragma unroll
            for (int j = 0; j < 4; ++j) xo[64 * j] = v[i][j] * rstd * gg[j];
        }
    }
}

__device__ __forceinline__ void phase_qk(Frame& F, int l, bool write_out = true) {
    const int gw = F.vcu * NWAVES + F.wave, NGW = F.G * NWAVES, lane = F.lane;
    h16* Z = (h16*)(F.ws + WS_ZU);
    const float* rope = (const float*)(F.ws + WS_ROPE);
    const float* qg = F.inp(I_QNG) + l * 64; const float* kg = F.inp(I_KNG) + l * 64;
    const int hl = lane & 7, hc0 = hl * 8;
    float qgv[8], kgv[8];
#pragma unroll
    for (int j = 0; j < 8; ++j) { qgv[j] = qg[hc0 + j]; kgv[j] = kg[hc0 + j]; }
    for (int row = gw; row < NTOK; row += NGW) {
        const bool is_ctx = row < NCTX;
        int rpos = 0, cpos = 0, b = 0, t = 0;
        if (is_ctx) { b = row >> 8; t = row & 255; } else { const int tt = (row - NCTX) & (LSEQ - 1); rpos = tt >> 6; cpos = tt & 63; }
        h16* zr = Z + (size_t)row * NMAIN;
#pragma unroll
        for (int pass = 0; pass < 3; ++pass) {
            const int col = C_QB + pass * 512 + lane * 8;
            int kind;
            if (pass == 0) kind = 0; else if (pass == 1) kind = lane < 8 * 2 ? 1 : (lane < 8 * 4 ? 2 : 3); else kind = lane < 32 ? 3 : (lane < 48 ? 4 : 5);
            const u32x4 w = *(const u32x4*)(zr + col);
            float x[8]; unpack8(w, x);
            if (kind <= 1) {
                float s = 0.f;
#pragma unroll
                for (int j = 0; j < 8; ++j) s += x[j] * x[j];
                s = sum8(s);
                const float rstd = 1.0f / sqrtf(s * (1.0f / 64.0f) + NORM_EPS);
#pragma unroll
                for (int j = 0; j < 8; ++j) x[j] = x[j] * rstd * (kind == 0 ? qgv[j] : kgv[j]);
            }
            if (!is_ctx) {
                float p[8];
#pragma unroll
                for (int j = 0; j < 8; ++j) p[j] = __shfl_xor(x[j], 2);
                if (kind == 0 || kind == 1 || kind == 3 || kind == 4) {
                    const int half = hl >> 2, second = (hl >> 1) & 1, f0 = (hl & 1) * 8, pos = half ? cpos : rpos;
                    const float* tp = rope + ((size_t)pos * 16 + f0) * 2;
#pragma unroll
                    for (int j = 0; j < 8; ++j) { const float cs = tp[2 * j], sn = tp[2 * j + 1]; x[j] = second ? (p[j] * sn + x[j] * cs) : (x[j] * cs - p[j] * sn); }
                }
            }
            if (kind == 0 || kind == 3) {
#pragma unroll
                for (int j = 0; j < 8; ++j) x[j] *= QSCALE;
            }
            if (kind != 2 && kind != 5) *(u32x4*)(zr + col) = pack8(x);
            if (write_out && is_ctx && (kind == 1 || kind == 2 || kind == 4 || kind == 5)) {
                const size_t ob = kind == 1 ? O_KB : kind == 2 ? O_VB : kind == 4 ? O_KC : O_VC;
                const int c128 = (kind == 1 || kind == 2) ? (col - (kind == 1 ? C_KB : C_VB)) : (col - (kind == 4 ? C_KC : C_VC));
                float* op = F.out + ob + ((size_t)((b * 2 + l) * 256 + t)) * 128 + c128;
                *(f32x4*)op = (f32x4){x[0], x[1], x[2], x[3]}; *(f32x4*)(op + 4) = (f32x4){x[4], x[5], x[6], x[7]};
            }
        }
    }
}

__device__ __forceinline__ int img_off(int row, int ch) { return row * 256 + ((((ch >> 3) ^ (row & 15)) << 4) | ((ch & 7) << 1)); }
template <int MODE, int DIR>
__device__ __forceinline__ void lru_scan(Frame& F, int l, int row0, int n, int lat_b, int lat_chunk, int ctx_b, bool write_out, int cb) {
    LAS unsigned char* img = F.lds; LAS unsigned char* hx = F.lds + 65536;
    const int lane = F.lane, r32 = lane & 31, hi = lane >> 5, hm = hi ^ DIR;
    const int C = n * 128 + cb * 32 + r32;
    h16x8 Br[8], Bi[8];
    if (MODE != 3) {
        const h16* wr_ = (const h16*)(F.ws + WS_W + W_LRU) + ((size_t)((DIR * 2 + 0) * 8 + n) * 128 + cb * 32 + r32) * 128 + 8 * hi;
        const h16* wi_ = (const h16*)(F.ws + WS_W + W_LRU) + ((size_t)((DIR * 2 + 1) * 8 + n) * 128 + cb * 32 + r32) * 128 + 8 * hi;
#pragma unroll
        for (int ks = 0; ks < 8; ++ks) { Br[ks] = *(const h16x8*)(wr_ + 16 * ks); Bi[ks] = *(const h16x8*)(wi_ + 16 * ks); }
    }
    float k8 = 0.f, nba = 0.f, nbx = 0.f;
    if (MODE != 3) {
        const float ba = F.inp(I_LBA)[(size_t)(l * 2 + DIR) * DLRU + C], bx = F.inp(I_LBX)[(size_t)(l * 2 + DIR) * DLRU + C];
        const float lam = F.inp(I_LAM)[(size_t)(l * 2 + DIR) * DLRU + C];
        const float sp = (-lam > 20.f) ? -lam : log1pf(expf(-lam));
        k8 = -8.0f * sp * LOG2E;
        nba = -LOG2E * ba; nbx = -LOG2E * bx;
    }
    u32x4* stash_u = (u32x4*)(F.ws + WS_STASH) + (size_t)(((lat_b * 2 + DIR) * 16 + lat_chunk) * 8) * (DLRU * 2 * 4);
    const unsigned sl = (unsigned)((C * 2 + hi) * 4);
    unsigned nxt[16];
    if (MODE == 3) { const int rb0 = DIR == 0 ? 0 : 7;
#pragma unroll
        for (int q = 0; q < 4; ++q) { const u32x4 t = stash_u[(size_t)rb0 * (DLRU * 2 * 4) + sl + q]; nxt[4 * q] = t.x; nxt[4 * q + 1] = t.y; nxt[4 * q + 2] = t.z; nxt[4 * q + 3] = t.w; } }
    float H = 0.f, aggP = 1.f;
    if (MODE == 2 || MODE == 3) {
        const float* agg = (const float*)(F.ws + WS_AGG);
        H = F.inp(I_STATE)[(size_t)((lat_b * 2 + l) * 2 + DIR) * DLRU + C];
        float ap[15], au[15];
#pragma unroll
        for (int k = 0; k < 15; ++k) { const int ch = DIR == 0 ? k : 15 - k; const bool use = DIR == 0 ? (ch < lat_chunk) : (ch > lat_chunk);
            const float* p = agg + ((size_t)((lat_b * 16 + (use ? ch : 0)) * 2 + DIR) * DLRU + C) * 2; ap[k] = use ? p[0] : 1.f; au[k] = use ? p[1] : 0.f; }
#pragma unroll
        for (int k = 0; k < 15; ++k) H = ap[k] * H + au[k];
    }
    const int xch = cb * 4 + (r32 >> 3), xel = (r32 & 7) * 2;
    int lo8[8];
#pragma unroll
    for (int ci = 0; ci < 8; ++ci) { const int c = (ci & 3) + 8 * (ci >> 2); lo8[ci] = (((xch ^ (4 * hi)) ^ c) << 4) + xel + (4 * hi) * 256; }
#define LOFF(rn) (lo8s[((rn) & 3) + 4 * (((rn) >> 2) & 1)] + (8 * ((rn) >> 2) + ((rn) & 3)) * 256)
#pragma unroll 1
    for (int step = 0; step < 8; ++step) {
        if (step == 4) __syncthreads();
        const int rb = DIR == 0 ? step : 7 - step;
        int lo8s[8];
#pragma unroll
        for (int ci = 0; ci < 8; ++ci) lo8s[ci] = lo8[ci] + rb * 8192;
        float an[16], un[16];
        if (MODE == 3) {
#pragma unroll
            for (int r = 0; r < 16; ++r) { const h16x2 w = __builtin_bit_cast(h16x2, nxt[r]); an[r] = fast_exp2((float)w[0]); un[r] = (float)w[1]; }
            if (step < 7) { const int rbn = DIR == 0 ? step + 1 : 6 - step;
#pragma unroll
                for (int q = 0; q < 4; ++q) { const u32x4 t = stash_u[(size_t)rbn * (DLRU * 2 * 4) + sl + q]; nxt[4 * q] = t.x; nxt[4 * q + 1] = t.y; nxt[4 * q + 2] = t.z; nxt[4 * q + 3] = t.w; } }
        } else {
        unsigned sw[16];
        f32x16 ar = {}, ai = {};
#pragma unroll
        for (int ks = 0; ks < 8; ++ks) {
            const h16x8 af = *(const LAS h16x8*)(img + (rb * 32 + r32) * 256 + (((2 * ks + hi) ^ (r32 & 15)) << 4));
            ar = __builtin_amdgcn_mfma_f32_32x32x16_f16(af, Br[ks], ar, 0, 0, 0);
            ai = __builtin_amdgcn_mfma_f32_32x32x16_f16(af, Bi[ks], ai, 0, 0, 0);
        }
#pragma unroll
        for (int r = 0; r < 16; ++r) {
            const float xv = (float)*(const LAS h16*)(img + LOFF(r));
            const float d1 = 1.0f + fast_exp2(__builtin_fmaf(ar[r], -LOG2E, nba)), d2 = 1.0f + fast_exp2(__builtin_fmaf(ai[r], -LOG2E, nbx));
            const float R = fast_rcp(d1 * d2);
            const float rr = R * d2, ii = R * d1;
            const float e2 = k8 * rr;
            const float av = fast_exp2(e2);
            an[r] = av;
            un[r] = __builtin_amdgcn_sqrtf(__builtin_fmaf(-av, av, 1.0f)) * (ii * xv);
            if (MODE == 1) sw[r] = pk_h2(e2, un[r]);
        }
        if (MODE == 1) {
#pragma unroll
            for (int q = 0; q < 4; ++q) stash_u[(size_t)rb * (DLRU * 2 * 4) + sl + q] = (u32x4){sw[4 * q], sw[4 * q + 1], sw[4 * q + 2], sw[4 * q + 3]}; }
        }
#define SA(r) (DIR ? an[15 - (r)] : an[(r)])
#define SU(r) (DIR ? un[15 - (r)] : un[(r)])
        float Pe[4], Ue[4], Po[4], Uo[4];
#pragma unroll
        for (int g = 0; g < 4; ++g) {
            float p = 1.f, uu = 0.f;
#pragma unroll
            for (int i = 0; i < 4; ++i) { uu = SA(4 * g + i) * uu + SU(4 * g + i); p *= SA(4 * g + i); }
            const auto sp_ = __builtin_amdgcn_permlane32_swap(__float_as_uint(p), __float_as_uint(p), false, false);
            const auto su_ = __builtin_amdgcn_permlane32_swap(__float_as_uint(uu), __float_as_uint(uu), false, false);
            Pe[g] = __uint_as_float(sp_[DIR]); Po[g] = __uint_as_float(sp_[1 - DIR]); Ue[g] = __uint_as_float(su_[DIR]); Uo[g] = __uint_as_float(su_[1 - DIR]);
        }
        float Hs[4];
        {
            float h = H;
#pragma unroll
            for (int g = 0; g < 4; ++g) { const float he = h; h = Pe[g] * h + Ue[g]; const float ho = h; h = Po[g] * h + Uo[g]; Hs[g] = hm ? ho : he; }
            H = h;
        }
        if (MODE == 1) { float p = 1.f;
#pragma unroll
            for (int g = 0; g < 4; ++g) p *= Pe[g] * Po[g];
            aggP *= p; }
        if (MODE != 1) {
#pragma unroll
            for (int g = 0; g < 4; ++g) { float h = Hs[g];
                float old[4];
#pragma unroll
                for (int i = 0; i < 4; ++i) old[i] = (float)*(const LAS h16*)(hx + LOFF(DIR ? 15 - (4 * g + i) : (4 * g + i)));
#pragma unroll
                for (int i = 0; i < 4; ++i) { const int r = 4 * g + i; h = SA(r) * h + SU(r);
                    const float o = step < 4 ? 0.f : old[i];
                    *(LAS h16*)(hx + LOFF(DIR ? 15 - r : r)) = (h16)(h + o); } }
        }
#undef SA
#undef SU
    }
#undef LOFF
    if (MODE == 0 && hi == 0 && write_out) F.out[O_LRU + (size_t)((ctx_b * 2 + l) * 2 + DIR) * DLRU + C] = H;
    if (MODE == 1 && hi == 0) { float* agg = (float*)(F.ws + WS_AGG) + ((size_t)((lat_b * 16 + lat_chunk) * 2 + DIR) * DLRU + C) * 2; agg[0] = aggP; agg[1] = H; }
}
template <int MODE>
__device__ __forceinline__ void lru_unit(Frame& F, int l, int row0, int n, int seq_first, int seq_last, int lat_b, int lat_chunk, int ctx_b, bool write_out = true, int pv = 0) {
    LAS unsigned char* img = F.lds; LAS unsigned char* hx = F.lds + 65536;
    const h16* Z = (const h16*)(F.ws + WS_ZU);
    const int tid = F.tid;
    __syncthreads();
    if (MODE != 3 && !(pv & 1)) {
        const int cc = tid & 15, tg = tid >> 4; const int ch0 = n * 128 + cc * 8;
        float w0[8], w1[8], w2[8], w3[8], bb[8];
        const float* cw = F.inp(I_LCW) + (size_t)l * 4 * DLRU + ch0; const float* cb = F.inp(I_LCB) + (size_t)l * DLRU + ch0;
#pragma unroll
        for (int j = 0; j < 8; ++j) { w0[j] = cw[j]; w1[j] = cw[DLRU + j]; w2[j] = cw[2 * DLRU + j]; w3[j] = cw[3 * DLRU + j]; bb[j] = cb[j]; }
        const int t0 = tg * 8;
        u32x4 raw[11];
#pragma unroll
        for (int i = 0; i < 11; ++i) { const int t = t0 - 2 + i; const bool ok = (t >= 0 || !seq_first) && (t < 256 || !seq_last);
            const int tc = ok ? t : (t < 0 ? 0 : 255);
            const u32x4 v = *(const u32x4*)(Z + (size_t)(row0 + tc) * NMAIN + C_XA + ch0);
            raw[i].x = ok ? v.x : 0u; raw[i].y = ok ? v.y : 0u; raw[i].z = ok ? v.z : 0u; raw[i].w = ok ? v.w : 0u; }
        float xm2[8], xm1[8], x0[8], xp1[8];
        unpack8(raw[0], xm2); unpack8(raw[1], xm1); unpack8(raw[2], x0);
#pragma unroll
        for (int i = 0; i < 8; ++i) {
            unpack8(raw[3 + i], xp1);
            float y[8];
#pragma unroll
            for (int j = 0; j < 8; ++j) y[j] = bb[j] + w0[j] * xm2[j] + w1[j] * xm1[j] + w2[j] * x0[j] + w3[j] * xp1[j];
            *(LAS u32x4*)(img + img_off(t0 + i, cc * 8)) = pack8(y);
#pragma unroll
            for (int j = 0; j < 8; ++j) { xm2[j] = xm1[j]; xm1[j] = x0[j]; x0[j] = xp1[j]; }
        }
    }
    __syncthreads();
    const int dir = F.wave >> 2, cb = F.wave & 3;
    if (!(pv & 2)) {
    if (dir == 0) lru_scan<MODE, 0>(F, l, row0, n, lat_b, lat_chunk, ctx_b, write_out, cb);
    else          lru_scan<MODE, 1>(F, l, row0, n, lat_b, lat_chunk, ctx_b, write_out, cb);
    }
    if (MODE != 1 && !(pv & 4)) {
        __syncthreads();
        h16* OA = (h16*)(F.ws + WS_ZU + ZU_OA);
#pragma unroll
        for (int k = 0; k < 8; ++k) { const int i = tid + NTHREADS * k, tk = i >> 4, cc = i & 15;
            float hs[8], ya[8], o[8];
            unpack8(*(const LAS u32x4*)(hx + img_off(tk, cc * 8)), hs);
            unpack8(*(const u32x4*)(Z + (size_t)(row0 + tk) * NMAIN + C_YA + n * 128 + cc * 8), ya);
#pragma unroll
            for (int j = 0; j < 8; ++j) o[j] = hs[j] * gelu_tanh(ya[j]);
            *(u32x4*)(OA + (size_t)(row0 + tk) * 1024 + n * 128 + cc * 8) = pack8(o); }
    }
}

struct AttnDesc {
    const h16* Qz; h16* O;
    const h16* Kc; const h16* Vc;
    const h16* Kz; const h16* Vz;
    int nc, zt0, nz;
    int windowed;
    const float* sink;
    int kvh, q0;
};
__device__ __forceinline__ void attn_unit(Frame& F, const AttnDesc& D, const h16* Qrow0  , h16* Orow0  ) {
    LAS unsigned char* lds = F.lds;
    const int tid = F.tid, lane = F.lane, wave = F.wave, r32 = lane & 31, hi = lane >> 5;
    const int head = D.kvh * 4 + (wave >> 1);
    const int qpos = D.q0 + (wave & 1) * 32 + r32;
    const int NT = D.nc + D.nz;
    h16x8 qr[4];
    { const h16* qp = Qrow0 + (size_t)qpos * NMAIN + head * 64 + 8 * hi;
#pragma unroll
      for (int d0 = 0; d0 < 4; ++d0) qr[d0] = *(const h16x8*)(qp + 16 * d0); }
    const int krow = tid >> 3, kch = tid & 7; const int kdst = krow * 128 + ((kch ^ ((krow >> 1) & 7)) << 4);
    const int vrow = 16 * (wave & 3) + (lane >> 2), vcol = (wave >> 2) * 32 + (lane & 3) * 8; const int vdst = wave * 1024 + lane * 16;
    auto ktile_ptr = [&](int j, int row, int col, bool isV) -> const h16* {
        if (j < D.nc) return (isV ? D.Vc : D.Kc) + (size_t)(64 * j + row) * 128 + col;
        return (isV ? D.Vz : D.Kz) + (size_t)((D.zt0 + (j - D.nc)) * 64 + row) * NMAIN + col;
    };
    u32x4 kreg, vreg;
    kreg = *(const u32x4*)ktile_ptr(0, krow, kch * 8, false); vreg = *(const u32x4*)ktile_ptr(0, vrow, vcol, true);
    __syncthreads();
    *(LAS u32x4*)(lds + kdst) = kreg; *(LAS u32x4*)(lds + 16384 + vdst) = vreg;
    __syncthreads();
    float mhat, l_run;
    const bool has_sink = D.sink != nullptr;
    if (has_sink) { mhat = D.sink[head] * LOG2E; l_run = hi == 0 ? 1.f : 0.f; } else { mhat = 0.f; l_run = 0.f; }
    f32x16 negm;
#pragma unroll
    for (int r = 0; r < 16; ++r) negm[r] = -mhat;
    f32x16 o0 = {}, o1 = {};
    LAS float* wsf = (LAS float*)(lds + 32768) + wave * 64;
    const int kfoff = r32 * 128;
    const int ksw = (r32 >> 1) & 7;
    const int vp0 = ((lane >> 4) & 1) * 32 + (lane & 3) * 8 + (4 * hi + ((lane & 15) >> 2)) * 64;
#pragma unroll 1
    for (int j = 0; j < NT; ++j) {
        const int buf = j & 1;
        if (j + 1 < NT) { kreg = *(const u32x4*)ktile_ptr(j + 1, krow, kch * 8, false); vreg = *(const u32x4*)ktile_ptr(j + 1, vrow, vcol, true); }
        LAS unsigned char* Kb = lds + buf * 8192; LAS unsigned char* Vb = lds + 16384 + buf * 8192;
        f32x16 p0, p1;
#pragma unroll
        for (int d0 = 0; d0 < 4; ++d0) {
            const int co = ((2 * d0 + hi) ^ ksw) << 4;
            const h16x8 k0 = *(const LAS h16x8*)(Kb + kfoff + co);
            const h16x8 k1 = *(const LAS h16x8*)(Kb + 4096 + kfoff + co);
            p0 = __builtin_amdgcn_mfma_f32_32x32x16_f16(k0, qr[d0], d0 == 0 ? negm : p0, 0, 0, 0);
            p1 = __builtin_amdgcn_mfma_f32_32x32x16_f16(k1, qr[d0], d0 == 0 ? negm : p1, 0, 0, 0);
        }
        if (D.windowed && j >= D.nc) {
            const int kb0 = (D.zt0 + (j - D.nc)) * 64 + 4 * hi;
#pragma unroll
            for (int r = 0; r < 16; ++r) { const int kp = kb0 + (r & 3) + 8 * (r >> 2);
                const int d0_ = qpos - kp, d1_ = qpos - (kp + 32);
                if (d0_ > 128 || d0_ < -128) p0[r] = -1e30f;
                if (d1_ > 128 || d1_ < -128) p1[r] = -1e30f; }
        }
        if (j == 0) {
            float mx = fmaxf(p0[0], p1[0]);
#pragma unroll
            for (int r = 1; r < 16; ++r) mx = fmaxf(mx, fmaxf(p0[r], p1[r]));
            mx = fmaxf(mx, __shfl_xor(mx, 32));
            const float dl = has_sink ? fmaxf(mx, 0.f) : mx;
#pragma unroll
            for (int r = 0; r < 16; ++r) { p0[r] -= dl; p1[r] -= dl; }
            mhat += dl; if (has_sink) l_run *= fast_exp2(-dl);
#pragma unroll
            for (int r = 0; r < 16; ++r) negm[r] = -mhat;
        }
        float rs = 0.f;
#pragma unroll
        for (int r = 0; r < 16; ++r) { p0[r] = fast_exp2(p0[r]); p1[r] = fast_exp2(p1[r]); rs += p0[r] + p1[r]; }
        if (__builtin_expect(__any(rs > 256.f), 0)) {
            const float rsm = fmaxf(rs, __shfl_xor(rs, 32));
            const float dl = rsm > 256.f ? ceilf(__builtin_log2f(rsm)) : 0.f;
            const float f = fast_exp2(-dl);
#pragma unroll
            for (int r = 0; r < 16; ++r) { p0[r] *= f; p1[r] *= f; }
            rs *= f; l_run *= f; mhat += dl;
#pragma unroll
            for (int r = 0; r < 16; ++r) negm[r] = -mhat;
            if (hi == 0) wsf[r32] = f;
            LDS_WAIT();
#pragma unroll
            for (int r = 0; r < 16; ++r) { const float g = wsf[(r & 3) + 8 * (r >> 2) + 4 * hi]; o0[r] *= g; o1[r] *= g; }
        }
        l_run += rs;
        u32x4 pw[4];
        pw[0] = (u32x4){pk_h2(p0[0], p0[1]), pk_h2(p0[2], p0[3]), pk_h2(p0[4], p0[5]), pk_h2(p0[6], p0[7])};
        pw[1] = (u32x4){pk_h2(p0[8], p0[9]), pk_h2(p0[10], p0[11]), pk_h2(p0[12], p0[13]), pk_h2(p0[14], p0[15])};
        pw[2] = (u32x4){pk_h2(p1[0], p1[1]), pk_h2(p1[2], p1[3]), pk_h2(p1[4], p1[5]), pk_h2(p1[6], p1[7])};
        pw[3] = (u32x4){pk_h2(p1[8], p1[9]), pk_h2(p1[10], p1[11]), pk_h2(p1[12], p1[13]), pk_h2(p1[14], p1[15])};
#pragma unroll
        for (int ks = 0; ks < 4; ++ks) {
            const h16x8 pa = __builtin_bit_cast(h16x8, pw[ks]);
#pragma unroll
            for (int d0 = 0; d0 < 2; ++d0) {
                const s16x4 lo = __builtin_amdgcn_ds_read_tr16_b64_v4i16((LAS s16x4*)(Vb + vp0 + d0 * 4096 + ks * 1024));
                const s16x4 hh = __builtin_amdgcn_ds_read_tr16_b64_v4i16((LAS s16x4*)(Vb + vp0 + d0 * 4096 + ks * 1024 + 512));
                typedef short s16x8 __attribute__((ext_vector_type(8)));
                const s16x8 vv = {lo[0], lo[1], lo[2], lo[3], hh[0], hh[1], hh[2], hh[3]};
                const h16x8 vf = __builtin_bit_cast(h16x8, vv);
                if (d0 == 0) o0 = __builtin_amdgcn_mfma_f32_32x32x16_f16(pa, vf, o0, 0, 0, 0);
                else         o1 = __builtin_amdgcn_mfma_f32_32x32x16_f16(pa, vf, o1, 0, 0, 0);
            }
        }
        if (j + 1 < NT) { *(LAS u32x4*)(lds + (buf ^ 1) * 8192 + kdst) = kreg; *(LAS u32x4*)(lds + 16384 + (buf ^ 1) * 8192 + vdst) = vreg; }
        __syncthreads();
    }
    l_run += __shfl_xor(l_run, 32);
    if (hi == 0) wsf[32 + r32] = l_run;
    LDS_WAIT();
    h16* op = Orow0 + (size_t)(D.q0 + (wave & 1) * 32) * 512 + head * 64 + r32;
#pragma unroll
    for (int r = 0; r < 16; ++r) { const int q = (r & 3) + 8 * (r >> 2) + 4 * hi; const float rl = fast_rcp(wsf[32 + q]);
        op[(size_t)q * 512] = (h16)(o0[r] * rl); op[(size_t)q * 512 + 32] = (h16)(o1[r] * rl); }
}
__device__ __forceinline__ void attn_dispatch(Frame& F, int l, int type, int u) {
    const h16* Z = (const h16*)(F.ws + WS_ZU);
    const h16* cache = (const h16*)(F.ws + WS_CACHE);
    AttnDesc D; D.sink = nullptr; D.windowed = 0; D.Kc = nullptr; D.Vc = nullptr; D.nc = 0;
    const bool isC = type & 1;
    const int qcol = isC ? C_QC : C_QB, kcol = isC ? C_KC : C_KB, vcol = isC ? C_VC : C_VB;
    h16* Obase = (h16*)(F.ws + WS_ZU + (isC ? ZU_OC : ZU_OB));
    size_t row_seq0;
    if (type < 2) {
        const int b = u >> 7, kvh = (u >> 6) & 1, qb = u & 63;
        row_seq0 = (size_t)NCTX + (size_t)b * LSEQ; D.kvh = kvh; D.q0 = qb * 64;
        D.Kc = cache + ((size_t)(isC ? 2 : 0) * 131072) + (size_t)((b * 2 + l) * 256) * 128 + kvh * 64;
        D.Vc = cache + ((size_t)(isC ? 3 : 1) * 131072) + (size_t)((b * 2 + l) * 256) * 128 + kvh * 64;
        D.nc = 4;
        if (!isC) { D.zt0 = 0; D.nz = 64; }
        else { int lo = qb - 2; if (lo < 0) lo = 0; int hi_ = qb + 2; if (hi_ > 63) hi_ = 63; D.zt0 = lo; D.nz = hi_ - lo + 1; D.windowed = 1; }
    } else {
        const int b = u >> 3, kvh = (u >> 2) & 1, qb = u & 3;
        row_seq0 = (size_t)b * SEQ; D.kvh = kvh; D.q0 = qb * 64; D.zt0 = 0; D.nz = 4;
    }
    if (isC) D.sink = F.inp(I_SINK) + l * 8;
    D.Kz = Z + row_seq0 * NMAIN + kcol + D.kvh * 64; D.Vz = Z + row_seq0 * NMAIN + vcol + D.kvh * 64;
    attn_unit(F, D, Z + row_seq0 * NMAIN + qcol, Obase + row_seq0 * 512);
}

__device__ __forceinline__ void phase_ffn_act(Frame& F, int l) {
    h16* U = (h16*)(F.ws + WS_ZU);
    const int gt = F.vcu * NTHREADS + F.tid, NGT = F.G * NTHREADS;
    constexpr int NCC = DFF / 8, RUN = 16, NRUN = NTOK / RUN;
    for (int it = gt; it < NCC * NRUN; it += NGT) {
        const int cc = it % NCC, run = it / NCC; const int c0 = cc * 8, r0 = run * RUN;
        const bool first = (r0 < NCTX) ? ((r0 & 255) == 0) : (((r0 - NCTX) & (LSEQ - 1)) == 0);
        const bool last = (r0 < NCTX) ? (((r0 + RUN) & 255) == 0) : ((((r0 + RUN) - NCTX) & (LSEQ - 1)) == 0);
        float w0[8], w1[8], w2[8], bb[8];
        const float* cw = F.inp(I_FCW) + (size_t)l * 3 * DFF + c0; const float* cb = F.inp(I_FCB) + (size_t)l * DFF + c0;
#pragma unroll
        for (int j = 0; j < 8; ++j) { w0[j] = cw[j]; w1[j] = cw[DFF + j]; w2[j] = cw[2 * DFF + j]; bb[j] = cb[j]; }
        u32x4 gr[RUN + 2], vr[RUN];
#pragma unroll
        for (int i = 0; i < RUN + 2; ++i) { const int r = r0 - 1 + i; const bool ok = !((i == 0 && first) || (i == RUN + 1 && last));
            const int rc = ok ? r : r0; const u32x4 v = *(const u32x4*)(U + (size_t)rc * DUP + c0);
            gr[i].x = ok ? v.x : 0u; gr[i].y = ok ? v.y : 0u; gr[i].z = ok ? v.z : 0u; gr[i].w = ok ? v.w : 0u; }
#pragma unroll
        for (int i = 0; i < RUN; ++i) vr[i] = *(const u32x4*)(U + (size_t)(r0 + i) * DUP + DFF + c0);
        float gp[8], gc[8], gn[8];
        unpack8(gr[0], gp); unpack8(gr[1], gc);
#pragma unroll
        for (int i = 0; i < RUN; ++i) {
            unpack8(gr[i + 2], gn);
            float v[8]; unpack8(vr[i], v);
            float o[8];
#pragma unroll
            for (int j = 0; j < 8; ++j) { const float g = bb[j] + w0[j] * gp[j] + w1[j] * gc[j] + w2[j] * gn[j]; o[j] = gelu_tanh(g) * v[j]; gp[j] = gc[j]; gc[j] = gn[j]; }
            *(u32x4*)(U + (size_t)(r0 + i) * DUP + DFF + c0) = pack8(o);
        }
    }
}

constexpr int N_PHASES = 25;
__global__ void __launch_bounds__(NTHREADS, 2) fwd_kernel(Args args) {
    extern __shared__ __attribute__((aligned(16))) unsigned char lds_raw[];
    Frame F;
    F.lds = (LAS unsigned char*)lds_raw;
    F.tid = threadIdx.x; F.lane = F.tid & 63; F.wave = __builtin_amdgcn_readfirstlane(F.tid >> 6);
    F.G = gridDim.x; { const int bx = blockIdx.x; F.vcu = (F.G % 8 == 0) ? (bx % 8) * (F.G / 8) + bx / 8 : bx; }
    F.out0 = args.out; F.ws0 = args.ws; F.refresh();
    volatile LAS unsigned* MISC = (volatile LAS unsigned*)(F.lds + MISC_OFF);
    for (int u = F.tid; u < (LDS_BYTES - LDSCTL_OFF) / 4; u += NTHREADS) ((LAS unsigned*)(F.lds + LDSCTL_OFF))[u] = 0u;
    __syncthreads();
#if !MK_PER_PHASE
    XcdBarrier bar = xcd_barrier_post((unsigned*)(F.ws + WS_CTL) + CW_BAR, MISC + 8);
#define GRID_BAR() xcd_barrier(bar)
#else
    (void)MISC;
#define GRID_BAR() do { } while (0)
#endif
    const int lo = args.ph_lo, hi_ph = args.ph_hi;
#if defined(TIME_PH)
#ifndef TIME_AMP
#define TIME_AMP 8
#endif
    unsigned long long t_acc = 0, t_0 = 0;
#define TSTART(k) do { TSL_PHASE(F.lds, (k)); if ((k) == TIME_PH) t_0 = __builtin_amdgcn_s_memrealtime(); } while (0)
#define TSTOP(k) do { if ((k) == TIME_PH) t_acc += __builtin_amdgcn_s_memrealtime() - t_0; } while (0)
#else
#define TSTART(k) do { TSL_PHASE(F.lds, (k)); } while (0)
#define TSTOP(k) do { } while (0)
#endif
#define IN(k) (lo <= (k) && (k) < hi_ph)
#define SEAM(k) do { if (IN((k) + 1)) GRID_BAR(); } while (0)
#pragma unroll
    for (int l = 0; l < DEPTH; ++l) {
        const int pb = 12 * l;
        if (IN(pb + 0)) { TSTART(0); F.refresh(); phase_convert_weights(F, l); if (l == 0) phase_prep_misc(F); SEAM(pb + 0); TSTOP(0); }
        if (IN(pb + 1)) { TSTART(1); F.refresh();
            if (l == 0) phase_norm0(F, F.inp(I_N1G), (const float*)(F.ws + WS_MOD), (float*)(F.ws + WS_SS));
            phase_cvec(F, l);
            SEAM(pb + 1); TSTOP(1); }
        if (IN(pb + 2)) { TSTART(2); F.refresh();
            pg8::Gemm g{(const h16*)(F.ws + WS_H), (const h16*)(F.ws + WS_W + W_IN), NTOK, NMAIN, DM, DM}; pg8::StaticOrder S; S.init(NTOK, NMAIN, F.G, (int)blockIdx.x);
            pg8::EpiF16<0> E{(h16*)(F.ws + WS_ZU), NMAIN, (const float*)(F.ws + WS_SS) + (size_t)(2 * l) * NTOK, (const float*)(F.ws + WS_CV) + (size_t)l * 3 * (DIN + DUP), DIN + DUP};
            pg8::gemm_phase<pg8::EpiF16<0>, pg8::StaticOrder, true, true>(F.lds, g, S, E);
            SEAM(pb + 2); TSTOP(2); }
        if (IN(pb + 3)) { TSTART(3); F.refresh();
            phase_qk(F, l);
            for (int u = F.vcu; u < 512; u += F.G) {
                if (u < 256) lru_unit<0>(F, l, (u >> 3) * 256, u & 7, 1, 1, 0, 0, u >> 3);
                else { const int v = u - 256, b = v >> 7, ch = (v >> 3) & 15; lru_unit<1>(F, l, NCTX + b * LSEQ + ch * 256, v & 7, ch == 0, ch == 15, b, ch, 0); }
            }
            SEAM(pb + 3); TSTOP(3); }
        if (IN(pb + 4)) { TSTART(4); F.refresh();
            for (int type = 0; type < 4; ++type) { TSL_START(F.lds, 20 + type); for (int u = F.vcu; u < 256; u += F.G) attn_dispatch(F, l, type, u); TSL_STOP(F.lds, 20 + type); }
            TSL_START(F.lds, 24);
            for (int v = F.vcu; v < 256; v += F.G) { const int b = v >> 7, ch = (v >> 3) & 15; lru_unit<3>(F, l, NCTX + b * LSEQ + ch * 256, v & 7, ch == 0, ch == 15, b, ch, 0); }
            TSL_STOP(F.lds, 24);
            SEAM(pb + 4); TSTOP(4); }
        if (IN(pb + 5)) { TSTART(5); F.refresh();
            pg8::Gemm g{(const h16*)(F.ws + WS_H), (const h16*)(F.ws + WS_W + W_IN) + (size_t)NMAIN * DM, NTOK, NGATE, DM, DM}; pg8::StaticOrder S; S.init(NTOK, NGATE, F.G, (int)blockIdx.x);
            pg8::EpiF16<1> E{(h16*)(F.ws + WS_ZU), NGATE, (const float*)(F.ws + WS_SS) + (size_t)(2 * l) * NTOK, (const float*)(F.ws + WS_CV) + (size_t)l * 3 * (DIN + DUP) + NMAIN, DIN + DUP};
            pg8::gemm_phase<pg8::EpiF16<1>, pg8::StaticOrder, true, true>(F.lds, g, S, E);
            SEAM(pb + 5); TSTOP(5); }
        if (IN(pb + 6)) { TSTART(6); F.refresh();
            pg8::StaticOrder S; S.init(NTOK, DM, F.G, (int)blockIdx.x);
            h16* Hb = (h16*)(F.ws + WS_H); const h16* Gb = (const h16*)(F.ws + WS_ZU);
            { pg8::Gemm g{(const h16*)(F.ws + WS_ZU + ZU_OA), (const h16*)(F.ws + WS_W + W_OA), NTOK, DM, 1024, 1024}; pg8::EpiGateMul<0> E{Hb, Gb, 0};
              pg8::gemm_phase<pg8::EpiGateMul<0>, pg8::StaticOrder, true, true>(F.lds, g, S, E); }
            { pg8::Gemm g{(const h16*)(F.ws + WS_ZU + ZU_OB), (const h16*)(F.ws + WS_W + W_OB), NTOK, DM, 512, 512}; pg8::EpiGateMul<1> E{Hb, Gb, 1024};
              pg8::gemm_phase<pg8::EpiGateMul<1>, pg8::StaticOrder, true, true>(F.lds, g, S, E); }
            { pg8::Gemm g{(const h16*)(F.ws + WS_ZU + ZU_OC), (const h16*)(F.ws + WS_W + W_OC), NTOK, DM, 512, 512}; pg8::EpiGateMul<1> E{Hb, Gb, 2048};
              pg8::gemm_phase<pg8::EpiGateMul<1>, pg8::StaticOrder, true, true>(F.lds, g, S, E); }
            SEAM(pb + 6); TSTOP(6); }
        if (IN(pb + 7)) { TSTART(7); F.refresh();
            pg8::Gemm g{(const h16*)(F.ws + WS_H), (const h16*)(F.ws + WS_W + W_OUT), NTOK, DM, DM, DM}; pg8::StaticOrder S; S.init(NTOK, DM, F.G, (int)blockIdx.x);
            pg8::EpiRes E{l == 0 ? F.inp(I_XP) : F.out + O_Y, l == 0 ? F.inp(I_XS) : F.out + O_Y + (size_t)NCTX * DM, F.out + O_Y, (const float*)(F.ws + WS_MOD) + (size_t)l * 3 * 6144 + 2 * 1024,
                          (h16*)(F.ws + WS_H2), F.inp(I_N2G) + l * DM, (const float*)(F.ws + WS_MOD) + (size_t)l * 3 * 6144 + 4 * 1024, (float*)(F.ws + WS_SS) + (size_t)(2 * l + 1) * NTOK, F.lds + EPI_SCR_OFF};
            pg8::gemm_phase<pg8::EpiRes, pg8::StaticOrder, true, true>(F.lds, g, S, E);
            SEAM(pb + 7); TSTOP(7); }
        if (IN(pb + 9)) { TSTART(9); F.refresh();
            pg8::Gemm g{(const h16*)(F.ws + WS_H2), (const h16*)(F.ws + WS_W + W_UP), NTOK, DUP, DM, DM}; pg8::StaticOrder S; S.init(NTOK, DUP, F.G, (int)blockIdx.x);
            pg8::EpiF16<0> E{(h16*)(F.ws + WS_ZU), DUP, (const float*)(F.ws + WS_SS) + (size_t)(2 * l + 1) * NTOK, (const float*)(F.ws + WS_CV) + (size_t)l * 3 * (DIN + DUP) + DIN, DIN + DUP};
            pg8::gemm_phase<pg8::EpiF16<0>, pg8::StaticOrder, true, true>(F.lds, g, S, E);
            SEAM(pb + 9); TSTOP(9); }
        if (IN(pb + 10)) { TSTART(10); F.refresh(); phase_ffn_act(F, l); SEAM(pb + 10); TSTOP(10); }
        if (IN(pb + 11)) { TSTART(11); F.refresh();
            pg8::Gemm g{(const h16*)(F.ws + WS_ZU) + DFF, (const h16*)(F.ws + WS_W + W_DOWN), NTOK, DM, DFF, DUP}; pg8::StaticOrder S; S.init(NTOK, DM, F.G, (int)blockIdx.x);
            const bool nx = l + 1 < DEPTH;
            pg8::EpiRes E{F.out + O_Y, F.out + O_Y + (size_t)NCTX * DM, F.out + O_Y, (const float*)(F.ws + WS_MOD) + (size_t)l * 3 * 6144 + 5 * 1024,
                          nx ? (h16*)(F.ws + WS_H) : (h16*)nullptr, F.inp(I_N1G) + (nx ? l + 1 : l) * DM, (const float*)(F.ws + WS_MOD) + (size_t)(nx ? l + 1 : l) * 3 * 6144 + 1 * 1024,
                          nx ? (float*)(F.ws + WS_SS) + (size_t)(2 * (l + 1)) * NTOK : (float*)nullptr, F.lds + EPI_SCR_OFF};
            pg8::gemm_phase<pg8::EpiRes, pg8::StaticOrder, true, true>(F.lds, g, S, E);
            SEAM(pb + 11); TSTOP(11); }
    }
    if (IN(24)) { TSTART(12); F.refresh(); phase_final_norm(F); TSTOP(12); }
#if defined(TIME_SUB)
    if (blockIdx.x == 0 && threadIdx.x == 0) { const unsigned long long ta = *(volatile LAS unsigned long long*)(F.lds + MISC_OFF + 64); const unsigned long long t1 = __builtin_amdgcn_s_memrealtime(); while (__builtin_amdgcn_s_memrealtime() - t1 < 8ull * ta) __builtin_amdgcn_s_sleep(8); }
#endif
#if defined(TIME_PH)
    if (blockIdx.x == 0 && threadIdx.x == 0) { const unsigned long long t1 = __builtin_amdgcn_s_memrealtime(); while (__builtin_amdgcn_s_memrealtime() - t1 < (unsigned long long)TIME_AMP * t_acc) __builtin_amdgcn_s_sleep(8); }
#endif
#if defined(PROBE_PH)
#ifndef PROBE_N
#define PROBE_N 4
#endif
#ifndef PROBE_SUB
#define PROBE_SUB 0xFF
#endif
#ifndef PROBE_VAR
#define PROBE_VAR 0
#endif
    if (IN(24)) {
        const int l = 1;
        for (int rep = 0; rep < PROBE_N; ++rep) {
            GRID_BAR(); F.refresh();
            if (PROBE_PH == 0) { phase_convert_weights(F, l); }
            if (PROBE_PH == 12) { phase_prep_misc(F); }
            if (PROBE_PH == 1) { phase_norm_mod(F, 0, F.inp(I_N1G) + l * DM, (const float*)(F.ws + WS_MOD) + (size_t)l * 3 * 6144, 0); }
            if (PROBE_PH == 2) { pg8::Gemm g{(const h16*)(F.ws + WS_H), (const h16*)(F.ws + WS_W + W_IN), NTOK, NMAIN, DM, DM}; pg8::StaticOrder S; S.init(NTOK, NMAIN, F.G, (int)blockIdx.x);
                pg8::EpiF16<0> E{(h16*)(F.ws + WS_ZU), NMAIN}; pg8::gemm_phase<pg8::EpiF16<0>, pg8::StaticOrder, true, true>(F.lds, g, S, E); }
            if (PROBE_PH == 3) {
                if (PROBE_SUB & 1) phase_qk(F, l, false);
                for (int u = F.vcu; u < 512; u += F.G) {
                    if (u < 256) { if (PROBE_SUB & 2) lru_unit<0>(F, l, (u >> 3) * 256, u & 7, 1, 1, 0, 0, u >> 3, false); }
                    else if (PROBE_SUB & 4) { const int v = u - 256, b = v >> 7, ch = (v >> 3) & 15; lru_unit<1>(F, l, NCTX + b * LSEQ + ch * 256, v & 7, ch == 0, ch == 15, b, ch, 0); }
                } }
            if (PROBE_PH == 4) {
                for (int type = 0; type < 4; ++type) if ((PROBE_SUB >> type) & 1) for (int u = F.vcu; u < 256; u += F.G) attn_dispatch(F, l, type, u);
                if (PROBE_SUB & 16) for (int v = F.vcu; v < 256; v += F.G) { const int b = v >> 7, ch = (v >> 3) & 15; lru_unit<2>(F, l, NCTX + b * LSEQ + ch * 256, v & 7, ch == 0, ch == 15, b, ch, 0, true, PROBE_VAR); } }
            if (PROBE_PH == 5) { pg8::Gemm g{(const h16*)(F.ws + WS_H), (const h16*)(F.ws + WS_W + W_IN) + (size_t)NMAIN * DM, NTOK, NGATE, DM, DM}; pg8::StaticOrder S; S.init(NTOK, NGATE, F.G, (int)blockIdx.x);
                pg8::EpiF16<1> E{(h16*)(F.ws + WS_ZU), NGATE}; pg8::gemm_phase<pg8::EpiF16<1>, pg8::StaticOrder, true, true>(F.lds, g, S, E); }
            if (PROBE_PH == 6) { pg8::StaticOrder S; S.init(NTOK, DM, F.G, (int)blockIdx.x);
                h16* Hb = (h16*)(F.ws + WS_H); const h16* Gb = (const h16*)(F.ws + WS_ZU);
                { pg8::Gemm g{(const h16*)(F.ws + WS_ZU + ZU_OA), (const h16*)(F.ws + WS_W + W_OA), NTOK, DM, 1024, 1024}; pg8::EpiGateMul<0> E{Hb, Gb, 0};
                  pg8::gemm_phase<pg8::EpiGateMul<0>, pg8::StaticOrder, true, true>(F.lds, g, S, E); }
                { pg8::Gemm g{(const h16*)(F.ws + WS_ZU + ZU_OB), (const h16*)(F.ws + WS_W + W_OB), NTOK, DM, 512, 512}; pg8::EpiGateMul<1> E{Hb, Gb, 1024};
                  pg8::gemm_phase<pg8::EpiGateMul<1>, pg8::StaticOrder, true, true>(F.lds, g, S, E); }
                { pg8::Gemm g{(const h16*)(F.ws + WS_ZU + ZU_OC), (const h16*)(F.ws + WS_W + W_OC), NTOK, DM, 512, 512}; pg8::EpiGateMul<1> E{Hb, Gb, 2048};
                  pg8::gemm_phase<pg8::EpiGateMul<1>, pg8::StaticOrder, true, true>(F.lds, g, S, E); } }
            if (PROBE_PH == 7) { pg8::Gemm g{(const h16*)(F.ws + WS_H), (const h16*)(F.ws + WS_W + W_OUT), NTOK, DM, DM, DM}; pg8::StaticOrder S; S.init(NTOK, DM, F.G, (int)blockIdx.x);
                pg8::EpiRes E{F.out + O_Y, F.out + O_Y + (size_t)NCTX * DM, (float*)(F.ws + WS_ZU), (const float*)(F.ws + WS_MOD) + (size_t)l * 3 * 6144 + 2 * 1024, nullptr, nullptr, nullptr, nullptr, F.lds + EPI_SCR_OFF};
                pg8::gemm_phase<pg8::EpiRes, pg8::StaticOrder, true, true>(F.lds, g, S, E); }
            if (PROBE_PH == 9) { pg8::Gemm g{(const h16*)(F.ws + WS_H), (const h16*)(F.ws + WS_W + W_UP), NTOK, DUP, DM, DM}; pg8::StaticOrder S; S.init(NTOK, DUP, F.G, (int)blockIdx.x);
                pg8::EpiF16<0> E{(h16*)(F.ws + WS_ZU), DUP}; pg8::gemm_phase<pg8::EpiF16<0>, pg8::StaticOrder, true, true>(F.lds, g, S, E); }
            if (PROBE_PH == 10) { phase_ffn_act(F, l); }
            if (PROBE_PH == 11) { pg8::Gemm g{(const h16*)(F.ws + WS_ZU) + DFF, (const h16*)(F.ws + WS_W + W_DOWN), NTOK, DM, DFF, DUP}; pg8::StaticOrder S; S.init(NTOK, DM, F.G, (int)blockIdx.x);
                pg8::EpiRes E{F.out + O_Y, F.out + O_Y + (size_t)NCTX * DM, (float*)(F.ws + WS_H), (const float*)(F.ws + WS_MOD) + (size_t)l * 3 * 6144 + 5 * 1024, nullptr, nullptr, nullptr, nullptr, F.lds + EPI_SCR_OFF};
                pg8::gemm_phase<pg8::EpiRes, pg8::StaticOrder, true, true>(F.lds, g, S, E); }
            if (PROBE_PH == 13) { }
        }
    }
#endif
#undef IN
#undef SEAM
}

extern "C" void kernel_launch(void* const* d_in, const int* in_sizes, int n_in, void* d_out, int out_size, void* d_ws, size_t ws_size, hipStream_t stream) {
    static int grid = 0;
    if (grid == 0) {
        if (n_in != 33 || out_size != (int)O_END || ws_size < WS_END) { fprintf(stderr, "kernel_launch: unexpected shapes: n_in %d out %d ws %zu (need %zu)\n", n_in, out_size, ws_size, (size_t)WS_END); grid = -1; return; }
        int dev = 0, cus = 0;
        if (hipGetDevice(&dev) != hipSuccess || hipDeviceGetAttribute(&cus, hipDeviceAttributeMultiprocessorCount, dev) != hipSuccess) { grid = -1; return; }
        if (hipFuncSetAttribute((const void*)fwd_kernel, hipFuncAttributeMaxDynamicSharedMemorySize, LDS_BYTES) != hipSuccess) { fprintf(stderr, "kernel_launch: hipFuncSetAttribute failed\n"); grid = -1; return; }
        (void)hipGetLastError();
        grid = cus;
    }
    if (grid < 0) return;
    (void)hipMemsetAsync((char*)d_ws + WS_CTL, 0, CTL_ZERO_BYTES, stream);
    Args a{};
    for (int i = 0; i < 33; ++i) a.in[i] = (const float*)d_in[i];
    a.out = (float*)d_out; a.ws = (unsigned char*)d_ws;
#if MK_PER_PHASE
    for (int ph = 0; ph < N_PHASES; ++ph) { a.ph_lo = ph; a.ph_hi = ph + 1; hipLaunchKernelGGL(fwd_kernel, dim3(grid), dim3(NTHREADS), LDS_BYTES, stream, a); }
#else
    a.ph_lo = 0; a.ph_hi = N_PHASES;
    hipLaunchKernelGGL(fwd_kernel, dim3(grid), dim3(NTHREADS), LDS_BYTES, stream, a);
#endif
}
```

```cpp
#include <hip/hip_runtime.h>
#include <cstdio>
#include <cstdint>
#include <cmath>

#ifndef MK_PER_PHASE
#define MK_PER_PHASE 0
#endif

#define LAS __attribute__((address_space(3)))
#define GAS __attribute__((address_space(1)))
typedef _Float16 h16;
typedef _Float16 h16x8 __attribute__((ext_vector_type(8)));
typedef _Float16 h16x4 __attribute__((ext_vector_type(4)));
typedef _Float16 h16x2 __attribute__((ext_vector_type(2)));
typedef short s16x4 __attribute__((ext_vector_type(4)));
typedef float f32x2 __attribute__((ext_vector_type(2)));
typedef float f32x4 __attribute__((ext_vector_type(4)));
typedef float f32x16 __attribute__((ext_vector_type(16)));
typedef unsigned u32x2 __attribute__((ext_vector_type(2)));
typedef unsigned u32x4 __attribute__((ext_vector_type(4)));

constexpr int DM = 1024, NTOK = 16384, NCTX = 8192, SEQ = 256, LSEQ = 4096, NB_CTX = 32, NB_LAT = 2, DEPTH = 2;
constexpr int DIN = 6656, NMAIN = 3584, NGATE = 3072, DFF = 2816, DUP = 5632, DLRU = 1024;
constexpr int C_XA = 0, C_YA = 1024, C_QB = 2048, C_KB = 2560, C_VB = 2688, C_QC = 2816, C_KC = 3328, C_VC = 3456;
constexpr float NORM_EPS = 1e-6f;
constexpr float LOG2E = 1.4426950408889634f;
constexpr float QSCALE = 0.125f * LOG2E;
constexpr size_t O_Y = 0, O_KB = 16777216, O_VB = 18874368, O_KC = 20971520, O_VC = 23068672, O_LRU = 25165824, O_END = 25296896;
constexpr size_t MiB = 1u << 20;
constexpr size_t WS_CTL = 0, WS_SS = 64 * 1024, CTL_ZERO_BYTES = 64 * 1024 + 4 * NTOK * 4;
constexpr size_t WS_MOD = 1 * MiB;
constexpr size_t WS_ROPE = 1 * MiB + 256 * 1024;
constexpr size_t WS_AGG = 1 * MiB + 320 * 1024;
constexpr size_t WS_CACHE = 2 * MiB;
constexpr size_t WS_W = 3 * MiB;
constexpr size_t W_IN = 0, W_OA = W_IN + (size_t)DIN * DM * 2, W_OB = W_OA + (size_t)DM * 1024 * 2, W_OC = W_OB + (size_t)DM * 512 * 2,
                 W_OUT = W_OC + (size_t)DM * 512 * 2, W_UP = W_OUT + (size_t)DM * DM * 2, W_DOWN = W_UP + (size_t)DUP * DM * 2,
                 W_LRU = W_DOWN + (size_t)DM * DFF * 2, W_END = W_LRU + (size_t)2 * 2 * 8 * 128 * 128 * 2;
static_assert(W_END <= 37 * MiB, "weights region");
constexpr size_t WS_H = 40 * MiB;
constexpr size_t WS_ZU = 72 * MiB;
constexpr size_t ZU_OA = (size_t)NTOK * NMAIN * 2, ZU_OB = ZU_OA + (size_t)NTOK * 1024 * 2, ZU_OC = ZU_OB + (size_t)NTOK * 512 * 2;
constexpr size_t WS_STASH = WS_ZU + (size_t)NTOK * DUP * 2;
static_assert(WS_STASH == 248 * MiB, "ws map");
constexpr size_t WS_H2 = WS_STASH + (size_t)NB_LAT * 2 * LSEQ * DLRU * 4;
constexpr size_t WS_CV = WS_H2 + (size_t)NTOK * DM * 2;
constexpr size_t WS_EDGE = WS_CV + MiB;
constexpr size_t WS_END = WS_EDGE + (size_t)64 * 8 * 3 * DFF * 4;

__device__ __forceinline__ unsigned pk_h2(float lo, float hi) { f32x2 v = {lo, hi}; h16x2 h = __builtin_convertvector(v, h16x2); return __builtin_bit_cast(unsigned, h); }
__device__ __forceinline__ void unpack8(u32x4 w, float* x) { h16x8 h = __builtin_bit_cast(h16x8, w);
#pragma unroll
    for (int j = 0; j < 8; ++j) x[j] = (float)h[j]; }
__device__ __forceinline__ u32x4 pack8(const float* x) { u32x4 w; w.x = pk_h2(x[0], x[1]); w.y = pk_h2(x[2], x[3]); w.z = pk_h2(x[4], x[5]); w.w = pk_h2(x[6], x[7]); return w; }
__device__ __forceinline__ float fast_exp2(float x) { return __builtin_amdgcn_exp2f(x); }
__device__ __forceinline__ float fast_rcp(float x) { return __builtin_amdgcn_rcpf(x); }
__device__ __forceinline__ float sigmoidf_(float x) { return fast_rcp(1.0f + fast_exp2(-LOG2E * x)); }
__device__ __forceinline__ float gelu_tanh(float x) { const float t = x + 0.044715f * x * x * x; return x * fast_rcp(1.0f + fast_exp2(-2.0f * 0.7978845608028654f * LOG2E * t)); }
template <int CTRL> __device__ __forceinline__ float dpp_f(float v) { return __int_as_float(__builtin_amdgcn_update_dpp(0, __float_as_int(v), CTRL, 0xf, 0xf, true)); }
__device__ __forceinline__ float sum8(float v) { v += dpp_f<0xB1>(v); v += dpp_f<0x4E>(v); v += dpp_f<0x141>(v); return v; }
__device__ __forceinline__ float wave_sum(float v) { v = sum8(v); v += dpp_f<0x140>(v); v += __shfl_xor(v, 16); v += __shfl_xor(v, 32); return v; }

constexpr int RING_BYTES = 131072;
constexpr int LDSCTL_OFF = RING_BYTES, MISC_OFF = LDSCTL_OFF + 320;
constexpr int LDS_BYTES = 163840;
constexpr int EPI_SCR_OFF = RING_BYTES + 2048, EPI_SCR_WAVE = 2304;
#if defined(TIME_SUB)
#ifndef TIME_FILTER
#define TIME_FILTER -1
#endif
#define TSL_OK(l_) (blockIdx.x == 0 && threadIdx.x == 0 && (TIME_FILTER < 0 || *(volatile LAS int*)((l_) + MISC_OFF + 96) == TIME_FILTER))
#define TSL_START(l_, id) do { if ((id) == TIME_SUB && TSL_OK(l_)) *(volatile LAS unsigned long long*)((l_) + MISC_OFF + 72) = __builtin_amdgcn_s_memrealtime(); } while (0)
#define TSL_STOP(l_, id) do { if ((id) == TIME_SUB && TSL_OK(l_)) { volatile LAS unsigned long long* a_ = (volatile LAS unsigned long long*)((l_) + MISC_OFF + 64); a_[0] = a_[0] + (__builtin_amdgcn_s_memrealtime() - a_[1]); } } while (0)
#define TSL_PHASE(l_, k) do { if (blockIdx.x == 0 && threadIdx.x == 0) *(volatile LAS int*)((l_) + MISC_OFF + 96) = (k); } while (0)
#else
#define TSL_START(l_, id) do { } while (0)
#define TSL_STOP(l_, id) do { } while (0)
#define TSL_PHASE(l_, k) do { } while (0)
#endif
namespace pg8 {
constexpr int BM = 256, BK = 64, HALF = 128, HTB = HALF * BK * 2, STAGE_BYTES = 8 * HTB, NXCD = 8, WGM = 8;
__host__ __device__ __forceinline__ int lds_byte(int r, int c) { const int st = (r >> 4) * 2 + (c >> 5), rr = r & 15, cc = c & 31, ob = rr * 64 + cc * 2; return st * 1024 + (ob ^ (((ob >> 9) & 1) << 5)); }
__host__ __device__ __forceinline__ void stage_rc(int b, int& R, int& C) { const int st = b / 1024, sb = b % 1024, swz = sb ^ (((sb >> 9) & 1) << 5); R = (st >> 1) * 16 + swz / 64; C = (st & 1) * 32 + (swz % 64) / 2; }
__host__ __device__ __forceinline__ int perm32(int rho) { const int n = rho >> 4, i = rho & 15; return 8 * (i >> 2) + 4 * n + (i & 3); }
struct Unit { int pm, pn; };
struct Gemm { const h16* A; const h16* Bt; int M, N, K, lda; };
struct StaticOrder {
    int nM, nN, nwg, G, c;
    __host__ __device__ void init(int M, int N, int G_, int c_) { nM = M / BM; nN = N / BM; nwg = nM * nN; G = G_; c = c_; }
    __host__ __device__ bool next(int i, Unit& u) const {
        const long L = (long)i * G + c; if (L >= nwg) return false;
        int wgid = (int)L; { const int q = nwg / NXCD, r = nwg % NXCD, xcd = wgid % NXCD, off = wgid / NXCD; wgid = (xcd < r ? xcd * (q + 1) : r * (q + 1) + (xcd - r) * q) + off; }
        const int nig = WGM * nN, gid = wgid / nig, fm = gid * WGM, gsz = (nM - fm) < WGM ? (nM - fm) : WGM;
        u.pm = fm + ((wgid % nig) % gsz); u.pn = (wgid % nig) / gsz; return true;
    }
    __device__ __forceinline__ void a_ready(const Unit&) const {}
    __device__ __forceinline__ void done(const Unit&) const {}
};

template <int ACT> struct EpiF16 {
    static constexpr bool PERM = true, AFTER_DRAIN = false;
    h16* O; int ldc;
    const float* ss; const float* cv;
    int cvld;
    __device__ __forceinline__ void operator()(const f32x4 (&acc)[2][2][4][2], const Unit& u, int wr, int wc, int fr, int fq) const {
        const int row0 = u.pm * BM + wr * 64 + fr, col0 = u.pn * BM + wc * 32 + 8 * fq;
        const int cond = u.pm < 32 ? 0 : (u.pm < 48 ? 1 : 2);
        f32x4 c0[2], c1[2];
#pragma unroll
        for (int bj = 0; bj < 2; ++bj) { const float* cp = cv + (size_t)cond * cvld + col0 + bj * HALF; c0[bj] = *(const f32x4*)cp; c1[bj] = *(const f32x4*)(cp + 4); }
#pragma unroll
        for (int ai = 0; ai < 2; ++ai)
#pragma unroll
            for (int m = 0; m < 4; ++m) { const int row = row0 + ai * HALF + m * 16; h16* rowp = O + (size_t)row * ldc + col0;
                const float rstd = 1.0f / sqrtf(ss[row] * (1.0f / DM) + NORM_EPS);
#pragma unroll
                for (int bj = 0; bj < 2; ++bj) { f32x4 v0 = acc[ai][bj][m][0] * rstd + c0[bj], v1 = acc[ai][bj][m][1] * rstd + c1[bj];
                    if (ACT == 1) {
#pragma unroll
                        for (int j = 0; j < 4; ++j) { v0[j] = sigmoidf_(v0[j]); v1[j] = sigmoidf_(v1[j]); } }
                    u32x4 w; w.x = pk_h2(v0[0], v0[1]); w.y = pk_h2(v0[2], v0[3]); w.z = pk_h2(v1[0], v1[1]); w.w = pk_h2(v1[2], v1[3]);
                    *(u32x4*)(rowp + bj * HALF) = w; } }
    }
};
template <int ACCUM> struct EpiGateMul {
    static constexpr bool PERM = true, AFTER_DRAIN = false;
    h16* Mg; const h16* G; int gcol0;
    __device__ __forceinline__ void operator()(const f32x4 (&acc)[2][2][4][2], const Unit& u, int wr, int wc, int fr, int fq) const {
        const int row0 = u.pm * BM + wr * 64 + fr, col0 = u.pn * BM + wc * 32 + 8 * fq;
#pragma unroll
        for (int ai = 0; ai < 2; ++ai) {
            u32x4 gw[4][2], mw[4][2];
#pragma unroll
            for (int m = 0; m < 4; ++m) { const size_t row = (size_t)(row0 + ai * HALF + m * 16);
#pragma unroll
                for (int bj = 0; bj < 2; ++bj) { gw[m][bj] = *(const u32x4*)(G + row * NGATE + gcol0 + col0 + bj * HALF);
                    if (ACCUM) mw[m][bj] = *(const u32x4*)(Mg + row * DM + col0 + bj * HALF); } }
#pragma unroll
            for (int m = 0; m < 4; ++m) { const size_t row = (size_t)(row0 + ai * HALF + m * 16);
#pragma unroll
                for (int bj = 0; bj < 2; ++bj) {
                    float g[8]; unpack8(gw[m][bj], g);
                    float o[8];
                    if (ACCUM) unpack8(mw[m][bj], o);
                    else {
#pragma unroll
                        for (int j = 0; j < 8; ++j) o[j] = 0.f; }
                    const f32x4 v0 = acc[ai][bj][m][0], v1 = acc[ai][bj][m][1];
#pragma unroll
                    for (int j = 0; j < 4; ++j) { o[j] += g[j] * v0[j]; o[4 + j] += g[4 + j] * v1[j]; }
                    *(u32x4*)(Mg + row * DM + col0 + bj * HALF) = pack8(o); } }
            asm volatile("" ::: "memory"); }
    }
};
template <int CTRL> __device__ __forceinline__ float dpp_old(float old, float v) { return __int_as_float(__builtin_amdgcn_update_dpp(__float_as_int(old), __float_as_int(v), CTRL, 0xf, 0xf, false)); }
struct EpiAct {
    static constexpr bool PERM = true, AFTER_DRAIN = false;
    h16* ACT; const float* ss; const float* cv; int cvld; const float* cw; const float* cb; float* edge;
    __device__ __forceinline__ void operator()(const f32x4 (&acc)[2][2][4][2], const Unit& u, int wr, int wc, int fr, int fq) const {
        const int cond = u.pm < 32 ? 0 : (u.pm < 48 ? 1 : 2);
        const int chb = u.pn * 128 + wc * 32 + 8 * fq;
        const int colg = u.pn * BM + wc * 32 + 8 * fq;
        float cg[8], cvv[8], w0[8], w1[8], w2[8], bb[8];
#pragma unroll
        for (int e = 0; e < 8; ++e) { cg[e] = cv[(size_t)cond * cvld + colg + e]; cvv[e] = cv[(size_t)cond * cvld + colg + HALF + e];
            w0[e] = cw[chb + e]; w1[e] = cw[DFF + chb + e]; w2[e] = cw[2 * DFF + chb + e]; bb[e] = cb[chb + e]; }
#pragma unroll
        for (int ai = 0; ai < 2; ++ai) {
            float rs[4]; float g[4][8];
#pragma unroll
            for (int m = 0; m < 4; ++m) { rs[m] = 1.0f / sqrtf(ss[u.pm * BM + ai * HALF + wr * 64 + m * 16 + fr] * (1.0f / DM) + NORM_EPS);
#pragma unroll
                for (int e = 0; e < 8; ++e) g[m][e] = acc[ai][0][m][e >> 2][e & 3] * rs[m] + cg[e]; }
#pragma unroll
            for (int m = 0; m < 4; ++m) {
                const int row = u.pm * BM + ai * HALF + wr * 64 + m * 16 + fr;
                float o[8], pre[8], vv[8];
#pragma unroll
                for (int e = 0; e < 8; ++e) {
                    const float pe = m > 0 ? dpp_f<0x121>(g[m > 0 ? m - 1 : 0][e]) : 0.f;
                    const float prev = dpp_old<0x111>(pe, g[m][e]);
                    const float ne = m < 3 ? dpp_f<0x12F>(g[m < 3 ? m + 1 : 3][e]) : 0.f;
                    const float next = dpp_old<0x101>(ne, g[m][e]);
                    vv[e] = acc[ai][1][m][e >> 2][e & 3] * rs[m] + cvv[e];
                    pre[e] = bb[e] + w0[e] * prev + w1[e] * g[m][e] + w2[e] * next;
                    o[e] = gelu_tanh(pre[e]) * vv[e];
                }
                *(u32x4*)(ACT + (size_t)row * DFF + chb) = pack8(o);
                if ((m == 0 && fr == 0) || (m == 3 && fr == 15)) {
                    float* ep = edge + ((size_t)(u.pm * 8 + 2 * (2 * ai + wr) + (m == 3 ? 1 : 0)) * 3) * DFF + chb;
#pragma unroll
                    for (int e = 0; e < 8; ++e) { ep[e] = g[m][e]; ep[DFF + e] = pre[e]; ep[2 * DFF + e] = vv[e]; }
                }
            }
        }
    }
};
struct EpiRes {
    static constexpr bool PERM = false, AFTER_DRAIN = false;
    const float* base_ctx; const float* base_lat; float* X; const float* gate;
    h16* Hn; const float* gn; const float* scn; float* ssn;
    LAS unsigned char* scr;
    __device__ __forceinline__ void operator()(const f32x4 (&acc)[2][2][4][2], const Unit& u, int wr, int wc, int fr, int fq) const {
        const int cond = u.pm < 32 ? 0 : (u.pm < 48 ? 1 : 2);
        const float* gp = gate + (size_t)cond * 6144;
        const float* bp = u.pm < 32 ? base_ctx + (size_t)u.pm * BM * DM : base_lat + (size_t)(u.pm - 32) * BM * DM;
        float* xp = X + (size_t)u.pm * BM * DM;
        const int lane = fq * 16 + fr, wave = wr * 4 + wc;
        LAS unsigned char* my = scr + wave * EPI_SCR_WAVE;
        const int wofs = fr * 144 + fq * 16;
        const int rrow = lane >> 3, rc4 = (lane & 7) * 4;
        const int rofs = rrow * 144 + rc4 * 4;
        const int colw = u.pn * BM + wc * 32 + rc4;
        const unsigned loff = (unsigned)((wr * 64 + rrow) * DM + colw);
        f32x4 gv[2], gsn[2];
#pragma unroll
        for (int bj = 0; bj < 2; ++bj) { gv[bj] = *(const f32x4*)(gp + colw + bj * HALF);
            if (Hn) gsn[bj] = *(const f32x4*)(gn + colw + bj * HALF) * (*(const f32x4*)(scn + (size_t)cond * 6144 + colw + bj * HALF) + 1.0f); }
        h16* hp = Hn ? Hn + (size_t)u.pm * BM * DM : nullptr;
        float* sp = ssn ? ssn + u.pm * BM : nullptr;
#pragma unroll
        for (int ai = 0; ai < 2; ++ai)
#pragma unroll
        for (int mh = 0; mh < 2; ++mh) {
            f32x4 b[2][2][2];
#pragma unroll
            for (int m2 = 0; m2 < 2; ++m2)
#pragma unroll
                for (int k = 0; k < 2; ++k) { const float* rb = bp + (size_t)(ai * HALF + (2 * mh + m2) * 16 + 8 * k) * DM;
#pragma unroll
                    for (int bj = 0; bj < 2; ++bj) b[m2][bj][k] = *(const f32x4*)(rb + loff + bj * HALF); }
#pragma unroll
            for (int m2 = 0; m2 < 2; ++m2)
            { float q[2] = {0.f, 0.f};
#pragma unroll
                for (int bj = 0; bj < 2; ++bj) { const int m = 2 * mh + m2;
                    *(LAS f32x4*)(my + wofs) = acc[ai][bj][m][0]; *(LAS f32x4*)(my + wofs + 64) = acc[ai][bj][m][1];
#pragma unroll
                    for (int k = 0; k < 2; ++k) { const f32x4 a = *(const LAS f32x4*)(my + rofs + k * 8 * 144);
                        float* xb = xp + (size_t)(ai * HALF + m * 16 + 8 * k) * DM;
                        const f32x4 xn = b[m2][bj][k] + gv[bj] * a;
                        *(f32x4*)(xb + loff + bj * HALF) = xn;
                        if (Hn) { const f32x4 hv = xn * gsn[bj]; u32x2 w; w.x = pk_h2(hv[0], hv[1]); w.y = pk_h2(hv[2], hv[3]);
                            *(u32x2*)(hp + (size_t)(ai * HALF + m * 16 + 8 * k) * DM + loff + bj * HALF) = w;
                            q[k] += (xn[0] * xn[0] + xn[1] * xn[1]) + (xn[2] * xn[2] + xn[3] * xn[3]); } }
                }
                if (Hn) {
#pragma unroll
                    for (int k = 0; k < 2; ++k) { float t = sum8(q[k]);
                        if ((lane & 7) == 0) atomicAdd(sp + wr * 64 + ai * HALF + (2 * mh + m2) * 16 + 8 * k + rrow, t); } }
            }
            asm volatile("" ::: "memory"); }
    }
};

template <class Epi, class Sched, bool ALIGN_EPI = false, bool SP2 = false>
__device__ __forceinline__ void gemm_phase(LAS unsigned char* lds, const Gemm g, const Sched& S, const Epi& E) {
    int tid_ = threadIdx.x; asm volatile("" : "+v"(tid_));
    const int tid = tid_, wid = __builtin_amdgcn_readfirstlane(tid >> 6), lane = tid & 63, wr = wid >> 2, wc = wid & 3, fr = lane & 15, fq = lane >> 4;
    const int K = g.K, nt = K / BK, lda = g.lda;
    unsigned voffA[2], voffB[2];
#pragma unroll
    for (int i = 0; i < 2; ++i) { int R, C; stage_rc(tid * 16 + i * 8192, R, C); const int Rb = Epi::PERM ? ((R & ~31) + perm32(R & 31)) : R;
        voffA[i] = (unsigned)(R * lda + C) * 2u; voffB[i] = (unsigned)(Rb * K + C) * 2u; }
    const size_t kstep = (size_t)(BK * 2);
    const size_t hstepA = (size_t)HALF * lda * 2, hstepB = (size_t)HALF * K * 2;
    const size_t tstepA = 2 * hstepA, tstepB = 2 * hstepB;
    const unsigned ldsw = (unsigned)wid * 1024u;
    const int aoff = lds_byte(wr * 64 + fr, fq * 8), boff = lds_byte(wc * 32 + fr, fq * 8);
#define PG8_SA(b, h) (((b) * 2 + (h)) * HTB)
#define PG8_SB(b, h) ((4 + (b) * 2 + (h)) * HTB)
#define PG8_STAGE(bufoff, gbase, voff) do { _Pragma("unroll") for (int _i = 0; _i < 2; ++_i) \
        __builtin_amdgcn_global_load_lds((const unsigned*)((const char*)(gbase) + (voff)[_i]), (LAS unsigned*)(lds + (bufoff) + ldsw + _i * 8192), 16, 0, 0); } while (0)
#define PG8_LDA(dst, b, h) do { _Pragma("unroll") for (int m = 0; m < 4; ++m) _Pragma("unroll") for (int k = 0; k < 2; ++k) dst[m][k] = *(const LAS h16x8*)(lds + PG8_SA(b, h) + aoff + m * 2048 + k * 1024); } while (0)
#define PG8_LDB(dst, b, h) do { _Pragma("unroll") for (int n = 0; n < 2; ++n) _Pragma("unroll") for (int k = 0; k < 2; ++k) dst[n][k] = *(const LAS h16x8*)(lds + PG8_SB(b, h) + boff + n * 2048 + k * 1024); } while (0)
#define PG8_MMA(ai, bj, At, Bt) do { __builtin_amdgcn_s_setprio(1); _Pragma("unroll") for (int m = 0; m < 4; ++m) _Pragma("unroll") for (int n = 0; n < 2; ++n) _Pragma("unroll") for (int k = 0; k < 2; ++k) \
        acc[ai][bj][m][n] = __builtin_amdgcn_mfma_f32_16x16x32_f16(Bt[n][k], At[m][k], acc[ai][bj][m][n], 0, 0, 0); __builtin_amdgcn_s_setprio(0); } while (0)
#define PG8_WAIT_V(n) asm volatile("s_waitcnt vmcnt(" #n ")" ::: "memory")
#define PG8_WAIT_L(n) asm volatile("s_waitcnt lgkmcnt(" #n ")" ::: "memory")
#define PG8_BAR __builtin_amdgcn_s_barrier()
#define PG8_SCHED __builtin_amdgcn_sched_barrier(0)
    Unit cur, nxt; int ui = 0;
    if (!S.next(0, cur)) return;
    TSL_START(lds, 10);
    f32x4 acc[2][2][4][2];
#pragma unroll
    for (int a = 0; a < 2; ++a)
#pragma unroll
        for (int b = 0; b < 2; ++b)
#pragma unroll
            for (int m = 0; m < 4; ++m)
#pragma unroll
                for (int n = 0; n < 2; ++n) acc[a][b][m][n] = (f32x4){0.f, 0.f, 0.f, 0.f};
    h16x8 At[4][2], B0[2][2], B1[2][2];
    const char* cA = (const char*)g.A + (size_t)cur.pm * tstepA; const char* cB = (const char*)g.Bt + (size_t)cur.pn * tstepB;
    S.a_ready(cur);
    if constexpr (SP2) {
        PG8_STAGE(PG8_SB(0, 0), cB, voffB); PG8_STAGE(PG8_SB(0, 1), cB + hstepB, voffB); PG8_STAGE(PG8_SA(0, 0), cA, voffA); PG8_STAGE(PG8_SA(0, 1), cA + hstepA, voffA);
        if (wr == 1) PG8_BAR;
        PG8_WAIT_V(2); PG8_BAR;
        PG8_STAGE(PG8_SB(1, 0), cB + kstep, voffB); PG8_STAGE(PG8_SA(1, 0), cA + kstep, voffA); PG8_STAGE(PG8_SB(1, 1), cB + hstepB + kstep, voffB);
        PG8_WAIT_V(6); PG8_BAR;
    } else {
        PG8_STAGE(PG8_SB(0, 0), cB, voffB); PG8_STAGE(PG8_SA(0, 0), cA, voffA); PG8_STAGE(PG8_SB(0, 1), cB + hstepB, voffB); PG8_STAGE(PG8_SA(0, 1), cA + hstepA, voffA);
        if (wr == 1) PG8_BAR;
        PG8_WAIT_V(4); PG8_BAR;
        PG8_STAGE(PG8_SB(1, 0), cB + kstep, voffB); PG8_STAGE(PG8_SA(1, 0), cA + kstep, voffA); PG8_STAGE(PG8_SB(1, 1), cB + hstepB + kstep, voffB);
        PG8_WAIT_V(6); PG8_BAR;
    }
    for (;;) {
        const bool has_next = S.next(ui + 1, nxt);
        const char* nA = has_next ? (const char*)g.A + (size_t)nxt.pm * tstepA : cA; const char* nB = has_next ? (const char*)g.Bt + (size_t)nxt.pn * tstepB : cB;
        for (int t = 0; t < nt; t += 2) {
            const bool last = (t == nt - 2);
            const char* a1 = cA + (size_t)(t + 1) * kstep;
            const char* a2 = last ? nA : cA + (size_t)(t + 2) * kstep; const char* b2 = last ? nB : cB + (size_t)(t + 2) * kstep;
            const char* a3 = a2 + kstep; const char* b3 = b2 + kstep;
            if (last && has_next) S.a_ready(nxt);
            if constexpr (SP2) {
            PG8_LDB(B0, 0, 0); PG8_LDB(B1, 0, 1); PG8_SCHED; PG8_LDA(At, 0, 0); PG8_STAGE(PG8_SA(1, 1), a1 + hstepA, voffA);
            PG8_WAIT_V(8); PG8_WAIT_L(0); PG8_BAR; PG8_MMA(0, 0, At, B0); PG8_MMA(0, 1, At, B1); PG8_BAR; PG8_SCHED;
            PG8_LDA(At, 0, 1); PG8_STAGE(PG8_SB(0, 0), b2, voffB); PG8_STAGE(PG8_SB(0, 1), b2 + hstepB, voffB); PG8_STAGE(PG8_SA(0, 0), a2, voffA);
            PG8_WAIT_V(8); PG8_WAIT_L(0); PG8_BAR; PG8_MMA(1, 0, At, B0); PG8_MMA(1, 1, At, B1); PG8_BAR; PG8_SCHED;
            PG8_LDB(B0, 1, 0); PG8_LDB(B1, 1, 1); PG8_SCHED; PG8_LDA(At, 1, 0); PG8_STAGE(PG8_SA(0, 1), a2 + hstepA, voffA);
            PG8_WAIT_V(8); PG8_WAIT_L(0); PG8_BAR; PG8_MMA(0, 0, At, B0); PG8_MMA(0, 1, At, B1); PG8_BAR; PG8_SCHED;
            PG8_LDA(At, 1, 1); PG8_STAGE(PG8_SB(1, 0), b3, voffB); PG8_STAGE(PG8_SB(1, 1), b3 + hstepB, voffB); PG8_STAGE(PG8_SA(1, 0), a3, voffA);
            PG8_WAIT_V(8); PG8_WAIT_L(0); PG8_BAR; PG8_MMA(1, 0, At, B0); PG8_MMA(1, 1, At, B1); PG8_BAR; PG8_SCHED;
            } else {
            PG8_LDB(B0, 0, 0); PG8_SCHED; PG8_LDA(At, 0, 0); PG8_STAGE(PG8_SA(1, 1), a1 + hstepA, voffA);
            PG8_WAIT_L(8); PG8_BAR; PG8_WAIT_L(0); PG8_MMA(0, 0, At, B0); PG8_BAR; PG8_SCHED;
            PG8_LDB(B1, 0, 1); PG8_STAGE(PG8_SB(0, 0), b2, voffB);
            PG8_BAR; PG8_WAIT_L(0); PG8_MMA(0, 1, At, B1); PG8_BAR;
            PG8_LDA(At, 0, 1); PG8_STAGE(PG8_SA(0, 0), a2, voffA);
            PG8_BAR; PG8_WAIT_L(0); PG8_MMA(1, 0, At, B0); PG8_BAR; PG8_SCHED;
            PG8_STAGE(PG8_SB(0, 1), b2 + hstepB, voffB);
            PG8_WAIT_V(6); PG8_BAR; PG8_MMA(1, 1, At, B1); PG8_BAR;
            PG8_LDB(B0, 1, 0); PG8_SCHED; PG8_LDA(At, 1, 0); PG8_STAGE(PG8_SA(0, 1), a2 + hstepA, voffA);
            PG8_WAIT_L(8); PG8_BAR; PG8_WAIT_L(0); PG8_MMA(0, 0, At, B0); PG8_BAR; PG8_SCHED;
            PG8_LDB(B1, 1, 1); PG8_STAGE(PG8_SB(1, 0), b3, voffB);
            PG8_BAR; PG8_WAIT_L(0); PG8_MMA(0, 1, At, B1); PG8_BAR;
            PG8_LDA(At, 1, 1); PG8_STAGE(PG8_SA(1, 0), a3, voffA);
            PG8_BAR; PG8_WAIT_L(0); PG8_MMA(1, 0, At, B0); PG8_BAR; PG8_SCHED;
            PG8_STAGE(PG8_SB(1, 1), b3 + hstepB, voffB);
            PG8_WAIT_V(6); PG8_BAR; PG8_MMA(1, 1, At, B1); PG8_BAR;
            }
        }
        if constexpr (ALIGN_EPI) { if (wr == 0) PG8_BAR; }
        TSL_STOP(lds, 10); TSL_START(lds, 11);
        if constexpr (!Epi::AFTER_DRAIN) { E(acc, cur, wr, wc, fr, fq); S.done(cur); }
        TSL_STOP(lds, 11); TSL_START(lds, 10);
        if (!has_next) break;
#pragma unroll
        for (int a = 0; a < 2; ++a)
#pragma unroll
            for (int b = 0; b < 2; ++b)
#pragma unroll
                for (int m = 0; m < 4; ++m)
#pragma unroll
                    for (int n = 0; n < 2; ++n) acc[a][b][m][n] = (f32x4){0.f, 0.f, 0.f, 0.f};
        cur = nxt; cA = nA; cB = nB; ++ui;
        if constexpr (ALIGN_EPI) { if (wr == 1) PG8_BAR; }
    }
    PG8_WAIT_V(0);
    if constexpr (!ALIGN_EPI) { if (wr == 0) PG8_BAR; }
    PG8_BAR;
    TSL_STOP(lds, 10);
#undef PG8_SA
#undef PG8_SB
#undef PG8_STAGE
#undef PG8_LDA
#undef PG8_LDB
#undef PG8_MMA
#undef PG8_WAIT_V
#undef PG8_WAIT_L
#undef PG8_BAR
#undef PG8_SCHED
}
}

constexpr int NWAVES = 8, NTHREADS = 512;

typedef GAS unsigned gu32;
#define RLX_AGENT __ATOMIC_RELAXED, __HIP_MEMORY_SCOPE_AGENT
#define LDS_WAIT() asm volatile("s_waitcnt lgkmcnt(0)" ::: "memory")
#define VM_WAIT() asm volatile("s_waitcnt vmcnt(0)" ::: "memory")

#define XB_TMO      128
#define XB_XCNT(j)  (256  + 64 * (j))
#define XB_XSUB(j)  (1280 + 64 * (j))
#define XB_XGEN(j)  (2304 + 64 * (j))
#define XB_TOP      3328
#define XB_TOPGEN   3392
#define XCD_BAR_WORDS 3456
#define XB_SPIN_CAP (1u << 18)
__device__ __forceinline__ unsigned xb_ld(unsigned* p)              { return __hip_atomic_load(p, __ATOMIC_RELAXED, __HIP_MEMORY_SCOPE_AGENT); }
__device__ __forceinline__ unsigned xb_add(unsigned* p, unsigned v) { return __hip_atomic_fetch_add(p, v, __ATOMIC_RELAXED, __HIP_MEMORY_SCOPE_AGENT); }
__device__ __forceinline__ unsigned xb_xcc_id() { return (unsigned)__builtin_amdgcn_s_getreg((3 << 11) | 20) & 0xFu; }
#define XB_SPIN(cond, bar) do { unsigned _sp = 0; while (cond) { __builtin_amdgcn_s_sleep(1); \
    if ((++_sp & 255u) == 0u) { if (xb_ld(&(bar)[XB_TMO])) break; if (_sp > XB_SPIN_CAP) { atomicAdd(&(bar)[XB_TMO], 1u); break; } } } } while (0)
struct XcdBarrier { unsigned* bar; unsigned x; volatile LAS unsigned* st; };
__device__ __forceinline__ XcdBarrier xcd_barrier_post(unsigned* bar, volatile LAS unsigned* st) {
    XcdBarrier b; b.bar = bar; b.x = xb_xcc_id(); b.st = st;
    if (threadIdx.x == 0) (void)xb_add(&bar[XB_XCNT(b.x)], 1u);
    return b;
}
__device__ __forceinline__ void xcd_barrier_complete(unsigned* bar, unsigned x, unsigned& nloc, unsigned& nx) {
    const unsigned G = gridDim.x * gridDim.y * gridDim.z;
    unsigned sum, cnt, mine, sp = 0u;
    for (;;) {
        sum = 0u; cnt = 0u; mine = 0u;
#pragma unroll
        for (unsigned j = 0; j < 16; ++j) { const unsigned c = xb_ld(&bar[XB_XCNT(j)]); sum += c; cnt += (c > 0u) ? 1u : 0u; mine = (j == x) ? c : mine; }
        if (sum == G) break;
        __builtin_amdgcn_s_sleep(1);
        if ((++sp & 255u) == 0u) { if (xb_ld(&bar[XB_TMO])) break; if (sp > XB_SPIN_CAP) { atomicAdd(&bar[XB_TMO], 1u); break; } }
    }
    nloc = mine > 0u ? mine : 1u; nx = cnt > 0u ? cnt : 1u;
}
__device__ __forceinline__ void xcd_barrier(const XcdBarrier& b) {
    asm volatile("s_waitcnt vmcnt(0)" ::: "memory");
    __syncthreads();
    if (threadIdx.x == 0) {
        unsigned* bar = b.bar;
        __builtin_amdgcn_s_waitcnt(0);
        unsigned nloc = b.st[0], nx = b.st[1];
        if (nloc == 0u) { xcd_barrier_complete(bar, b.x, nloc, nx); b.st[0] = nloc; b.st[1] = nx; }
        const unsigned old = xb_add(&bar[XB_XSUB(b.x)], 1u);
        const unsigned gen = old / nloc;
        if (old + 1u == (gen + 1u) * nloc) {
            __builtin_amdgcn_fence(__ATOMIC_RELEASE, "agent");
            asm volatile("s_waitcnt vmcnt(0)" ::: "memory");
            const unsigned og = xb_add(&bar[XB_TOP], 1u);
            const unsigned tg = og / nx;
            if (og + 1u == (tg + 1u) * nx) xb_add(&bar[XB_TOPGEN], 1u);
            else XB_SPIN(xb_ld(&bar[XB_TOPGEN]) == tg, bar);
            __builtin_amdgcn_fence(__ATOMIC_ACQUIRE, "agent");
            xb_add(&bar[XB_XGEN(b.x)], 1u);
            asm volatile("s_waitcnt vmcnt(0)" ::: "memory");
        } else {
            XB_SPIN(xb_ld(&bar[XB_XGEN(b.x)]) == gen, bar);
            __builtin_amdgcn_fence(__ATOMIC_ACQUIRE, "agent");
            asm volatile("s_waitcnt vmcnt(0)" ::: "memory");
        }
    }
    __syncthreads();
}
constexpr int CW_BAR = 4096;
static_assert((CW_BAR + XCD_BAR_WORDS) * 4 <= (int)CTL_ZERO_BYTES, "ctl");

struct Args {
    const float* in[33]; float* out; unsigned char* ws; int ph_lo, ph_hi;
};
typedef const GAS float* cfp_t;
struct Frame {
    LAS unsigned char* lds;
    int tid, lane, wave, vcu, G;
    const __attribute__((address_space(4))) cfp_t* in; float* out; unsigned char* ws; float* out0; unsigned char* ws0;
    __device__ __forceinline__ const float* inp(int i) const { return (const float*)in[i]; }
    __device__ __forceinline__ void refresh() { int t = threadIdx.x; asm volatile("" : "+v"(t)); tid = t; lane = t & 63; wave = __builtin_amdgcn_readfirstlane(t >> 6);
        const __attribute__((address_space(4))) cfp_t* p = (const __attribute__((address_space(4))) cfp_t*)__builtin_amdgcn_kernarg_segment_ptr(); asm volatile("" : "+s"(p)); in = p;
        GAS float* o_ = (GAS float*)out0; GAS unsigned char* w_ = (GAS unsigned char*)ws0; asm volatile("" : "+s"(o_), "+s"(w_)); out = (float*)o_; ws = (unsigned char*)w_; }
};
enum { I_XP = 0, I_XS, I_C, I_CKB, I_CVB, I_CKC, I_CVC, I_STATE, I_CCTX, I_N1G, I_N2G, I_WMOD, I_BMOD, I_WIN, I_LCW, I_LCB, I_LWA, I_LBA, I_LWX, I_LBX, I_LAM,
       I_QNG, I_KNG, I_SINK, I_WOA, I_WOB, I_WOC, I_WOUT, I_WUP, I_FCW, I_FCB, I_WDOWN, I_FING };

__device__ __forceinline__ void transpose_item(const float* W, int K, int N, h16* WT, LAS float* scr, int item, int lane, bool upmap = false) {
    const int nblk = N / 32, kb = item / nblk, nb = item % nblk, k0 = 64 * kb, n0 = 32 * nb;
    const int d0 = !upmap ? n0 : (n0 < DFF ? (n0 / 128) * 256 + n0 % 128 : ((n0 - DFF) / 128) * 256 + 128 + (n0 - DFF) % 128);
    f32x4 v[8];
#pragma unroll
    for (int i = 0; i < 8; ++i) v[i] = *(const f32x4*)(W + (size_t)(k0 + 8 * i + (lane >> 3)) * N + n0 + 4 * (lane & 7));
#pragma unroll
    for (int i = 0; i < 8; ++i) { LAS float* d = scr + (8 * i + (lane >> 3)) * 33 + 4 * (lane & 7); d[0] = v[i].x; d[1] = v[i].y; d[2] = v[i].z; d[3] = v[i].w; }
    LDS_WAIT(); asm volatile("" ::: "memory");
    const int c = lane & 7;
#pragma unroll
    for (int j = 0; j < 4; ++j) { const int n = (lane >> 3) + 8 * j; const LAS float* sp = scr + (8 * c) * 33 + n;
        u32x4 o; o.x = pk_h2(sp[0 * 33], sp[1 * 33]); o.y = pk_h2(sp[2 * 33], sp[3 * 33]); o.z = pk_h2(sp[4 * 33], sp[5 * 33]); o.w = pk_h2(sp[6 * 33], sp[7 * 33]);
        *(u32x4*)(WT + (size_t)(d0 + n) * K + k0 + 8 * c) = o; }
    LDS_WAIT(); asm volatile("" ::: "memory");
}
__device__ __forceinline__ void phase_convert_weights(Frame& F, int l) {
    LAS float* scr = (LAS float*)(F.lds + F.wave * 16384);
    const int gw = F.vcu * NWAVES + F.wave, NGW = F.G * NWAVES;
    unsigned char* wb = F.ws + WS_W;
    constexpr int IT_IN = (DM / 64) * (DIN / 32), IT_OA = (1024 / 64) * (DM / 32), IT_OB = (512 / 64) * (DM / 32), IT_OUT = (DM / 64) * (DM / 32),
                  IT_UP = (DM / 64) * (DUP / 32), IT_DOWN = (DFF / 64) * (DM / 32), IT_LRU1 = (128 / 64) * (128 / 32), IT_LRU = 32 * IT_LRU1;
    constexpr int NITEMS = IT_IN + IT_OA + 2 * IT_OB + IT_OUT + IT_UP + IT_DOWN + IT_LRU;
    for (int it = gw; it < NITEMS; it += NGW) {
        int r = it;
        if (r < IT_IN) { transpose_item(F.inp(I_WIN) + (size_t)l * DM * DIN, DM, DIN, (h16*)(wb + W_IN), scr, r, F.lane); continue; } r -= IT_IN;
        if (r < IT_OA) { transpose_item(F.inp(I_WOA) + (size_t)l * 1024 * DM, 1024, DM, (h16*)(wb + W_OA), scr, r, F.lane); continue; } r -= IT_OA;
        if (r < IT_OB) { transpose_item(F.inp(I_WOB) + (size_t)l * 512 * DM, 512, DM, (h16*)(wb + W_OB), scr, r, F.lane); continue; } r -= IT_OB;
        if (r < IT_OB) { transpose_item(F.inp(I_WOC) + (size_t)l * 512 * DM, 512, DM, (h16*)(wb + W_OC), scr, r, F.lane); continue; } r -= IT_OB;
        if (r < IT_OUT) { transpose_item(F.inp(I_WOUT) + (size_t)l * DM * DM, DM, DM, (h16*)(wb + W_OUT), scr, r, F.lane); continue; } r -= IT_OUT;
        if (r < IT_UP) { transpose_item(F.inp(I_WUP) + (size_t)l * DM * DUP, DM, DUP, (h16*)(wb + W_UP), scr, r, F.lane, true); continue; } r -= IT_UP;
        if (r < IT_DOWN) { transpose_item(F.inp(I_WDOWN) + (size_t)l * DFF * DM, DFF, DM, (h16*)(wb + W_DOWN), scr, r, F.lane); continue; } r -= IT_DOWN;
        {
            const int mi = r / IT_LRU1, sub = r % IT_LRU1, dir = mi >> 4, gate = (mi >> 3) & 1, n = mi & 7;
            const float* src = (gate ? F.inp(I_LWX) : F.inp(I_LWA)) + ((size_t)((l * 2 + dir) * 8 + n)) * 128 * 128;
            transpose_item(src, 128, 128, (h16*)(wb + W_LRU) + (size_t)mi * 128 * 128, scr, sub, F.lane);
        }
    }
}
__device__ __forceinline__ void phase_prep_misc(Frame& F) {
    LAS float* sil = (LAS float*)F.lds;
    LAS float* part = (LAS float*)(F.lds + 16384);
    float* mod = (float*)(F.ws + WS_MOD);
    for (int item = F.vcu; item < 192; item += F.G) {
        const int l = item / 96, n0 = (item % 96) * 64;
        __syncthreads();
        for (int i = F.tid; i < 3 * 1024; i += NTHREADS) { const int j = i >> 10, k = i & 1023;
            const float v = j == 0 ? F.inp(I_CCTX)[k] : F.inp(I_C)[(j - 1) * 1024 + k]; sil[i] = v * sigmoidf_(v); }
        __syncthreads();
        const float* wp = F.inp(I_WMOD) + (size_t)l * DM * 6144 + n0 + F.lane;
        float a0 = 0.f, a1 = 0.f, a2 = 0.f;
        const int kb = F.wave * 128;
#pragma unroll 8
        for (int k = 0; k < 128; ++k) { const float w = wp[(size_t)(kb + k) * 6144]; a0 += w * sil[kb + k]; a1 += w * sil[1024 + kb + k]; a2 += w * sil[2048 + kb + k]; }
        part[(F.wave * 3 + 0) * 64 + F.lane] = a0; part[(F.wave * 3 + 1) * 64 + F.lane] = a1; part[(F.wave * 3 + 2) * 64 + F.lane] = a2;
        __syncthreads();
        if (F.tid < 192) { const int j = F.tid >> 6, c = F.tid & 63; float s = F.inp(I_BMOD)[l * 6144 + n0 + c];
#pragma unroll
            for (int w = 0; w < 8; ++w) s += part[(w * 3 + j) * 64 + c];
            mod[((size_t)l * 3 + j) * 6144 + n0 + c] = s; }
    }
    __syncthreads();
    const int gt = F.vcu * NTHREADS + F.tid, NGT = F.G * NTHREADS;
    float* rope = (float*)(F.ws + WS_ROPE);
    for (int i = gt; i < 64 * 16; i += NGT) { const int pos = i >> 4, fi = i & 15; const float inv = expf(-(float)fi * (1.0f / 16.0f) * 9.210340371976184f);
        const float ang = (float)pos * inv; rope[2 * i] = cosf(ang); rope[2 * i + 1] = sinf(ang); }
    h16* cache = (h16*)(F.ws + WS_CACHE);
    for (int i = gt; i < 4 * 131072 / 4; i += NGT) { const int kind = i / 32768, e = (i % 32768) * 4;
        const float* src = kind == 0 ? F.inp(I_CKB) : kind == 1 ? F.inp(I_CVB) : kind == 2 ? F.inp(I_CKC) : F.inp(I_CVC);
        const f32x4 v = *(const f32x4*)(src + e); u32x2 w; w.x = pk_h2(v[0], v[1]); w.y = pk_h2(v[2], v[3]); *(u32x2*)(cache + (size_t)kind * 131072 + e) = w; }
}

__device__ __forceinline__ const float* xrow_ptr(const Frame& F, int layer_src_is_input, int row) {
    if (layer_src_is_input) return row < NCTX ? F.inp(I_XP) + (size_t)row * DM : F.inp(I_XS) + (size_t)(row - NCTX) * DM;
    return F.out + O_Y + (size_t)row * DM;
}
__device__ __forceinline__ void phase_norm0(Frame& F, const float* g, const float* mod_l, float* ss) {
    const int gw = F.vcu * NWAVES + F.wave, NGW = F.G * NWAVES;
    h16* H = (h16*)(F.ws + WS_H);
    for (int grp = gw; grp < NTOK / 4; grp += NGW) {
        const int row0 = grp * 4;
        const int cond = row0 < NCTX ? 0 : (row0 < NCTX + LSEQ ? 1 : 2);
        const float* mp = mod_l + (size_t)cond * 6144;
        f32x4 v[4][4];
#pragma unroll
        for (int i = 0; i < 4; ++i) { const f32x4* xr = (const f32x4*)xrow_ptr(F, 1, row0 + i) + F.lane;
#pragma unroll
            for (int j = 0; j < 4; ++j) v[i][j] = xr[64 * j]; }
        f32x4 gs[4];
#pragma unroll
        for (int j = 0; j < 4; ++j) { const int c = F.lane * 4 + 256 * j; gs[j] = *(const f32x4*)(g + c) * (*(const f32x4*)(mp + 1024 + c) + 1.0f); }
#pragma unroll
        for (int i = 0; i < 4; ++i) {
            float sq = 0.f;
#pragma unroll
            for (int j = 0; j < 4; ++j) sq += (v[i][j].x * v[i][j].x + v[i][j].y * v[i][j].y) + (v[i][j].z * v[i][j].z + v[i][j].w * v[i][j].w);
            sq = wave_sum(sq);
            if (F.lane == 0) ss[row0 + i] = sq;
            u32x2* o8 = (u32x2*)(H + (size_t)(row0 + i) * DM) + F.lane;
#pragma unroll
            for (int j = 0; j < 4; ++j) { const f32x4 y = v[i][j] * gs[j]; u32x2 w; w.x = pk_h2(y.x, y.y); w.y = pk_h2(y.z, y.w); o8[64 * j] = w; }
        }
    }
}
__device__ __forceinline__ void phase_cvec(Frame& F, int l) {
    const int gw = F.vcu * NWAVES + F.wave, NGW = F.G * NWAVES, lane = F.lane;
    const float* mod_l = (const float*)(F.ws + WS_MOD) + (size_t)l * 3 * 6144;
    float* cv = (float*)(F.ws + WS_CV) + (size_t)l * 3 * (DIN + DUP);
    for (int kind = 0; kind < 2; ++kind) {
        const int N = kind == 0 ? DIN : DUP, sc = kind == 0 ? 0 : 3;
        const h16* Wt = (const h16*)(F.ws + WS_W + (kind == 0 ? W_IN : W_UP));
        float sh[3][16];
#pragma unroll
        for (int c = 0; c < 3; ++c)
#pragma unroll
            for (int j = 0; j < 2; ++j)
#pragma unroll
                for (int e = 0; e < 8; ++e) sh[c][8 * j + e] = mod_l[(size_t)c * 6144 + sc * 1024 + 8 * lane + 512 * j + e];
        for (int n0 = gw * 4; n0 < N; n0 += NGW * 4) {
            u32x4 raw[4][2];
#pragma unroll
            for (int i = 0; i < 4; ++i) { raw[i][0] = *(const u32x4*)(Wt + (size_t)(n0 + i) * DM + 8 * lane); raw[i][1] = *(const u32x4*)(Wt + (size_t)(n0 + i) * DM + 512 + 8 * lane); }
#pragma unroll
            for (int i = 0; i < 4; ++i) {
                float w[16]; unpack8(raw[i][0], w); unpack8(raw[i][1], w + 8);
                float a0 = 0.f, a1 = 0.f, a2 = 0.f;
#pragma unroll
                for (int e = 0; e < 16; ++e) { a0 += w[e] * sh[0][e]; a1 += w[e] * sh[1][e]; a2 += w[e] * sh[2][e]; }
                a0 = wave_sum(a0); a1 = wave_sum(a1); a2 = wave_sum(a2);
                if (lane == 0) { float* o = cv + (kind == 0 ? 0 : DIN) + n0 + i; o[0] = a0; o[DIN + DUP] = a1; o[2 * (DIN + DUP)] = a2; }
            }
        }
    }
}
__device__ __forceinline__ void phase_final_norm(Frame& F) {
    const int gw = F.vcu * NWAVES + F.wave, NGW = F.G * NWAVES;
    f32x4 gg[4];
#pragma unroll
    for (int j = 0; j < 4; ++j) gg[j] = *(const f32x4*)(F.inp(I_FING) + F.lane * 4 + 256 * j);
    for (int grp = gw; grp < NTOK / 4; grp += NGW) {
        const int row0 = grp * 4;
        f32x4 v[4][4];
#pragma unroll
        for (int i = 0; i < 4; ++i) { const f32x4* xr = (const f32x4*)(F.out + O_Y + (size_t)(row0 + i) * DM) + F.lane;
#pragma unroll
            for (int j = 0; j < 4; ++j) v[i][j] = xr[64 * j]; }
#pragma unroll
        for (int i = 0; i < 4; ++i) {
            float s = 0.f;
#pragma unroll
            for (int j = 0; j < 4; ++j) s += (v[i][j].x * v[i][j].x + v[i][j].y * v[i][j].y) + (v[i][j].z * v[i][j].z + v[i][j].w * v[i][j].w);
            const float rstd = 1.0f / sqrtf(wave_sum(s) * (1.0f / DM) + NORM_EPS);
            f32x4* xo = (f32x4*)(F.out + O_Y + (size_t)(row0 + i) * DM) + F.lane;
#pragma unroll
            for (int j = 0; j < 4; ++j) xo[64 * j] = v[i][j] * rstd * gg[j];
        }
    }
}

__device__ __forceinline__ void phase_qk(Frame& F, int l, bool write_out = true) {
    const int gw = F.vcu * NWAVES + F.wave, NGW = F.G * NWAVES, lane = F.lane;
    h16* Z = (h16*)(F.ws + WS_ZU);
    const float* rope = (const float*)(F.ws + WS_ROPE);
    const float* qg = F.inp(I_QNG) + l * 64; const float* kg = F.inp(I_KNG) + l * 64;
    const int hl = lane & 7, hc0 = hl * 8;
    float qgv[8], kgv[8];
#pragma unroll
    for (int j = 0; j < 8; ++j) { qgv[j] = qg[hc0 + j]; kgv[j] = kg[hc0 + j]; }
    for (int row = gw; row < NTOK; row += NGW) {
        const bool is_ctx = row < NCTX;
        int rpos = 0, cpos = 0, b = 0, t = 0;
        if (is_ctx) { b = row >> 8; t = row & 255; } else { const int tt = (row - NCTX) & (LSEQ - 1); rpos = tt >> 6; cpos = tt & 63; }
        h16* zr = Z + (size_t)row * NMAIN;
#pragma unroll
        for (int pass = 0; pass < 3; ++pass) {
            const int col = C_QB + pass * 512 + lane * 8;
            int kind;
            if (pass == 0) kind = 0; else if (pass == 1) kind = lane < 8 * 2 ? 1 : (lane < 8 * 4 ? 2 : 3); else kind = lane < 32 ? 3 : (lane < 48 ? 4 : 5);
            const u32x4 w = *(const u32x4*)(zr + col);
            float x[8]; unpack8(w, x);
            if (kind <= 1) {
                float s = 0.f;
#pragma unroll
                for (int j = 0; j < 8; ++j) s += x[j] * x[j];
                s = sum8(s);
                const float rstd = 1.0f / sqrtf(s * (1.0f / 64.0f) + NORM_EPS);
#pragma unroll
                for (int j = 0; j < 8; ++j) x[j] = x[j] * rstd * (kind == 0 ? qgv[j] : kgv[j]);
            }
            if (!is_ctx) {
                float p[8];
#pragma unroll
                for (int j = 0; j < 8; ++j) p[j] = __shfl_xor(x[j], 2);
                if (kind == 0 || kind == 1 || kind == 3 || kind == 4) {
                    const int half = hl >> 2, second = (hl >> 1) & 1, f0 = (hl & 1) * 8, pos = half ? cpos : rpos;
                    const float* tp = rope + ((size_t)pos * 16 + f0) * 2;
#pragma unroll
                    for (int j = 0; j < 8; ++j) { const float cs = tp[2 * j], sn = tp[2 * j + 1]; x[j] = second ? (p[j] * sn + x[j] * cs) : (x[j] * cs - p[j] * sn); }
                }
            }
            if (kind == 0 || kind == 3) {
#pragma unroll
                for (int j = 0; j < 8; ++j) x[j] *= QSCALE;
            }
            if (kind != 2 && kind != 5) *(u32x4*)(zr + col) = pack8(x);
            if (write_out && is_ctx && (kind == 1 || kind == 2 || kind == 4 || kind == 5)) {
                const size_t ob = kind == 1 ? O_KB : kind == 2 ? O_VB : kind == 4 ? O_KC : O_VC;
                const int c128 = (kind == 1 || kind == 2) ? (col - (kind == 1 ? C_KB : C_VB)) : (col - (kind == 4 ? C_KC : C_VC));
                float* op = F.out + ob + ((size_t)((b * 2 + l) * 256 + t)) * 128 + c128;
                *(f32x4*)op = (f32x4){x[0], x[1], x[2], x[3]}; *(f32x4*)(op + 4) = (f32x4){x[4], x[5], x[6], x[7]};
            }
        }
    }
}

__device__ __forceinline__ int img_off(int row, int ch) { return row * 256 + ((((ch >> 3) ^ (row & 15)) << 4) | ((ch & 7) << 1)); }
template <int MODE, int DIR>
__device__ __forceinline__ void lru_scan(Frame& F, int l, int row0, int n, int lat_b, int lat_chunk, int ctx_b, bool write_out, int cb) {
    LAS unsigned char* img = F.lds; LAS unsigned char* hx = F.lds + 65536;
    const int lane = F.lane, r32 = lane & 31, hi = lane >> 5, hm = hi ^ DIR;
    const int C = n * 128 + cb * 32 + r32;
    h16x8 Br[8], Bi[8];
    if (MODE != 3) {
        const h16* wr_ = (const h16*)(F.ws + WS_W + W_LRU) + ((size_t)((DIR * 2 + 0) * 8 + n) * 128 + cb * 32 + r32) * 128 + 8 * hi;
        const h16* wi_ = (const h16*)(F.ws + WS_W + W_LRU) + ((size_t)((DIR * 2 + 1) * 8 + n) * 128 + cb * 32 + r32) * 128 + 8 * hi;
#pragma unroll
        for (int ks = 0; ks < 8; ++ks) { Br[ks] = *(const h16x8*)(wr_ + 16 * ks); Bi[ks] = *(const h16x8*)(wi_ + 16 * ks); }
    }
    float k8 = 0.f, nba = 0.f, nbx = 0.f;
    if (MODE != 3) {
        const float ba = F.inp(I_LBA)[(size_t)(l * 2 + DIR) * DLRU + C], bx = F.inp(I_LBX)[(size_t)(l * 2 + DIR) * DLRU + C];
        const float lam = F.inp(I_LAM)[(size_t)(l * 2 + DIR) * DLRU + C];
        const float sp = (-lam > 20.f) ? -lam : log1pf(expf(-lam));
        k8 = -8.0f * sp * LOG2E;
        nba = -LOG2E * ba; nbx = -LOG2E * bx;
    }
    u32x4* stash_u = (u32x4*)(F.ws + WS_STASH) + (size_t)(((lat_b * 2 + DIR) * 16 + lat_chunk) * 8) * (DLRU * 2 * 4);
    const unsigned sl = (unsigned)((C * 2 + hi) * 4);
    unsigned nxt[16];
    if (MODE == 3) { const int rb0 = DIR == 0 ? 0 : 7;
#pragma unroll
        for (int q = 0; q < 4; ++q) { const u32x4 t = stash_u[(size_t)rb0 * (DLRU * 2 * 4) + sl + q]; nxt[4 * q] = t.x; nxt[4 * q + 1] = t.y; nxt[4 * q + 2] = t.z; nxt[4 * q + 3] = t.w; } }
    float H = 0.f, aggP = 1.f;
    if (MODE == 2 || MODE == 3) {
        const float* agg = (const float*)(F.ws + WS_AGG);
        H = F.inp(I_STATE)[(size_t)((lat_b * 2 + l) * 2 + DIR) * DLRU + C];
        float ap[15], au[15];
#pragma unroll
        for (int k = 0; k < 15; ++k) { const int ch = DIR == 0 ? k : 15 - k; const bool use = DIR == 0 ? (ch < lat_chunk) : (ch > lat_chunk);
            const float* p = agg + ((size_t)((lat_b * 16 + (use ? ch : 0)) * 2 + DIR) * DLRU + C) * 2; ap[k] = use ? p[0] : 1.f; au[k] = use ? p[1] : 0.f; }
#pragma unroll
        for (int k = 0; k < 15; ++k) H = ap[k] * H + au[k];
    }
    const int xch = cb * 4 + (r32 >> 3), xel = (r32 & 7) * 2;
    int lo8[8];
#pragma unroll
    for (int ci = 0; ci < 8; ++ci) { const int c = (ci & 3) + 8 * (ci >> 2); lo8[ci] = (((xch ^ (4 * hi)) ^ c) << 4) + xel + (4 * hi) * 256; }
#define LOFF(rn) (lo8s[((rn) & 3) + 4 * (((rn) >> 2) & 1)] + (8 * ((rn) >> 2) + ((rn) & 3)) * 256)
#pragma unroll 1
    for (int step = 0; step < 8; ++step) {
        if (step == 4) __syncthreads();
        const int rb = DIR == 0 ? step : 7 - step;
        int lo8s[8];
#pragma unroll
        for (int ci = 0; ci < 8; ++ci) lo8s[ci] = lo8[ci] + rb * 8192;
        float an[16], un[16];
        if (MODE == 3) {
#pragma unroll
            for (int r = 0; r < 16; ++r) { const h16x2 w = __builtin_bit_cast(h16x2, nxt[r]); an[r] = fast_exp2((float)w[0]); un[r] = (float)w[1]; }
            if (step < 7) { const int rbn = DIR == 0 ? step + 1 : 6 - step;
#pragma unroll
                for (int q = 0; q < 4; ++q) { const u32x4 t = stash_u[(size_t)rbn * (DLRU * 2 * 4) + sl + q]; nxt[4 * q] = t.x; nxt[4 * q + 1] = t.y; nxt[4 * q + 2] = t.z; nxt[4 * q + 3] = t.w; } }
        } else {
        unsigned sw[16];
        f32x16 ar = {}, ai = {};
#pragma unroll
        for (int ks = 0; ks < 8; ++ks) {
            const h16x8 af = *(const LAS h16x8*)(img + (rb * 32 + r32) * 256 + (((2 * ks + hi) ^ (r32 & 15)) << 4));
            ar = __builtin_amdgcn_mfma_f32_32x32x16_f16(af, Br[ks], ar, 0, 0, 0);
            ai = __builtin_amdgcn_mfma_f32_32x32x16_f16(af, Bi[ks], ai, 0, 0, 0);
        }
#pragma unroll
        for (int r = 0; r < 16; ++r) {
            const float xv = (float)*(const LAS h16*)(img + LOFF(r));
            const float d1 = 1.0f + fast_exp2(__builtin_fmaf(ar[r], -LOG2E, nba)), d2 = 1.0f + fast_exp2(__builtin_fmaf(ai[r], -LOG2E, nbx));
            const float R = fast_rcp(d1 * d2);
            const float rr = R * d2, ii = R * d1;
            const float e2 = k8 * rr;
            const float av = fast_exp2(e2);
            an[r] = av;
            un[r] = __builtin_amdgcn_sqrtf(__builtin_fmaf(-av, av, 1.0f)) * (ii * xv);
            if (MODE == 1) sw[r] = pk_h2(e2, un[r]);
        }
        if (MODE == 1) {
#pragma unroll
            for (int q = 0; q < 4; ++q) stash_u[(size_t)rb * (DLRU * 2 * 4) + sl + q] = (u32x4){sw[4 * q], sw[4 * q + 1], sw[4 * q + 2], sw[4 * q + 3]}; }
        }
#define SA(r) (DIR ? an[15 - (r)] : an[(r)])
#define SU(r) (DIR ? un[15 - (r)] : un[(r)])
        float Pe[4], Ue[4], Po[4], Uo[4];
#pragma unroll
        for (int g = 0; g < 4; ++g) {
            float p = 1.f, uu = 0.f;
#pragma unroll
            for (int i = 0; i < 4; ++i) { uu = SA(4 * g + i) * uu + SU(4 * g + i); p *= SA(4 * g + i); }
            const auto sp_ = __builtin_amdgcn_permlane32_swap(__float_as_uint(p), __float_as_uint(p), false, false);
            const auto su_ = __builtin_amdgcn_permlane32_swap(__float_as_uint(uu), __float_as_uint(uu), false, false);
            Pe[g] = __uint_as_float(sp_[DIR]); Po[g] = __uint_as_float(sp_[1 - DIR]); Ue[g] = __uint_as_float(su_[DIR]); Uo[g] = __uint_as_float(su_[1 - DIR]);
        }
        float Hs[4];
        {
            float h = H;
#pragma unroll
            for (int g = 0; g < 4; ++g) { const float he = h; h = Pe[g] * h + Ue[g]; const float ho = h; h = Po[g] * h + Uo[g]; Hs[g] = hm ? ho : he; }
            H = h;
        }
        if (MODE == 1) { float p = 1.f;
#pragma unroll
            for (int g = 0; g < 4; ++g) p *= Pe[g] * Po[g];
            aggP *= p; }
        if (MODE != 1) {
#pragma unroll
            for (int g = 0; g < 4; ++g) { float h = Hs[g];
                float old[4];
#pragma unroll
                for (int i = 0; i < 4; ++i) old[i] = (float)*(const LAS h16*)(hx + LOFF(DIR ? 15 - (4 * g + i) : (4 * g + i)));
#pragma unroll
                for (int i = 0; i < 4; ++i) { const int r = 4 * g + i; h = SA(r) * h + SU(r);
                    const float o = step < 4 ? 0.f : old[i];
                    *(LAS h16*)(hx + LOFF(DIR ? 15 - r : r)) = (h16)(h + o); } }
        }
#undef SA
#undef SU
    }
#undef LOFF
    if (MODE == 0 && hi == 0 && write_out) F.out[O_LRU + (size_t)((ctx_b * 2 + l) * 2 + DIR) * DLRU + C] = H;
    if (MODE == 1 && hi == 0) { float* agg = (float*)(F.ws + WS_AGG) + ((size_t)((lat_b * 16 + lat_chunk) * 2 + DIR) * DLRU + C) * 2; agg[0] = aggP; agg[1] = H; }
}
template <int MODE>
__device__ __forceinline__ void lru_unit(Frame& F, int l, int row0, int n, int seq_first, int seq_last, int lat_b, int lat_chunk, int ctx_b, bool write_out = true, int pv = 0) {
    LAS unsigned char* img = F.lds; LAS unsigned char* hx = F.lds + 65536;
    const h16* Z = (const h16*)(F.ws + WS_ZU);
    const int tid = F.tid;
    __syncthreads();
    if (MODE != 3 && !(pv & 1)) {
        const int cc = tid & 15, tg = tid >> 4; const int ch0 = n * 128 + cc * 8;
        float w0[8], w1[8], w2[8], w3[8], bb[8];
        const float* cw = F.inp(I_LCW) + (size_t)l * 4 * DLRU + ch0; const float* cb = F.inp(I_LCB) + (size_t)l * DLRU + ch0;
#pragma unroll
        for (int j = 0; j < 8; ++j) { w0[j] = cw[j]; w1[j] = cw[DLRU + j]; w2[j] = cw[2 * DLRU + j]; w3[j] = cw[3 * DLRU + j]; bb[j] = cb[j]; }
        const int t0 = tg * 8;
        u32x4 raw[11];
#pragma unroll
        for (int i = 0; i < 11; ++i) { const int t = t0 - 2 + i; const bool ok = (t >= 0 || !seq_first) && (t < 256 || !seq_last);
            const int tc = ok ? t : (t < 0 ? 0 : 255);
            const u32x4 v = *(const u32x4*)(Z + (size_t)(row0 + tc) * NMAIN + C_XA + ch0);
            raw[i].x = ok ? v.x : 0u; raw[i].y = ok ? v.y : 0u; raw[i].z = ok ? v.z : 0u; raw[i].w = ok ? v.w : 0u; }
        float xm2[8], xm1[8], x0[8], xp1[8];
        unpack8(raw[0], xm2); unpack8(raw[1], xm1); unpack8(raw[2], x0);
#pragma unroll
        for (int i = 0; i < 8; ++i) {
            unpack8(raw[3 + i], xp1);
            float y[8];
#pragma unroll
            for (int j = 0; j < 8; ++j) y[j] = bb[j] + w0[j] * xm2[j] + w1[j] * xm1[j] + w2[j] * x0[j] + w3[j] * xp1[j];
            *(LAS u32x4*)(img + img_off(t0 + i, cc * 8)) = pack8(y);
#pragma unroll
            for (int j = 0; j < 8; ++j) { xm2[j] = xm1[j]; xm1[j] = x0[j]; x0[j] = xp1[j]; }
        }
    }
    __syncthreads();
    const int dir = F.wave >> 2, cb = F.wave & 3;
    if (!(pv & 2)) {
    if (dir == 0) lru_scan<MODE, 0>(F, l, row0, n, lat_b, lat_chunk, ctx_b, write_out, cb);
    else          lru_scan<MODE, 1>(F, l, row0, n, lat_b, lat_chunk, ctx_b, write_out, cb);
    }
    if (MODE != 1 && !(pv & 4)) {
        __syncthreads();
        h16* OA = (h16*)(F.ws + WS_ZU + ZU_OA);
#pragma unroll
        for (int k = 0; k < 8; ++k) { const int i = tid + NTHREADS * k, tk = i >> 4, cc = i & 15;
            float hs[8], ya[8], o[8];
            unpack8(*(const LAS u32x4*)(hx + img_off(tk, cc * 8)), hs);
            unpack8(*(const u32x4*)(Z + (size_t)(row0 + tk) * NMAIN + C_YA + n * 128 + cc * 8), ya);
#pragma unroll
            for (int j = 0; j < 8; ++j) o[j] = hs[j] * gelu_tanh(ya[j]);
            *(u32x4*)(OA + (size_t)(row0 + tk) * 1024 + n * 128 + cc * 8) = pack8(o); }
    }
}

struct AttnDesc {
    const h16* Qz; h16* O;
    const h16* Kc; const h16* Vc;
    const h16* Kz; const h16* Vz;
    int nc, zt0, nz;
    int windowed;
    const float* sink;
    int kvh, q0;
};
__device__ __forceinline__ void attn_unit(Frame& F, const AttnDesc& D, const h16* Qrow0  , h16* Orow0  ) {
    LAS unsigned char* lds = F.lds;
    const int tid = F.tid, lane = F.lane, wave = F.wave, r32 = lane & 31, hi = lane >> 5;
    const int head = D.kvh * 4 + (wave >> 1);
    const int qpos = D.q0 + (wave & 1) * 32 + r32;
    const int NT = D.nc + D.nz;
    h16x8 qr[4];
    { const h16* qp = Qrow0 + (size_t)qpos * NMAIN + head * 64 + 8 * hi;
#pragma unroll
      for (int d0 = 0; d0 < 4; ++d0) qr[d0] = *(const h16x8*)(qp + 16 * d0); }
    const int krow = tid >> 3, kch = tid & 7; const int kdst = krow * 128 + ((kch ^ ((krow >> 1) & 7)) << 4);
    const int vrow = 16 * (wave & 3) + (lane >> 2), vcol = (wave >> 2) * 32 + (lane & 3) * 8; const int vdst = wave * 1024 + lane * 16;
    auto ktile_ptr = [&](int j, int row, int col, bool isV) -> const h16* {
        if (j < D.nc) return (isV ? D.Vc : D.Kc) + (size_t)(64 * j + row) * 128 + col;
        return (isV ? D.Vz : D.Kz) + (size_t)((D.zt0 + (j - D.nc)) * 64 + row) * NMAIN + col;
    };
    u32x4 kreg, vreg;
    kreg = *(const u32x4*)ktile_ptr(0, krow, kch * 8, false); vreg = *(const u32x4*)ktile_ptr(0, vrow, vcol, true);
    __syncthreads();
    *(LAS u32x4*)(lds + kdst) = kreg; *(LAS u32x4*)(lds + 16384 + vdst) = vreg;
    __syncthreads();
    float mhat, l_run;
    const bool has_sink = D.sink != nullptr;
    if (has_sink) { mhat = D.sink[head] * LOG2E; l_run = hi == 0 ? 1.f : 0.f; } else { mhat = 0.f; l_run = 0.f; }
    f32x16 negm;
#pragma unroll
    for (int r = 0; r < 16; ++r) negm[r] = -mhat;
    f32x16 o0 = {}, o1 = {};
    LAS float* wsf = (LAS float*)(lds + 32768) + wave * 64;
    const int kfoff = r32 * 128;
    const int ksw = (r32 >> 1) & 7;
    const int vp0 = ((lane >> 4) & 1) * 32 + (lane & 3) * 8 + (4 * hi + ((lane & 15) >> 2)) * 64;
#pragma unroll 1
    for (int j = 0; j < NT; ++j) {
        const int buf = j & 1;
        if (j + 1 < NT) { kreg = *(const u32x4*)ktile_ptr(j + 1, krow, kch * 8, false); vreg = *(const u32x4*)ktile_ptr(j + 1, vrow, vcol, true); }
        LAS unsigned char* Kb = lds + buf * 8192; LAS unsigned char* Vb = lds + 16384 + buf * 8192;
        f32x16 p0, p1;
#pragma unroll
        for (int d0 = 0; d0 < 4; ++d0) {
            const int co = ((2 * d0 + hi) ^ ksw) << 4;
            const h16x8 k0 = *(const LAS h16x8*)(Kb + kfoff + co);
            const h16x8 k1 = *(const LAS h16x8*)(Kb + 4096 + kfoff + co);
            p0 = __builtin_amdgcn_mfma_f32_32x32x16_f16(k0, qr[d0], d0 == 0 ? negm : p0, 0, 0, 0);
            p1 = __builtin_amdgcn_mfma_f32_32x32x16_f16(k1, qr[d0], d0 == 0 ? negm : p1, 0, 0, 0);
        }
        if (D.windowed && j >= D.nc) {
            const int kb0 = (D.zt0 + (j - D.nc)) * 64 + 4 * hi;
#pragma unroll
            for (int r = 0; r < 16; ++r) { const int kp = kb0 + (r & 3) + 8 * (r >> 2);
                const int d0_ = qpos - kp, d1_ = qpos - (kp + 32);
                if (d0_ > 128 || d0_ < -128) p0[r] = -1e30f;
                if (d1_ > 128 || d1_ < -128) p1[r] = -1e30f; }
        }
        if (j == 0) {
            float mx = fmaxf(p0[0], p1[0]);
#pragma unroll
            for (int r = 1; r < 16; ++r) mx = fmaxf(mx, fmaxf(p0[r], p1[r]));
            mx = fmaxf(mx, __shfl_xor(mx, 32));
            const float dl = has_sink ? fmaxf(mx, 0.f) : mx;
#pragma unroll
            for (int r = 0; r < 16; ++r) { p0[r] -= dl; p1[r] -= dl; }
            mhat += dl; if (has_sink) l_run *= fast_exp2(-dl);
#pragma unroll
            for (int r = 0; r < 16; ++r) negm[r] = -mhat;
        }
        float rs = 0.f;
#pragma unroll
        for (int r = 0; r < 16; ++r) { p0[r] = fast_exp2(p0[r]); p1[r] = fast_exp2(p1[r]); rs += p0[r] + p1[r]; }
        if (__builtin_expect(__any(rs > 256.f), 0)) {
            const float rsm = fmaxf(rs, __shfl_xor(rs, 32));
            const float dl = rsm > 256.f ? ceilf(__builtin_log2f(rsm)) : 0.f;
            const float f = fast_exp2(-dl);
#pragma unroll
            for (int r = 0; r < 16; ++r) { p0[r] *= f; p1[r] *= f; }
            rs *= f; l_run *= f; mhat += dl;
#pragma unroll
            for (int r = 0; r < 16; ++r) negm[r] = -mhat;
            if (hi == 0) wsf[r32] = f;
            LDS_WAIT();
#pragma unroll
            for (int r = 0; r < 16; ++r) { const float g = wsf[(r & 3) + 8 * (r >> 2) + 4 * hi]; o0[r] *= g; o1[r] *= g; }
        }
        l_run += rs;
        u32x4 pw[4];
        pw[0] = (u32x4){pk_h2(p0[0], p0[1]), pk_h2(p0[2], p0[3]), pk_h2(p0[4], p0[5]), pk_h2(p0[6], p0[7])};
        pw[1] = (u32x4){pk_h2(p0[8], p0[9]), pk_h2(p0[10], p0[11]), pk_h2(p0[12], p0[13]), pk_h2(p0[14], p0[15])};
        pw[2] = (u32x4){pk_h2(p1[0], p1[1]), pk_h2(p1[2], p1[3]), pk_h2(p1[4], p1[5]), pk_h2(p1[6], p1[7])};
        pw[3] = (u32x4){pk_h2(p1[8], p1[9]), pk_h2(p1[10], p1[11]), pk_h2(p1[12], p1[13]), pk_h2(p1[14], p1[15])};
#pragma unroll
        for (int ks = 0; ks < 4; ++ks) {
            const h16x8 pa = __builtin_bit_cast(h16x8, pw[ks]);
#pragma unroll
            for (int d0 = 0; d0 < 2; ++d0) {
                const s16x4 lo = __builtin_amdgcn_ds_read_tr16_b64_v4i16((LAS s16x4*)(Vb + vp0 + d0 * 4096 + ks * 1024));
                const s16x4 hh = __builtin_amdgcn_ds_read_tr16_b64_v4i16((LAS s16x4*)(Vb + vp0 + d0 * 4096 + ks * 1024 + 512));
                typedef short s16x8 __attribute__((ext_vector_type(8)));
                const s16x8 vv = {lo[0], lo[1], lo[2], lo[3], hh[0], hh[1], hh[2], hh[3]};
                const h16x8 vf = __builtin_bit_cast(h16x8, vv);
                if (d0 == 0) o0 = __builtin_amdgcn_mfma_f32_32x32x16_f16(pa, vf, o0, 0, 0, 0);
                else         o1 = __builtin_amdgcn_mfma_f32_32x32x16_f16(pa, vf, o1, 0, 0, 0);
            }
        }
        if (j + 1 < NT) { *(LAS u32x4*)(lds + (buf ^ 1) * 8192 + kdst) = kreg; *(LAS u32x4*)(lds + 16384 + (buf ^ 1) * 8192 + vdst) = vreg; }
        __syncthreads();
    }
    l_run += __shfl_xor(l_run, 32);
    if (hi == 0) wsf[32 + r32] = l_run;
    LDS_WAIT();
    h16* op = Orow0 + (size_t)(D.q0 + (wave & 1) * 32) * 512 + head * 64 + r32;
#pragma unroll
    for (int r = 0; r < 16; ++r) { const int q = (r & 3) + 8 * (r >> 2) + 4 * hi; const float rl = fast_rcp(wsf[32 + q]);
        op[(size_t)q * 512] = (h16)(o0[r] * rl); op[(size_t)q * 512 + 32] = (h16)(o1[r] * rl); }
}
__device__ __forceinline__ void attn_dispatch(Frame& F, int l, int type, int u) {
    const h16* Z = (const h16*)(F.ws + WS_ZU);
    const h16* cache = (const h16*)(F.ws + WS_CACHE);
    AttnDesc D; D.sink = nullptr; D.windowed = 0; D.Kc = nullptr; D.Vc = nullptr; D.nc = 0;
    const bool isC = type & 1;
    const int qcol = isC ? C_QC : C_QB, kcol = isC ? C_KC : C_KB, vcol = isC ? C_VC : C_VB;
    h16* Obase = (h16*)(F.ws + WS_ZU + (isC ? ZU_OC : ZU_OB));
    size_t row_seq0;
    if (type < 2) {
        const int b = u >> 7, kvh = (u >> 6) & 1, qb = u & 63;
        row_seq0 = (size_t)NCTX + (size_t)b * LSEQ; D.kvh = kvh; D.q0 = qb * 64;
        D.Kc = cache + ((size_t)(isC ? 2 : 0) * 131072) + (size_t)((b * 2 + l) * 256) * 128 + kvh * 64;
        D.Vc = cache + ((size_t)(isC ? 3 : 1) * 131072) + (size_t)((b * 2 + l) * 256) * 128 + kvh * 64;
        D.nc = 4;
        if (!isC) { D.zt0 = 0; D.nz = 64; }
        else { int lo = qb - 2; if (lo < 0) lo = 0; int hi_ = qb + 2; if (hi_ > 63) hi_ = 63; D.zt0 = lo; D.nz = hi_ - lo + 1; D.windowed = 1; }
    } else {
        const int b = u >> 3, kvh = (u >> 2) & 1, qb = u & 3;
        row_seq0 = (size_t)b * SEQ; D.kvh = kvh; D.q0 = qb * 64; D.zt0 = 0; D.nz = 4;
    }
    if (isC) D.sink = F.inp(I_SINK) + l * 8;
    D.Kz = Z + row_seq0 * NMAIN + kcol + D.kvh * 64; D.Vz = Z + row_seq0 * NMAIN + vcol + D.kvh * 64;
    attn_unit(F, D, Z + row_seq0 * NMAIN + qcol, Obase + row_seq0 * 512);
}

__device__ __forceinline__ void phase_ffn_act(Frame& F, int l) {
    h16* U = (h16*)(F.ws + WS_ZU);
    const int gt = F.vcu * NTHREADS + F.tid, NGT = F.G * NTHREADS;
    constexpr int NCC = DFF / 8, RUN = 16, NRUN = NTOK / RUN;
    for (int it = gt; it < NCC * NRUN; it += NGT) {
        const int cc = it % NCC, run = it / NCC; const int c0 = cc * 8, r0 = run * RUN;
        const bool first = (r0 < NCTX) ? ((r0 & 255) == 0) : (((r0 - NCTX) & (LSEQ - 1)) == 0);
        const bool last = (r0 < NCTX) ? (((r0 + RUN) & 255) == 0) : ((((r0 + RUN) - NCTX) & (LSEQ - 1)) == 0);
        float w0[8], w1[8], w2[8], bb[8];
        const float* cw = F.inp(I_FCW) + (size_t)l * 3 * DFF + c0; const float* cb = F.inp(I_FCB) + (size_t)l * DFF + c0;
#pragma unroll
        for (int j = 0; j < 8; ++j) { w0[j] = cw[j]; w1[j] = cw[DFF + j]; w2[j] = cw[2 * DFF + j]; bb[j] = cb[j]; }
        u32x4 gr[RUN + 2], vr[RUN];
#pragma unroll
        for (int i = 0; i < RUN + 2; ++i) { const int r = r0 - 1 + i; const bool ok = !((i == 0 && first) || (i == RUN + 1 && last));
            const int rc = ok ? r : r0; const u32x4 v = *(const u32x4*)(U + (size_t)rc * DUP + c0);
            gr[i].x = ok ? v.x : 0u; gr[i].y = ok ? v.y : 0u; gr[i].z = ok ? v.z : 0u; gr[i].w = ok ? v.w : 0u; }
#pragma unroll
        for (int i = 0; i < RUN; ++i) vr[i] = *(const u32x4*)(U + (size_t)(r0 + i) * DUP + DFF + c0);
        float gp[8], gc[8], gn[8];
        unpack8(gr[0], gp); unpack8(gr[1], gc);
#pragma unroll
        for (int i = 0; i < RUN; ++i) {
            unpack8(gr[i + 2], gn);
            float v[8]; unpack8(vr[i], v);
            float o[8];
#pragma unroll
            for (int j = 0; j < 8; ++j) { const float g = bb[j] + w0[j] * gp[j] + w1[j] * gc[j] + w2[j] * gn[j]; o[j] = gelu_tanh(g) * v[j]; gp[j] = gc[j]; gc[j] = gn[j]; }
            *(u32x4*)(U + (size_t)(r0 + i) * DUP + DFF + c0) = pack8(o);
        }
    }
}

__device__ __forceinline__ void phase_act_fixup(Frame& F, int l) {
    h16* ACT = (h16*)(F.ws + WS_ZU);
    const float* edge = (const float*)(F.ws + WS_EDGE);
    const float* cw = F.inp(I_FCW) + (size_t)l * 3 * DFF;
    const int gt = F.vcu * NTHREADS + F.tid, NGT = F.G * NTHREADS;
    for (int it = gt; it < 64 * 8 * DFF; it += NGT) {
        const int ch = it % DFF, ri = it / DFF, pm = ri >> 3, idx = ri & 7, b = idx >> 1, last = idx & 1;
        const int row = pm * 256 + b * 64 + (last ? 63 : 0);
        const int nrow = last ? row + 1 : row - 1;
        const bool seq_edge = (row < NCTX) ? (last ? ((row & 255) == 255) : ((row & 255) == 0)) : (last ? (((row - NCTX) & (LSEQ - 1)) == LSEQ - 1) : (((row - NCTX) & (LSEQ - 1)) == 0));
        float gnb = 0.f;
        if (!seq_edge) { const int npm = nrow >> 8, nb = (nrow >> 6) & 3; gnb = edge[((size_t)(npm * 8 + 2 * nb + (last ? 0 : 1)) * 3) * DFF + ch]; }
        const float* ep = edge + ((size_t)(pm * 8 + idx) * 3) * DFF + ch;
        const float pre = ep[DFF] + cw[(last ? 2 : 0) * DFF + ch] * gnb;
        ACT[(size_t)row * DFF + ch] = (h16)(gelu_tanh(pre) * ep[2 * DFF]);
    }
}

constexpr int N_PHASES = 25;
__global__ void __launch_bounds__(NTHREADS, 2) fwd_kernel(Args args) {
    extern __shared__ __attribute__((aligned(16))) unsigned char lds_raw[];
    Frame F;
    F.lds = (LAS unsigned char*)lds_raw;
    F.tid = threadIdx.x; F.lane = F.tid & 63; F.wave = __builtin_amdgcn_readfirstlane(F.tid >> 6);
    F.G = gridDim.x; { const int bx = blockIdx.x; F.vcu = (F.G % 8 == 0) ? (bx % 8) * (F.G / 8) + bx / 8 : bx; }
    F.out0 = args.out; F.ws0 = args.ws; F.refresh();
    volatile LAS unsigned* MISC = (volatile LAS unsigned*)(F.lds + MISC_OFF);
    for (int u = F.tid; u < (LDS_BYTES - LDSCTL_OFF) / 4; u += NTHREADS) ((LAS unsigned*)(F.lds + LDSCTL_OFF))[u] = 0u;
    __syncthreads();
#if !MK_PER_PHASE
    XcdBarrier bar = xcd_barrier_post((unsigned*)(F.ws + WS_CTL) + CW_BAR, MISC + 8);
#define GRID_BAR() xcd_barrier(bar)
#else
    (void)MISC;
#define GRID_BAR() do { } while (0)
#endif
    const int lo = args.ph_lo, hi_ph = args.ph_hi;
#if defined(TIME_PH)
#ifndef TIME_AMP
#define TIME_AMP 8
#endif
    unsigned long long t_acc = 0, t_0 = 0;
#define TSTART(k) do { TSL_PHASE(F.lds, (k)); if ((k) == TIME_PH) t_0 = __builtin_amdgcn_s_memrealtime(); } while (0)
#define TSTOP(k) do { if ((k) == TIME_PH) t_acc += __builtin_amdgcn_s_memrealtime() - t_0; } while (0)
#else
#define TSTART(k) do { TSL_PHASE(F.lds, (k)); } while (0)
#define TSTOP(k) do { } while (0)
#endif
#define IN(k) (lo <= (k) && (k) < hi_ph)
#define SEAM(k) do { if (IN((k) + 1)) GRID_BAR(); } while (0)
#pragma unroll
    for (int l = 0; l < DEPTH; ++l) {
        const int pb = 12 * l;
        if (IN(pb + 0)) { TSTART(0); F.refresh(); phase_convert_weights(F, l); if (l == 0) phase_prep_misc(F); SEAM(pb + 0); TSTOP(0); }
        if (IN(pb + 1)) { TSTART(1); F.refresh();
            if (l == 0) phase_norm0(F, F.inp(I_N1G), (const float*)(F.ws + WS_MOD), (float*)(F.ws + WS_SS));
            phase_cvec(F, l);
            SEAM(pb + 1); TSTOP(1); }
        if (IN(pb + 2)) { TSTART(2); F.refresh();
            pg8::Gemm g{(const h16*)(F.ws + WS_H), (const h16*)(F.ws + WS_W + W_IN), NTOK, NMAIN, DM, DM}; pg8::StaticOrder S; S.init(NTOK, NMAIN, F.G, (int)blockIdx.x);
            pg8::EpiF16<0> E{(h16*)(F.ws + WS_ZU), NMAIN, (const float*)(F.ws + WS_SS) + (size_t)(2 * l) * NTOK, (const float*)(F.ws + WS_CV) + (size_t)l * 3 * (DIN + DUP), DIN + DUP};
            pg8::gemm_phase<pg8::EpiF16<0>, pg8::StaticOrder, true, true>(F.lds, g, S, E);
            SEAM(pb + 2); TSTOP(2); }
        if (IN(pb + 3)) { TSTART(3); F.refresh();
            phase_qk(F, l);
            for (int u = F.vcu; u < 512; u += F.G) {
                if (u < 256) lru_unit<0>(F, l, (u >> 3) * 256, u & 7, 1, 1, 0, 0, u >> 3);
                else { const int v = u - 256, b = v >> 7, ch = (v >> 3) & 15; lru_unit<1>(F, l, NCTX + b * LSEQ + ch * 256, v & 7, ch == 0, ch == 15, b, ch, 0); }
            }
            SEAM(pb + 3); TSTOP(3); }
        if (IN(pb + 4)) { TSTART(4); F.refresh();
            for (int type = 0; type < 4; ++type) { TSL_START(F.lds, 20 + type); for (int u = F.vcu; u < 256; u += F.G) attn_dispatch(F, l, type, u); TSL_STOP(F.lds, 20 + type); }
            TSL_START(F.lds, 24);
            for (int v = F.vcu; v < 256; v += F.G) { const int b = v >> 7, ch = (v >> 3) & 15; lru_unit<3>(F, l, NCTX + b * LSEQ + ch * 256, v & 7, ch == 0, ch == 15, b, ch, 0); }
            TSL_STOP(F.lds, 24);
            SEAM(pb + 4); TSTOP(4); }
        if (IN(pb + 5)) { TSTART(5); F.refresh();
            pg8::Gemm g{(const h16*)(F.ws + WS_H), (const h16*)(F.ws + WS_W + W_IN) + (size_t)NMAIN * DM, NTOK, NGATE, DM, DM}; pg8::StaticOrder S; S.init(NTOK, NGATE, F.G, (int)blockIdx.x);
            pg8::EpiF16<1> E{(h16*)(F.ws + WS_ZU), NGATE, (const float*)(F.ws + WS_SS) + (size_t)(2 * l) * NTOK, (const float*)(F.ws + WS_CV) + (size_t)l * 3 * (DIN + DUP) + NMAIN, DIN + DUP};
            pg8::gemm_phase<pg8::EpiF16<1>, pg8::StaticOrder, true, true>(F.lds, g, S, E);
            SEAM(pb + 5); TSTOP(5); }
        if (IN(pb + 6)) { TSTART(6); F.refresh();
            pg8::StaticOrder S; S.init(NTOK, DM, F.G, (int)blockIdx.x);
            h16* Hb = (h16*)(F.ws + WS_H); const h16* Gb = (const h16*)(F.ws + WS_ZU);
            { pg8::Gemm g{(const h16*)(F.ws + WS_ZU + ZU_OA), (const h16*)(F.ws + WS_W + W_OA), NTOK, DM, 1024, 1024}; pg8::EpiGateMul<0> E{Hb, Gb, 0};
              pg8::gemm_phase<pg8::EpiGateMul<0>, pg8::StaticOrder, true, true>(F.lds, g, S, E); }
            { pg8::Gemm g{(const h16*)(F.ws + WS_ZU + ZU_OB), (const h16*)(F.ws + WS_W + W_OB), NTOK, DM, 512, 512}; pg8::EpiGateMul<1> E{Hb, Gb, 1024};
              pg8::gemm_phase<pg8::EpiGateMul<1>, pg8::StaticOrder, true, true>(F.lds, g, S, E); }
            { pg8::Gemm g{(const h16*)(F.ws + WS_ZU + ZU_OC), (const h16*)(F.ws + WS_W + W_OC), NTOK, DM, 512, 512}; pg8::EpiGateMul<1> E{Hb, Gb, 2048};
              pg8::gemm_phase<pg8::EpiGateMul<1>, pg8::StaticOrder, true, true>(F.lds, g, S, E); }
            SEAM(pb + 6); TSTOP(6); }
        if (IN(pb + 7)) { TSTART(7); F.refresh();
            pg8::Gemm g{(const h16*)(F.ws + WS_H), (const h16*)(F.ws + WS_W + W_OUT), NTOK, DM, DM, DM}; pg8::StaticOrder S; S.init(NTOK, DM, F.G, (int)blockIdx.x);
            pg8::EpiRes E{l == 0 ? F.inp(I_XP) : F.out + O_Y, l == 0 ? F.inp(I_XS) : F.out + O_Y + (size_t)NCTX * DM, F.out + O_Y, (const float*)(F.ws + WS_MOD) + (size_t)l * 3 * 6144 + 2 * 1024,
                          (h16*)(F.ws + WS_H2), F.inp(I_N2G) + l * DM, (const float*)(F.ws + WS_MOD) + (size_t)l * 3 * 6144 + 4 * 1024, (float*)(F.ws + WS_SS) + (size_t)(2 * l + 1) * NTOK, F.lds + EPI_SCR_OFF};
            pg8::gemm_phase<pg8::EpiRes, pg8::StaticOrder, true, true>(F.lds, g, S, E);
            SEAM(pb + 7); TSTOP(7); }
        if (IN(pb + 9)) { TSTART(9); F.refresh();
            pg8::Gemm g{(const h16*)(F.ws + WS_H2), (const h16*)(F.ws + WS_W + W_UP), NTOK, DUP, DM, DM}; pg8::StaticOrder S; S.init(NTOK, DUP, F.G, (int)blockIdx.x);
            pg8::EpiAct E{(h16*)(F.ws + WS_ZU), (const float*)(F.ws + WS_SS) + (size_t)(2 * l + 1) * NTOK, (const float*)(F.ws + WS_CV) + (size_t)l * 3 * (DIN + DUP) + DIN, DIN + DUP,
                          F.inp(I_FCW) + (size_t)l * 3 * DFF, F.inp(I_FCB) + (size_t)l * DFF, (float*)(F.ws + WS_EDGE)};
            pg8::gemm_phase<pg8::EpiAct, pg8::StaticOrder, true, true>(F.lds, g, S, E);
            SEAM(pb + 9); TSTOP(9); }
        if (IN(pb + 10)) { TSTART(10); F.refresh(); phase_act_fixup(F, l); SEAM(pb + 10); TSTOP(10); }
        if (IN(pb + 11)) { TSTART(11); F.refresh();
            pg8::Gemm g{(const h16*)(F.ws + WS_ZU), (const h16*)(F.ws + WS_W + W_DOWN), NTOK, DM, DFF, DFF}; pg8::StaticOrder S; S.init(NTOK, DM, F.G, (int)blockIdx.x);
            const bool nx = l + 1 < DEPTH;
            pg8::EpiRes E{F.out + O_Y, F.out + O_Y + (size_t)NCTX * DM, F.out + O_Y, (const float*)(F.ws + WS_MOD) + (size_t)l * 3 * 6144 + 5 * 1024,
                          nx ? (h16*)(F.ws + WS_H) : (h16*)nullptr, F.inp(I_N1G) + (nx ? l + 1 : l) * DM, (const float*)(F.ws + WS_MOD) + (size_t)(nx ? l + 1 : l) * 3 * 6144 + 1 * 1024,
                          nx ? (float*)(F.ws + WS_SS) + (size_t)(2 * (l + 1)) * NTOK : (float*)nullptr, F.lds + EPI_SCR_OFF};
            pg8::gemm_phase<pg8::EpiRes, pg8::StaticOrder, true, true>(F.lds, g, S, E);
            SEAM(pb + 11); TSTOP(11); }
    }
    if (IN(24)) { TSTART(12); F.refresh(); phase_final_norm(F); TSTOP(12); }
#if defined(TIME_SUB)
    if (blockIdx.x == 0 && threadIdx.x == 0) { const unsigned long long ta = *(volatile LAS unsigned long long*)(F.lds + MISC_OFF + 64); const unsigned long long t1 = __builtin_amdgcn_s_memrealtime(); while (__builtin_amdgcn_s_memrealtime() - t1 < 8ull * ta) __builtin_amdgcn_s_sleep(8); }
#endif
#if defined(TIME_PH)
    if (blockIdx.x == 0 && threadIdx.x == 0) { const unsigned long long t1 = __builtin_amdgcn_s_memrealtime(); while (__builtin_amdgcn_s_memrealtime() - t1 < (unsigned long long)TIME_AMP * t_acc) __builtin_amdgcn_s_sleep(8); }
#endif
#if defined(PROBE_PH)
#ifndef PROBE_N
#define PROBE_N 4
#endif
#ifndef PROBE_SUB
#define PROBE_SUB 0xFF
#endif
#ifndef PROBE_VAR
#define PROBE_VAR 0
#endif
    if (IN(24)) {
        const int l = 1;
        for (int rep = 0; rep < PROBE_N; ++rep) {
            GRID_BAR(); F.refresh();
            if (PROBE_PH == 0) { phase_convert_weights(F, l); }
            if (PROBE_PH == 12) { phase_prep_misc(F); }
            if (PROBE_PH == 1) { phase_norm_mod(F, 0, F.inp(I_N1G) + l * DM, (const float*)(F.ws + WS_MOD) + (size_t)l * 3 * 6144, 0); }
            if (PROBE_PH == 2) { pg8::Gemm g{(const h16*)(F.ws + WS_H), (const h16*)(F.ws + WS_W + W_IN), NTOK, NMAIN, DM, DM}; pg8::StaticOrder S; S.init(NTOK, NMAIN, F.G, (int)blockIdx.x);
                pg8::EpiF16<0> E{(h16*)(F.ws + WS_ZU), NMAIN}; pg8::gemm_phase<pg8::EpiF16<0>, pg8::StaticOrder, true, true>(F.lds, g, S, E); }
            if (PROBE_PH == 3) {
                if (PROBE_SUB & 1) phase_qk(F, l, false);
                for (int u = F.vcu; u < 512; u += F.G) {
                    if (u < 256) { if (PROBE_SUB & 2) lru_unit<0>(F, l, (u >> 3) * 256, u & 7, 1, 1, 0, 0, u >> 3, false); }
                    else if (PROBE_SUB & 4) { const int v = u - 256, b = v >> 7, ch = (v >> 3) & 15; lru_unit<1>(F, l, NCTX + b * LSEQ + ch * 256, v & 7, ch == 0, ch == 15, b, ch, 0); }
                } }
            if (PROBE_PH == 4) {
                for (int type = 0; type < 4; ++type) if ((PROBE_SUB >> type) & 1) for (int u = F.vcu; u < 256; u += F.G) attn_dispatch(F, l, type, u);
                if (PROBE_SUB & 16) for (int v = F.vcu; v < 256; v += F.G) { const int b = v >> 7, ch = (v >> 3) & 15; lru_unit<2>(F, l, NCTX + b * LSEQ + ch * 256, v & 7, ch == 0, ch == 15, b, ch, 0, true, PROBE_VAR); } }
            if (PROBE_PH == 5) { pg8::Gemm g{(const h16*)(F.ws + WS_H), (const h16*)(F.ws + WS_W + W_IN) + (size_t)NMAIN * DM, NTOK, NGATE, DM, DM}; pg8::StaticOrder S; S.init(NTOK, NGATE, F.G, (int)blockIdx.x);
                pg8::EpiF16<1> E{(h16*)(F.ws + WS_ZU), NGATE}; pg8::gemm_phase<pg8::EpiF16<1>, pg8::StaticOrder, true, true>(F.lds, g, S, E); }
            if (PROBE_PH == 6) { pg8::StaticOrder S; S.init(NTOK, DM, F.G, (int)blockIdx.x);
                h16* Hb = (h16*)(F.ws + WS_H); const h16* Gb = (const h16*)(F.ws + WS_ZU);
                { pg8::Gemm g{(const h16*)(F.ws + WS_ZU + ZU_OA), (const h16*)(F.ws + WS_W + W_OA), NTOK, DM, 1024, 1024}; pg8::EpiGateMul<0> E{Hb, Gb, 0};
                  pg8::gemm_phase<pg8::EpiGateMul<0>, pg8::StaticOrder, true, true>(F.lds, g, S, E); }
                { pg8::Gemm g{(const h16*)(F.ws + WS_ZU + ZU_OB), (const h16*)(F.ws + WS_W + W_OB), NTOK, DM, 512, 512}; pg8::EpiGateMul<1> E{Hb, Gb, 1024};
                  pg8::gemm_phase<pg8::EpiGateMul<1>, pg8::StaticOrder, true, true>(F.lds, g, S, E); }
                { pg8::Gemm g{(const h16*)(F.ws + WS_ZU + ZU_OC), (const h16*)(F.ws + WS_W + W_OC), NTOK, DM, 512, 512}; pg8::EpiGateMul<1> E{Hb, Gb, 2048};
                  pg8::gemm_phase<pg8::EpiGateMul<1>, pg8::StaticOrder, true, true>(F.lds, g, S, E); } }
            if (PROBE_PH == 7) { pg8::Gemm g{(const h16*)(F.ws + WS_H), (const h16*)(F.ws + WS_W + W_OUT), NTOK, DM, DM, DM}; pg8::StaticOrder S; S.init(NTOK, DM, F.G, (int)blockIdx.x);
                pg8::EpiRes E{F.out + O_Y, F.out + O_Y + (size_t)NCTX * DM, (float*)(F.ws + WS_ZU), (const float*)(F.ws + WS_MOD) + (size_t)l * 3 * 6144 + 2 * 1024, nullptr, nullptr, nullptr, nullptr, F.lds + EPI_SCR_OFF};
                pg8::gemm_phase<pg8::EpiRes, pg8::StaticOrder, true, true>(F.lds, g, S, E); }
            if (PROBE_PH == 9) { pg8::Gemm g{(const h16*)(F.ws + WS_H), (const h16*)(F.ws + WS_W + W_UP), NTOK, DUP, DM, DM}; pg8::StaticOrder S; S.init(NTOK, DUP, F.G, (int)blockIdx.x);
                pg8::EpiF16<0> E{(h16*)(F.ws + WS_ZU), DUP}; pg8::gemm_phase<pg8::EpiF16<0>, pg8::StaticOrder, true, true>(F.lds, g, S, E); }
            if (PROBE_PH == 10) { phase_ffn_act(F, l); }
            if (PROBE_PH == 11) { pg8::Gemm g{(const h16*)(F.ws + WS_ZU) + DFF, (const h16*)(F.ws + WS_W + W_DOWN), NTOK, DM, DFF, DUP}; pg8::StaticOrder S; S.init(NTOK, DM, F.G, (int)blockIdx.x);
                pg8::EpiRes E{F.out + O_Y, F.out + O_Y + (size_t)NCTX * DM, (float*)(F.ws + WS_H), (const float*)(F.ws + WS_MOD) + (size_t)l * 3 * 6144 + 5 * 1024, nullptr, nullptr, nullptr, nullptr, F.lds + EPI_SCR_OFF};
                pg8::gemm_phase<pg8::EpiRes, pg8::StaticOrder, true, true>(F.lds, g, S, E); }
            if (PROBE_PH == 13) { }
        }
    }
#endif
#undef IN
#undef SEAM
}

extern "C" void kernel_launch(void* const* d_in, const int* in_sizes, int n_in, void* d_out, int out_size, void* d_ws, size_t ws_size, hipStream_t stream) {
    static int grid = 0;
    if (grid == 0) {
        if (n_in != 33 || out_size != (int)O_END || ws_size < WS_END) { fprintf(stderr, "kernel_launch: unexpected shapes: n_in %d out %d ws %zu (need %zu)\n", n_in, out_size, ws_size, (size_t)WS_END); grid = -1; return; }
        int dev = 0, cus = 0;
        if (hipGetDevice(&dev) != hipSuccess || hipDeviceGetAttribute(&cus, hipDeviceAttributeMultiprocessorCount, dev) != hipSuccess) { grid = -1; return; }
        if (hipFuncSetAttribute((const void*)fwd_kernel, hipFuncAttributeMaxDynamicSharedMemorySize, LDS_BYTES) != hipSuccess) { fprintf(stderr, "kernel_launch: hipFuncSetAttribute failed\n"); grid = -1; return; }
        (void)hipGetLastError();
        grid = cus;
    }
    if (grid < 0) return;
    (void)hipMemsetAsync((char*)d_ws + WS_CTL, 0, CTL_ZERO_BYTES, stream);
    Args a{};
    for (int i = 0; i < 33; ++i) a.in[i] = (const float*)d_in[i];
    a.out = (float*)d_out; a.ws = (unsigned char*)d_ws;
#if MK_PER_PHASE
    for (int ph = 0; ph < N_PHASES; ++ph) { a.ph_lo = ph; a.ph_hi = ph + 1; hipLaunchKernelGGL(fwd_kernel, dim3(grid), dim3(NTHREADS), LDS_BYTES, stream, a); }
#else
    a.ph_lo = 0; a.ph_hi = N_PHASES;
    hipLaunchKernelGGL(fwd_kernel, dim3(grid), dim3(NTHREADS), LDS_BYTES, stream, a);
#endif
}
```

```cpp
#include <hip/hip_runtime.h>
#include <cstdio>
#include <cstdint>
#include <cmath>

#ifndef MK_PER_PHASE
#define MK_PER_PHASE 0
#endif

#define LAS __attribute__((address_space(3)))
#define GAS __attribute__((address_space(1)))
typedef _Float16 h16;
typedef _Float16 h16x8 __attribute__((ext_vector_type(8)));
typedef _Float16 h16x4 __attribute__((ext_vector_type(4)));
typedef _Float16 h16x2 __attribute__((ext_vector_type(2)));
typedef short s16x4 __attribute__((ext_vector_type(4)));
typedef float f32x2 __attribute__((ext_vector_type(2)));
typedef float f32x4 __attribute__((ext_vector_type(4)));
typedef float f32x16 __attribute__((ext_vector_type(16)));
typedef unsigned u32x2 __attribute__((ext_vector_type(2)));
typedef unsigned u32x4 __attribute__((ext_vector_type(4)));

constexpr int DM = 1024, NTOK = 16384, NCTX = 8192, SEQ = 256, LSEQ = 4096, NB_CTX = 32, NB_LAT = 2, DEPTH = 2;
constexpr int DIN = 6656, NMAIN = 3584, NGATE = 3072, DFF = 2816, DUP = 5632, DLRU = 1024;
constexpr int C_XA = 0, C_YA = 1024, C_QB = 2048, C_KB = 2560, C_VB = 2688, C_QC = 2816, C_KC = 3328, C_VC = 3456;
constexpr float NORM_EPS = 1e-6f;
constexpr float LOG2E = 1.4426950408889634f;
constexpr float QSCALE = 0.125f * LOG2E;
constexpr size_t O_Y = 0, O_KB = 16777216, O_VB = 18874368, O_KC = 20971520, O_VC = 23068672, O_LRU = 25165824, O_END = 25296896;
constexpr size_t MiB = 1u << 20;
constexpr size_t WS_CTL = 0, WS_SS = 64 * 1024, CTL_ZERO_BYTES = 64 * 1024 + 4 * NTOK * 4;
constexpr size_t WS_MOD = 1 * MiB;
constexpr size_t WS_ROPE = 1 * MiB + 256 * 1024;
constexpr size_t WS_AGG = 1 * MiB + 320 * 1024;
constexpr size_t WS_CACHE = 2 * MiB;
constexpr size_t WS_W = 3 * MiB;
constexpr size_t W_IN = 0, W_OA = W_IN + (size_t)DIN * DM * 2, W_OB = W_OA + (size_t)DM * 1024 * 2, W_OC = W_OB + (size_t)DM * 512 * 2,
                 W_OUT = W_OC + (size_t)DM * 512 * 2, W_UP = W_OUT + (size_t)DM * DM * 2, W_DOWN = W_UP + (size_t)DUP * DM * 2,
                 W_LRU = W_DOWN + (size_t)DM * DFF * 2, W_END = W_LRU + (size_t)2 * 2 * 8 * 128 * 128 * 2;
static_assert(W_END <= 37 * MiB, "weights region");
constexpr size_t WS_H = 40 * MiB;
constexpr size_t WS_ZU = 72 * MiB;
constexpr size_t ZU_OA = (size_t)NTOK * NMAIN * 2, ZU_OB = ZU_OA + (size_t)NTOK * 1024 * 2, ZU_OC = ZU_OB + (size_t)NTOK * 512 * 2;
constexpr size_t WS_STASH = WS_ZU + (size_t)NTOK * DUP * 2;
static_assert(WS_STASH == 248 * MiB, "ws map");
constexpr size_t WS_H2 = WS_STASH + (size_t)NB_LAT * 2 * LSEQ * DLRU * 4;
constexpr size_t WS_CV = WS_H2 + (size_t)NTOK * DM * 2;
constexpr size_t WS_EDGE = WS_CV + MiB;
constexpr size_t WS_END = WS_EDGE + (size_t)64 * 8 * 3 * DFF * 4;

__device__ __forceinline__ unsigned pk_h2(float lo, float hi) { f32x2 v = {lo, hi}; h16x2 h = __builtin_convertvector(v, h16x2); return __builtin_bit_cast(unsigned, h); }
__device__ __forceinline__ void unpack8(u32x4 w, float* x) { h16x8 h = __builtin_bit_cast(h16x8, w);
#pragma unroll
    for (int j = 0; j < 8; ++j) x[j] = (float)h[j]; }
__device__ __forceinline__ u32x4 pack8(const float* x) { u32x4 w; w.x = pk_h2(x[0], x[1]); w.y = pk_h2(x[2], x[3]); w.z = pk_h2(x[4], x[5]); w.w = pk_h2(x[6], x[7]); return w; }
__device__ __forceinline__ float fast_exp2(float x) { return __builtin_amdgcn_exp2f(x); }
__device__ __forceinline__ float fast_rcp(float x) { return __builtin_amdgcn_rcpf(x); }
__device__ __forceinline__ float sigmoidf_(float x) { return fast_rcp(1.0f + fast_exp2(-LOG2E * x)); }
__device__ __forceinline__ float gelu_tanh(float x) { const float t = x + 0.044715f * x * x * x; return x * fast_rcp(1.0f + fast_exp2(-2.0f * 0.7978845608028654f * LOG2E * t)); }
template <int CTRL> __device__ __forceinline__ float dpp_f(float v) { return __int_as_float(__builtin_amdgcn_update_dpp(0, __float_as_int(v), CTRL, 0xf, 0xf, true)); }
__device__ __forceinline__ float sum8(float v) { v += dpp_f<0xB1>(v); v += dpp_f<0x4E>(v); v += dpp_f<0x141>(v); return v; }
__device__ __forceinline__ float wave_sum(float v) { v = sum8(v); v += dpp_f<0x140>(v); v += __shfl_xor(v, 16); v += __shfl_xor(v, 32); return v; }

constexpr int RING_BYTES = 131072;
constexpr int LDSCTL_OFF = RING_BYTES, MISC_OFF = LDSCTL_OFF + 320;
constexpr int LDS_BYTES = 163840;
constexpr int EPI_SCR_OFF = RING_BYTES + 2048, EPI_SCR_WAVE = 2304;
#if defined(TIME_SUB)
#ifndef TIME_FILTER
#define TIME_FILTER -1
#endif
#define TSL_OK(l_) (blockIdx.x == 0 && threadIdx.x == 0 && (TIME_FILTER < 0 || *(volatile LAS int*)((l_) + MISC_OFF + 96) == TIME_FILTER))
#define TSL_START(l_, id) do { if ((id) == TIME_SUB && TSL_OK(l_)) *(volatile LAS unsigned long long*)((l_) + MISC_OFF + 72) = __builtin_amdgcn_s_memrealtime(); } while (0)
#define TSL_STOP(l_, id) do { if ((id) == TIME_SUB && TSL_OK(l_)) { volatile LAS unsigned long long* a_ = (volatile LAS unsigned long long*)((l_) + MISC_OFF + 64); a_[0] = a_[0] + (__builtin_amdgcn_s_memrealtime() - a_[1]); } } while (0)
#define TSL_PHASE(l_, k) do { if (blockIdx.x == 0 && threadIdx.x == 0) *(volatile LAS int*)((l_) + MISC_OFF + 96) = (k); } while (0)
#else
#define TSL_START(l_, id) do { } while (0)
#define TSL_STOP(l_, id) do { } while (0)
#define TSL_PHASE(l_, k) do { } while (0)
#endif
namespace pg8 {
constexpr int BM = 256, BK = 64, HALF = 128, HTB = HALF * BK * 2, STAGE_BYTES = 8 * HTB, NXCD = 8, WGM = 8;
__host__ __device__ __forceinline__ int lds_byte(int r, int c) { const int st = (r >> 4) * 2 + (c >> 5), rr = r & 15, cc = c & 31, ob = rr * 64 + cc * 2; return st * 1024 + (ob ^ (((ob >> 9) & 1) << 5)); }
__host__ __device__ __forceinline__ void stage_rc(int b, int& R, int& C) { const int st = b / 1024, sb = b % 1024, swz = sb ^ (((sb >> 9) & 1) << 5); R = (st >> 1) * 16 + swz / 64; C = (st & 1) * 32 + (swz % 64) / 2; }
__host__ __device__ __forceinline__ int perm32(int rho) { const int n = rho >> 4, i = rho & 15; return 8 * (i >> 2) + 4 * n + (i & 3); }
struct Unit { int pm, pn; };
struct Gemm { const h16* A; const h16* Bt; int M, N, K, lda; };
struct StaticOrder {
    int nM, nN, nwg, G, c;
    __host__ __device__ void init(int M, int N, int G_, int c_) { nM = M / BM; nN = N / BM; nwg = nM * nN; G = G_; c = c_; }
    __host__ __device__ bool next(int i, Unit& u) const {
        const long L = (long)i * G + c; if (L >= nwg) return false;
        int wgid = (int)L; { const int q = nwg / NXCD, r = nwg % NXCD, xcd = wgid % NXCD, off = wgid / NXCD; wgid = (xcd < r ? xcd * (q + 1) : r * (q + 1) + (xcd - r) * q) + off; }
        const int nig = WGM * nN, gid = wgid / nig, fm = gid * WGM, gsz = (nM - fm) < WGM ? (nM - fm) : WGM;
        u.pm = fm + ((wgid % nig) % gsz); u.pn = (wgid % nig) / gsz; return true;
    }
    __device__ __forceinline__ void a_ready(const Unit&) const {}
    __device__ __forceinline__ void done(const Unit&) const {}
};

template <int ACT> struct EpiF16 {
    static constexpr bool PERM = true, AFTER_DRAIN = false;
    h16* O; int ldc;
    const float* ss; const float* cv;
    int cvld;
    __device__ __forceinline__ void operator()(const f32x4 (&acc)[2][2][4][2], const Unit& u, int wr, int wc, int fr, int fq) const {
        const int row0 = u.pm * BM + wr * 64 + fr, col0 = u.pn * BM + wc * 32 + 8 * fq;
        const int cond = u.pm < 32 ? 0 : (u.pm < 48 ? 1 : 2);
        f32x4 c0[2], c1[2];
#pragma unroll
        for (int bj = 0; bj < 2; ++bj) { const float* cp = cv + (size_t)cond * cvld + col0 + bj * HALF; c0[bj] = *(const f32x4*)cp; c1[bj] = *(const f32x4*)(cp + 4); }
#pragma unroll
        for (int ai = 0; ai < 2; ++ai)
#pragma unroll
            for (int m = 0; m < 4; ++m) { const int row = row0 + ai * HALF + m * 16; h16* rowp = O + (size_t)row * ldc + col0;
                const float rstd = 1.0f / sqrtf(ss[row] * (1.0f / DM) + NORM_EPS);
#pragma unroll
                for (int bj = 0; bj < 2; ++bj) { f32x4 v0 = acc[ai][bj][m][0] * rstd + c0[bj], v1 = acc[ai][bj][m][1] * rstd + c1[bj];
                    if (ACT == 1) {
#pragma unroll
                        for (int j = 0; j < 4; ++j) { v0[j] = sigmoidf_(v0[j]); v1[j] = sigmoidf_(v1[j]); } }
                    u32x4 w; w.x = pk_h2(v0[0], v0[1]); w.y = pk_h2(v0[2], v0[3]); w.z = pk_h2(v1[0], v1[1]); w.w = pk_h2(v1[2], v1[3]);
                    *(u32x4*)(rowp + bj * HALF) = w; } }
    }
};
template <int ACCUM> struct EpiGateMul {
    static constexpr bool PERM = true, AFTER_DRAIN = false;
    h16* Mg; const h16* G; int gcol0;
    __device__ __forceinline__ void operator()(const f32x4 (&acc)[2][2][4][2], const Unit& u, int wr, int wc, int fr, int fq) const {
        const int row0 = u.pm * BM + wr * 64 + fr, col0 = u.pn * BM + wc * 32 + 8 * fq;
#pragma unroll
        for (int ai = 0; ai < 2; ++ai) {
            u32x4 gw[4][2], mw[4][2];
#pragma unroll
            for (int m = 0; m < 4; ++m) { const size_t row = (size_t)(row0 + ai * HALF + m * 16);
#pragma unroll
                for (int bj = 0; bj < 2; ++bj) { gw[m][bj] = *(const u32x4*)(G + row * NGATE + gcol0 + col0 + bj * HALF);
                    if (ACCUM) mw[m][bj] = *(const u32x4*)(Mg + row * DM + col0 + bj * HALF); } }
#pragma unroll
            for (int m = 0; m < 4; ++m) { const size_t row = (size_t)(row0 + ai * HALF + m * 16);
#pragma unroll
                for (int bj = 0; bj < 2; ++bj) {
                    float g[8]; unpack8(gw[m][bj], g);
                    float o[8];
                    if (ACCUM) unpack8(mw[m][bj], o);
                    else {
#pragma unroll
                        for (int j = 0; j < 8; ++j) o[j] = 0.f; }
                    const f32x4 v0 = acc[ai][bj][m][0], v1 = acc[ai][bj][m][1];
#pragma unroll
                    for (int j = 0; j < 4; ++j) { o[j] += g[j] * v0[j]; o[4 + j] += g[4 + j] * v1[j]; }
                    *(u32x4*)(Mg + row * DM + col0 + bj * HALF) = pack8(o); } }
            asm volatile("" ::: "memory"); }
    }
};
template <int CTRL> __device__ __forceinline__ float dpp_old(float old, float v) { return __int_as_float(__builtin_amdgcn_update_dpp(__float_as_int(old), __float_as_int(v), CTRL, 0xf, 0xf, false)); }
struct EpiAct {
    static constexpr bool PERM = true, AFTER_DRAIN = false;
    h16* ACT; const float* ss; const float* cv; int cvld; const float* cw; const float* cb; float* edge;
    __device__ __forceinline__ void operator()(const f32x4 (&acc)[2][2][4][2], const Unit& u, int wr, int wc, int fr, int fq) const {
        const int cond = u.pm < 32 ? 0 : (u.pm < 48 ? 1 : 2);
        const int chb = u.pn * 128 + wc * 32 + 8 * fq;
        const int colg = u.pn * BM + wc * 32 + 8 * fq;
        float cg[8], cvv[8], w0[8], w1[8], w2[8], bb[8];
#pragma unroll
        for (int e = 0; e < 8; ++e) { cg[e] = cv[(size_t)cond * cvld + colg + e]; cvv[e] = cv[(size_t)cond * cvld + colg + HALF + e];
            w0[e] = cw[chb + e]; w1[e] = cw[DFF + chb + e]; w2[e] = cw[2 * DFF + chb + e]; bb[e] = cb[chb + e]; }
#pragma unroll
        for (int ai = 0; ai < 2; ++ai) {
            float rs[4]; float g[4][8];
#pragma unroll
            for (int m = 0; m < 4; ++m) { rs[m] = 1.0f / sqrtf(ss[u.pm * BM + ai * HALF + wr * 64 + m * 16 + fr] * (1.0f / DM) + NORM_EPS);
#pragma unroll
                for (int e = 0; e < 8; ++e) g[m][e] = acc[ai][0][m][e >> 2][e & 3] * rs[m] + cg[e]; }
#pragma unroll
            for (int m = 0; m < 4; ++m) {
                const int row = u.pm * BM + ai * HALF + wr * 64 + m * 16 + fr;
                float o[8], pre[8], vv[8];
#pragma unroll
                for (int e = 0; e < 8; ++e) {
                    const float pe = m > 0 ? dpp_f<0x121>(g[m > 0 ? m - 1 : 0][e]) : 0.f;
                    const float prev = dpp_old<0x111>(pe, g[m][e]);
                    const float ne = m < 3 ? dpp_f<0x12F>(g[m < 3 ? m + 1 : 3][e]) : 0.f;
                    const float next = dpp_old<0x101>(ne, g[m][e]);
                    vv[e] = acc[ai][1][m][e >> 2][e & 3] * rs[m] + cvv[e];
                    pre[e] = bb[e] + w0[e] * prev + w1[e] * g[m][e] + w2[e] * next;
                    o[e] = gelu_tanh(pre[e]) * vv[e];
                }
                *(u32x4*)(ACT + (size_t)row * DFF + chb) = pack8(o);
                if ((m == 0 && fr == 0) || (m == 3 && fr == 15)) {
                    float* ep = edge + ((size_t)(u.pm * 8 + 2 * (2 * ai + wr) + (m == 3 ? 1 : 0)) * 3) * DFF + chb;
#pragma unroll
                    for (int e = 0; e < 8; ++e) { ep[e] = g[m][e]; ep[DFF + e] = pre[e]; ep[2 * DFF + e] = vv[e]; }
                }
            }
        }
    }
};
struct EpiRes {
    static constexpr bool PERM = false, AFTER_DRAIN = false;
    const float* base_ctx; const float* base_lat; float* X; const float* gate;
    h16* Hn; const float* gn; const float* scn; float* ssn;
    LAS unsigned char* scr;
    __device__ __forceinline__ void operator()(const f32x4 (&acc)[2][2][4][2], const Unit& u, int wr, int wc, int fr, int fq) const {
        const int cond = u.pm < 32 ? 0 : (u.pm < 48 ? 1 : 2);
        const float* gp = gate + (size_t)cond * 6144;
        const float* bp = u.pm < 32 ? base_ctx + (size_t)u.pm * BM * DM : base_lat + (size_t)(u.pm - 32) * BM * DM;
        float* xp = X + (size_t)u.pm * BM * DM;
        const int lane = fq * 16 + fr, wave = wr * 4 + wc;
        LAS unsigned char* my = scr + wave * EPI_SCR_WAVE;
        const int wofs = fr * 144 + fq * 16;
        const int rrow = lane >> 3, rc4 = (lane & 7) * 4;
        const int rofs = rrow * 144 + rc4 * 4;
        const int colw = u.pn * BM + wc * 32 + rc4;
        const unsigned loff = (unsigned)((wr * 64 + rrow) * DM + colw);
        f32x4 gv[2], gsn[2];
#pragma unroll
        for (int bj = 0; bj < 2; ++bj) { gv[bj] = *(const f32x4*)(gp + colw + bj * HALF);
            if (Hn) gsn[bj] = *(const f32x4*)(gn + colw + bj * HALF) * (*(const f32x4*)(scn + (size_t)cond * 6144 + colw + bj * HALF) + 1.0f); }
        h16* hp = Hn ? Hn + (size_t)u.pm * BM * DM : nullptr;
        float* sp = ssn ? ssn + u.pm * BM : nullptr;
#pragma unroll
        for (int ai = 0; ai < 2; ++ai)
#pragma unroll
        for (int mh = 0; mh < 2; ++mh) {
            f32x4 b[2][2][2];
#pragma unroll
            for (int m2 = 0; m2 < 2; ++m2)
#pragma unroll
                for (int k = 0; k < 2; ++k) { const float* rb = bp + (size_t)(ai * HALF + (2 * mh + m2) * 16 + 8 * k) * DM;
#pragma unroll
                    for (int bj = 0; bj < 2; ++bj) b[m2][bj][k] = *(const f32x4*)(rb + loff + bj * HALF); }
#pragma unroll
            for (int m2 = 0; m2 < 2; ++m2)
            { float q[2] = {0.f, 0.f};
#pragma unroll
                for (int bj = 0; bj < 2; ++bj) { const int m = 2 * mh + m2;
                    *(LAS f32x4*)(my + wofs) = acc[ai][bj][m][0]; *(LAS f32x4*)(my + wofs + 64) = acc[ai][bj][m][1];
#pragma unroll
                    for (int k = 0; k < 2; ++k) { const f32x4 a = *(const LAS f32x4*)(my + rofs + k * 8 * 144);
                        float* xb = xp + (size_t)(ai * HALF + m * 16 + 8 * k) * DM;
                        const f32x4 xn = b[m2][bj][k] + gv[bj] * a;
                        *(f32x4*)(xb + loff + bj * HALF) = xn;
                        if (Hn) { const f32x4 hv = xn * gsn[bj]; u32x2 w; w.x = pk_h2(hv[0], hv[1]); w.y = pk_h2(hv[2], hv[3]);
                            *(u32x2*)(hp + (size_t)(ai * HALF + m * 16 + 8 * k) * DM + loff + bj * HALF) = w;
                            q[k] += (xn[0] * xn[0] + xn[1] * xn[1]) + (xn[2] * xn[2] + xn[3] * xn[3]); } }
                }
                if (Hn) {
#pragma unroll
                    for (int k = 0; k < 2; ++k) { float t = sum8(q[k]);
                        if ((lane & 7) == 0) atomicAdd(sp + wr * 64 + ai * HALF + (2 * mh + m2) * 16 + 8 * k + rrow, t); } }
            }
            asm volatile("" ::: "memory"); }
    }
};

template <class Epi, class Sched, bool ALIGN_EPI = false, bool SP2 = false>
__device__ __forceinline__ void gemm_phase(LAS unsigned char* lds, const Gemm g, const Sched& S, const Epi& E) {
    int tid_ = threadIdx.x; asm volatile("" : "+v"(tid_));
    const int tid = tid_, wid = __builtin_amdgcn_readfirstlane(tid >> 6), lane = tid & 63, wr = wid >> 2, wc = wid & 3, fr = lane & 15, fq = lane >> 4;
    const int K = g.K, nt = K / BK, lda = g.lda;
    unsigned voffA[2], voffB[2];
#pragma unroll
    for (int i = 0; i < 2; ++i) { int R, C; stage_rc(tid * 16 + i * 8192, R, C); const int Rb = Epi::PERM ? ((R & ~31) + perm32(R & 31)) : R;
        voffA[i] = (unsigned)(R * lda + C) * 2u; voffB[i] = (unsigned)(Rb * K + C) * 2u; }
    const size_t kstep = (size_t)(BK * 2);
    const size_t hstepA = (size_t)HALF * lda * 2, hstepB = (size_t)HALF * K * 2;
    const size_t tstepA = 2 * hstepA, tstepB = 2 * hstepB;
    const unsigned ldsw = (unsigned)wid * 1024u;
    const int aoff = lds_byte(wr * 64 + fr, fq * 8), boff = lds_byte(wc * 32 + fr, fq * 8);
#define PG8_SA(b, h) (((b) * 2 + (h)) * HTB)
#define PG8_SB(b, h) ((4 + (b) * 2 + (h)) * HTB)
#define PG8_STAGE(bufoff, gbase, voff) do { _Pragma("unroll") for (int _i = 0; _i < 2; ++_i) \
        __builtin_amdgcn_global_load_lds((const unsigned*)((const char*)(gbase) + (voff)[_i]), (LAS unsigned*)(lds + (bufoff) + ldsw + _i * 8192), 16, 0, 0); } while (0)
#define PG8_LDA(dst, b, h) do { _Pragma("unroll") for (int m = 0; m < 4; ++m) _Pragma("unroll") for (int k = 0; k < 2; ++k) dst[m][k] = *(const LAS h16x8*)(lds + PG8_SA(b, h) + aoff + m * 2048 + k * 1024); } while (0)
#define PG8_LDB(dst, b, h) do { _Pragma("unroll") for (int n = 0; n < 2; ++n) _Pragma("unroll") for (int k = 0; k < 2; ++k) dst[n][k] = *(const LAS h16x8*)(lds + PG8_SB(b, h) + boff + n * 2048 + k * 1024); } while (0)
#define PG8_MMA(ai, bj, At, Bt) do { __builtin_amdgcn_s_setprio(1); _Pragma("unroll") for (int m = 0; m < 4; ++m) _Pragma("unroll") for (int n = 0; n < 2; ++n) _Pragma("unroll") for (int k = 0; k < 2; ++k) \
        acc[ai][bj][m][n] = __builtin_amdgcn_mfma_f32_16x16x32_f16(Bt[n][k], At[m][k], acc[ai][bj][m][n], 0, 0, 0); __builtin_amdgcn_s_setprio(0); } while (0)
#define PG8_WAIT_V(n) asm volatile("s_waitcnt vmcnt(" #n ")" ::: "memory")
#define PG8_WAIT_L(n) asm volatile("s_waitcnt lgkmcnt(" #n ")" ::: "memory")
#define PG8_BAR __builtin_amdgcn_s_barrier()
#define PG8_SCHED __builtin_amdgcn_sched_barrier(0)
    Unit cur, nxt; int ui = 0;
    if (!S.next(0, cur)) return;
    TSL_START(lds, 10);
    f32x4 acc[2][2][4][2];
#pragma unroll
    for (int a = 0; a < 2; ++a)
#pragma unroll
        for (int b = 0; b < 2; ++b)
#pragma unroll
            for (int m = 0; m < 4; ++m)
#pragma unroll
                for (int n = 0; n < 2; ++n) acc[a][b][m][n] = (f32x4){0.f, 0.f, 0.f, 0.f};
    h16x8 At[4][2], B0[2][2], B1[2][2];
    const char* cA = (const char*)g.A + (size_t)cur.pm * tstepA; const char* cB = (const char*)g.Bt + (size_t)cur.pn * tstepB;
    S.a_ready(cur);
    if constexpr (SP2) {
        PG8_STAGE(PG8_SB(0, 0), cB, voffB); PG8_STAGE(PG8_SB(0, 1), cB + hstepB, voffB); PG8_STAGE(PG8_SA(0, 0), cA, voffA); PG8_STAGE(PG8_SA(0, 1), cA + hstepA, voffA);
        if (wr == 1) PG8_BAR;
        PG8_WAIT_V(2); PG8_BAR;
        PG8_STAGE(PG8_SB(1, 0), cB + kstep, voffB); PG8_STAGE(PG8_SA(1, 0), cA + kstep, voffA); PG8_STAGE(PG8_SB(1, 1), cB + hstepB + kstep, voffB);
        PG8_WAIT_V(6); PG8_BAR;
    } else {
        PG8_STAGE(PG8_SB(0, 0), cB, voffB); PG8_STAGE(PG8_SA(0, 0), cA, voffA); PG8_STAGE(PG8_SB(0, 1), cB + hstepB, voffB); PG8_STAGE(PG8_SA(0, 1), cA + hstepA, voffA);
        if (wr == 1) PG8_BAR;
        PG8_WAIT_V(4); PG8_BAR;
        PG8_STAGE(PG8_SB(1, 0), cB + kstep, voffB); PG8_STAGE(PG8_SA(1, 0), cA + kstep, voffA); PG8_STAGE(PG8_SB(1, 1), cB + hstepB + kstep, voffB);
        PG8_WAIT_V(6); PG8_BAR;
    }
    for (;;) {
        const bool has_next = S.next(ui + 1, nxt);
        const char* nA = has_next ? (const char*)g.A + (size_t)nxt.pm * tstepA : cA; const char* nB = has_next ? (const char*)g.Bt + (size_t)nxt.pn * tstepB : cB;
        for (int t = 0; t < nt; t += 2) {
            const bool last = (t == nt - 2);
            const char* a1 = cA + (size_t)(t + 1) * kstep;
            const char* a2 = last ? nA : cA + (size_t)(t + 2) * kstep; const char* b2 = last ? nB : cB + (size_t)(t + 2) * kstep;
            const char* a3 = a2 + kstep; const char* b3 = b2 + kstep;
            if (last && has_next) S.a_ready(nxt);
            if constexpr (SP2) {
            PG8_LDB(B0, 0, 0); PG8_LDB(B1, 0, 1); PG8_SCHED; PG8_LDA(At, 0, 0); PG8_STAGE(PG8_SA(1, 1), a1 + hstepA, voffA);
            PG8_WAIT_V(8); PG8_WAIT_L(0); PG8_BAR; PG8_MMA(0, 0, At, B0); PG8_MMA(0, 1, At, B1); PG8_BAR; PG8_SCHED;
            PG8_LDA(At, 0, 1); PG8_STAGE(PG8_SB(0, 0), b2, voffB); PG8_STAGE(PG8_SB(0, 1), b2 + hstepB, voffB); PG8_STAGE(PG8_SA(0, 0), a2, voffA);
            PG8_WAIT_V(8); PG8_WAIT_L(0); PG8_BAR; PG8_MMA(1, 0, At, B0); PG8_MMA(1, 1, At, B1); PG8_BAR; PG8_SCHED;
            PG8_LDB(B0, 1, 0); PG8_LDB(B1, 1, 1); PG8_SCHED; PG8_LDA(At, 1, 0); PG8_STAGE(PG8_SA(0, 1), a2 + hstepA, voffA);
            PG8_WAIT_V(8); PG8_WAIT_L(0); PG8_BAR; PG8_MMA(0, 0, At, B0); PG8_MMA(0, 1, At, B1); PG8_BAR; PG8_SCHED;
            PG8_LDA(At, 1, 1); PG8_STAGE(PG8_SB(1, 0), b3, voffB); PG8_STAGE(PG8_SB(1, 1), b3 + hstepB, voffB); PG8_STAGE(PG8_SA(1, 0), a3, voffA);
            PG8_WAIT_V(8); PG8_WAIT_L(0); PG8_BAR; PG8_MMA(1, 0, At, B0); PG8_MMA(1, 1, At, B1); PG8_BAR; PG8_SCHED;
            } else {
            PG8_LDB(B0, 0, 0); PG8_SCHED; PG8_LDA(At, 0, 0); PG8_STAGE(PG8_SA(1, 1), a1 + hstepA, voffA);
            PG8_WAIT_L(8); PG8_BAR; PG8_WAIT_L(0); PG8_MMA(0, 0, At, B0); PG8_BAR; PG8_SCHED;
            PG8_LDB(B1, 0, 1); PG8_STAGE(PG8_SB(0, 0), b2, voffB);
            PG8_BAR; PG8_WAIT_L(0); PG8_MMA(0, 1, At, B1); PG8_BAR;
            PG8_LDA(At, 0, 1); PG8_STAGE(PG8_SA(0, 0), a2, voffA);
            PG8_BAR; PG8_WAIT_L(0); PG8_MMA(1, 0, At, B0); PG8_BAR; PG8_SCHED;
            PG8_STAGE(PG8_SB(0, 1), b2 + hstepB, voffB);
            PG8_WAIT_V(6); PG8_BAR; PG8_MMA(1, 1, At, B1); PG8_BAR;
            PG8_LDB(B0, 1, 0); PG8_SCHED; PG8_LDA(At, 1, 0); PG8_STAGE(PG8_SA(0, 1), a2 + hstepA, voffA);
            PG8_WAIT_L(8); PG8_BAR; PG8_WAIT_L(0); PG8_MMA(0, 0, At, B0); PG8_BAR; PG8_SCHED;
            PG8_LDB(B1, 1, 1); PG8_STAGE(PG8_SB(1, 0), b3, voffB);
            PG8_BAR; PG8_WAIT_L(0); PG8_MMA(0, 1, At, B1); PG8_BAR;
            PG8_LDA(At, 1, 1); PG8_STAGE(PG8_SA(1, 0), a3, voffA);
            PG8_BAR; PG8_WAIT_L(0); PG8_MMA(1, 0, At, B0); PG8_BAR; PG8_SCHED;
            PG8_STAGE(PG8_SB(1, 1), b3 + hstepB, voffB);
            PG8_WAIT_V(6); PG8_BAR; PG8_MMA(1, 1, At, B1); PG8_BAR;
            }
        }
        if constexpr (ALIGN_EPI) { if (wr == 0) PG8_BAR; }
        TSL_STOP(lds, 10); TSL_START(lds, 11);
        if constexpr (!Epi::AFTER_DRAIN) { E(acc, cur, wr, wc, fr, fq); S.done(cur); }
        TSL_STOP(lds, 11); TSL_START(lds, 10);
        if (!has_next) break;
#pragma unroll
        for (int a = 0; a < 2; ++a)
#pragma unroll
            for (int b = 0; b < 2; ++b)
#pragma unroll
                for (int m = 0; m < 4; ++m)
#pragma unroll
                    for (int n = 0; n < 2; ++n) acc[a][b][m][n] = (f32x4){0.f, 0.f, 0.f, 0.f};
        cur = nxt; cA = nA; cB = nB; ++ui;
        if constexpr (ALIGN_EPI) { if (wr == 1) PG8_BAR; }
    }
    PG8_WAIT_V(0);
    if constexpr (!ALIGN_EPI) { if (wr == 0) PG8_BAR; }
    PG8_BAR;
    TSL_STOP(lds, 10);
#undef PG8_SA
#undef PG8_SB
#undef PG8_STAGE
#undef PG8_LDA
#undef PG8_LDB
#undef PG8_MMA
#undef PG8_WAIT_V
#undef PG8_WAIT_L
#undef PG8_BAR
#undef PG8_SCHED
}
}

constexpr int NWAVES = 8, NTHREADS = 512;

typedef GAS unsigned gu32;
#define RLX_AGENT __ATOMIC_RELAXED, __HIP_MEMORY_SCOPE_AGENT
#define LDS_WAIT() asm volatile("s_waitcnt lgkmcnt(0)" ::: "memory")
#define VM_WAIT() asm volatile("s_waitcnt vmcnt(0)" ::: "memory")

#define XB_TMO      128
#define XB_XCNT(j)  (256  + 64 * (j))
#define XB_XSUB(j)  (1280 + 64 * (j))
#define XB_XGEN(j)  (2304 + 64 * (j))
#define XB_TOP      3328
#define XB_TOPGEN   3392
#define XCD_BAR_WORDS 3456
#define XB_SPIN_CAP (1u << 18)
__device__ __forceinline__ unsigned xb_ld(unsigned* p)              { return __hip_atomic_load(p, __ATOMIC_RELAXED, __HIP_MEMORY_SCOPE_AGENT); }
__device__ __forceinline__ unsigned xb_add(unsigned* p, unsigned v) { return __hip_atomic_fetch_add(p, v, __ATOMIC_RELAXED, __HIP_MEMORY_SCOPE_AGENT); }
__device__ __forceinline__ unsigned xb_xcc_id() { return (unsigned)__builtin_amdgcn_s_getreg((3 << 11) | 20) & 0xFu; }
#define XB_SPIN(cond, bar) do { unsigned _sp = 0; while (cond) { __builtin_amdgcn_s_sleep(1); \
    if ((++_sp & 255u) == 0u) { if (xb_ld(&(bar)[XB_TMO])) break; if (_sp > XB_SPIN_CAP) { atomicAdd(&(bar)[XB_TMO], 1u); break; } } } } while (0)
struct XcdBarrier { unsigned* bar; unsigned x; volatile LAS unsigned* st; };
__device__ __forceinline__ XcdBarrier xcd_barrier_post(unsigned* bar, volatile LAS unsigned* st) {
    XcdBarrier b; b.bar = bar; b.x = xb_xcc_id(); b.st = st;
    if (threadIdx.x == 0) (void)xb_add(&bar[XB_XCNT(b.x)], 1u);
    return b;
}
__device__ __forceinline__ void xcd_barrier_complete(unsigned* bar, unsigned x, unsigned& nloc, unsigned& nx) {
    const unsigned G = gridDim.x * gridDim.y * gridDim.z;
    unsigned sum, cnt, mine, sp = 0u;
    for (;;) {
        sum = 0u; cnt = 0u; mine = 0u;
#pragma unroll
        for (unsigned j = 0; j < 16; ++j) { const unsigned c = xb_ld(&bar[XB_XCNT(j)]); sum += c; cnt += (c > 0u) ? 1u : 0u; mine = (j == x) ? c : mine; }
        if (sum == G) break;
        __builtin_amdgcn_s_sleep(1);
        if ((++sp & 255u) == 0u) { if (xb_ld(&bar[XB_TMO])) break; if (sp > XB_SPIN_CAP) { atomicAdd(&bar[XB_TMO], 1u); break; } }
    }
    nloc = mine > 0u ? mine : 1u; nx = cnt > 0u ? cnt : 1u;
}
__device__ __forceinline__ void xcd_barrier(const XcdBarrier& b) {
    asm volatile("s_waitcnt vmcnt(0)" ::: "memory");
    __syncthreads();
    if (threadIdx.x == 0) {
        unsigned* bar = b.bar;
        __builtin_amdgcn_s_waitcnt(0);
        unsigned nloc = b.st[0], nx = b.st[1];
        if (nloc == 0u) { xcd_barrier_complete(bar, b.x, nloc, nx); b.st[0] = nloc; b.st[1] = nx; }
        const unsigned old = xb_add(&bar[XB_XSUB(b.x)], 1u);
        const unsigned gen = old / nloc;
        if (old + 1u == (gen + 1u) * nloc) {
            __builtin_amdgcn_fence(__ATOMIC_RELEASE, "agent");
            asm volatile("s_waitcnt vmcnt(0)" ::: "memory");
            const unsigned og = xb_add(&bar[XB_TOP], 1u);
            const unsigned tg = og / nx;
            if (og + 1u == (tg + 1u) * nx) xb_add(&bar[XB_TOPGEN], 1u);
            else XB_SPIN(xb_ld(&bar[XB_TOPGEN]) == tg, bar);
            __builtin_amdgcn_fence(__ATOMIC_ACQUIRE, "agent");
            xb_add(&bar[XB_XGEN(b.x)], 1u);
            asm volatile("s_waitcnt vmcnt(0)" ::: "memory");
        } else {
            XB_SPIN(xb_ld(&bar[XB_XGEN(b.x)]) == gen, bar);
            __builtin_amdgcn_fence(__ATOMIC_ACQUIRE, "agent");
            asm volatile("s_waitcnt vmcnt(0)" ::: "memory");
        }
    }
    __syncthreads();
}
constexpr int CW_BAR = 4096;
static_assert((CW_BAR + XCD_BAR_WORDS) * 4 <= (int)CTL_ZERO_BYTES, "ctl");

struct Args {
    const float* in[33]; float* out; unsigned char* ws; int ph_lo, ph_hi;
};
typedef const GAS float* cfp_t;
struct Frame {
    LAS unsigned char* lds;
    int tid, lane, wave, vcu, G;
    const __attribute__((address_space(4))) cfp_t* in; float* out; unsigned char* ws; float* out0; unsigned char* ws0;
    __device__ __forceinline__ const float* inp(int i) const { return (const float*)in[i]; }
    __device__ __forceinline__ void refresh() { int t = threadIdx.x; asm volatile("" : "+v"(t)); tid = t; lane = t & 63; wave = __builtin_amdgcn_readfirstlane(t >> 6);
        const __attribute__((address_space(4))) cfp_t* p = (const __attribute__((address_space(4))) cfp_t*)__builtin_amdgcn_kernarg_segment_ptr(); asm volatile("" : "+s"(p)); in = p;
        GAS float* o_ = (GAS float*)out0; GAS unsigned char* w_ = (GAS unsigned char*)ws0; asm volatile("" : "+s"(o_), "+s"(w_)); out = (float*)o_; ws = (unsigned char*)w_; }
};
enum { I_XP = 0, I_XS, I_C, I_CKB, I_CVB, I_CKC, I_CVC, I_STATE, I_CCTX, I_N1G, I_N2G, I_WMOD, I_BMOD, I_WIN, I_LCW, I_LCB, I_LWA, I_LBA, I_LWX, I_LBX, I_LAM,
       I_QNG, I_KNG, I_SINK, I_WOA, I_WOB, I_WOC, I_WOUT, I_WUP, I_FCW, I_FCB, I_WDOWN, I_FING };

__device__ __forceinline__ void transpose_item(const float* W, int K, int N, h16* WT, LAS float* scr, int item, int lane, bool upmap = false) {
    const int nblk = N / 32, kb = item / nblk, nb = item % nblk, k0 = 64 * kb, n0 = 32 * nb;
    const int d0 = !upmap ? n0 : (n0 < DFF ? (n0 / 128) * 256 + n0 % 128 : ((n0 - DFF) / 128) * 256 + 128 + (n0 - DFF) % 128);
    f32x4 v[8];
#pragma unroll
    for (int i = 0; i < 8; ++i) v[i] = *(const f32x4*)(W + (size_t)(k0 + 8 * i + (lane >> 3)) * N + n0 + 4 * (lane & 7));
#pragma unroll
    for (int i = 0; i < 8; ++i) { LAS float* d = scr + (8 * i + (lane >> 3)) * 33 + 4 * (lane & 7); d[0] = v[i].x; d[1] = v[i].y; d[2] = v[i].z; d[3] = v[i].w; }
    LDS_WAIT(); asm volatile("" ::: "memory");
    const int c = lane & 7;
#pragma unroll
    for (int j = 0; j < 4; ++j) { const int n = (lane >> 3) + 8 * j; const LAS float* sp = scr + (8 * c) * 33 + n;
        u32x4 o; o.x = pk_h2(sp[0 * 33], sp[1 * 33]); o.y = pk_h2(sp[2 * 33], sp[3 * 33]); o.z = pk_h2(sp[4 * 33], sp[5 * 33]); o.w = pk_h2(sp[6 * 33], sp[7 * 33]);
        *(u32x4*)(WT + (size_t)(d0 + n) * K + k0 + 8 * c) = o; }
    LDS_WAIT(); asm volatile("" ::: "memory");
}
__device__ __forceinline__ void phase_convert_weights(Frame& F, int l) {
    LAS float* scr = (LAS float*)(F.lds + F.wave * 16384);
    const int gw = F.vcu * NWAVES + F.wave, NGW = F.G * NWAVES;
    unsigned char* wb = F.ws + WS_W;
    constexpr int IT_IN = (DM / 64) * (DIN / 32), IT_OA = (1024 / 64) * (DM / 32), IT_OB = (512 / 64) * (DM / 32), IT_OUT = (DM / 64) * (DM / 32),
                  IT_UP = (DM / 64) * (DUP / 32), IT_DOWN = (DFF / 64) * (DM / 32), IT_LRU1 = (128 / 64) * (128 / 32), IT_LRU = 32 * IT_LRU1;
    constexpr int NITEMS = IT_IN + IT_OA + 2 * IT_OB + IT_OUT + IT_UP + IT_DOWN + IT_LRU;
    for (int it = gw; it < NITEMS; it += NGW) {
        int r = it;
        if (r < IT_IN) { transpose_item(F.inp(I_WIN) + (size_t)l * DM * DIN, DM, DIN, (h16*)(wb + W_IN), scr, r, F.lane); continue; } r -= IT_IN;
        if (r < IT_OA) { transpose_item(F.inp(I_WOA) + (size_t)l * 1024 * DM, 1024, DM, (h16*)(wb + W_OA), scr, r, F.lane); continue; } r -= IT_OA;
        if (r < IT_OB) { transpose_item(F.inp(I_WOB) + (size_t)l * 512 * DM, 512, DM, (h16*)(wb + W_OB), scr, r, F.lane); continue; } r -= IT_OB;
        if (r < IT_OB) { transpose_item(F.inp(I_WOC) + (size_t)l * 512 * DM, 512, DM, (h16*)(wb + W_OC), scr, r, F.lane); continue; } r -= IT_OB;
        if (r < IT_OUT) { transpose_item(F.inp(I_WOUT) + (size_t)l * DM * DM, DM, DM, (h16*)(wb + W_OUT), scr, r, F.lane); continue; } r -= IT_OUT;
        if (r < IT_UP) { transpose_item(F.inp(I_WUP) + (size_t)l * DM * DUP, DM, DUP, (h16*)(wb + W_UP), scr, r, F.lane, true); continue; } r -= IT_UP;
        if (r < IT_DOWN) { transpose_item(F.inp(I_WDOWN) + (size_t)l * DFF * DM, DFF, DM, (h16*)(wb + W_DOWN), scr, r, F.lane); continue; } r -= IT_DOWN;
        {
            const int mi = r / IT_LRU1, sub = r % IT_LRU1, dir = mi >> 4, gate = (mi >> 3) & 1, n = mi & 7;
            const float* src = (gate ? F.inp(I_LWX) : F.inp(I_LWA)) + ((size_t)((l * 2 + dir) * 8 + n)) * 128 * 128;
            transpose_item(src, 128, 128, (h16*)(wb + W_LRU) + (size_t)mi * 128 * 128, scr, sub, F.lane);
        }
    }
}
__device__ __forceinline__ void phase_prep_misc(Frame& F) {
    LAS float* sil = (LAS float*)F.lds;
    LAS float* part = (LAS float*)(F.lds + 16384);
    float* mod = (float*)(F.ws + WS_MOD);
    for (int item = F.vcu; item < 192; item += F.G) {
        const int l = item / 96, n0 = (item % 96) * 64;
        __syncthreads();
        for (int i = F.tid; i < 3 * 1024; i += NTHREADS) { const int j = i >> 10, k = i & 1023;
            const float v = j == 0 ? F.inp(I_CCTX)[k] : F.inp(I_C)[(j - 1) * 1024 + k]; sil[i] = v * sigmoidf_(v); }
        __syncthreads();
        const float* wp = F.inp(I_WMOD) + (size_t)l * DM * 6144 + n0 + F.lane;
        float a0 = 0.f, a1 = 0.f, a2 = 0.f;
        const int kb = F.wave * 128;
#pragma unroll 8
        for (int k = 0; k < 128; ++k) { const float w = wp[(size_t)(kb + k) * 6144]; a0 += w * sil[kb + k]; a1 += w * sil[1024 + kb + k]; a2 += w * sil[2048 + kb + k]; }
        part[(F.wave * 3 + 0) * 64 + F.lane] = a0; part[(F.wave * 3 + 1) * 64 + F.lane] = a1; part[(F.wave * 3 + 2) * 64 + F.lane] = a2;
        __syncthreads();
        if (F.tid < 192) { const int j = F.tid >> 6, c = F.tid & 63; float s = F.inp(I_BMOD)[l * 6144 + n0 + c];
#pragma unroll
            for (int w = 0; w < 8; ++w) s += part[(w * 3 + j) * 64 + c];
            mod[((size_t)l * 3 + j) * 6144 + n0 + c] = s; }
    }
    __syncthreads();
    const int gt = F.vcu * NTHREADS + F.tid, NGT = F.G * NTHREADS;
    float* rope = (float*)(F.ws + WS_ROPE);
    for (int i = gt; i < 64 * 16; i += NGT) { const int pos = i >> 4, fi = i & 15; const float inv = expf(-(float)fi * (1.0f / 16.0f) * 9.210340371976184f);
        const float ang = (float)pos * inv; rope[2 * i] = cosf(ang); rope[2 * i + 1] = sinf(ang); }
    h16* cache = (h16*)(F.ws + WS_CACHE);
    for (int i = gt; i < 4 * 131072 / 4; i += NGT) { const int kind = i / 32768, e = (i % 32768) * 4;
        const float* src = kind == 0 ? F.inp(I_CKB) : kind == 1 ? F.inp(I_CVB) : kind == 2 ? F.inp(I_CKC) : F.inp(I_CVC);
        const f32x4 v = *(const f32x4*)(src + e); u32x2 w; w.x = pk_h2(v[0], v[1]); w.y = pk_h2(v[2], v[3]); *(u32x2*)(cache + (size_t)kind * 131072 + e) = w; }
}

__device__ __forceinline__ const float* xrow_ptr(const Frame& F, int layer_src_is_input, int row) {
    if (layer_src_is_input) return row < NCTX ? F.inp(I_XP) + (size_t)row * DM : F.inp(I_XS) + (size_t)(row - NCTX) * DM;
    return F.out + O_Y + (size_t)row * DM;
}
__device__ __forceinline__ void phase_norm0(Frame& F, const float* g, const float* mod_l, float* ss) {
    const int gw = F.vcu * NWAVES + F.wave, NGW = F.G * NWAVES;
    h16* H = (h16*)(F.ws + WS_H);
    for (int grp = gw; grp < NTOK / 4; grp += NGW) {
        const int row0 = grp * 4;
        const int cond = row0 < NCTX ? 0 : (row0 < NCTX + LSEQ ? 1 : 2);
        const float* mp = mod_l + (size_t)cond * 6144;
        f32x4 v[4][4];
#pragma unroll
        for (int i = 0; i < 4; ++i) { const f32x4* xr = (const f32x4*)xrow_ptr(F, 1, row0 + i) + F.lane;
#pragma unroll
            for (int j = 0; j < 4; ++j) v[i][j] = xr[64 * j]; }
        f32x4 gs[4];
#pragma unroll
        for (int j = 0; j < 4; ++j) { const int c = F.lane * 4 + 256 * j; gs[j] = *(const f32x4*)(g + c) * (*(const f32x4*)(mp + 1024 + c) + 1.0f); }
#pragma unroll
        for (int i = 0; i < 4; ++i) {
            float sq = 0.f;
#pragma unroll
            for (int j = 0; j < 4; ++j) sq += (v[i][j].x * v[i][j].x + v[i][j].y * v[i][j].y) + (v[i][j].z * v[i][j].z + v[i][j].w * v[i][j].w);
            sq = wave_sum(sq);
            if (F.lane == 0) ss[row0 + i] = sq;
            u32x2* o8 = (u32x2*)(H + (size_t)(row0 + i) * DM) + F.lane;
#pragma unroll
            for (int j = 0; j < 4; ++j) { const f32x4 y = v[i][j] * gs[j]; u32x2 w; w.x = pk_h2(y.x, y.y); w.y = pk_h2(y.z, y.w); o8[64 * j] = w; }
        }
    }
}
__device__ __forceinline__ void phase_cvec(Frame& F, int l) {
    const int gw = F.vcu * NWAVES + F.wave, NGW = F.G * NWAVES, lane = F.lane;
    const float* mod_l = (const float*)(F.ws + WS_MOD) + (size_t)l * 3 * 6144;
    float* cv = (float*)(F.ws + WS_CV) + (size_t)l * 3 * (DIN + DUP);
    for (int kind = 0; kind < 2; ++kind) {
        const int N = kind == 0 ? DIN : DUP, sc = kind == 0 ? 0 : 3;
        const h16* Wt = (const h16*)(F.ws + WS_W + (kind == 0 ? W_IN : W_UP));
        float sh[3][16];
#pragma unroll
        for (int c = 0; c < 3; ++c)
#pragma unroll
            for (int j = 0; j < 2; ++j)
#pragma unroll
                for (int e = 0; e < 8; ++e) sh[c][8 * j + e] = mod_l[(size_t)c * 6144 + sc * 1024 + 8 * lane + 512 * j + e];
        for (int n0 = gw * 4; n0 < N; n0 += NGW * 4) {
            u32x4 raw[4][2];
#pragma unroll
            for (int i = 0; i < 4; ++i) { raw[i][0] = *(const u32x4*)(Wt + (size_t)(n0 + i) * DM + 8 * lane); raw[i][1] = *(const u32x4*)(Wt + (size_t)(n0 + i) * DM + 512 + 8 * lane); }
#pragma unroll
            for (int i = 0; i < 4; ++i) {
                float w[16]; unpack8(raw[i][0], w); unpack8(raw[i][1], w + 8);
                float a0 = 0.f, a1 = 0.f, a2 = 0.f;
#pragma unroll
                for (int e = 0; e < 16; ++e) { a0 += w[e] * sh[0][e]; a1 += w[e] * sh[1][e]; a2 += w[e] * sh[2][e]; }
                a0 = wave_sum(a0); a1 = wave_sum(a1); a2 = wave_sum(a2);
                if (lane == 0) { float* o = cv + (kind == 0 ? 0 : DIN) + n0 + i; o[0] = a0; o[DIN + DUP] = a1; o[2 * (DIN + DUP)] = a2; }
            }
        }
    }
}
__device__ __forceinline__ void phase_final_norm(Frame& F) {
    const int gw = F.vcu * NWAVES + F.wave, NGW = F.G * NWAVES;
    f32x4 gg[4];
#pragma unroll
    for (int j = 0; j < 4; ++j) gg[j] = *(const f32x4*)(F.inp(I_FING) + F.lane * 4 + 256 * j);
    for (int grp = gw; grp < NTOK / 4; grp += NGW) {
        const int row0 = grp * 4;
        f32x4 v[4][4];
#pragma unroll
        for (int i = 0; i < 4; ++i) { const f32x4* xr = (const f32x4*)(F.out + O_Y + (size_t)(row0 + i) * DM) + F.lane;
#pragma unroll
            for (int j = 0; j < 4; ++j) v[i][j] = xr[64 * j]; }
#pragma unroll
        for (int i = 0; i < 4; ++i) {
            float s = 0.f;
#pragma unroll
            for (int j = 0; j < 4; ++j) s += (v[i][j].x * v[i][j].x + v[i][j].y * v[i][j].y) + (v[i][j].z * v[i][j].z + v[i][j].w * v[i][j].w);
            const float rstd = 1.0f / sqrtf(wave_sum(s) * (1.0f / DM) + NORM_EPS);
            f32x4* xo = (f32x4*)(F.out + O_Y + (size_t)(row0 + i) * DM) + F.lane;
#pragma unroll
            for (int j = 0; j < 4; ++j) xo[64 * j] = v[i][j] * rstd * gg[j];
        }
    }
}

__device__ __forceinline__ void phase_qk(Frame& F, int l, bool write_out = true) {
    const int gw = F.vcu * NWAVES + F.wave, NGW = F.G * NWAVES, lane = F.lane;
    h16* Z = (h16*)(F.ws + WS_ZU);
    const float* rope = (const float*)(F.ws + WS_ROPE);
    const float* qg = F.inp(I_QNG) + l * 64; const float* kg = F.inp(I_KNG) + l * 64;
    const int hl = lane & 7, hc0 = hl * 8;
    float qgv[8], kgv[8];
#pragma unroll
    for (int j = 0; j < 8; ++j) { qgv[j] = qg[hc0 + j]; kgv[j] = kg[hc0 + j]; }
    for (int row = gw; row < NTOK; row += NGW) {
        const bool is_ctx = row < NCTX;
        int rpos = 0, cpos = 0, b = 0, t = 0;
        if (is_ctx) { b = row >> 8; t = row & 255; } else { const int tt = (row - NCTX) & (LSEQ - 1); rpos = tt >> 6; cpos = tt & 63; }
        h16* zr = Z + (size_t)row * NMAIN;
#pragma unroll
        for (int pass = 0; pass < 3; ++pass) {
            const int col = C_QB + pass * 512 + lane * 8;
            int kind;
            if (pass == 0) kind = 0; else if (pass == 1) kind = lane < 8 * 2 ? 1 : (lane < 8 * 4 ? 2 : 3); else kind = lane < 32 ? 3 : (lane < 48 ? 4 : 5);
            const u32x4 w = *(const u32x4*)(zr + col);
            float x[8]; unpack8(w, x);
            if (kind <= 1) {
                float s = 0.f;
#pragma unroll
                for (int j = 0; j < 8; ++j) s += x[j] * x[j];
                s = sum8(s);
                const float rstd = 1.0f / sqrtf(s * (1.0f / 64.0f) + NORM_EPS);
#pragma unroll
                for (int j = 0; j < 8; ++j) x[j] = x[j] * rstd * (kind == 0 ? qgv[j] : kgv[j]);
            }
            if (!is_ctx) {
                float p[8];
#pragma unroll
                for (int j = 0; j < 8; ++j) p[j] = __shfl_xor(x[j], 2);
                if (kind == 0 || kind == 1 || kind == 3 || kind == 4) {
                    const int half = hl >> 2, second = (hl >> 1) & 1, f0 = (hl & 1) * 8, pos = half ? cpos : rpos;
                    const float* tp = rope + ((size_t)pos * 16 + f0) * 2;
#pragma unroll
                    for (int j = 0; j < 8; ++j) { const float cs = tp[2 * j], sn = tp[2 * j + 1]; x[j] = second ? (p[j] * sn + x[j] * cs) : (x[j] * cs - p[j] * sn); }
                }
            }
            if (kind == 0 || kind == 3) {
#pragma unroll
                for (int j = 0; j < 8; ++j) x[j] *= QSCALE;
            }
            if (kind != 2 && kind != 5) *(u32x4*)(zr + col) = pack8(x);
            if (write_out && is_ctx && (kind == 1 || kind == 2 || kind == 4 || kind == 5)) {
                const size_t ob = kind == 1 ? O_KB : kind == 2 ? O_VB : kind == 4 ? O_KC : O_VC;
                const int c128 = (kind == 1 || kind == 2) ? (col - (kind == 1 ? C_KB : C_VB)) : (col - (kind == 4 ? C_KC : C_VC));
                float* op = F.out + ob + ((size_t)((b * 2 + l) * 256 + t)) * 128 + c128;
                *(f32x4*)op = (f32x4){x[0], x[1], x[2], x[3]}; *(f32x4*)(op + 4) = (f32x4){x[4], x[5], x[6], x[7]};
            }
        }
    }
}

__device__ __forceinline__ int img_off(int row, int ch) { return row * 256 + ((((ch >> 3) ^ (row & 15)) << 4) | ((ch & 7) << 1)); }
template <int MODE, int DIR>
__device__ __forceinline__ void lru_scan(Frame& F, int l, int row0, int n, int lat_b, int lat_chunk, int ctx_b, bool write_out, int cb) {
    LAS unsigned char* img = F.lds; LAS unsigned char* hx = F.lds + 65536;
    const int lane = F.lane, r32 = lane & 31, hi = lane >> 5, hm = hi ^ DIR;
    const int C = n * 128 + cb * 32 + r32;
    h16x8 Br[8], Bi[8];
    if (MODE != 3) {
        const h16* wr_ = (const h16*)(F.ws + WS_W + W_LRU) + ((size_t)((DIR * 2 + 0) * 8 + n) * 128 + cb * 32 + r32) * 128 + 8 * hi;
        const h16* wi_ = (const h16*)(F.ws + WS_W + W_LRU) + ((size_t)((DIR * 2 + 1) * 8 + n) * 128 + cb * 32 + r32) * 128 + 8 * hi;
#pragma unroll
        for (int ks = 0; ks < 8; ++ks) { Br[ks] = *(const h16x8*)(wr_ + 16 * ks); Bi[ks] = *(const h16x8*)(wi_ + 16 * ks); }
    }
    float k8 = 0.f, nba = 0.f, nbx = 0.f;
    if (MODE != 3) {
        const float ba = F.inp(I_LBA)[(size_t)(l * 2 + DIR) * DLRU + C], bx = F.inp(I_LBX)[(size_t)(l * 2 + DIR) * DLRU + C];
        const float lam = F.inp(I_LAM)[(size_t)(l * 2 + DIR) * DLRU + C];
        const float sp = (-lam > 20.f) ? -lam : log1pf(expf(-lam));
        k8 = -8.0f * sp * LOG2E;
        nba = -LOG2E * ba; nbx = -LOG2E * bx;
    }
    u32x4* stash_u = (u32x4*)(F.ws + WS_STASH) + (size_t)(((lat_b * 2 + DIR) * 16 + lat_chunk) * 8) * (DLRU * 2 * 4);
    const unsigned sl = (unsigned)((C * 2 + hi) * 4);
    unsigned nxt[16];
    if (MODE == 3) { const int rb0 = DIR == 0 ? 0 : 7;
#pragma unroll
        for (int q = 0; q < 4; ++q) { const u32x4 t = stash_u[(size_t)rb0 * (DLRU * 2 * 4) + sl + q]; nxt[4 * q] = t.x; nxt[4 * q + 1] = t.y; nxt[4 * q + 2] = t.z; nxt[4 * q + 3] = t.w; } }
    float H = 0.f, aggP = 1.f;
    if (MODE == 2 || MODE == 3) {
        const float* agg = (const float*)(F.ws + WS_AGG);
        H = F.inp(I_STATE)[(size_t)((lat_b * 2 + l) * 2 + DIR) * DLRU + C];
        float ap[15], au[15];
#pragma unroll
        for (int k = 0; k < 15; ++k) { const int ch = DIR == 0 ? k : 15 - k; const bool use = DIR == 0 ? (ch < lat_chunk) : (ch > lat_chunk);
            const float* p = agg + ((size_t)((lat_b * 16 + (use ? ch : 0)) * 2 + DIR) * DLRU + C) * 2; ap[k] = use ? p[0] : 1.f; au[k] = use ? p[1] : 0.f; }
#pragma unroll
        for (int k = 0; k < 15; ++k) H = ap[k] * H + au[k];
    }
    const int xch = cb * 4 + (r32 >> 3), xel = (r32 & 7) * 2;
    int lo8[8];
#pragma unroll
    for (int ci = 0; ci < 8; ++ci) { const int c = (ci & 3) + 8 * (ci >> 2); lo8[ci] = (((xch ^ (4 * hi)) ^ c) << 4) + xel + (4 * hi) * 256; }
#define LOFF(rn) (lo8s[((rn) & 3) + 4 * (((rn) >> 2) & 1)] + (8 * ((rn) >> 2) + ((rn) & 3)) * 256)
#pragma unroll 1
    for (int step = 0; step < 8; ++step) {
        if (step == 4) __syncthreads();
        const int rb = DIR == 0 ? step : 7 - step;
        int lo8s[8];
#pragma unroll
        for (int ci = 0; ci < 8; ++ci) lo8s[ci] = lo8[ci] + rb * 8192;
        float an[16], un[16];
        if (MODE == 3) {
#pragma unroll
            for (int r = 0; r < 16; ++r) { const h16x2 w = __builtin_bit_cast(h16x2, nxt[r]); an[r] = fast_exp2((float)w[0]); un[r] = (float)w[1]; }
            if (step < 7) { const int rbn = DIR == 0 ? step + 1 : 6 - step;
#pragma unroll
                for (int q = 0; q < 4; ++q) { const u32x4 t = stash_u[(size_t)rbn * (DLRU * 2 * 4) + sl + q]; nxt[4 * q] = t.x; nxt[4 * q + 1] = t.y; nxt[4 * q + 2] = t.z; nxt[4 * q + 3] = t.w; } }
        } else {
        unsigned sw[16];
        f32x16 ar = {}, ai = {};
#pragma unroll
        for (int ks = 0; ks < 8; ++ks) {
            const h16x8 af = *(const LAS h16x8*)(img + (rb * 32 + r32) * 256 + (((2 * ks + hi) ^ (r32 & 15)) << 4));
            ar = __builtin_amdgcn_mfma_f32_32x32x16_f16(af, Br[ks], ar, 0, 0, 0);
            ai = __builtin_amdgcn_mfma_f32_32x32x16_f16(af, Bi[ks], ai, 0, 0, 0);
        }
#pragma unroll
        for (int r = 0; r < 16; ++r) {
            const float xv = (float)*(const LAS h16*)(img + LOFF(r));
            const float d1 = 1.0f + fast_exp2(__builtin_fmaf(ar[r], -LOG2E, nba)), d2 = 1.0f + fast_exp2(__builtin_fmaf(ai[r], -LOG2E, nbx));
            const float R = fast_rcp(d1 * d2);
            const float rr = R * d2, ii = R * d1;
            const float e2 = k8 * rr;
            const float av = fast_exp2(e2);
            an[r] = av;
            un[r] = __builtin_amdgcn_sqrtf(__builtin_fmaf(-av, av, 1.0f)) * (ii * xv);
            if (MODE == 1) sw[r] = pk_h2(e2, un[r]);
        }
        if (MODE == 1) {
#pragma unroll
            for (int q = 0; q < 4; ++q) stash_u[(size_t)rb * (DLRU * 2 * 4) + sl + q] = (u32x4){sw[4 * q], sw[4 * q + 1], sw[4 * q + 2], sw[4 * q + 3]}; }
        }
#define SA(r) (DIR ? an[15 - (r)] : an[(r)])
#define SU(r) (DIR ? un[15 - (r)] : un[(r)])
        float Pe[4], Ue[4], Po[4], Uo[4];
#pragma unroll
        for (int g = 0; g < 4; ++g) {
            float p = 1.f, uu = 0.f;
#pragma unroll
            for (int i = 0; i < 4; ++i) { uu = SA(4 * g + i) * uu + SU(4 * g + i); p *= SA(4 * g + i); }
            const auto sp_ = __builtin_amdgcn_permlane32_swap(__float_as_uint(p), __float_as_uint(p), false, false);
            const auto su_ = __builtin_amdgcn_permlane32_swap(__float_as_uint(uu), __float_as_uint(uu), false, false);
            Pe[g] = __uint_as_float(sp_[DIR]); Po[g] = __uint_as_float(sp_[1 - DIR]); Ue[g] = __uint_as_float(su_[DIR]); Uo[g] = __uint_as_float(su_[1 - DIR]);
        }
        float Hs[4];
        {
            float h = H;
#pragma unroll
            for (int g = 0; g < 4; ++g) { const float he = h; h = Pe[g] * h + Ue[g]; const float ho = h; h = Po[g] * h + Uo[g]; Hs[g] = hm ? ho : he; }
            H = h;
        }
        if (MODE == 1) { float p = 1.f;
#pragma unroll
            for (int g = 0; g < 4; ++g) p *= Pe[g] * Po[g];
            aggP *= p; }
        if (MODE != 1) {
#pragma unroll
            for (int g = 0; g < 4; ++g) { float h = Hs[g];
                float old[4];
#pragma unroll
                for (int i = 0; i < 4; ++i) old[i] = (float)*(const LAS h16*)(hx + LOFF(DIR ? 15 - (4 * g + i) : (4 * g + i)));
#pragma unroll
                for (int i = 0; i < 4; ++i) { const int r = 4 * g + i; h = SA(r) * h + SU(r);
                    const float o = step < 4 ? 0.f : old[i];
                    *(LAS h16*)(hx + LOFF(DIR ? 15 - r : r)) = (h16)(h + o); } }
        }
#undef SA
#undef SU
    }
#undef LOFF
    if (MODE == 0 && hi == 0 && write_out) F.out[O_LRU + (size_t)((ctx_b * 2 + l) * 2 + DIR) * DLRU + C] = H;
    if (MODE == 1 && hi == 0) { float* agg = (float*)(F.ws + WS_AGG) + ((size_t)((lat_b * 16 + lat_chunk) * 2 + DIR) * DLRU + C) * 2; agg[0] = aggP; agg[1] = H; }
}
template <int MODE>
__device__ __forceinline__ void lru_unit(Frame& F, int l, int row0, int n, int seq_first, int seq_last, int lat_b, int lat_chunk, int ctx_b, bool write_out = true, int pv = 0) {
    LAS unsigned char* img = F.lds; LAS unsigned char* hx = F.lds + 65536;
    const h16* Z = (const h16*)(F.ws + WS_ZU);
    const int tid = F.tid;
    __syncthreads();
    if (MODE != 3 && !(pv & 1)) {
        const int cc = tid & 15, tg = tid >> 4; const int ch0 = n * 128 + cc * 8;
        float w0[8], w1[8], w2[8], w3[8], bb[8];
        const float* cw = F.inp(I_LCW) + (size_t)l * 4 * DLRU + ch0; const float* cb = F.inp(I_LCB) + (size_t)l * DLRU + ch0;
#pragma unroll
        for (int j = 0; j < 8; ++j) { w0[j] = cw[j]; w1[j] = cw[DLRU + j]; w2[j] = cw[2 * DLRU + j]; w3[j] = cw[3 * DLRU + j]; bb[j] = cb[j]; }
        const int t0 = tg * 8;
        u32x4 raw[11];
#pragma unroll
        for (int i = 0; i < 11; ++i) { const int t = t0 - 2 + i; const bool ok = (t >= 0 || !seq_first) && (t < 256 || !seq_last);
            const int tc = ok ? t : (t < 0 ? 0 : 255);
            const u32x4 v = *(const u32x4*)(Z + (size_t)(row0 + tc) * NMAIN + C_XA + ch0);
            raw[i].x = ok ? v.x : 0u; raw[i].y = ok ? v.y : 0u; raw[i].z = ok ? v.z : 0u; raw[i].w = ok ? v.w : 0u; }
        float xm2[8], xm1[8], x0[8], xp1[8];
        unpack8(raw[0], xm2); unpack8(raw[1], xm1); unpack8(raw[2], x0);
#pragma unroll
        for (int i = 0; i < 8; ++i) {
            unpack8(raw[3 + i], xp1);
            float y[8];
#pragma unroll
            for (int j = 0; j < 8; ++j) y[j] = bb[j] + w0[j] * xm2[j] + w1[j] * xm1[j] + w2[j] * x0[j] + w3[j] * xp1[j];
            *(LAS u32x4*)(img + img_off(t0 + i, cc * 8)) = pack8(y);
#pragma unroll
            for (int j = 0; j < 8; ++j) { xm2[j] = xm1[j]; xm1[j] = x0[j]; x0[j] = xp1[j]; }
        }
    }
    __syncthreads();
    const int dir = F.wave >> 2, cb = F.wave & 3;
    if (!(pv & 2)) {
    if (dir == 0) lru_scan<MODE, 0>(F, l, row0, n, lat_b, lat_chunk, ctx_b, write_out, cb);
    else          lru_scan<MODE, 1>(F, l, row0, n, lat_b, lat_chunk, ctx_b, write_out, cb);
    }
    if (MODE != 1 && !(pv & 4)) {
        __syncthreads();
        h16* OA = (h16*)(F.ws + WS_ZU + ZU_OA);
#pragma unroll
        for (int k = 0; k < 8; ++k) { const int i = tid + NTHREADS * k, tk = i >> 4, cc = i & 15;
            float hs[8], ya[8], o[8];
            unpack8(*(const LAS u32x4*)(hx + img_off(tk, cc * 8)), hs);
            unpack8(*(const u32x4*)(Z + (size_t)(row0 + tk) * NMAIN + C_YA + n * 128 + cc * 8), ya);
#pragma unroll
            for (int j = 0; j < 8; ++j) o[j] = hs[j] * gelu_tanh(ya[j]);
            *(u32x4*)(OA + (size_t)(row0 + tk) * 1024 + n * 128 + cc * 8) = pack8(o); }
    }
}

struct AttnDesc {
    const h16* Qz; h16* O;
    const h16* Kc; const h16* Vc;
    const h16* Kz; const h16* Vz;
    int nc, zt0, nz;
    int windowed;
    const float* sink;
    int kvh, q0;
};
__device__ __forceinline__ void attn_unit(Frame& F, const AttnDesc& D, const h16* Qrow0  , h16* Orow0  ) {
    LAS unsigned char* lds = F.lds;
    const int tid = F.tid, lane = F.lane, wave = F.wave, r32 = lane & 31, hi = lane >> 5;
    const int head = D.kvh * 4 + (wave >> 1);
    const int qpos = D.q0 + (wave & 1) * 32 + r32;
    const int NT = D.nc + D.nz;
    h16x8 qr[4];
    { const h16* qp = Qrow0 + (size_t)qpos * NMAIN + head * 64 + 8 * hi;
#pragma unroll
      for (int d0 = 0; d0 < 4; ++d0) qr[d0] = *(const h16x8*)(qp + 16 * d0); }
    const int krow = tid >> 3, kch = tid & 7; const int kdst = krow * 128 + ((kch ^ ((krow >> 1) & 7)) << 4);
    const int vrow = 16 * (wave & 3) + (lane >> 2), vcol = (wave >> 2) * 32 + (lane & 3) * 8; const int vdst = wave * 1024 + lane * 16;
    auto ktile_ptr = [&](int j, int row, int col, bool isV) -> const h16* {
        if (j < D.nc) return (isV ? D.Vc : D.Kc) + (size_t)(64 * j + row) * 128 + col;
        return (isV ? D.Vz : D.Kz) + (size_t)((D.zt0 + (j - D.nc)) * 64 + row) * NMAIN + col;
    };
    u32x4 kreg, vreg;
    kreg = *(const u32x4*)ktile_ptr(0, krow, kch * 8, false); vreg = *(const u32x4*)ktile_ptr(0, vrow, vcol, true);
    __syncthreads();
    *(LAS u32x4*)(lds + kdst) = kreg; *(LAS u32x4*)(lds + 16384 + vdst) = vreg;
    __syncthreads();
    float mhat, l_run;
    const bool has_sink = D.sink != nullptr;
    if (has_sink) { mhat = D.sink[head] * LOG2E; l_run = hi == 0 ? 1.f : 0.f; } else { mhat = 0.f; l_run = 0.f; }
    f32x16 negm;
#pragma unroll
    for (int r = 0; r < 16; ++r) negm[r] = -mhat;
    f32x16 o0 = {}, o1 = {};
    LAS float* wsf = (LAS float*)(lds + 32768) + wave * 64;
    const int kfoff = r32 * 128;
    const int ksw = (r32 >> 1) & 7;
    const int vp0 = ((lane >> 4) & 1) * 32 + (lane & 3) * 8 + (4 * hi + ((lane & 15) >> 2)) * 64;
#pragma unroll 1
    for (int j = 0; j < NT; ++j) {
        const int buf = j & 1;
        if (j + 1 < NT) { kreg = *(const u32x4*)ktile_ptr(j + 1, krow, kch * 8, false); vreg = *(const u32x4*)ktile_ptr(j + 1, vrow, vcol, true); }
        LAS unsigned char* Kb = lds + buf * 8192; LAS unsigned char* Vb = lds + 16384 + buf * 8192;
        f32x16 p0, p1;
#pragma unroll
        for (int d0 = 0; d0 < 4; ++d0) {
            const int co = ((2 * d0 + hi) ^ ksw) << 4;
            const h16x8 k0 = *(const LAS h16x8*)(Kb + kfoff + co);
            const h16x8 k1 = *(const LAS h16x8*)(Kb + 4096 + kfoff + co);
            p0 = __builtin_amdgcn_mfma_f32_32x32x16_f16(k0, qr[d0], d0 == 0 ? negm : p0, 0, 0, 0);
            p1 = __builtin_amdgcn_mfma_f32_32x32x16_f16(k1, qr[d0], d0 == 0 ? negm : p1, 0, 0, 0);
        }
        if (D.windowed && j >= D.nc) {
            const int kb0 = (D.zt0 + (j - D.nc)) * 64 + 4 * hi;
#pragma unroll
            for (int r = 0; r < 16; ++r) { const int kp = kb0 + (r & 3) + 8 * (r >> 2);
                const int d0_ = qpos - kp, d1_ = qpos - (kp + 32);
                if (d0_ > 128 || d0_ < -128) p0[r] = -1e30f;
                if (d1_ > 128 || d1_ < -128) p1[r] = -1e30f; }
        }
        if (j == 0) {
            float mx = fmaxf(p0[0], p1[0]);
#pragma unroll
            for (int r = 1; r < 16; ++r) mx = fmaxf(mx, fmaxf(p0[r], p1[r]));
            mx = fmaxf(mx, __shfl_xor(mx, 32));
            const float dl = has_sink ? fmaxf(mx, 0.f) : mx;
#pragma unroll
            for (int r = 0; r < 16; ++r) { p0[r] -= dl; p1[r] -= dl; }
            mhat += dl; if (has_sink) l_run *= fast_exp2(-dl);
#pragma unroll
            for (int r = 0; r < 16; ++r) negm[r] = -mhat;
        }
        float rs = 0.f;
#pragma unroll
        for (int r = 0; r < 16; ++r) { p0[r] = fast_exp2(p0[r]); p1[r] = fast_exp2(p1[r]); rs += p0[r] + p1[r]; }
        if (__builtin_expect(__any(rs > 256.f), 0)) {
            const float rsm = fmaxf(rs, __shfl_xor(rs, 32));
            const float dl = rsm > 256.f ? ceilf(__builtin_log2f(rsm)) : 0.f;
            const float f = fast_exp2(-dl);
#pragma unroll
            for (int r = 0; r < 16; ++r) { p0[r] *= f; p1[r] *= f; }
            rs *= f; l_run *= f; mhat += dl;
#pragma unroll
            for (int r = 0; r < 16; ++r) negm[r] = -mhat;
            if (hi == 0) wsf[r32] = f;
            LDS_WAIT();
#pragma unroll
            for (int r = 0; r < 16; ++r) { const float g = wsf[(r & 3) + 8 * (r >> 2) + 4 * hi]; o0[r] *= g; o1[r] *= g; }
        }
        l_run += rs;
        u32x4 pw[4];
        pw[0] = (u32x4){pk_h2(p0[0], p0[1]), pk_h2(p0[2], p0[3]), pk_h2(p0[4], p0[5]), pk_h2(p0[6], p0[7])};
        pw[1] = (u32x4){pk_h2(p0[8], p0[9]), pk_h2(p0[10], p0[11]), pk_h2(p0[12], p0[13]), pk_h2(p0[14], p0[15])};
        pw[2] = (u32x4){pk_h2(p1[0], p1[1]), pk_h2(p1[2], p1[3]), pk_h2(p1[4], p1[5]), pk_h2(p1[6], p1[7])};
        pw[3] = (u32x4){pk_h2(p1[8], p1[9]), pk_h2(p1[10], p1[11]), pk_h2(p1[12], p1[13]), pk_h2(p1[14], p1[15])};
#pragma unroll
        for (int ks = 0; ks < 4; ++ks) {
            const h16x8 pa = __builtin_bit_cast(h16x8, pw[ks]);
#pragma unroll
            for (int d0 = 0; d0 < 2; ++d0) {
                const s16x4 lo = __builtin_amdgcn_ds_read_tr16_b64_v4i16((LAS s16x4*)(Vb + vp0 + d0 * 4096 + ks * 1024));
                const s16x4 hh = __builtin_amdgcn_ds_read_tr16_b64_v4i16((LAS s16x4*)(Vb + vp0 + d0 * 4096 + ks * 1024 + 512));
                typedef short s16x8 __attribute__((ext_vector_type(8)));
                const s16x8 vv = {lo[0], lo[1], lo[2], lo[3], hh[0], hh[1], hh[2], hh[3]};
                const h16x8 vf = __builtin_bit_cast(h16x8, vv);
                if (d0 == 0) o0 = __builtin_amdgcn_mfma_f32_32x32x16_f16(pa, vf, o0, 0, 0, 0);
                else         o1 = __builtin_amdgcn_mfma_f32_32x32x16_f16(pa, vf, o1, 0, 0, 0);
            }
        }
        if (j + 1 < NT) { *(LAS u32x4*)(lds + (buf ^ 1) * 8192 + kdst) = kreg; *(LAS u32x4*)(lds + 16384 + (buf ^ 1) * 8192 + vdst) = vreg; }
        __syncthreads();
    }
    l_run += __shfl_xor(l_run, 32);
    if (hi == 0) wsf[32 + r32] = l_run;
    LDS_WAIT();
    h16* op = Orow0 + (size_t)(D.q0 + (wave & 1) * 32) * 512 + head * 64 + r32;
#pragma unroll
    for (int r = 0; r < 16; ++r) { const int q = (r & 3) + 8 * (r >> 2) + 4 * hi; const float rl = fast_rcp(wsf[32 + q]);
        op[(size_t)q * 512] = (h16)(o0[r] * rl); op[(size_t)q * 512 + 32] = (h16)(o1[r] * rl); }
}
__device__ __forceinline__ void attn_dispatch(Frame& F, int l, int type, int u) {
    const h16* Z = (const h16*)(F.ws + WS_ZU);
    const h16* cache = (const h16*)(F.ws + WS_CACHE);
    AttnDesc D; D.sink = nullptr; D.windowed = 0; D.Kc = nullptr; D.Vc = nullptr; D.nc = 0;
    const bool isC = type & 1;
    const int qcol = isC ? C_QC : C_QB, kcol = isC ? C_KC : C_KB, vcol = isC ? C_VC : C_VB;
    h16* Obase = (h16*)(F.ws + WS_ZU + (isC ? ZU_OC : ZU_OB));
    size_t row_seq0;
    if (type < 2) {
        const int b = u >> 7, kvh = (u >> 6) & 1, qb = u & 63;
        row_seq0 = (size_t)NCTX + (size_t)b * LSEQ; D.kvh = kvh; D.q0 = qb * 64;
        D.Kc = cache + ((size_t)(isC ? 2 : 0) * 131072) + (size_t)((b * 2 + l) * 256) * 128 + kvh * 64;
        D.Vc = cache + ((size_t)(isC ? 3 : 1) * 131072) + (size_t)((b * 2 + l) * 256) * 128 + kvh * 64;
        D.nc = 4;
        if (!isC) { D.zt0 = 0; D.nz = 64; }
        else { int lo = qb - 2; if (lo < 0) lo = 0; int hi_ = qb + 2; if (hi_ > 63) hi_ = 63; D.zt0 = lo; D.nz = hi_ - lo + 1; D.windowed = 1; }
    } else {
        const int b = u >> 3, kvh = (u >> 2) & 1, qb = u & 3;
        row_seq0 = (size_t)b * SEQ; D.kvh = kvh; D.q0 = qb * 64; D.zt0 = 0; D.nz = 4;
    }
    if (isC) D.sink = F.inp(I_SINK) + l * 8;
    D.Kz = Z + row_seq0 * NMAIN + kcol + D.kvh * 64; D.Vz = Z + row_seq0 * NMAIN + vcol + D.kvh * 64;
    attn_unit(F, D, Z + row_seq0 * NMAIN + qcol, Obase + row_seq0 * 512);
}

__device__ __forceinline__ void phase_ffn_act(Frame& F, int l) {
    h16* U = (h16*)(F.ws + WS_ZU);
    const int gt = F.vcu * NTHREADS + F.tid, NGT = F.G * NTHREADS;
    constexpr int NCC = DFF / 8, RUN = 16, NRUN = NTOK / RUN;
    for (int it = gt; it < NCC * NRUN; it += NGT) {
        const int cc = it % NCC, run = it / NCC; const int c0 = cc * 8, r0 = run * RUN;
        const bool first = (r0 < NCTX) ? ((r0 & 255) == 0) : (((r0 - NCTX) & (LSEQ - 1)) == 0);
        const bool last = (r0 < NCTX) ? (((r0 + RUN) & 255) == 0) : ((((r0 + RUN) - NCTX) & (LSEQ - 1)) == 0);
        float w0[8], w1[8], w2[8], bb[8];
        const float* cw = F.inp(I_FCW) + (size_t)l * 3 * DFF + c0; const float* cb = F.inp(I_FCB) + (size_t)l * DFF + c0;
#pragma unroll
        for (int j = 0; j < 8; ++j) { w0[j] = cw[j]; w1[j] = cw[DFF + j]; w2[j] = cw[2 * DFF + j]; bb[j] = cb[j]; }
        u32x4 gr[RUN + 2], vr[RUN];
#pragma unroll
        for (int i = 0; i < RUN + 2; ++i) { const int r = r0 - 1 + i; const bool ok = !((i == 0 && first) || (i == RUN + 1 && last));
            const int rc = ok ? r : r0; const u32x4 v = *(const u32x4*)(U + (size_t)rc * DUP + c0);
            gr[i].x = ok ? v.x : 0u; gr[i].y = ok ? v.y : 0u; gr[i].z = ok ? v.z : 0u; gr[i].w = ok ? v.w : 0u; }
#pragma unroll
        for (int i = 0; i < RUN; ++i) vr[i] = *(const u32x4*)(U + (size_t)(r0 + i) * DUP + DFF + c0);
        float gp[8], gc[8], gn[8];
        unpack8(gr[0], gp); unpack8(gr[1], gc);
#pragma unroll
        for (int i = 0; i < RUN; ++i) {
            unpack8(gr[i + 2], gn);
            float v[8]; unpack8(vr[i], v);
            float o[8];
#pragma unroll
            for (int j = 0; j < 8; ++j) { const float g = bb[j] + w0[j] * gp[j] + w1[j] * gc[j] + w2[j] * gn[j]; o[j] = gelu_tanh(g) * v[j]; gp[j] = gc[j]; gc[j] = gn[j]; }
            *(u32x4*)(U + (size_t)(r0 + i) * DUP + DFF + c0) = pack8(o);
        }
    }
}

__device__ __forceinline__ void phase_act_fixup(Frame& F, int l) {
    h16* ACT = (h16*)(F.ws + WS_ZU);
    const float* edge = (const float*)(F.ws + WS_EDGE);
    const float* cw = F.inp(I_FCW) + (size_t)l * 3 * DFF;
    const int gt = F.vcu * NTHREADS + F.tid, NGT = F.G * NTHREADS;
    constexpr int NC8 = DFF / 8;
    for (int it = gt; it < 64 * 8 * NC8; it += NGT) {
        const int ch = (it % NC8) * 8, ri = it / NC8, pm = ri >> 3, idx = ri & 7, b = idx >> 1, last = idx & 1;
        const int row = pm * 256 + b * 64 + (last ? 63 : 0);
        const int nrow = last ? row + 1 : row - 1;
        const bool seq_edge = (row < NCTX) ? (last ? ((row & 255) == 255) : ((row & 255) == 0)) : (last ? (((row - NCTX) & (LSEQ - 1)) == LSEQ - 1) : (((row - NCTX) & (LSEQ - 1)) == 0));
        const int nr = seq_edge ? row : nrow;
        const int npm = nr >> 8, nb = (nr >> 6) & 3;
        const float* gp = edge + ((size_t)(npm * 8 + 2 * nb + (last ? 0 : 1)) * 3) * DFF + ch;
        const float* ep = edge + ((size_t)(pm * 8 + idx) * 3) * DFF + ch;
        const float* wp = cw + (last ? 2 : 0) * DFF + ch;
        f32x4 g0 = *(const f32x4*)gp, g1 = *(const f32x4*)(gp + 4), p0 = *(const f32x4*)(ep + DFF), p1 = *(const f32x4*)(ep + DFF + 4);
        const f32x4 v0 = *(const f32x4*)(ep + 2 * DFF), v1 = *(const f32x4*)(ep + 2 * DFF + 4), w0 = *(const f32x4*)wp, w1 = *(const f32x4*)(wp + 4);
        const float nz = seq_edge ? 0.f : 1.f;
        p0 = p0 + w0 * g0 * nz; p1 = p1 + w1 * g1 * nz;
        float o[8];
#pragma unroll
        for (int j = 0; j < 4; ++j) { o[j] = gelu_tanh(p0[j]) * v0[j]; o[4 + j] = gelu_tanh(p1[j]) * v1[j]; }
        *(u32x4*)(ACT + (size_t)row * DFF + ch) = pack8(o);
    }
}

constexpr int N_PHASES = 25;
__global__ void __launch_bounds__(NTHREADS, 2) fwd_kernel(Args args) {
    extern __shared__ __attribute__((aligned(16))) unsigned char lds_raw[];
    Frame F;
    F.lds = (LAS unsigned char*)lds_raw;
    F.tid = threadIdx.x; F.lane = F.tid & 63; F.wave = __builtin_amdgcn_readfirstlane(F.tid >> 6);
    F.G = gridDim.x; { const int bx = blockIdx.x; F.vcu = (F.G % 8 == 0) ? (bx % 8) * (F.G / 8) + bx / 8 : bx; }
    F.out0 = args.out; F.ws0 = args.ws; F.refresh();
    volatile LAS unsigned* MISC = (volatile LAS unsigned*)(F.lds + MISC_OFF);
    for (int u = F.tid; u < (LDS_BYTES - LDSCTL_OFF) / 4; u += NTHREADS) ((LAS unsigned*)(F.lds + LDSCTL_OFF))[u] = 0u;
    __syncthreads();
#if !MK_PER_PHASE
    XcdBarrier bar = xcd_barrier_post((unsigned*)(F.ws + WS_CTL) + CW_BAR, MISC + 8);
#define GRID_BAR() xcd_barrier(bar)
#else
    (void)MISC;
#define GRID_BAR() do { } while (0)
#endif
    const int lo = args.ph_lo, hi_ph = args.ph_hi;
#if defined(TIME_PH)
#ifndef TIME_AMP
#define TIME_AMP 8
#endif
    unsigned long long t_acc = 0, t_0 = 0;
#define TSTART(k) do { TSL_PHASE(F.lds, (k)); if ((k) == TIME_PH) t_0 = __builtin_amdgcn_s_memrealtime(); } while (0)
#define TSTOP(k) do { if ((k) == TIME_PH) t_acc += __builtin_amdgcn_s_memrealtime() - t_0; } while (0)
#else
#define TSTART(k) do { TSL_PHASE(F.lds, (k)); } while (0)
#define TSTOP(k) do { } while (0)
#endif
#define IN(k) (lo <= (k) && (k) < hi_ph)
#define SEAM(k) do { if (IN((k) + 1)) GRID_BAR(); } while (0)
#pragma unroll
    for (int l = 0; l < DEPTH; ++l) {
        const int pb = 12 * l;
        if (IN(pb + 0)) { TSTART(0); F.refresh(); phase_convert_weights(F, l); if (l == 0) phase_prep_misc(F); SEAM(pb + 0); TSTOP(0); }
        if (IN(pb + 1)) { TSTART(1); F.refresh();
            if (l == 0) phase_norm0(F, F.inp(I_N1G), (const float*)(F.ws + WS_MOD), (float*)(F.ws + WS_SS));
            phase_cvec(F, l);
            SEAM(pb + 1); TSTOP(1); }
        if (IN(pb + 2)) { TSTART(2); F.refresh();
            pg8::Gemm g{(const h16*)(F.ws + WS_H), (const h16*)(F.ws + WS_W + W_IN), NTOK, NMAIN, DM, DM}; pg8::StaticOrder S; S.init(NTOK, NMAIN, F.G, (int)blockIdx.x);
            pg8::EpiF16<0> E{(h16*)(F.ws + WS_ZU), NMAIN, (const float*)(F.ws + WS_SS) + (size_t)(2 * l) * NTOK, (const float*)(F.ws + WS_CV) + (size_t)l * 3 * (DIN + DUP), DIN + DUP};
            pg8::gemm_phase<pg8::EpiF16<0>, pg8::StaticOrder, true, true>(F.lds, g, S, E);
            SEAM(pb + 2); TSTOP(2); }
        if (IN(pb + 3)) { TSTART(3); F.refresh();
            phase_qk(F, l);
            for (int u = F.vcu; u < 512; u += F.G) {
                if (u < 256) lru_unit<0>(F, l, (u >> 3) * 256, u & 7, 1, 1, 0, 0, u >> 3);
                else { const int v = u - 256, b = v >> 7, ch = (v >> 3) & 15; lru_unit<1>(F, l, NCTX + b * LSEQ + ch * 256, v & 7, ch == 0, ch == 15, b, ch, 0); }
            }
            SEAM(pb + 3); TSTOP(3); }
        if (IN(pb + 4)) { TSTART(4); F.refresh();
            for (int type = 0; type < 4; ++type) { TSL_START(F.lds, 20 + type); for (int u = F.vcu; u < 256; u += F.G) attn_dispatch(F, l, type, u); TSL_STOP(F.lds, 20 + type); }
            TSL_START(F.lds, 24);
            for (int v = F.vcu; v < 256; v += F.G) { const int b = v >> 7, ch = (v >> 3) & 15; lru_unit<3>(F, l, NCTX + b * LSEQ + ch * 256, v & 7, ch == 0, ch == 15, b, ch, 0); }
            TSL_STOP(F.lds, 24);
            SEAM(pb + 4); TSTOP(4); }
        if (IN(pb + 5)) { TSTART(5); F.refresh();
            pg8::Gemm g{(const h16*)(F.ws + WS_H), (const h16*)(F.ws + WS_W + W_IN) + (size_t)NMAIN * DM, NTOK, NGATE, DM, DM}; pg8::StaticOrder S; S.init(NTOK, NGATE, F.G, (int)blockIdx.x);
            pg8::EpiF16<1> E{(h16*)(F.ws + WS_ZU), NGATE, (const float*)(F.ws + WS_SS) + (size_t)(2 * l) * NTOK, (const float*)(F.ws + WS_CV) + (size_t)l * 3 * (DIN + DUP) + NMAIN, DIN + DUP};
            pg8::gemm_phase<pg8::EpiF16<1>, pg8::StaticOrder, true, true>(F.lds, g, S, E);
            SEAM(pb + 5); TSTOP(5); }
        if (IN(pb + 6)) { TSTART(6); F.refresh();
            pg8::StaticOrder S; S.init(NTOK, DM, F.G, (int)blockIdx.x);
            h16* Hb = (h16*)(F.ws + WS_H); const h16* Gb = (const h16*)(F.ws + WS_ZU);
            { pg8::Gemm g{(const h16*)(F.ws + WS_ZU + ZU_OA), (const h16*)(F.ws + WS_W + W_OA), NTOK, DM, 1024, 1024}; pg8::EpiGateMul<0> E{Hb, Gb, 0};
              pg8::gemm_phase<pg8::EpiGateMul<0>, pg8::StaticOrder, true, true>(F.lds, g, S, E); }
            { pg8::Gemm g{(const h16*)(F.ws + WS_ZU + ZU_OB), (const h16*)(F.ws + WS_W + W_OB), NTOK, DM, 512, 512}; pg8::EpiGateMul<1> E{Hb, Gb, 1024};
              pg8::gemm_phase<pg8::EpiGateMul<1>, pg8::StaticOrder, true, true>(F.lds, g, S, E); }
            { pg8::Gemm g{(const h16*)(F.ws + WS_ZU + ZU_OC), (const h16*)(F.ws + WS_W + W_OC), NTOK, DM, 512, 512}; pg8::EpiGateMul<1> E{Hb, Gb, 2048};
              pg8::gemm_phase<pg8::EpiGateMul<1>, pg8::StaticOrder, true, true>(F.lds, g, S, E); }
            SEAM(pb + 6); TSTOP(6); }
        if (IN(pb + 7)) { TSTART(7); F.refresh();
            pg8::Gemm g{(const h16*)(F.ws + WS_H), (const h16*)(F.ws + WS_W + W_OUT), NTOK, DM, DM, DM}; pg8::StaticOrder S; S.init(NTOK, DM, F.G, (int)blockIdx.x);
            pg8::EpiRes E{l == 0 ? F.inp(I_XP) : F.out + O_Y, l == 0 ? F.inp(I_XS) : F.out + O_Y + (size_t)NCTX * DM, F.out + O_Y, (const float*)(F.ws + WS_MOD) + (size_t)l * 3 * 6144 + 2 * 1024,
                          (h16*)(F.ws + WS_H2), F.inp(I_N2G) + l * DM, (const float*)(F.ws + WS_MOD) + (size_t)l * 3 * 6144 + 4 * 1024, (float*)(F.ws + WS_SS) + (size_t)(2 * l + 1) * NTOK, F.lds + EPI_SCR_OFF};
            pg8::gemm_phase<pg8::EpiRes, pg8::StaticOrder, true, true>(F.lds, g, S, E);
            SEAM(pb + 7); TSTOP(7); }
        if (IN(pb + 9)) { TSTART(9); F.refresh();
            pg8::Gemm g{(const h16*)(F.ws + WS_H2), (const h16*)(F.ws + WS_W + W_UP), NTOK, DUP, DM, DM}; pg8::StaticOrder S; S.init(NTOK, DUP, F.G, (int)blockIdx.x);
            pg8::EpiAct E{(h16*)(F.ws + WS_ZU), (const float*)(F.ws + WS_SS) + (size_t)(2 * l + 1) * NTOK, (const float*)(F.ws + WS_CV) + (size_t)l * 3 * (DIN + DUP) + DIN, DIN + DUP,
                          F.inp(I_FCW) + (size_t)l * 3 * DFF, F.inp(I_FCB) + (size_t)l * DFF, (float*)(F.ws + WS_EDGE)};
            pg8::gemm_phase<pg8::EpiAct, pg8::StaticOrder, true, true>(F.lds, g, S, E);
            SEAM(pb + 9); TSTOP(9); }
        if (IN(pb + 10)) { TSTART(10); F.refresh(); phase_act_fixup(F, l); SEAM(pb + 10); TSTOP(10); }
        if (IN(pb + 11)) { TSTART(11); F.refresh();
            pg8::Gemm g{(const h16*)(F.ws + WS_ZU), (const h16*)(F.ws + WS_W + W_DOWN), NTOK, DM, DFF, DFF}; pg8::StaticOrder S; S.init(NTOK, DM, F.G, (int)blockIdx.x);
            const bool nx = l + 1 < DEPTH;
            pg8::EpiRes E{F.out + O_Y, F.out + O_Y + (size_t)NCTX * DM, F.out + O_Y, (const float*)(F.ws + WS_MOD) + (size_t)l * 3 * 6144 + 5 * 1024,
                          nx ? (h16*)(F.ws + WS_H) : (h16*)nullptr, F.inp(I_N1G) + (nx ? l + 1 : l) * DM, (const float*)(F.ws + WS_MOD) + (size_t)(nx ? l + 1 : l) * 3 * 6144 + 1 * 1024,
                          nx ? (float*)(F.ws + WS_SS) + (size_t)(2 * (l + 1)) * NTOK : (float*)nullptr, F.lds + EPI_SCR_OFF};
            pg8::gemm_phase<pg8::EpiRes, pg8::StaticOrder, true, true>(F.lds, g, S, E);
            SEAM(pb + 11); TSTOP(11); }
    }
    if (IN(24)) { TSTART(12); F.refresh(); phase_final_norm(F); TSTOP(12); }
#if defined(TIME_SUB)
    if (blockIdx.x == 0 && threadIdx.x == 0) { const unsigned long long ta = *(volatile LAS unsigned long long*)(F.lds + MISC_OFF + 64); const unsigned long long t1 = __builtin_amdgcn_s_memrealtime(); while (__builtin_amdgcn_s_memrealtime() - t1 < 8ull * ta) __builtin_amdgcn_s_sleep(8); }
#endif
#if defined(TIME_PH)
    if (blockIdx.x == 0 && threadIdx.x == 0) { const unsigned long long t1 = __builtin_amdgcn_s_memrealtime(); while (__builtin_amdgcn_s_memrealtime() - t1 < (unsigned long long)TIME_AMP * t_acc) __builtin_amdgcn_s_sleep(8); }
#endif
#if defined(PROBE_PH)
#ifndef PROBE_N
#define PROBE_N 4
#endif
#ifndef PROBE_SUB
#define PROBE_SUB 0xFF
#endif
#ifndef PROBE_VAR
#define PROBE_VAR 0
#endif
    if (IN(24)) {
        const int l = 1;
        for (int rep = 0; rep < PROBE_N; ++rep) {
            GRID_BAR(); F.refresh();
            if (PROBE_PH == 0) { phase_convert_weights(F, l); }
            if (PROBE_PH == 12) { phase_prep_misc(F); }
            if (PROBE_PH == 1) { phase_norm_mod(F, 0, F.inp(I_N1G) + l * DM, (const float*)(F.ws + WS_MOD) + (size_t)l * 3 * 6144, 0); }
            if (PROBE_PH == 2) { pg8::Gemm g{(const h16*)(F.ws + WS_H), (const h16*)(F.ws + WS_W + W_IN), NTOK, NMAIN, DM, DM}; pg8::StaticOrder S; S.init(NTOK, NMAIN, F.G, (int)blockIdx.x);
                pg8::EpiF16<0> E{(h16*)(F.ws + WS_ZU), NMAIN}; pg8::gemm_phase<pg8::EpiF16<0>, pg8::StaticOrder, true, true>(F.lds, g, S, E); }
            if (PROBE_PH == 3) {
                if (PROBE_SUB & 1) phase_qk(F, l, false);
                for (int u = F.vcu; u < 512; u += F.G) {
                    if (u < 256) { if (PROBE_SUB & 2) lru_unit<0>(F, l, (u >> 3) * 256, u & 7, 1, 1, 0, 0, u >> 3, false); }
                    else if (PROBE_SUB & 4) { const int v = u - 256, b = v >> 7, ch = (v >> 3) & 15; lru_unit<1>(F, l, NCTX + b * LSEQ + ch * 256, v & 7, ch == 0, ch == 15, b, ch, 0); }
                } }
            if (PROBE_PH == 4) {
                for (int type = 0; type < 4; ++type) if ((PROBE_SUB >> type) & 1) for (int u = F.vcu; u < 256; u += F.G) attn_dispatch(F, l, type, u);
                if (PROBE_SUB & 16) for (int v = F.vcu; v < 256; v += F.G) { const int b = v >> 7, ch = (v >> 3) & 15; lru_unit<2>(F, l, NCTX + b * LSEQ + ch * 256, v & 7, ch == 0, ch == 15, b, ch, 0, true, PROBE_VAR); } }
            if (PROBE_PH == 5) { pg8::Gemm g{(const h16*)(F.ws + WS_H), (const h16*)(F.ws + WS_W + W_IN) + (size_t)NMAIN * DM, NTOK, NGATE, DM, DM}; pg8::StaticOrder S; S.init(NTOK, NGATE, F.G, (int)blockIdx.x);
                pg8::EpiF16<1> E{(h16*)(F.ws + WS_ZU), NGATE}; pg8::gemm_phase<pg8::EpiF16<1>, pg8::StaticOrder, true, true>(F.lds, g, S, E); }
            if (PROBE_PH == 6) { pg8::StaticOrder S; S.init(NTOK, DM, F.G, (int)blockIdx.x);
                h16* Hb = (h16*)(F.ws + WS_H); const h16* Gb = (const h16*)(F.ws + WS_ZU);
                { pg8::Gemm g{(const h16*)(F.ws + WS_ZU + ZU_OA), (const h16*)(F.ws + WS_W + W_OA), NTOK, DM, 1024, 1024}; pg8::EpiGateMul<0> E{Hb, Gb, 0};
                  pg8::gemm_phase<pg8::EpiGateMul<0>, pg8::StaticOrder, true, true>(F.lds, g, S, E); }
                { pg8::Gemm g{(const h16*)(F.ws + WS_ZU + ZU_OB), (const h16*)(F.ws + WS_W + W_OB), NTOK, DM, 512, 512}; pg8::EpiGateMul<1> E{Hb, Gb, 1024};
                  pg8::gemm_phase<pg8::EpiGateMul<1>, pg8::StaticOrder, true, true>(F.lds, g, S, E); }
                { pg8::Gemm g{(const h16*)(F.ws + WS_ZU + ZU_OC), (const h16*)(F.ws + WS_W + W_OC), NTOK, DM, 512, 512}; pg8::EpiGateMul<1> E{Hb, Gb, 2048};
                  pg8::gemm_phase<pg8::EpiGateMul<1>, pg8::StaticOrder, true, true>(F.lds, g, S, E); } }
            if (PROBE_PH == 7) { pg8::Gemm g{(const h16*)(F.ws + WS_H), (const h16*)(F.ws + WS_W + W_OUT), NTOK, DM, DM, DM}; pg8::StaticOrder S; S.init(NTOK, DM, F.G, (int)blockIdx.x);
                pg8::EpiRes E{F.out + O_Y, F.out + O_Y + (size_t)NCTX * DM, (float*)(F.ws + WS_ZU), (const float*)(F.ws + WS_MOD) + (size_t)l * 3 * 6144 + 2 * 1024, nullptr, nullptr, nullptr, nullptr, F.lds + EPI_SCR_OFF};
                pg8::gemm_phase<pg8::EpiRes, pg8::StaticOrder, true, true>(F.lds, g, S, E); }
            if (PROBE_PH == 9) { pg8::Gemm g{(const h16*)(F.ws + WS_H), (const h16*)(F.ws + WS_W + W_UP), NTOK, DUP, DM, DM}; pg8::StaticOrder S; S.init(NTOK, DUP, F.G, (int)blockIdx.x);
                pg8::EpiF16<0> E{(h16*)(F.ws + WS_ZU), DUP}; pg8::gemm_phase<pg8::EpiF16<0>, pg8::StaticOrder, true, true>(F.lds, g, S, E); }
            if (PROBE_PH == 10) { phase_ffn_act(F, l); }
            if (PROBE_PH == 11) { pg8::Gemm g{(const h16*)(F.ws + WS_ZU) + DFF, (const h16*)(F.ws + WS_W + W_DOWN), NTOK, DM, DFF, DUP}; pg8::StaticOrder S; S.init(NTOK, DM, F.G, (int)blockIdx.x);
                pg8::EpiRes E{F.out + O_Y, F.out + O_Y + (size_t)NCTX * DM, (float*)(F.ws + WS_H), (const float*)(F.ws + WS_MOD) + (size_t)l * 3 * 6144 + 5 * 1024, nullptr, nullptr, nullptr, nullptr, F.lds + EPI_SCR_OFF};
                pg8::gemm_phase<pg8::EpiRes, pg8::StaticOrder, true, true>(F.lds, g, S, E); }
            if (PROBE_PH == 13) { }
        }
    }
#endif
#undef IN
#undef SEAM
}

extern "C" void kernel_launch(void* const* d_in, const int* in_sizes, int n_in, void* d_out, int out_size, void* d_ws, size_t ws_size, hipStream_t stream) {
    static int grid = 0;
    if (grid == 0) {
        if (n_in != 33 || out_size != (int)O_END || ws_size < WS_END) { fprintf(stderr, "kernel_launch: unexpected shapes: n_in %d out %d ws %zu (need %zu)\n", n_in, out_size, ws_size, (size_t)WS_END); grid = -1; return; }
        int dev = 0, cus = 0;
        if (hipGetDevice(&dev) != hipSuccess || hipDeviceGetAttribute(&cus, hipDeviceAttributeMultiprocessorCount, dev) != hipSuccess) { grid = -1; return; }
        if (hipFuncSetAttribute((const void*)fwd_kernel, hipFuncAttributeMaxDynamicSharedMemorySize, LDS_BYTES) != hipSuccess) { fprintf(stderr, "kernel_launch: hipFuncSetAttribute failed\n"); grid = -1; return; }
        (void)hipGetLastError();
        grid = cus;
    }
    if (grid < 0) return;
    (void)hipMemsetAsync((char*)d_ws + WS_CTL, 0, CTL_ZERO_BYTES, stream);
    Args a{};
    for (int i = 0; i < 33; ++i) a.in[i] = (const float*)d_in[i];
    a.out = (float*)d_out; a.ws = (unsigned char*)d_ws;
#if MK_PER_PHASE
    for (int ph = 0; ph < N_PHASES; ++ph) { a.ph_lo = ph; a.ph_hi = ph + 1; hipLaunchKernelGGL(fwd_kernel, dim3(grid), dim3(NTHREADS), LDS_BYTES, stream, a); }
#else
    a.ph_lo = 0; a.ph_hi = N_PHASES;
    hipLaunchKernelGGL(fwd_kernel, dim3(grid), dim3(NTHREADS), LDS_BYTES, stream, a);
#endif
}
```

```cpp
#include <hip/hip_runtime.h>
#include <cstdio>
#include <cstdint>
#include <cmath>

#ifndef MK_PER_PHASE
#define MK_PER_PHASE 0
#endif

#define LAS __attribute__((address_space(3)))
#define GAS __attribute__((address_space(1)))
typedef _Float16 h16;
typedef _Float16 h16x8 __attribute__((ext_vector_type(8)));
typedef _Float16 h16x4 __attribute__((ext_vector_type(4)));
typedef _Float16 h16x2 __attribute__((ext_vector_type(2)));
typedef short s16x4 __attribute__((ext_vector_type(4)));
typedef float f32x2 __attribute__((ext_vector_type(2)));
typedef float f32x4 __attribute__((ext_vector_type(4)));
typedef float f32x16 __attribute__((ext_vector_type(16)));
typedef unsigned u32x2 __attribute__((ext_vector_type(2)));
typedef unsigned u32x4 __attribute__((ext_vector_type(4)));

constexpr int DM = 1024, NTOK = 16384, NCTX = 8192, SEQ = 256, LSEQ = 4096, NB_CTX = 32, NB_LAT = 2, DEPTH = 2;
constexpr int DIN = 6656, NMAIN = 3584, NGATE = 3072, DFF = 2816, DUP = 5632, DLRU = 1024;
constexpr int C_XA = 0, C_YA = 1024, C_QB = 2048, C_KB = 2560, C_VB = 2688, C_QC = 2816, C_KC = 3328, C_VC = 3456;
constexpr float NORM_EPS = 1e-6f;
constexpr float LOG2E = 1.4426950408889634f;
constexpr float QSCALE = 0.125f * LOG2E;
constexpr size_t O_Y = 0, O_KB = 16777216, O_VB = 18874368, O_KC = 20971520, O_VC = 23068672, O_LRU = 25165824, O_END = 25296896;
constexpr size_t MiB = 1u << 20;
constexpr size_t WS_CTL = 0, WS_SS = 64 * 1024, CTL_ZERO_BYTES = 64 * 1024 + 4 * NTOK * 4;
constexpr size_t WS_MOD = 1 * MiB;
constexpr size_t WS_ROPE = 1 * MiB + 256 * 1024;
constexpr size_t WS_AGG = 1 * MiB + 320 * 1024;
constexpr size_t WS_CACHE = 2 * MiB;
constexpr size_t WS_W = 3 * MiB;
constexpr size_t W_IN = 0, W_OA = W_IN + (size_t)DIN * DM * 2, W_OB = W_OA + (size_t)DM * 1024 * 2, W_OC = W_OB + (size_t)DM * 512 * 2,
                 W_OUT = W_OC + (size_t)DM * 512 * 2, W_UP = W_OUT + (size_t)DM * DM * 2, W_DOWN = W_UP + (size_t)DUP * DM * 2,
                 W_LRU = W_DOWN + (size_t)DM * DFF * 2, W_END = W_LRU + (size_t)2 * 2 * 8 * 128 * 128 * 2;
static_assert(W_END <= 37 * MiB, "weights region");
constexpr size_t WS_H = 40 * MiB;
constexpr size_t WS_ZU = 72 * MiB;
constexpr size_t ZU_OA = (size_t)NTOK * NMAIN * 2, ZU_OB = ZU_OA + (size_t)NTOK * 1024 * 2, ZU_OC = ZU_OB + (size_t)NTOK * 512 * 2;
constexpr size_t WS_STASH = WS_ZU + (size_t)NTOK * DUP * 2;
static_assert(WS_STASH == 248 * MiB, "ws map");
constexpr size_t WS_H2 = WS_STASH + (size_t)NB_LAT * 2 * LSEQ * DLRU * 4;
constexpr size_t WS_CV = WS_H2 + (size_t)NTOK * DM * 2;
constexpr size_t WS_EDGE = WS_CV + MiB;
constexpr size_t WS_END = WS_EDGE + (size_t)64 * 8 * 3 * DFF * 4;

__device__ __forceinline__ unsigned pk_h2(float lo, float hi) { f32x2 v = {lo, hi}; h16x2 h = __builtin_convertvector(v, h16x2); return __builtin_bit_cast(unsigned, h); }
__device__ __forceinline__ void unpack8(u32x4 w, float* x) { h16x8 h = __builtin_bit_cast(h16x8, w);
#pragma unroll
    for (int j = 0; j < 8; ++j) x[j] = (float)h[j]; }
__device__ __forceinline__ u32x4 pack8(const float* x) { u32x4 w; w.x = pk_h2(x[0], x[1]); w.y = pk_h2(x[2], x[3]); w.z = pk_h2(x[4], x[5]); w.w = pk_h2(x[6], x[7]); return w; }
__device__ __forceinline__ float fast_exp2(float x) { return __builtin_amdgcn_exp2f(x); }
__device__ __forceinline__ float fast_rcp(float x) { return __builtin_amdgcn_rcpf(x); }
__device__ __forceinline__ float sigmoidf_(float x) { return fast_rcp(1.0f + fast_exp2(-LOG2E * x)); }
__device__ __forceinline__ float gelu_tanh(float x) { const float t = x + 0.044715f * x * x * x; return x * fast_rcp(1.0f + fast_exp2(-2.0f * 0.7978845608028654f * LOG2E * t)); }
template <int CTRL> __device__ __forceinline__ float dpp_f(float v) { return __int_as_float(__builtin_amdgcn_update_dpp(0, __float_as_int(v), CTRL, 0xf, 0xf, true)); }
__device__ __forceinline__ float sum8(float v) { v += dpp_f<0xB1>(v); v += dpp_f<0x4E>(v); v += dpp_f<0x141>(v); return v; }
__device__ __forceinline__ float wave_sum(float v) { v = sum8(v); v += dpp_f<0x140>(v); v += __shfl_xor(v, 16); v += __shfl_xor(v, 32); return v; }

constexpr int RING_BYTES = 131072;
constexpr int LDSCTL_OFF = RING_BYTES, MISC_OFF = LDSCTL_OFF + 320;
constexpr int LDS_BYTES = 163840;
constexpr int EPI_SCR_OFF = RING_BYTES + 2048, EPI_SCR_WAVE = 2304;
#if defined(TIME_SUB)
#ifndef TIME_FILTER
#define TIME_FILTER -1
#endif
#define TSL_OK(l_) (blockIdx.x == 0 && threadIdx.x == 0 && (TIME_FILTER < 0 || *(volatile LAS int*)((l_) + MISC_OFF + 96) == TIME_FILTER))
#define TSL_START(l_, id) do { if ((id) == TIME_SUB && TSL_OK(l_)) *(volatile LAS unsigned long long*)((l_) + MISC_OFF + 72) = __builtin_amdgcn_s_memrealtime(); } while (0)
#define TSL_STOP(l_, id) do { if ((id) == TIME_SUB && TSL_OK(l_)) { volatile LAS unsigned long long* a_ = (volatile LAS unsigned long long*)((l_) + MISC_OFF + 64); a_[0] = a_[0] + (__builtin_amdgcn_s_memrealtime() - a_[1]); } } while (0)
#define TSL_PHASE(l_, k) do { if (blockIdx.x == 0 && threadIdx.x == 0) *(volatile LAS int*)((l_) + MISC_OFF + 96) = (k); } while (0)
#else
#define TSL_START(l_, id) do { } while (0)
#define TSL_STOP(l_, id) do { } while (0)
#define TSL_PHASE(l_, k) do { } while (0)
#endif
namespace pg8 {
constexpr int BM = 256, BK = 64, HALF = 128, HTB = HALF * BK * 2, STAGE_BYTES = 8 * HTB, NXCD = 8, WGM = 8;
__host__ __device__ __forceinline__ int lds_byte(int r, int c) { const int st = (r >> 4) * 2 + (c >> 5), rr = r & 15, cc = c & 31, ob = rr * 64 + cc * 2; return st * 1024 + (ob ^ (((ob >> 9) & 1) << 5)); }
__host__ __device__ __forceinline__ void stage_rc(int b, int& R, int& C) { const int st = b / 1024, sb = b % 1024, swz = sb ^ (((sb >> 9) & 1) << 5); R = (st >> 1) * 16 + swz / 64; C = (st & 1) * 32 + (swz % 64) / 2; }
__host__ __device__ __forceinline__ int perm32(int rho) { const int n = rho >> 4, i = rho & 15; return 8 * (i >> 2) + 4 * n + (i & 3); }
struct Unit { int pm, pn; };
struct Gemm { const h16* A; const h16* Bt; int M, N, K, lda; };
struct StaticOrder {
    int nM, nN, nwg, G, c;
    __host__ __device__ void init(int M, int N, int G_, int c_) { nM = M / BM; nN = N / BM; nwg = nM * nN; G = G_; c = c_; }
    __host__ __device__ bool next(int i, Unit& u) const {
        const long L = (long)i * G + c; if (L >= nwg) return false;
        int wgid = (int)L; { const int q = nwg / NXCD, r = nwg % NXCD, xcd = wgid % NXCD, off = wgid / NXCD; wgid = (xcd < r ? xcd * (q + 1) : r * (q + 1) + (xcd - r) * q) + off; }
        const int nig = WGM * nN, gid = wgid / nig, fm = gid * WGM, gsz = (nM - fm) < WGM ? (nM - fm) : WGM;
        u.pm = fm + ((wgid % nig) % gsz); u.pn = (wgid % nig) / gsz; return true;
    }
    __device__ __forceinline__ void a_ready(const Unit&) const {}
    __device__ __forceinline__ void done(const Unit&) const {}
};

template <int ACT> struct EpiF16 {
    static constexpr bool PERM = true, AFTER_DRAIN = false;
    h16* O; int ldc;
    const float* ss; const float* cv;
    int cvld;
    __device__ __forceinline__ void operator()(const f32x4 (&acc)[2][2][4][2], const Unit& u, int wr, int wc, int fr, int fq) const {
        const int row0 = u.pm * BM + wr * 64 + fr, col0 = u.pn * BM + wc * 32 + 8 * fq;
        const int cond = u.pm < 32 ? 0 : (u.pm < 48 ? 1 : 2);
        f32x4 c0[2], c1[2];
#pragma unroll
        for (int bj = 0; bj < 2; ++bj) { const float* cp = cv + (size_t)cond * cvld + col0 + bj * HALF; c0[bj] = *(const f32x4*)cp; c1[bj] = *(const f32x4*)(cp + 4); }
#pragma unroll
        for (int ai = 0; ai < 2; ++ai)
#pragma unroll
            for (int m = 0; m < 4; ++m) { const int row = row0 + ai * HALF + m * 16; h16* rowp = O + (size_t)row * ldc + col0;
                const float rstd = 1.0f / sqrtf(ss[row] * (1.0f / DM) + NORM_EPS);
#pragma unroll
                for (int bj = 0; bj < 2; ++bj) { f32x4 v0 = acc[ai][bj][m][0] * rstd + c0[bj], v1 = acc[ai][bj][m][1] * rstd + c1[bj];
                    if (ACT == 1) {
#pragma unroll
                        for (int j = 0; j < 4; ++j) { v0[j] = sigmoidf_(v0[j]); v1[j] = sigmoidf_(v1[j]); } }
                    u32x4 w; w.x = pk_h2(v0[0], v0[1]); w.y = pk_h2(v0[2], v0[3]); w.z = pk_h2(v1[0], v1[1]); w.w = pk_h2(v1[2], v1[3]);
                    *(u32x4*)(rowp + bj * HALF) = w; } }
    }
};
template <int ACCUM> struct EpiGateMul {
    static constexpr bool PERM = true, AFTER_DRAIN = false;
    h16* Mg; const h16* G; int gcol0;
    __device__ __forceinline__ void operator()(const f32x4 (&acc)[2][2][4][2], const Unit& u, int wr, int wc, int fr, int fq) const {
        const int row0 = u.pm * BM + wr * 64 + fr, col0 = u.pn * BM + wc * 32 + 8 * fq;
#pragma unroll
        for (int ai = 0; ai < 2; ++ai) {
            u32x4 gw[4][2], mw[4][2];
#pragma unroll
            for (int m = 0; m < 4; ++m) { const size_t row = (size_t)(row0 + ai * HALF + m * 16);
#pragma unroll
                for (int bj = 0; bj < 2; ++bj) { gw[m][bj] = *(const u32x4*)(G + row * NGATE + gcol0 + col0 + bj * HALF);
                    if (ACCUM) mw[m][bj] = *(const u32x4*)(Mg + row * DM + col0 + bj * HALF); } }
#pragma unroll
            for (int m = 0; m < 4; ++m) { const size_t row = (size_t)(row0 + ai * HALF + m * 16);
#pragma unroll
                for (int bj = 0; bj < 2; ++bj) {
                    float g[8]; unpack8(gw[m][bj], g);
                    float o[8];
                    if (ACCUM) unpack8(mw[m][bj], o);
                    else {
#pragma unroll
                        for (int j = 0; j < 8; ++j) o[j] = 0.f; }
                    const f32x4 v0 = acc[ai][bj][m][0], v1 = acc[ai][bj][m][1];
#pragma unroll
                    for (int j = 0; j < 4; ++j) { o[j] += g[j] * v0[j]; o[4 + j] += g[4 + j] * v1[j]; }
                    *(u32x4*)(Mg + row * DM + col0 + bj * HALF) = pack8(o); } }
            asm volatile("" ::: "memory"); }
    }
};
template <int CTRL> __device__ __forceinline__ float dpp_old(float old, float v) { return __int_as_float(__builtin_amdgcn_update_dpp(__float_as_int(old), __float_as_int(v), CTRL, 0xf, 0xf, false)); }
struct EpiAct {
    static constexpr bool PERM = true, AFTER_DRAIN = false;
    h16* ACT; const float* ss; const float* cv; int cvld; const float* cw; const float* cb; float* edge;
    __device__ __forceinline__ void operator()(const f32x4 (&acc)[2][2][4][2], const Unit& u, int wr, int wc, int fr, int fq) const {
        const int cond = u.pm < 32 ? 0 : (u.pm < 48 ? 1 : 2);
        const int chb = u.pn * 128 + wc * 32 + 8 * fq;
        const int colg = u.pn * BM + wc * 32 + 8 * fq;
        float cg[8], cvv[8], w0[8], w1[8], w2[8], bb[8];
#pragma unroll
        for (int e = 0; e < 8; ++e) { cg[e] = cv[(size_t)cond * cvld + colg + e]; cvv[e] = cv[(size_t)cond * cvld + colg + HALF + e];
            w0[e] = cw[chb + e]; w1[e] = cw[DFF + chb + e]; w2[e] = cw[2 * DFF + chb + e]; bb[e] = cb[chb + e]; }
#pragma unroll
        for (int ai = 0; ai < 2; ++ai) {
            float rs[4]; float g[4][8];
#pragma unroll
            for (int m = 0; m < 4; ++m) { rs[m] = 1.0f / sqrtf(ss[u.pm * BM + ai * HALF + wr * 64 + m * 16 + fr] * (1.0f / DM) + NORM_EPS);
#pragma unroll
                for (int e = 0; e < 8; ++e) g[m][e] = acc[ai][0][m][e >> 2][e & 3] * rs[m] + cg[e]; }
#pragma unroll
            for (int m = 0; m < 4; ++m) {
                const int row = u.pm * BM + ai * HALF + wr * 64 + m * 16 + fr;
                float o[8], pre[8], vv[8];
#pragma unroll
                for (int e = 0; e < 8; ++e) {
                    const float pe = m > 0 ? dpp_f<0x121>(g[m > 0 ? m - 1 : 0][e]) : 0.f;
                    const float prev = dpp_old<0x111>(pe, g[m][e]);
                    const float ne = m < 3 ? dpp_f<0x12F>(g[m < 3 ? m + 1 : 3][e]) : 0.f;
                    const float next = dpp_old<0x101>(ne, g[m][e]);
                    vv[e] = acc[ai][1][m][e >> 2][e & 3] * rs[m] + cvv[e];
                    pre[e] = bb[e] + w0[e] * prev + w1[e] * g[m][e] + w2[e] * next;
                    o[e] = gelu_tanh(pre[e]) * vv[e];
                }
                *(u32x4*)(ACT + (size_t)row * DFF + chb) = pack8(o);
                if ((m == 0 && fr == 0) || (m == 3 && fr == 15)) {
                    float* ep = edge + ((size_t)(u.pm * 8 + 2 * (2 * ai + wr) + (m == 3 ? 1 : 0)) * 3) * DFF + chb;
#pragma unroll
                    for (int e = 0; e < 8; ++e) { ep[e] = g[m][e]; ep[DFF + e] = pre[e]; ep[2 * DFF + e] = vv[e]; }
                }
            }
        }
    }
};
struct EpiRes {
    static constexpr bool PERM = false, AFTER_DRAIN = false;
    const float* base_ctx; const float* base_lat; float* X; const float* gate;
    h16* Hn; const float* gn; const float* scn; float* ssn;
    LAS unsigned char* scr;
    __device__ __forceinline__ void operator()(const f32x4 (&acc)[2][2][4][2], const Unit& u, int wr, int wc, int fr, int fq) const {
        const int cond = u.pm < 32 ? 0 : (u.pm < 48 ? 1 : 2);
        const float* gp = gate + (size_t)cond * 6144;
        const float* bp = u.pm < 32 ? base_ctx + (size_t)u.pm * BM * DM : base_lat + (size_t)(u.pm - 32) * BM * DM;
        float* xp = X + (size_t)u.pm * BM * DM;
        const int lane = fq * 16 + fr, wave = wr * 4 + wc;
        LAS unsigned char* my = scr + wave * EPI_SCR_WAVE;
        const int wofs = fr * 144 + fq * 16;
        const int rrow = lane >> 3, rc4 = (lane & 7) * 4;
        const int rofs = rrow * 144 + rc4 * 4;
        const int colw = u.pn * BM + wc * 32 + rc4;
        const unsigned loff = (unsigned)((wr * 64 + rrow) * DM + colw);
        f32x4 gv[2], gsn[2];
#pragma unroll
        for (int bj = 0; bj < 2; ++bj) { gv[bj] = *(const f32x4*)(gp + colw + bj * HALF);
            if (Hn) gsn[bj] = *(const f32x4*)(gn + colw + bj * HALF) * (*(const f32x4*)(scn + (size_t)cond * 6144 + colw + bj * HALF) + 1.0f); }
        h16* hp = Hn ? Hn + (size_t)u.pm * BM * DM : nullptr;
        float* sp = ssn ? ssn + u.pm * BM : nullptr;
#pragma unroll
        for (int ai = 0; ai < 2; ++ai)
#pragma unroll
        for (int mh = 0; mh < 2; ++mh) {
            f32x4 b[2][2][2];
#pragma unroll
            for (int m2 = 0; m2 < 2; ++m2)
#pragma unroll
                for (int k = 0; k < 2; ++k) { const float* rb = bp + (size_t)(ai * HALF + (2 * mh + m2) * 16 + 8 * k) * DM;
#pragma unroll
                    for (int bj = 0; bj < 2; ++bj) b[m2][bj][k] = *(const f32x4*)(rb + loff + bj * HALF); }
#pragma unroll
            for (int m2 = 0; m2 < 2; ++m2)
            { float q[2] = {0.f, 0.f};
#pragma unroll
                for (int bj = 0; bj < 2; ++bj) { const int m = 2 * mh + m2;
                    *(LAS f32x4*)(my + wofs) = acc[ai][bj][m][0]; *(LAS f32x4*)(my + wofs + 64) = acc[ai][bj][m][1];
#pragma unroll
                    for (int k = 0; k < 2; ++k) { const f32x4 a = *(const LAS f32x4*)(my + rofs + k * 8 * 144);
                        float* xb = xp + (size_t)(ai * HALF + m * 16 + 8 * k) * DM;
                        const f32x4 xn = b[m2][bj][k] + gv[bj] * a;
                        *(f32x4*)(xb + loff + bj * HALF) = xn;
                        if (Hn) { const f32x4 hv = xn * gsn[bj]; u32x2 w; w.x = pk_h2(hv[0], hv[1]); w.y = pk_h2(hv[2], hv[3]);
                            *(u32x2*)(hp + (size_t)(ai * HALF + m * 16 + 8 * k) * DM + loff + bj * HALF) = w;
                            q[k] += (xn[0] * xn[0] + xn[1] * xn[1]) + (xn[2] * xn[2] + xn[3] * xn[3]); } }
                }
                if (Hn) {
#pragma unroll
                    for (int k = 0; k < 2; ++k) { float t = sum8(q[k]);
                        if ((lane & 7) == 0) atomicAdd(sp + wr * 64 + ai * HALF + (2 * mh + m2) * 16 + 8 * k + rrow, t); } }
            }
            asm volatile("" ::: "memory"); }
    }
};

template <class Epi, class Sched, bool ALIGN_EPI = false, bool SP2 = false>
__device__ __forceinline__ void gemm_phase(LAS unsigned char* lds, const Gemm g, const Sched& S, const Epi& E) {
    int tid_ = threadIdx.x; asm volatile("" : "+v"(tid_));
    const int tid = tid_, wid = __builtin_amdgcn_readfirstlane(tid >> 6), lane = tid & 63, wr = wid >> 2, wc = wid & 3, fr = lane & 15, fq = lane >> 4;
    const int K = g.K, nt = K / BK, lda = g.lda;
    unsigned voffA[2], voffB[2];
#pragma unroll
    for (int i = 0; i < 2; ++i) { int R, C; stage_rc(tid * 16 + i * 8192, R, C); const int Rb = Epi::PERM ? ((R & ~31) + perm32(R & 31)) : R;
        voffA[i] = (unsigned)(R * lda + C) * 2u; voffB[i] = (unsigned)(Rb * K + C) * 2u; }
    const size_t kstep = (size_t)(BK * 2);
    const size_t hstepA = (size_t)HALF * lda * 2, hstepB = (size_t)HALF * K * 2;
    const size_t tstepA = 2 * hstepA, tstepB = 2 * hstepB;
    const unsigned ldsw = (unsigned)wid * 1024u;
    const int aoff = lds_byte(wr * 64 + fr, fq * 8), boff = lds_byte(wc * 32 + fr, fq * 8);
#define PG8_SA(b, h) (((b) * 2 + (h)) * HTB)
#define PG8_SB(b, h) ((4 + (b) * 2 + (h)) * HTB)
#define PG8_STAGE(bufoff, gbase, voff) do { _Pragma("unroll") for (int _i = 0; _i < 2; ++_i) \
        __builtin_amdgcn_global_load_lds((const unsigned*)((const char*)(gbase) + (voff)[_i]), (LAS unsigned*)(lds + (bufoff) + ldsw + _i * 8192), 16, 0, 0); } while (0)
#define PG8_LDA(dst, b, h) do { _Pragma("unroll") for (int m = 0; m < 4; ++m) _Pragma("unroll") for (int k = 0; k < 2; ++k) dst[m][k] = *(const LAS h16x8*)(lds + PG8_SA(b, h) + aoff + m * 2048 + k * 1024); } while (0)
#define PG8_LDB(dst, b, h) do { _Pragma("unroll") for (int n = 0; n < 2; ++n) _Pragma("unroll") for (int k = 0; k < 2; ++k) dst[n][k] = *(const LAS h16x8*)(lds + PG8_SB(b, h) + boff + n * 2048 + k * 1024); } while (0)
#define PG8_MMA(ai, bj, At, Bt) do { __builtin_amdgcn_s_setprio(1); _Pragma("unroll") for (int m = 0; m < 4; ++m) _Pragma("unroll") for (int n = 0; n < 2; ++n) _Pragma("unroll") for (int k = 0; k < 2; ++k) \
        acc[ai][bj][m][n] = __builtin_amdgcn_mfma_f32_16x16x32_f16(Bt[n][k], At[m][k], acc[ai][bj][m][n], 0, 0, 0); __builtin_amdgcn_s_setprio(0); } while (0)
#define PG8_WAIT_V(n) asm volatile("s_waitcnt vmcnt(" #n ")" ::: "memory")
#define PG8_WAIT_L(n) asm volatile("s_waitcnt lgkmcnt(" #n ")" ::: "memory")
#define PG8_BAR __builtin_amdgcn_s_barrier()
#define PG8_SCHED __builtin_amdgcn_sched_barrier(0)
    Unit cur, nxt; int ui = 0;
    if (!S.next(0, cur)) return;
    TSL_START(lds, 10);
    f32x4 acc[2][2][4][2];
#pragma unroll
    for (int a = 0; a < 2; ++a)
#pragma unroll
        for (int b = 0; b < 2; ++b)
#pragma unroll
            for (int m = 0; m < 4; ++m)
#pragma unroll
                for (int n = 0; n < 2; ++n) acc[a][b][m][n] = (f32x4){0.f, 0.f, 0.f, 0.f};
    h16x8 At[4][2], B0[2][2], B1[2][2];
    const char* cA = (const char*)g.A + (size_t)cur.pm * tstepA; const char* cB = (const char*)g.Bt + (size_t)cur.pn * tstepB;
    S.a_ready(cur);
    if constexpr (SP2) {
        PG8_STAGE(PG8_SB(0, 0), cB, voffB); PG8_STAGE(PG8_SB(0, 1), cB + hstepB, voffB); PG8_STAGE(PG8_SA(0, 0), cA, voffA); PG8_STAGE(PG8_SA(0, 1), cA + hstepA, voffA);
        if (wr == 1) PG8_BAR;
        PG8_WAIT_V(2); PG8_BAR;
        PG8_STAGE(PG8_SB(1, 0), cB + kstep, voffB); PG8_STAGE(PG8_SA(1, 0), cA + kstep, voffA); PG8_STAGE(PG8_SB(1, 1), cB + hstepB + kstep, voffB);
        PG8_WAIT_V(6); PG8_BAR;
    } else {
        PG8_STAGE(PG8_SB(0, 0), cB, voffB); PG8_STAGE(PG8_SA(0, 0), cA, voffA); PG8_STAGE(PG8_SB(0, 1), cB + hstepB, voffB); PG8_STAGE(PG8_SA(0, 1), cA + hstepA, voffA);
        if (wr == 1) PG8_BAR;
        PG8_WAIT_V(4); PG8_BAR;
        PG8_STAGE(PG8_SB(1, 0), cB + kstep, voffB); PG8_STAGE(PG8_SA(1, 0), cA + kstep, voffA); PG8_STAGE(PG8_SB(1, 1), cB + hstepB + kstep, voffB);
        PG8_WAIT_V(6); PG8_BAR;
    }
    for (;;) {
        const bool has_next = S.next(ui + 1, nxt);
        const char* nA = has_next ? (const char*)g.A + (size_t)nxt.pm * tstepA : cA; const char* nB = has_next ? (const char*)g.Bt + (size_t)nxt.pn * tstepB : cB;
        for (int t = 0; t < nt; t += 2) {
            const bool last = (t == nt - 2);
            const char* a1 = cA + (size_t)(t + 1) * kstep;
            const char* a2 = last ? nA : cA + (size_t)(t + 2) * kstep; const char* b2 = last ? nB : cB + (size_t)(t + 2) * kstep;
            const char* a3 = a2 + kstep; const char* b3 = b2 + kstep;
            if (last && has_next) S.a_ready(nxt);
            if constexpr (SP2) {
            PG8_LDB(B0, 0, 0); PG8_LDB(B1, 0, 1); PG8_SCHED; PG8_LDA(At, 0, 0); PG8_STAGE(PG8_SA(1, 1), a1 + hstepA, voffA);
            PG8_WAIT_V(8); PG8_WAIT_L(0); PG8_BAR; PG8_MMA(0, 0, At, B0); PG8_MMA(0, 1, At, B1); PG8_BAR; PG8_SCHED;
            PG8_LDA(At, 0, 1); PG8_STAGE(PG8_SB(0, 0), b2, voffB); PG8_STAGE(PG8_SB(0, 1), b2 + hstepB, voffB); PG8_STAGE(PG8_SA(0, 0), a2, voffA);
            PG8_WAIT_V(8); PG8_WAIT_L(0); PG8_BAR; PG8_MMA(1, 0, At, B0); PG8_MMA(1, 1, At, B1); PG8_BAR; PG8_SCHED;
            PG8_LDB(B0, 1, 0); PG8_LDB(B1, 1, 1); PG8_SCHED; PG8_LDA(At, 1, 0); PG8_STAGE(PG8_SA(0, 1), a2 + hstepA, voffA);
            PG8_WAIT_V(8); PG8_WAIT_L(0); PG8_BAR; PG8_MMA(0, 0, At, B0); PG8_MMA(0, 1, At, B1); PG8_BAR; PG8_SCHED;
            PG8_LDA(At, 1, 1); PG8_STAGE(PG8_SB(1, 0), b3, voffB); PG8_STAGE(PG8_SB(1, 1), b3 + hstepB, voffB); PG8_STAGE(PG8_SA(1, 0), a3, voffA);
            PG8_WAIT_V(8); PG8_WAIT_L(0); PG8_BAR; PG8_MMA(1, 0, At, B0); PG8_MMA(1, 1, At, B1); PG8_BAR; PG8_SCHED;
            } else {
            PG8_LDB(B0, 0, 0); PG8_SCHED; PG8_LDA(At, 0, 0); PG8_STAGE(PG8_SA(1, 1), a1 + hstepA, voffA);
            PG8_WAIT_L(8); PG8_BAR; PG8_WAIT_L(0); PG8_MMA(0, 0, At, B0); PG8_BAR; PG8_SCHED;
            PG8_LDB(B1, 0, 1); PG8_STAGE(PG8_SB(0, 0), b2, voffB);
            PG8_BAR; PG8_WAIT_L(0); PG8_MMA(0, 1, At, B1); PG8_BAR;
            PG8_LDA(At, 0, 1); PG8_STAGE(PG8_SA(0, 0), a2, voffA);
            PG8_BAR; PG8_WAIT_L(0); PG8_MMA(1, 0, At, B0); PG8_BAR; PG8_SCHED;
            PG8_STAGE(PG8_SB(0, 1), b2 + hstepB, voffB);
            PG8_WAIT_V(6); PG8_BAR; PG8_MMA(1, 1, At, B1); PG8_BAR;
            PG8_LDB(B0, 1, 0); PG8_SCHED; PG8_LDA(At, 1, 0); PG8_STAGE(PG8_SA(0, 1), a2 + hstepA, voffA);
            PG8_WAIT_L(8); PG8_BAR; PG8_WAIT_L(0); PG8_MMA(0, 0, At, B0); PG8_BAR; PG8_SCHED;
            PG8_LDB(B1, 1, 1); PG8_STAGE(PG8_SB(1, 0), b3, voffB);
            PG8_BAR; PG8_WAIT_L(0); PG8_MMA(0, 1, At, B1); PG8_BAR;
            PG8_LDA(At, 1, 1); PG8_STAGE(PG8_SA(1, 0), a3, voffA);
            PG8_BAR; PG8_WAIT_L(0); PG8_MMA(1, 0, At, B0); PG8_BAR; PG8_SCHED;
            PG8_STAGE(PG8_SB(1, 1), b3 + hstepB, voffB);
            PG8_WAIT_V(6); PG8_BAR; PG8_MMA(1, 1, At, B1); PG8_BAR;
            }
        }
        if constexpr (ALIGN_EPI) { if (wr == 0) PG8_BAR; }
        TSL_STOP(lds, 10); TSL_START(lds, 11);
        if constexpr (!Epi::AFTER_DRAIN) { E(acc, cur, wr, wc, fr, fq); S.done(cur); }
        TSL_STOP(lds, 11); TSL_START(lds, 10);
        if (!has_next) break;
#pragma unroll
        for (int a = 0; a < 2; ++a)
#pragma unroll
            for (int b = 0; b < 2; ++b)
#pragma unroll
                for (int m = 0; m < 4; ++m)
#pragma unroll
                    for (int n = 0; n < 2; ++n) acc[a][b][m][n] = (f32x4){0.f, 0.f, 0.f, 0.f};
        cur = nxt; cA = nA; cB = nB; ++ui;
        if constexpr (ALIGN_EPI) { if (wr == 1) PG8_BAR; }
    }
    PG8_WAIT_V(0);
    if constexpr (!ALIGN_EPI) { if (wr == 0) PG8_BAR; }
    PG8_BAR;
    TSL_STOP(lds, 10);
#undef PG8_SA
#undef PG8_SB
#undef PG8_STAGE
#undef PG8_LDA
#undef PG8_LDB
#undef PG8_MMA
#undef PG8_WAIT_V
#undef PG8_WAIT_L
#undef PG8_BAR
#undef PG8_SCHED
}

struct EpiGM {
    static constexpr bool PERM = true, AFTER_DRAIN = false;
    h16* Mg; h16* S; const float* ss; const float* cv; int cvld;
    __device__ __forceinline__ void operator()(const f32x4 (&acc)[2][2][4][2], const Unit& u, int kind, int wr, int wc, int fr_, int fq_) const {
        int fr = fr_, fq = fq_; asm volatile("" : "+v"(fr), "+v"(fq));
        const int r0 = wr * 64 + fr, c0 = wc * 32 + 8 * fq;
        if ((kind & 15) == 0) {
            const int gi = kind >> 4, cond = u.pm < 32 ? 0 : (u.pm < 48 ? 1 : 2);
            f32x4 ca[2], cb[2];
#pragma unroll
            for (int bj = 0; bj < 2; ++bj) { const float* cp = cv + (size_t)cond * cvld + gi * 1024 + u.pn * BM + c0 + bj * HALF; ca[bj] = *(const f32x4*)cp; cb[bj] = *(const f32x4*)(cp + 4); }
#pragma unroll
            for (int ai = 0; ai < 2; ++ai)
#pragma unroll
                for (int m = 0; m < 4; ++m) { const int rt = r0 + ai * HALF + m * 16;
                    const float rstd = 1.0f / sqrtf(ss[u.pm * BM + rt] * (1.0f / DM) + NORM_EPS);
#pragma unroll
                    for (int bj = 0; bj < 2; ++bj) { f32x4 v0 = acc[ai][bj][m][0] * rstd + ca[bj], v1 = acc[ai][bj][m][1] * rstd + cb[bj];
#pragma unroll
                        for (int j = 0; j < 4; ++j) { v0[j] = sigmoidf_(v0[j]); v1[j] = sigmoidf_(v1[j]); }
                        u32x4 w; w.x = pk_h2(v0[0], v0[1]); w.y = pk_h2(v0[2], v0[3]); w.z = pk_h2(v1[0], v1[1]); w.w = pk_h2(v1[2], v1[3]);
                        *(u32x4*)(S + rt * BM + c0 + bj * HALF) = w; } }
        } else {
            const bool accum = kind == 2;
#pragma unroll
            for (int ai = 0; ai < 2; ++ai)
#pragma unroll
            for (int mh = 0; mh < 2; ++mh) {
                u32x4 gw[2][2], mw[2][2];
#pragma unroll
                for (int m2 = 0; m2 < 2; ++m2) { const int rt = r0 + ai * HALF + (2 * mh + m2) * 16;
#pragma unroll
                    for (int bj = 0; bj < 2; ++bj) { gw[m2][bj] = *(const u32x4*)(S + rt * BM + c0 + bj * HALF);
                        mw[m2][bj] = accum ? *(const u32x4*)(Mg + (size_t)(u.pm * BM + rt) * DM + u.pn * BM + c0 + bj * HALF) : (u32x4){0u, 0u, 0u, 0u}; } }
#pragma unroll
                for (int m2 = 0; m2 < 2; ++m2) { const int m = 2 * mh + m2; const int rt = r0 + ai * HALF + m * 16;
#pragma unroll
                    for (int bj = 0; bj < 2; ++bj) {
                        float g[8], o[8]; unpack8(gw[m2][bj], g); unpack8(mw[m2][bj], o);
                        const f32x4 v0 = acc[ai][bj][m][0], v1 = acc[ai][bj][m][1];
#pragma unroll
                        for (int j = 0; j < 4; ++j) { o[j] += g[j] * v0[j]; o[4 + j] += g[4 + j] * v1[j]; }
                        *(u32x4*)(Mg + (size_t)(u.pm * BM + rt) * DM + u.pn * BM + c0 + bj * HALF) = pack8(o); } }
                asm volatile("" ::: "memory"); }
        }
    }
};
struct Sub { const h16* A; const h16* Bt; int K, lda, kind; };
template <class Jobs, class Epi>
__device__ __forceinline__ void gemm_multi(LAS unsigned char* lds, const Jobs& J, const Epi& E) {
    int tid_ = threadIdx.x; asm volatile("" : "+v"(tid_));
    const int tid = tid_, wid = __builtin_amdgcn_readfirstlane(tid >> 6), lane = tid & 63, wr = wid >> 2, wc = wid & 3, fr = lane & 15, fq = lane >> 4;
    unsigned rA2[2], rB2[2], c2[2];
#pragma unroll
    for (int i = 0; i < 2; ++i) { int R, C; stage_rc(tid * 16 + i * 8192, R, C); const int Rb = Epi::PERM ? ((R & ~31) + perm32(R & 31)) : R;
        rA2[i] = (unsigned)R * 2u; rB2[i] = (unsigned)Rb * 2u; c2[i] = (unsigned)C * 2u; }
    const size_t kstep = (size_t)(BK * 2);
    const unsigned ldsw = (unsigned)wid * 1024u;
    const int aoff = lds_byte(wr * 64 + fr, fq * 8), boff = lds_byte(wc * 32 + fr, fq * 8);
#define PG8_SA(b, h) (((b) * 2 + (h)) * HTB)
#define PG8_SB(b, h) ((4 + (b) * 2 + (h)) * HTB)
#define PG8_STAGE2(bufoff, gbase, rr, ld) do { _Pragma("unroll") for (int _i = 0; _i < 2; ++_i) \
        __builtin_amdgcn_global_load_lds((const unsigned*)((const char*)(gbase) + ((rr)[_i] * (unsigned)(ld) + c2[_i])), (LAS unsigned*)(lds + (bufoff) + ldsw + _i * 8192), 16, 0, 0); } while (0)
#define PG8_LDA(dst, b, h) do { _Pragma("unroll") for (int m = 0; m < 4; ++m) _Pragma("unroll") for (int k = 0; k < 2; ++k) dst[m][k] = *(const LAS h16x8*)(lds + PG8_SA(b, h) + aoff + m * 2048 + k * 1024); } while (0)
#define PG8_LDB(dst, b, h) do { _Pragma("unroll") for (int n = 0; n < 2; ++n) _Pragma("unroll") for (int k = 0; k < 2; ++k) dst[n][k] = *(const LAS h16x8*)(lds + PG8_SB(b, h) + boff + n * 2048 + k * 1024); } while (0)
#define PG8_MMA(ai, bj, At, Bt) do { __builtin_amdgcn_s_setprio(1); _Pragma("unroll") for (int m = 0; m < 4; ++m) _Pragma("unroll") for (int n = 0; n < 2; ++n) _Pragma("unroll") for (int k = 0; k < 2; ++k) \
        acc[ai][bj][m][n] = __builtin_amdgcn_mfma_f32_16x16x32_f16(Bt[n][k], At[m][k], acc[ai][bj][m][n], 0, 0, 0); __builtin_amdgcn_s_setprio(0); } while (0)
#define PG8_WAIT_V(n) asm volatile("s_waitcnt vmcnt(" #n ")" ::: "memory")
#define PG8_WAIT_L(n) asm volatile("s_waitcnt lgkmcnt(" #n ")" ::: "memory")
#define PG8_BAR __builtin_amdgcn_s_barrier()
#define PG8_SCHED __builtin_amdgcn_sched_barrier(0)
    const int njobs = J.count(); if (njobs == 0) return;
    int ui = 0; Unit cur = J.unit(0); Sub cs = J.sub(0);
    f32x4 acc[2][2][4][2];
#pragma unroll
    for (int a = 0; a < 2; ++a)
#pragma unroll
        for (int b = 0; b < 2; ++b)
#pragma unroll
            for (int m = 0; m < 4; ++m)
#pragma unroll
                for (int n = 0; n < 2; ++n) acc[a][b][m][n] = (f32x4){0.f, 0.f, 0.f, 0.f};
    h16x8 At[4][2], B0[2][2], B1[2][2];
    int ldA = cs.lda, ldB = cs.K;
    size_t hA = (size_t)HALF * ldA * 2, hB = (size_t)HALF * ldB * 2;
    const char* cA = (const char*)cs.A + (size_t)cur.pm * 2 * hA; const char* cB = (const char*)cs.Bt + (size_t)cur.pn * 2 * hB;
    PG8_STAGE2(PG8_SB(0, 0), cB, rB2, ldB); PG8_STAGE2(PG8_SB(0, 1), cB + hB, rB2, ldB); PG8_STAGE2(PG8_SA(0, 0), cA, rA2, ldA); PG8_STAGE2(PG8_SA(0, 1), cA + hA, rA2, ldA);
    if (wr == 1) PG8_BAR;
    PG8_WAIT_V(2); PG8_BAR;
    PG8_STAGE2(PG8_SB(1, 0), cB + kstep, rB2, ldB); PG8_STAGE2(PG8_SA(1, 0), cA + kstep, rA2, ldA); PG8_STAGE2(PG8_SB(1, 1), cB + hB + kstep, rB2, ldB);
    PG8_WAIT_V(6); PG8_BAR;
    for (;;) {
        const bool has_next = ui + 1 < njobs;
        const Unit nxt = J.unit(has_next ? ui + 1 : ui); const Sub ns = J.sub(has_next ? ui + 1 : ui);
        const int nldA = has_next ? ns.lda : ldA, nldB = has_next ? ns.K : ldB;
        const size_t nhA = (size_t)HALF * nldA * 2, nhB = (size_t)HALF * nldB * 2;
        const char* nA = has_next ? (const char*)ns.A + (size_t)nxt.pm * 2 * nhA : cA; const char* nB = has_next ? (const char*)ns.Bt + (size_t)nxt.pn * 2 * nhB : cB;
        const int nt = cs.K / BK;
        for (int t = 0; t < nt; t += 2) {
            const bool last = (t == nt - 2);
            const char* a1 = cA + (size_t)(t + 1) * kstep;
            const char* a2 = last ? nA : cA + (size_t)(t + 2) * kstep; const char* b2 = last ? nB : cB + (size_t)(t + 2) * kstep;
            const char* a3 = a2 + kstep; const char* b3 = b2 + kstep;
            const int l2A = last ? nldA : ldA, l2B = last ? nldB : ldB; const size_t h2A = last ? nhA : hA, h2B = last ? nhB : hB;
            PG8_LDB(B0, 0, 0); PG8_LDB(B1, 0, 1); PG8_SCHED; PG8_LDA(At, 0, 0); PG8_STAGE2(PG8_SA(1, 1), a1 + hA, rA2, ldA);
            PG8_WAIT_V(8); PG8_WAIT_L(0); PG8_BAR; PG8_MMA(0, 0, At, B0); PG8_MMA(0, 1, At, B1); PG8_BAR; PG8_SCHED;
            PG8_LDA(At, 0, 1); PG8_STAGE2(PG8_SB(0, 0), b2, rB2, l2B); PG8_STAGE2(PG8_SB(0, 1), b2 + h2B, rB2, l2B); PG8_STAGE2(PG8_SA(0, 0), a2, rA2, l2A);
            PG8_WAIT_V(8); PG8_WAIT_L(0); PG8_BAR; PG8_MMA(1, 0, At, B0); PG8_MMA(1, 1, At, B1); PG8_BAR; PG8_SCHED;
            PG8_LDB(B0, 1, 0); PG8_LDB(B1, 1, 1); PG8_SCHED; PG8_LDA(At, 1, 0); PG8_STAGE2(PG8_SA(0, 1), a2 + h2A, rA2, l2A);
            PG8_WAIT_V(8); PG8_WAIT_L(0); PG8_BAR; PG8_MMA(0, 0, At, B0); PG8_MMA(0, 1, At, B1); PG8_BAR; PG8_SCHED;
            PG8_LDA(At, 1, 1); PG8_STAGE2(PG8_SB(1, 0), b3, rB2, l2B); PG8_STAGE2(PG8_SB(1, 1), b3 + h2B, rB2, l2B); PG8_STAGE2(PG8_SA(1, 0), a3, rA2, l2A);
            PG8_WAIT_V(8); PG8_WAIT_L(0); PG8_BAR; PG8_MMA(1, 0, At, B0); PG8_MMA(1, 1, At, B1); PG8_BAR; PG8_SCHED;
        }
        if (wr == 0) PG8_BAR;
        E(acc, cur, cs.kind, wr, wc, fr, fq);
        if (!has_next) break;
#pragma unroll
        for (int a = 0; a < 2; ++a)
#pragma unroll
            for (int b = 0; b < 2; ++b)
#pragma unroll
                for (int m = 0; m < 4; ++m)
#pragma unroll
                    for (int n = 0; n < 2; ++n) acc[a][b][m][n] = (f32x4){0.f, 0.f, 0.f, 0.f};
        cur = nxt; cs = ns; cA = nA; cB = nB; ldA = nldA; ldB = nldB; hA = nhA; hB = nhB; ++ui;
        if (wr == 1) PG8_BAR;
    }
    PG8_WAIT_V(0);
    PG8_BAR;
#undef PG8_SA
#undef PG8_SB
#undef PG8_STAGE2
#undef PG8_LDA
#undef PG8_LDB
#undef PG8_MMA
#undef PG8_WAIT_V
#undef PG8_WAIT_L
#undef PG8_BAR
#undef PG8_SCHED
}
struct GateMergeJobs {
    StaticOrder S; const unsigned char* ws;
    __device__ __forceinline__ int count() const { int n = 0; Unit u; while (S.next(n, u)) ++n; return 6 * n; }
    __device__ __forceinline__ Unit unit(int i) const { Unit u; u.pm = 0; u.pn = 0; (void)S.next(i / 6, u); return u; }
    __device__ __forceinline__ Sub sub(int i) const {
        const int k = i % 6, br = k >> 1; const bool gate = (k & 1) == 0; Sub sb;
        const size_t a_off = gate ? WS_H : WS_ZU + (br == 0 ? ZU_OA : (br == 1 ? ZU_OB : ZU_OC));
        const size_t b_off = WS_W + (gate ? W_IN + ((size_t)NMAIN + (size_t)br * 1024) * DM * 2 : (br == 0 ? W_OA : (br == 1 ? W_OB : W_OC)));
        sb.A = (const h16*)(ws + a_off); sb.Bt = (const h16*)(ws + b_off);
        sb.K = (gate || br == 0) ? 1024 : 512; sb.lda = sb.K; sb.kind = gate ? (br << 4) : (br == 0 ? 1 : 2);
        return sb;
    }
};
}

constexpr int NWAVES = 8, NTHREADS = 512;

typedef GAS unsigned gu32;
#define RLX_AGENT __ATOMIC_RELAXED, __HIP_MEMORY_SCOPE_AGENT
#define LDS_WAIT() asm volatile("s_waitcnt lgkmcnt(0)" ::: "memory")
#define VM_WAIT() asm volatile("s_waitcnt vmcnt(0)" ::: "memory")

#define XB_TMO      128
#define XB_XCNT(j)  (256  + 64 * (j))
#define XB_XSUB(j)  (1280 + 64 * (j))
#define XB_XGEN(j)  (2304 + 64 * (j))
#define XB_TOP      3328
#define XB_TOPGEN   3392
#define XCD_BAR_WORDS 3456
#define XB_SPIN_CAP (1u << 18)
__device__ __forceinline__ unsigned xb_ld(unsigned* p)              { return __hip_atomic_load(p, __ATOMIC_RELAXED, __HIP_MEMORY_SCOPE_AGENT); }
__device__ __forceinline__ unsigned xb_add(unsigned* p, unsigned v) { return __hip_atomic_fetch_add(p, v, __ATOMIC_RELAXED, __HIP_MEMORY_SCOPE_AGENT); }
__device__ __forceinline__ unsigned xb_xcc_id() { return (unsigned)__builtin_amdgcn_s_getreg((3 << 11) | 20) & 0xFu; }
#define XB_SPIN(cond, bar) do { unsigned _sp = 0; while (cond) { __builtin_amdgcn_s_sleep(1); \
    if ((++_sp & 255u) == 0u) { if (xb_ld(&(bar)[XB_TMO])) break; if (_sp > XB_SPIN_CAP) { atomicAdd(&(bar)[XB_TMO], 1u); break; } } } } while (0)
struct XcdBarrier { unsigned* bar; unsigned x; volatile LAS unsigned* st; };
__device__ __forceinline__ XcdBarrier xcd_barrier_post(unsigned* bar, volatile LAS unsigned* st) {
    XcdBarrier b; b.bar = bar; b.x = xb_xcc_id(); b.st = st;
    if (threadIdx.x == 0) (void)xb_add(&bar[XB_XCNT(b.x)], 1u);
    return b;
}
__device__ __forceinline__ void xcd_barrier_complete(unsigned* bar, unsigned x, unsigned& nloc, unsigned& nx) {
    const unsigned G = gridDim.x * gridDim.y * gridDim.z;
    unsigned sum, cnt, mine, sp = 0u;
    for (;;) {
        sum = 0u; cnt = 0u; mine = 0u;
#pragma unroll
        for (unsigned j = 0; j < 16; ++j) { const unsigned c = xb_ld(&bar[XB_XCNT(j)]); sum += c; cnt += (c > 0u) ? 1u : 0u; mine = (j == x) ? c : mine; }
        if (sum == G) break;
        __builtin_amdgcn_s_sleep(1);
        if ((++sp & 255u) == 0u) { if (xb_ld(&bar[XB_TMO])) break; if (sp > XB_SPIN_CAP) { atomicAdd(&bar[XB_TMO], 1u); break; } }
    }
    nloc = mine > 0u ? mine : 1u; nx = cnt > 0u ? cnt : 1u;
}
__device__ __forceinline__ void xcd_barrier(const XcdBarrier& b) {
    asm volatile("s_waitcnt vmcnt(0)" ::: "memory");
    __syncthreads();
    if (threadIdx.x == 0) {
        unsigned* bar = b.bar;
        __builtin_amdgcn_s_waitcnt(0);
        unsigned nloc = b.st[0], nx = b.st[1];
        if (nloc == 0u) { xcd_barrier_complete(bar, b.x, nloc, nx); b.st[0] = nloc; b.st[1] = nx; }
        const unsigned old = xb_add(&bar[XB_XSUB(b.x)], 1u);
        const unsigned gen = old / nloc;
        if (old + 1u == (gen + 1u) * nloc) {
            __builtin_amdgcn_fence(__ATOMIC_RELEASE, "agent");
            asm volatile("s_waitcnt vmcnt(0)" ::: "memory");
            const unsigned og = xb_add(&bar[XB_TOP], 1u);
            const unsigned tg = og / nx;
            if (og + 1u == (tg + 1u) * nx) xb_add(&bar[XB_TOPGEN], 1u);
            else XB_SPIN(xb_ld(&bar[XB_TOPGEN]) == tg, bar);
            __builtin_amdgcn_fence(__ATOMIC_ACQUIRE, "agent");
            xb_add(&bar[XB_XGEN(b.x)], 1u);
            asm volatile("s_waitcnt vmcnt(0)" ::: "memory");
        } else {
            XB_SPIN(xb_ld(&bar[XB_XGEN(b.x)]) == gen, bar);
            __builtin_amdgcn_fence(__ATOMIC_ACQUIRE, "agent");
            asm volatile("s_waitcnt vmcnt(0)" ::: "memory");
        }
    }
    __syncthreads();
}
constexpr int CW_BAR = 4096;
static_assert((CW_BAR + XCD_BAR_WORDS) * 4 <= (int)CTL_ZERO_BYTES, "ctl");

struct Args {
    const float* in[33]; float* out; unsigned char* ws; int ph_lo, ph_hi;
};
typedef const GAS float* cfp_t;
struct Frame {
    LAS unsigned char* lds;
    int tid, lane, wave, vcu, G, bid, vcu0, G0;
    const __attribute__((address_space(4))) cfp_t* in; float* out; unsigned char* ws; float* out0; unsigned char* ws0;
    __device__ __forceinline__ const float* inp(int i) const { return (const float*)in[i]; }
    __device__ __forceinline__ void refresh() { int t = threadIdx.x; asm volatile("" : "+v"(t)); tid = t; lane = t & 63; wave = __builtin_amdgcn_readfirstlane(t >> 6);
        { int b_ = blockIdx.x, v_ = vcu0, g_ = G0; asm volatile("" : "+s"(b_), "+s"(v_), "+s"(g_)); bid = b_; vcu = v_; G = g_; }
        const __attribute__((address_space(4))) cfp_t* p = (const __attribute__((address_space(4))) cfp_t*)__builtin_amdgcn_kernarg_segment_ptr(); asm volatile("" : "+s"(p)); in = p;
        GAS float* o_ = (GAS float*)out0; GAS unsigned char* w_ = (GAS unsigned char*)ws0; asm volatile("" : "+s"(o_), "+s"(w_)); out = (float*)o_; ws = (unsigned char*)w_; }
};
enum { I_XP = 0, I_XS, I_C, I_CKB, I_CVB, I_CKC, I_CVC, I_STATE, I_CCTX, I_N1G, I_N2G, I_WMOD, I_BMOD, I_WIN, I_LCW, I_LCB, I_LWA, I_LBA, I_LWX, I_LBX, I_LAM,
       I_QNG, I_KNG, I_SINK, I_WOA, I_WOB, I_WOC, I_WOUT, I_WUP, I_FCW, I_FCB, I_WDOWN, I_FING };

__device__ __forceinline__ void transpose_item(const float* W, int K, int N, h16* WT, LAS float* scr, int item, int lane, bool upmap = false) {
    const int nblk = N / 32, kb = item / nblk, nb = item % nblk, k0 = 64 * kb, n0 = 32 * nb;
    const int d0 = !upmap ? n0 : (n0 < DFF ? (n0 / 128) * 256 + n0 % 128 : ((n0 - DFF) / 128) * 256 + 128 + (n0 - DFF) % 128);
    f32x4 v[8];
#pragma unroll
    for (int i = 0; i < 8; ++i) v[i] = *(const f32x4*)(W + (size_t)(k0 + 8 * i + (lane >> 3)) * N + n0 + 4 * (lane & 7));
#pragma unroll
    for (int i = 0; i < 8; ++i) { LAS float* d = scr + (8 * i + (lane >> 3)) * 33 + 4 * (lane & 7); d[0] = v[i].x; d[1] = v[i].y; d[2] = v[i].z; d[3] = v[i].w; }
    LDS_WAIT(); asm volatile("" ::: "memory");
    const int c = lane & 7;
#pragma unroll
    for (int j = 0; j < 4; ++j) { const int n = (lane >> 3) + 8 * j; const LAS float* sp = scr + (8 * c) * 33 + n;
        u32x4 o; o.x = pk_h2(sp[0 * 33], sp[1 * 33]); o.y = pk_h2(sp[2 * 33], sp[3 * 33]); o.z = pk_h2(sp[4 * 33], sp[5 * 33]); o.w = pk_h2(sp[6 * 33], sp[7 * 33]);
        *(u32x4*)(WT + (size_t)(d0 + n) * K + k0 + 8 * c) = o; }
    LDS_WAIT(); asm volatile("" ::: "memory");
}
__device__ __forceinline__ void phase_convert_weights(Frame& F, int l) {
    LAS float* scr = (LAS float*)(F.lds + F.wave * 16384);
    const int gw = F.vcu * NWAVES + F.wave, NGW = F.G * NWAVES;
    unsigned char* wb = F.ws + WS_W;
    constexpr int IT_IN = (DM / 64) * (DIN / 32), IT_OA = (1024 / 64) * (DM / 32), IT_OB = (512 / 64) * (DM / 32), IT_OUT = (DM / 64) * (DM / 32),
                  IT_UP = (DM / 64) * (DUP / 32), IT_DOWN = (DFF / 64) * (DM / 32), IT_LRU1 = (128 / 64) * (128 / 32), IT_LRU = 32 * IT_LRU1;
    constexpr int NITEMS = IT_IN + IT_OA + 2 * IT_OB + IT_OUT + IT_UP + IT_DOWN + IT_LRU;
    for (int it = gw; it < NITEMS; it += NGW) {
        int r = it;
        if (r < IT_IN) { transpose_item(F.inp(I_WIN) + (size_t)l * DM * DIN, DM, DIN, (h16*)(wb + W_IN), scr, r, F.lane); continue; } r -= IT_IN;
        if (r < IT_OA) { transpose_item(F.inp(I_WOA) + (size_t)l * 1024 * DM, 1024, DM, (h16*)(wb + W_OA), scr, r, F.lane); continue; } r -= IT_OA;
        if (r < IT_OB) { transpose_item(F.inp(I_WOB) + (size_t)l * 512 * DM, 512, DM, (h16*)(wb + W_OB), scr, r, F.lane); continue; } r -= IT_OB;
        if (r < IT_OB) { transpose_item(F.inp(I_WOC) + (size_t)l * 512 * DM, 512, DM, (h16*)(wb + W_OC), scr, r, F.lane); continue; } r -= IT_OB;
        if (r < IT_OUT) { transpose_item(F.inp(I_WOUT) + (size_t)l * DM * DM, DM, DM, (h16*)(wb + W_OUT), scr, r, F.lane); continue; } r -= IT_OUT;
        if (r < IT_UP) { transpose_item(F.inp(I_WUP) + (size_t)l * DM * DUP, DM, DUP, (h16*)(wb + W_UP), scr, r, F.lane, true); continue; } r -= IT_UP;
        if (r < IT_DOWN) { transpose_item(F.inp(I_WDOWN) + (size_t)l * DFF * DM, DFF, DM, (h16*)(wb + W_DOWN), scr, r, F.lane); continue; } r -= IT_DOWN;
        {
            const int mi = r / IT_LRU1, sub = r % IT_LRU1, dir = mi >> 4, gate = (mi >> 3) & 1, n = mi & 7;
            const float* src = (gate ? F.inp(I_LWX) : F.inp(I_LWA)) + ((size_t)((l * 2 + dir) * 8 + n)) * 128 * 128;
            transpose_item(src, 128, 128, (h16*)(wb + W_LRU) + (size_t)mi * 128 * 128, scr, sub, F.lane);
        }
    }
}
__device__ __forceinline__ void phase_prep_misc(Frame& F) {
    LAS float* sil = (LAS float*)F.lds;
    LAS float* part = (LAS float*)(F.lds + 16384);
    float* mod = (float*)(F.ws + WS_MOD);
    for (int item = F.vcu; item < 192; item += F.G) {
        const int l = item / 96, n0 = (item % 96) * 64;
        __syncthreads();
        for (int i = F.tid; i < 3 * 1024; i += NTHREADS) { const int j = i >> 10, k = i & 1023;
            const float v = j == 0 ? F.inp(I_CCTX)[k] : F.inp(I_C)[(j - 1) * 1024 + k]; sil[i] = v * sigmoidf_(v); }
        __syncthreads();
        const float* wp = F.inp(I_WMOD) + (size_t)l * DM * 6144 + n0 + F.lane;
        float a0 = 0.f, a1 = 0.f, a2 = 0.f;
        const int kb = F.wave * 128;
#pragma unroll 8
        for (int k = 0; k < 128; ++k) { const float w = wp[(size_t)(kb + k) * 6144]; a0 += w * sil[kb + k]; a1 += w * sil[1024 + kb + k]; a2 += w * sil[2048 + kb + k]; }
        part[(F.wave * 3 + 0) * 64 + F.lane] = a0; part[(F.wave * 3 + 1) * 64 + F.lane] = a1; part[(F.wave * 3 + 2) * 64 + F.lane] = a2;
        __syncthreads();
        if (F.tid < 192) { const int j = F.tid >> 6, c = F.tid & 63; float s = F.inp(I_BMOD)[l * 6144 + n0 + c];
#pragma unroll
            for (int w = 0; w < 8; ++w) s += part[(w * 3 + j) * 64 + c];
            mod[((size_t)l * 3 + j) * 6144 + n0 + c] = s; }
    }
    __syncthreads();
    const int gt = F.vcu * NTHREADS + F.tid, NGT = F.G * NTHREADS;
    float* rope = (float*)(F.ws + WS_ROPE);
    for (int i = gt; i < 64 * 16; i += NGT) { const int pos = i >> 4, fi = i & 15; const float inv = expf(-(float)fi * (1.0f / 16.0f) * 9.210340371976184f);
        const float ang = (float)pos * inv; rope[2 * i] = cosf(ang); rope[2 * i + 1] = sinf(ang); }
    h16* cache = (h16*)(F.ws + WS_CACHE);
    for (int i = gt; i < 4 * 131072 / 4; i += NGT) { const int kind = i / 32768, e = (i % 32768) * 4;
        const float* src = kind == 0 ? F.inp(I_CKB) : kind == 1 ? F.inp(I_CVB) : kind == 2 ? F.inp(I_CKC) : F.inp(I_CVC);
        const f32x4 v = *(const f32x4*)(src + e); u32x2 w; w.x = pk_h2(v[0], v[1]); w.y = pk_h2(v[2], v[3]); *(u32x2*)(cache + (size_t)kind * 131072 + e) = w; }
}

__device__ __forceinline__ const float* xrow_ptr(const Frame& F, int layer_src_is_input, int row) {
    if (layer_src_is_input) return row < NCTX ? F.inp(I_XP) + (size_t)row * DM : F.inp(I_XS) + (size_t)(row - NCTX) * DM;
    return F.out + O_Y + (size_t)row * DM;
}
__device__ __forceinline__ void phase_norm0(Frame& F, const float* g, const float* mod_l, float* ss) {
    const int gw = F.vcu * NWAVES + F.wave, NGW = F.G * NWAVES;
    h16* H = (h16*)(F.ws + WS_H);
    for (int grp = gw; grp < NTOK / 4; grp += NGW) {
        const int row0 = grp * 4;
        const int cond = row0 < NCTX ? 0 : (row0 < NCTX + LSEQ ? 1 : 2);
        const float* mp = mod_l + (size_t)cond * 6144;
        f32x4 v[4][4];
#pragma unroll
        for (int i = 0; i < 4; ++i) { const f32x4* xr = (const f32x4*)xrow_ptr(F, 1, row0 + i) + F.lane;
#pragma unroll
            for (int j = 0; j < 4; ++j) v[i][j] = xr[64 * j]; }
        f32x4 gs[4];
#pragma unroll
        for (int j = 0; j < 4; ++j) { const int c = F.lane * 4 + 256 * j; gs[j] = *(const f32x4*)(g + c) * (*(const f32x4*)(mp + 1024 + c) + 1.0f); }
#pragma unroll
        for (int i = 0; i < 4; ++i) {
            float sq = 0.f;
#pragma unroll
            for (int j = 0; j < 4; ++j) sq += (v[i][j].x * v[i][j].x + v[i][j].y * v[i][j].y) + (v[i][j].z * v[i][j].z + v[i][j].w * v[i][j].w);
            sq = wave_sum(sq);
            if (F.lane == 0) ss[row0 + i] = sq;
            u32x2* o8 = (u32x2*)(H + (size_t)(row0 + i) * DM) + F.lane;
#pragma unroll
            for (int j = 0; j < 4; ++j) { const f32x4 y = v[i][j] * gs[j]; u32x2 w; w.x = pk_h2(y.x, y.y); w.y = pk_h2(y.z, y.w); o8[64 * j] = w; }
        }
    }
}
__device__ __forceinline__ void phase_cvec(Frame& F, int l) {
    const int gw = F.vcu * NWAVES + F.wave, NGW = F.G * NWAVES, lane = F.lane;
    const float* mod_l = (const float*)(F.ws + WS_MOD) + (size_t)l * 3 * 6144;
    float* cv = (float*)(F.ws + WS_CV) + (size_t)l * 3 * (DIN + DUP);
    for (int kind = 0; kind < 2; ++kind) {
        const int N = kind == 0 ? DIN : DUP, sc = kind == 0 ? 0 : 3;
        const h16* Wt = (const h16*)(F.ws + WS_W + (kind == 0 ? W_IN : W_UP));
        float sh[3][16];
#pragma unroll
        for (int c = 0; c < 3; ++c)
#pragma unroll
            for (int j = 0; j < 2; ++j)
#pragma unroll
                for (int e = 0; e < 8; ++e) sh[c][8 * j + e] = mod_l[(size_t)c * 6144 + sc * 1024 + 8 * lane + 512 * j + e];
        for (int n0 = gw * 4; n0 < N; n0 += NGW * 4) {
            u32x4 raw[4][2];
#pragma unroll
            for (int i = 0; i < 4; ++i) { raw[i][0] = *(const u32x4*)(Wt + (size_t)(n0 + i) * DM + 8 * lane); raw[i][1] = *(const u32x4*)(Wt + (size_t)(n0 + i) * DM + 512 + 8 * lane); }
#pragma unroll
            for (int i = 0; i < 4; ++i) {
                float w[16]; unpack8(raw[i][0], w); unpack8(raw[i][1], w + 8);
                float a0 = 0.f, a1 = 0.f, a2 = 0.f;
#pragma unroll
                for (int e = 0; e < 16; ++e) { a0 += w[e] * sh[0][e]; a1 += w[e] * sh[1][e]; a2 += w[e] * sh[2][e]; }
                a0 = wave_sum(a0); a1 = wave_sum(a1); a2 = wave_sum(a2);
                if (lane == 0) { float* o = cv + (kind == 0 ? 0 : DIN) + n0 + i; o[0] = a0; o[DIN + DUP] = a1; o[2 * (DIN + DUP)] = a2; }
            }
        }
    }
}
__device__ __forceinline__ void phase_final_norm(Frame& F) {
    const int gw = F.vcu * NWAVES + F.wave, NGW = F.G * NWAVES;
    f32x4 gg[4];
#pragma unroll
    for (int j = 0; j < 4; ++j) gg[j] = *(const f32x4*)(F.inp(I_FING) + F.lane * 4 + 256 * j);
    for (int grp = gw; grp < NTOK / 4; grp += NGW) {
        const int row0 = grp * 4;
        f32x4 v[4][4];
#pragma unroll
        for (int i = 0; i < 4; ++i) { const f32x4* xr = (const f32x4*)(F.out + O_Y + (size_t)(row0 + i) * DM) + F.lane;
#pragma unroll
            for (int j = 0; j < 4; ++j) v[i][j] = xr[64 * j]; }
#pragma unroll
        for (int i = 0; i < 4; ++i) {
            float s = 0.f;
#pragma unroll
            for (int j = 0; j < 4; ++j) s += (v[i][j].x * v[i][j].x + v[i][j].y * v[i][j].y) + (v[i][j].z * v[i][j].z + v[i][j].w * v[i][j].w);
            const float rstd = 1.0f / sqrtf(wave_sum(s) * (1.0f / DM) + NORM_EPS);
            f32x4* xo = (f32x4*)(F.out + O_Y + (size_t)(row0 + i) * DM) + F.lane;
#pragma unroll
            for (int j = 0; j < 4; ++j) xo[64 * j] = v[i][j] * rstd * gg[j];
        }
    }
}

__device__ __forceinline__ void phase_qk(Frame& F, int l, bool write_out = true) {
    const int gw = F.vcu * NWAVES + F.wave, NGW = F.G * NWAVES, lane = F.lane;
    h16* Z = (h16*)(F.ws + WS_ZU);
    const float* rope = (const float*)(F.ws + WS_ROPE);
    const float* qg = F.inp(I_QNG) + l * 64; const float* kg = F.inp(I_KNG) + l * 64;
    const int hl = lane & 7, hc0 = hl * 8;
    float qgv[8], kgv[8];
#pragma unroll
    for (int j = 0; j < 8; ++j) { qgv[j] = qg[hc0 + j]; kgv[j] = kg[hc0 + j]; }
    for (int row = gw; row < NTOK; row += NGW) {
        const bool is_ctx = row < NCTX;
        int rpos = 0, cpos = 0, b = 0, t = 0;
        if (is_ctx) { b = row >> 8; t = row & 255; } else { const int tt = (row - NCTX) & (LSEQ - 1); rpos = tt >> 6; cpos = tt & 63; }
        h16* zr = Z + (size_t)row * NMAIN;
#pragma unroll
        for (int pass = 0; pass < 3; ++pass) {
            const int col = C_QB + pass * 512 + lane * 8;
            int kind;
            if (pass == 0) kind = 0; else if (pass == 1) kind = lane < 8 * 2 ? 1 : (lane < 8 * 4 ? 2 : 3); else kind = lane < 32 ? 3 : (lane < 48 ? 4 : 5);
            const u32x4 w = *(const u32x4*)(zr + col);
            float x[8]; unpack8(w, x);
            if (kind <= 1) {
                float s = 0.f;
#pragma unroll
                for (int j = 0; j < 8; ++j) s += x[j] * x[j];
                s = sum8(s);
                const float rstd = 1.0f / sqrtf(s * (1.0f / 64.0f) + NORM_EPS);
#pragma unroll
                for (int j = 0; j < 8; ++j) x[j] = x[j] * rstd * (kind == 0 ? qgv[j] : kgv[j]);
            }
            if (!is_ctx) {
                float p[8];
#pragma unroll
                for (int j = 0; j < 8; ++j) p[j] = __shfl_xor(x[j], 2);
                if (kind == 0 || kind == 1 || kind == 3 || kind == 4) {
                    const int half = hl >> 2, second = (hl >> 1) & 1, f0 = (hl & 1) * 8, pos = half ? cpos : rpos;
                    const float* tp = rope + ((size_t)pos * 16 + f0) * 2;
#pragma unroll
                    for (int j = 0; j < 8; ++j) { const float cs = tp[2 * j], sn = tp[2 * j + 1]; x[j] = second ? (p[j] * sn + x[j] * cs) : (x[j] * cs - p[j] * sn); }
                }
            }
            if (kind == 0 || kind == 3) {
#pragma unroll
                for (int j = 0; j < 8; ++j) x[j] *= QSCALE;
            }
            if (kind != 2 && kind != 5) *(u32x4*)(zr + col) = pack8(x);
            if (write_out && is_ctx && (kind == 1 || kind == 2 || kind == 4 || kind == 5)) {
                const size_t ob = kind == 1 ? O_KB : kind == 2 ? O_VB : kind == 4 ? O_KC : O_VC;
                const int c128 = (kind == 1 || kind == 2) ? (col - (kind == 1 ? C_KB : C_VB)) : (col - (kind == 4 ? C_KC : C_VC));
                float* op = F.out + ob + ((size_t)((b * 2 + l) * 256 + t)) * 128 + c128;
                *(f32x4*)op = (f32x4){x[0], x[1], x[2], x[3]}; *(f32x4*)(op + 4) = (f32x4){x[4], x[5], x[6], x[7]};
            }
        }
    }
}

__device__ __forceinline__ int img_off(int row, int ch) { return row * 256 + ((((ch >> 3) ^ (row & 15)) << 4) | ((ch & 7) << 1)); }
template <int MODE, int DIR>
__device__ __forceinline__ void lru_scan(Frame& F, int l, int row0, int n, int lat_b, int lat_chunk, int ctx_b, bool write_out, int cb) {
    LAS unsigned char* img = F.lds; LAS unsigned char* hx = F.lds + 65536;
    const int lane = F.lane, r32 = lane & 31, hi = lane >> 5, hm = hi ^ DIR;
    const int C = n * 128 + cb * 32 + r32;
    h16x8 Br[8], Bi[8];
    if (MODE != 3) {
        const h16* wr_ = (const h16*)(F.ws + WS_W + W_LRU) + ((size_t)((DIR * 2 + 0) * 8 + n) * 128 + cb * 32 + r32) * 128 + 8 * hi;
        const h16* wi_ = (const h16*)(F.ws + WS_W + W_LRU) + ((size_t)((DIR * 2 + 1) * 8 + n) * 128 + cb * 32 + r32) * 128 + 8 * hi;
#pragma unroll
        for (int ks = 0; ks < 8; ++ks) { Br[ks] = *(const h16x8*)(wr_ + 16 * ks); Bi[ks] = *(const h16x8*)(wi_ + 16 * ks); }
    }
    float k8 = 0.f, nba = 0.f, nbx = 0.f;
    if (MODE != 3) {
        const float ba = F.inp(I_LBA)[(size_t)(l * 2 + DIR) * DLRU + C], bx = F.inp(I_LBX)[(size_t)(l * 2 + DIR) * DLRU + C];
        const float lam = F.inp(I_LAM)[(size_t)(l * 2 + DIR) * DLRU + C];
        const float sp = (-lam > 20.f) ? -lam : log1pf(expf(-lam));
        k8 = -8.0f * sp * LOG2E;
        nba = -LOG2E * ba; nbx = -LOG2E * bx;
    }
    u32x4* stash_u = (u32x4*)(F.ws + WS_STASH) + (size_t)(((lat_b * 2 + DIR) * 16 + lat_chunk) * 8) * (DLRU * 2 * 4);
    const unsigned sl = (unsigned)((C * 2 + hi) * 4);
    unsigned nxt[16];
    if (MODE == 3) { const int rb0 = DIR == 0 ? 0 : 7;
#pragma unroll
        for (int q = 0; q < 4; ++q) { const u32x4 t = stash_u[(size_t)rb0 * (DLRU * 2 * 4) + sl + q]; nxt[4 * q] = t.x; nxt[4 * q + 1] = t.y; nxt[4 * q + 2] = t.z; nxt[4 * q + 3] = t.w; } }
    float H = 0.f, aggP = 1.f;
    if (MODE == 2 || MODE == 3) {
        const float* agg = (const float*)(F.ws + WS_AGG);
        H = F.inp(I_STATE)[(size_t)((lat_b * 2 + l) * 2 + DIR) * DLRU + C];
        float ap[15], au[15];
#pragma unroll
        for (int k = 0; k < 15; ++k) { const int ch = DIR == 0 ? k : 15 - k; const bool use = DIR == 0 ? (ch < lat_chunk) : (ch > lat_chunk);
            const float* p = agg + ((size_t)((lat_b * 16 + (use ? ch : 0)) * 2 + DIR) * DLRU + C) * 2; ap[k] = use ? p[0] : 1.f; au[k] = use ? p[1] : 0.f; }
#pragma unroll
        for (int k = 0; k < 15; ++k) H = ap[k] * H + au[k];
    }
    const int xch = cb * 4 + (r32 >> 3), xel = (r32 & 7) * 2;
    int lo8[8];
#pragma unroll
    for (int ci = 0; ci < 8; ++ci) { const int c = (ci & 3) + 8 * (ci >> 2); lo8[ci] = (((xch ^ (4 * hi)) ^ c) << 4) + xel + (4 * hi) * 256; }
#define LOFF(rn) (lo8s[((rn) & 3) + 4 * (((rn) >> 2) & 1)] + (8 * ((rn) >> 2) + ((rn) & 3)) * 256)
#pragma unroll 1
    for (int step = 0; step < 8; ++step) {
        if (step == 4) __syncthreads();
        const int rb = DIR == 0 ? step : 7 - step;
        int lo8s[8];
#pragma unroll
        for (int ci = 0; ci < 8; ++ci) lo8s[ci] = lo8[ci] + rb * 8192;
        float an[16], un[16];
        if (MODE == 3) {
#pragma unroll
            for (int r = 0; r < 16; ++r) { const h16x2 w = __builtin_bit_cast(h16x2, nxt[r]); an[r] = fast_exp2((float)w[0]); un[r] = (float)w[1]; }
            if (step < 7) { const int rbn = DIR == 0 ? step + 1 : 6 - step;
#pragma unroll
                for (int q = 0; q < 4; ++q) { const u32x4 t = stash_u[(size_t)rbn * (DLRU * 2 * 4) + sl + q]; nxt[4 * q] = t.x; nxt[4 * q + 1] = t.y; nxt[4 * q + 2] = t.z; nxt[4 * q + 3] = t.w; } }
        } else {
        unsigned sw[16];
        f32x16 ar = {}, ai = {};
#pragma unroll
        for (int ks = 0; ks < 8; ++ks) {
            const h16x8 af = *(const LAS h16x8*)(img + (rb * 32 + r32) * 256 + (((2 * ks + hi) ^ (r32 & 15)) << 4));
            ar = __builtin_amdgcn_mfma_f32_32x32x16_f16(af, Br[ks], ar, 0, 0, 0);
            ai = __builtin_amdgcn_mfma_f32_32x32x16_f16(af, Bi[ks], ai, 0, 0, 0);
        }
#pragma unroll
        for (int r = 0; r < 16; ++r) {
            const float xv = (float)*(const LAS h16*)(img + LOFF(r));
            const float d1 = 1.0f + fast_exp2(__builtin_fmaf(ar[r], -LOG2E, nba)), d2 = 1.0f + fast_exp2(__builtin_fmaf(ai[r], -LOG2E, nbx));
            const float R = fast_rcp(d1 * d2);
            const float rr = R * d2, ii = R * d1;
            const float e2 = k8 * rr;
            const float av = fast_exp2(e2);
            an[r] = av;
            un[r] = __builtin_amdgcn_sqrtf(__builtin_fmaf(-av, av, 1.0f)) * (ii * xv);
            if (MODE == 1) sw[r] = pk_h2(e2, un[r]);
        }
        if (MODE == 1) {
#pragma unroll
            for (int q = 0; q < 4; ++q) stash_u[(size_t)rb * (DLRU * 2 * 4) + sl + q] = (u32x4){sw[4 * q], sw[4 * q + 1], sw[4 * q + 2], sw[4 * q + 3]}; }
        }
#define SA(r) (DIR ? an[15 - (r)] : an[(r)])
#define SU(r) (DIR ? un[15 - (r)] : un[(r)])
        float Pe[4], Ue[4], Po[4], Uo[4];
#pragma unroll
        for (int g = 0; g < 4; ++g) {
            float p = 1.f, uu = 0.f;
#pragma unroll
            for (int i = 0; i < 4; ++i) { uu = SA(4 * g + i) * uu + SU(4 * g + i); p *= SA(4 * g + i); }
            const auto sp_ = __builtin_amdgcn_permlane32_swap(__float_as_uint(p), __float_as_uint(p), false, false);
            const auto su_ = __builtin_amdgcn_permlane32_swap(__float_as_uint(uu), __float_as_uint(uu), false, false);
            Pe[g] = __uint_as_float(sp_[DIR]); Po[g] = __uint_as_float(sp_[1 - DIR]); Ue[g] = __uint_as_float(su_[DIR]); Uo[g] = __uint_as_float(su_[1 - DIR]);
        }
        float Hs[4];
        {
            float h = H;
#pragma unroll
            for (int g = 0; g < 4; ++g) { const float he = h; h = Pe[g] * h + Ue[g]; const float ho = h; h = Po[g] * h + Uo[g]; Hs[g] = hm ? ho : he; }
            H = h;
        }
        if (MODE == 1) { float p = 1.f;
#pragma unroll
            for (int g = 0; g < 4; ++g) p *= Pe[g] * Po[g];
            aggP *= p; }
        if (MODE != 1) {
#pragma unroll
            for (int g = 0; g < 4; ++g) { float h = Hs[g];
                float old[4];
#pragma unroll
                for (int i = 0; i < 4; ++i) old[i] = (float)*(const LAS h16*)(hx + LOFF(DIR ? 15 - (4 * g + i) : (4 * g + i)));
#pragma unroll
                for (int i = 0; i < 4; ++i) { const int r = 4 * g + i; h = SA(r) * h + SU(r);
                    const float o = step < 4 ? 0.f : old[i];
                    *(LAS h16*)(hx + LOFF(DIR ? 15 - r : r)) = (h16)(h + o); } }
        }
#undef SA
#undef SU
    }
#undef LOFF
    if (MODE == 0 && hi == 0 && write_out) F.out[O_LRU + (size_t)((ctx_b * 2 + l) * 2 + DIR) * DLRU + C] = H;
    if (MODE == 1 && hi == 0) { float* agg = (float*)(F.ws + WS_AGG) + ((size_t)((lat_b * 16 + lat_chunk) * 2 + DIR) * DLRU + C) * 2; agg[0] = aggP; agg[1] = H; }
}
template <int MODE>
__device__ __forceinline__ void lru_unit(Frame& F, int l, int row0, int n, int seq_first, int seq_last, int lat_b, int lat_chunk, int ctx_b, bool write_out = true, int pv = 0) {
    LAS unsigned char* img = F.lds; LAS unsigned char* hx = F.lds + 65536;
    const h16* Z = (const h16*)(F.ws + WS_ZU);
    const int tid = F.tid;
    __syncthreads();
    if (MODE != 3 && !(pv & 1)) {
        const int cc = tid & 15, tg = tid >> 4; const int ch0 = n * 128 + cc * 8;
        float w0[8], w1[8], w2[8], w3[8], bb[8];
        const float* cw = F.inp(I_LCW) + (size_t)l * 4 * DLRU + ch0; const float* cb = F.inp(I_LCB) + (size_t)l * DLRU + ch0;
#pragma unroll
        for (int j = 0; j < 8; ++j) { w0[j] = cw[j]; w1[j] = cw[DLRU + j]; w2[j] = cw[2 * DLRU + j]; w3[j] = cw[3 * DLRU + j]; bb[j] = cb[j]; }
        const int t0 = tg * 8;
        u32x4 raw[11];
#pragma unroll
        for (int i = 0; i < 11; ++i) { const int t = t0 - 2 + i; const bool ok = (t >= 0 || !seq_first) && (t < 256 || !seq_last);
            const int tc = ok ? t : (t < 0 ? 0 : 255);
            const u32x4 v = *(const u32x4*)(Z + (size_t)(row0 + tc) * NMAIN + C_XA + ch0);
            raw[i].x = ok ? v.x : 0u; raw[i].y = ok ? v.y : 0u; raw[i].z = ok ? v.z : 0u; raw[i].w = ok ? v.w : 0u; }
        float xm2[8], xm1[8], x0[8], xp1[8];
        unpack8(raw[0], xm2); unpack8(raw[1], xm1); unpack8(raw[2], x0);
#pragma unroll
        for (int i = 0; i < 8; ++i) {
            unpack8(raw[3 + i], xp1);
            float y[8];
#pragma unroll
            for (int j = 0; j < 8; ++j) y[j] = bb[j] + w0[j] * xm2[j] + w1[j] * xm1[j] + w2[j] * x0[j] + w3[j] * xp1[j];
            *(LAS u32x4*)(img + img_off(t0 + i, cc * 8)) = pack8(y);
#pragma unroll
            for (int j = 0; j < 8; ++j) { xm2[j] = xm1[j]; xm1[j] = x0[j]; x0[j] = xp1[j]; }
        }
    }
    __syncthreads();
    const int dir = F.wave >> 2, cb = F.wave & 3;
    if (!(pv & 2)) {
    if (dir == 0) lru_scan<MODE, 0>(F, l, row0, n, lat_b, lat_chunk, ctx_b, write_out, cb);
    else          lru_scan<MODE, 1>(F, l, row0, n, lat_b, lat_chunk, ctx_b, write_out, cb);
    }
    if (MODE != 1 && !(pv & 4)) {
        __syncthreads();
        h16* OA = (h16*)(F.ws + WS_ZU + ZU_OA);
#pragma unroll
        for (int k = 0; k < 8; ++k) { const int i = tid + NTHREADS * k, tk = i >> 4, cc = i & 15;
            float hs[8], ya[8], o[8];
            unpack8(*(const LAS u32x4*)(hx + img_off(tk, cc * 8)), hs);
            unpack8(*(const u32x4*)(Z + (size_t)(row0 + tk) * NMAIN + C_YA + n * 128 + cc * 8), ya);
#pragma unroll
            for (int j = 0; j < 8; ++j) o[j] = hs[j] * gelu_tanh(ya[j]);
            *(u32x4*)(OA + (size_t)(row0 + tk) * 1024 + n * 128 + cc * 8) = pack8(o); }
    }
}

struct AttnDesc {
    const h16* Qz; h16* O;
    const h16* Kc; const h16* Vc;
    const h16* Kz; const h16* Vz;
    int nc, zt0, nz;
    int windowed;
    const float* sink;
    int kvh, q0;
};
__device__ __forceinline__ void attn_unit(Frame& F, const AttnDesc& D, const h16* Qrow0  , h16* Orow0  ) {
    LAS unsigned char* lds = F.lds;
    const int tid = F.tid, lane = F.lane, wave = F.wave, r32 = lane & 31, hi = lane >> 5;
    const int head = D.kvh * 4 + (wave >> 1);
    const int qpos = D.q0 + (wave & 1) * 32 + r32;
    const int NT = D.nc + D.nz;
    h16x8 qr[4];
    { const h16* qp = Qrow0 + (size_t)qpos * NMAIN + head * 64 + 8 * hi;
#pragma unroll
      for (int d0 = 0; d0 < 4; ++d0) qr[d0] = *(const h16x8*)(qp + 16 * d0); }
    const int krow = tid >> 3, kch = tid & 7; const int kdst = krow * 128 + ((kch ^ ((krow >> 1) & 7)) << 4);
    const int vrow = 16 * (wave & 3) + (lane >> 2), vcol = (wave >> 2) * 32 + (lane & 3) * 8; const int vdst = wave * 1024 + lane * 16;
    auto ktile_ptr = [&](int j, int row, int col, bool isV) -> const h16* {
        if (j < D.nc) return (isV ? D.Vc : D.Kc) + (size_t)(64 * j + row) * 128 + col;
        return (isV ? D.Vz : D.Kz) + (size_t)((D.zt0 + (j - D.nc)) * 64 + row) * NMAIN + col;
    };
    u32x4 kreg, vreg;
    kreg = *(const u32x4*)ktile_ptr(0, krow, kch * 8, false); vreg = *(const u32x4*)ktile_ptr(0, vrow, vcol, true);
    __syncthreads();
    *(LAS u32x4*)(lds + kdst) = kreg; *(LAS u32x4*)(lds + 16384 + vdst) = vreg;
    __syncthreads();
    float mhat, l_run;
    const bool has_sink = D.sink != nullptr;
    if (has_sink) { mhat = D.sink[head] * LOG2E; l_run = hi == 0 ? 1.f : 0.f; } else { mhat = 0.f; l_run = 0.f; }
    f32x16 negm;
#pragma unroll
    for (int r = 0; r < 16; ++r) negm[r] = -mhat;
    f32x16 o0 = {}, o1 = {};
    LAS float* wsf = (LAS float*)(lds + 32768) + wave * 64;
    const int kfoff = r32 * 128;
    const int ksw = (r32 >> 1) & 7;
    const int vp0 = ((lane >> 4) & 1) * 32 + (lane & 3) * 8 + (4 * hi + ((lane & 15) >> 2)) * 64;
#pragma unroll 1
    for (int j = 0; j < NT; ++j) {
        const int buf = j & 1;
        if (j + 1 < NT) { kreg = *(const u32x4*)ktile_ptr(j + 1, krow, kch * 8, false); vreg = *(const u32x4*)ktile_ptr(j + 1, vrow, vcol, true); }
        LAS unsigned char* Kb = lds + buf * 8192; LAS unsigned char* Vb = lds + 16384 + buf * 8192;
        f32x16 p0, p1;
#pragma unroll
        for (int d0 = 0; d0 < 4; ++d0) {
            const int co = ((2 * d0 + hi) ^ ksw) << 4;
            const h16x8 k0 = *(const LAS h16x8*)(Kb + kfoff + co);
            const h16x8 k1 = *(const LAS h16x8*)(Kb + 4096 + kfoff + co);
            p0 = __builtin_amdgcn_mfma_f32_32x32x16_f16(k0, qr[d0], d0 == 0 ? negm : p0, 0, 0, 0);
            p1 = __builtin_amdgcn_mfma_f32_32x32x16_f16(k1, qr[d0], d0 == 0 ? negm : p1, 0, 0, 0);
        }
        if (D.windowed && j >= D.nc) {
            const int kb0 = (D.zt0 + (j - D.nc)) * 64 + 4 * hi;
#pragma unroll
            for (int r = 0; r < 16; ++r) { const int kp = kb0 + (r & 3) + 8 * (r >> 2);
                const int d0_ = qpos - kp, d1_ = qpos - (kp + 32);
                if (d0_ > 128 || d0_ < -128) p0[r] = -1e30f;
                if (d1_ > 128 || d1_ < -128) p1[r] = -1e30f; }
        }
        if (j == 0) {
            float mx = fmaxf(p0[0], p1[0]);
#pragma unroll
            for (int r = 1; r < 16; ++r) mx = fmaxf(mx, fmaxf(p0[r], p1[r]));
            mx = fmaxf(mx, __shfl_xor(mx, 32));
            const float dl = has_sink ? fmaxf(mx, 0.f) : mx;
#pragma unroll
            for (int r = 0; r < 16; ++r) { p0[r] -= dl; p1[r] -= dl; }
            mhat += dl; if (has_sink) l_run *= fast_exp2(-dl);
#pragma unroll
            for (int r = 0; r < 16; ++r) negm[r] = -mhat;
        }
        float rs = 0.f;
#pragma unroll
        for (int r = 0; r < 16; ++r) { p0[r] = fast_exp2(p0[r]); p1[r] = fast_exp2(p1[r]); rs += p0[r] + p1[r]; }
        if (__builtin_expect(__any(rs > 256.f), 0)) {
            const float rsm = fmaxf(rs, __shfl_xor(rs, 32));
            const float dl = rsm > 256.f ? ceilf(__builtin_log2f(rsm)) : 0.f;
            const float f = fast_exp2(-dl);
#pragma unroll
            for (int r = 0; r < 16; ++r) { p0[r] *= f; p1[r] *= f; }
            rs *= f; l_run *= f; mhat += dl;
#pragma unroll
            for (int r = 0; r < 16; ++r) negm[r] = -mhat;
            if (hi == 0) wsf[r32] = f;
            LDS_WAIT();
#pragma unroll
            for (int r = 0; r < 16; ++r) { const float g = wsf[(r & 3) + 8 * (r >> 2) + 4 * hi]; o0[r] *= g; o1[r] *= g; }
        }
        l_run += rs;
        u32x4 pw[4];
        pw[0] = (u32x4){pk_h2(p0[0], p0[1]), pk_h2(p0[2], p0[3]), pk_h2(p0[4], p0[5]), pk_h2(p0[6], p0[7])};
        pw[1] = (u32x4){pk_h2(p0[8], p0[9]), pk_h2(p0[10], p0[11]), pk_h2(p0[12], p0[13]), pk_h2(p0[14], p0[15])};
        pw[2] = (u32x4){pk_h2(p1[0], p1[1]), pk_h2(p1[2], p1[3]), pk_h2(p1[4], p1[5]), pk_h2(p1[6], p1[7])};
        pw[3] = (u32x4){pk_h2(p1[8], p1[9]), pk_h2(p1[10], p1[11]), pk_h2(p1[12], p1[13]), pk_h2(p1[14], p1[15])};
#pragma unroll
        for (int ks = 0; ks < 4; ++ks) {
            const h16x8 pa = __builtin_bit_cast(h16x8, pw[ks]);
#pragma unroll
            for (int d0 = 0; d0 < 2; ++d0) {
                const s16x4 lo = __builtin_amdgcn_ds_read_tr16_b64_v4i16((LAS s16x4*)(Vb + vp0 + d0 * 4096 + ks * 1024));
                const s16x4 hh = __builtin_amdgcn_ds_read_tr16_b64_v4i16((LAS s16x4*)(Vb + vp0 + d0 * 4096 + ks * 1024 + 512));
                typedef short s16x8 __attribute__((ext_vector_type(8)));
                const s16x8 vv = {lo[0], lo[1], lo[2], lo[3], hh[0], hh[1], hh[2], hh[3]};
                const h16x8 vf = __builtin_bit_cast(h16x8, vv);
                if (d0 == 0) o0 = __builtin_amdgcn_mfma_f32_32x32x16_f16(pa, vf, o0, 0, 0, 0);
                else         o1 = __builtin_amdgcn_mfma_f32_32x32x16_f16(pa, vf, o1, 0, 0, 0);
            }
        }
        if (j + 1 < NT) { *(LAS u32x4*)(lds + (buf ^ 1) * 8192 + kdst) = kreg; *(LAS u32x4*)(lds + 16384 + (buf ^ 1) * 8192 + vdst) = vreg; }
        __syncthreads();
    }
    l_run += __shfl_xor(l_run, 32);
    if (hi == 0) wsf[32 + r32] = l_run;
    LDS_WAIT();
    h16* op = Orow0 + (size_t)(D.q0 + (wave & 1) * 32) * 512 + head * 64 + r32;
#pragma unroll
    for (int r = 0; r < 16; ++r) { const int q = (r & 3) + 8 * (r >> 2) + 4 * hi; const float rl = fast_rcp(wsf[32 + q]);
        op[(size_t)q * 512] = (h16)(o0[r] * rl); op[(size_t)q * 512 + 32] = (h16)(o1[r] * rl); }
}
__device__ __forceinline__ void attn_dispatch(Frame& F, int l, int type, int u) {
    const h16* Z = (const h16*)(F.ws + WS_ZU);
    const h16* cache = (const h16*)(F.ws + WS_CACHE);
    AttnDesc D; D.sink = nullptr; D.windowed = 0; D.Kc = nullptr; D.Vc = nullptr; D.nc = 0;
    const bool isC = type & 1;
    const int qcol = isC ? C_QC : C_QB, kcol = isC ? C_KC : C_KB, vcol = isC ? C_VC : C_VB;
    h16* Obase = (h16*)(F.ws + WS_ZU + (isC ? ZU_OC : ZU_OB));
    size_t row_seq0;
    if (type < 2) {
        const int b = u >> 7, kvh = (u >> 6) & 1, qb = u & 63;
        row_seq0 = (size_t)NCTX + (size_t)b * LSEQ; D.kvh = kvh; D.q0 = qb * 64;
        D.Kc = cache + ((size_t)(isC ? 2 : 0) * 131072) + (size_t)((b * 2 + l) * 256) * 128 + kvh * 64;
        D.Vc = cache + ((size_t)(isC ? 3 : 1) * 131072) + (size_t)((b * 2 + l) * 256) * 128 + kvh * 64;
        D.nc = 4;
        if (!isC) { D.zt0 = 0; D.nz = 64; }
        else { int lo = qb - 2; if (lo < 0) lo = 0; int hi_ = qb + 2; if (hi_ > 63) hi_ = 63; D.zt0 = lo; D.nz = hi_ - lo + 1; D.windowed = 1; }
    } else {
        const int b = u >> 3, kvh = (u >> 2) & 1, qb = u & 3;
        row_seq0 = (size_t)b * SEQ; D.kvh = kvh; D.q0 = qb * 64; D.zt0 = 0; D.nz = 4;
    }
    if (isC) D.sink = F.inp(I_SINK) + l * 8;
    D.Kz = Z + row_seq0 * NMAIN + kcol + D.kvh * 64; D.Vz = Z + row_seq0 * NMAIN + vcol + D.kvh * 64;
    attn_unit(F, D, Z + row_seq0 * NMAIN + qcol, Obase + row_seq0 * 512);
}

__device__ __forceinline__ void phase_ffn_act(Frame& F, int l) {
    h16* U = (h16*)(F.ws + WS_ZU);
    const int gt = F.vcu * NTHREADS + F.tid, NGT = F.G * NTHREADS;
    constexpr int NCC = DFF / 8, RUN = 16, NRUN = NTOK / RUN;
    for (int it = gt; it < NCC * NRUN; it += NGT) {
        const int cc = it % NCC, run = it / NCC; const int c0 = cc * 8, r0 = run * RUN;
        const bool first = (r0 < NCTX) ? ((r0 & 255) == 0) : (((r0 - NCTX) & (LSEQ - 1)) == 0);
        const bool last = (r0 < NCTX) ? (((r0 + RUN) & 255) == 0) : ((((r0 + RUN) - NCTX) & (LSEQ - 1)) == 0);
        float w0[8], w1[8], w2[8], bb[8];
        const float* cw = F.inp(I_FCW) + (size_t)l * 3 * DFF + c0; const float* cb = F.inp(I_FCB) + (size_t)l * DFF + c0;
#pragma unroll
        for (int j = 0; j < 8; ++j) { w0[j] = cw[j]; w1[j] = cw[DFF + j]; w2[j] = cw[2 * DFF + j]; bb[j] = cb[j]; }
        u32x4 gr[RUN + 2], vr[RUN];
#pragma unroll
        for (int i = 0; i < RUN + 2; ++i) { const int r = r0 - 1 + i; const bool ok = !((i == 0 && first) || (i == RUN + 1 && last));
            const int rc = ok ? r : r0; const u32x4 v = *(const u32x4*)(U + (size_t)rc * DUP + c0);
            gr[i].x = ok ? v.x : 0u; gr[i].y = ok ? v.y : 0u; gr[i].z = ok ? v.z : 0u; gr[i].w = ok ? v.w : 0u; }
#pragma unroll
        for (int i = 0; i < RUN; ++i) vr[i] = *(const u32x4*)(U + (size_t)(r0 + i) * DUP + DFF + c0);
        float gp[8], gc[8], gn[8];
        unpack8(gr[0], gp); unpack8(gr[1], gc);
#pragma unroll
        for (int i = 0; i < RUN; ++i) {
            unpack8(gr[i + 2], gn);
            float v[8]; unpack8(vr[i], v);
            float o[8];
#pragma unroll
            for (int j = 0; j < 8; ++j) { const float g = bb[j] + w0[j] * gp[j] + w1[j] * gc[j] + w2[j] * gn[j]; o[j] = gelu_tanh(g) * v[j]; gp[j] = gc[j]; gc[j] = gn[j]; }
            *(u32x4*)(U + (size_t)(r0 + i) * DUP + DFF + c0) = pack8(o);
        }
    }
}

__device__ __forceinline__ void phase_act_fixup(Frame& F, int l) {
    h16* ACT = (h16*)(F.ws + WS_ZU);
    const float* edge = (const float*)(F.ws + WS_EDGE);
    const float* cw = F.inp(I_FCW) + (size_t)l * 3 * DFF;
    const int gt = F.vcu * NTHREADS + F.tid, NGT = F.G * NTHREADS;
    constexpr int NC8 = DFF / 8;
    for (int it = gt; it < 64 * 8 * NC8; it += NGT) {
        const int ch = (it % NC8) * 8, ri = it / NC8, pm = ri >> 3, idx = ri & 7, b = idx >> 1, last = idx & 1;
        const int row = pm * 256 + b * 64 + (last ? 63 : 0);
        const int nrow = last ? row + 1 : row - 1;
        const bool seq_edge = (row < NCTX) ? (last ? ((row & 255) == 255) : ((row & 255) == 0)) : (last ? (((row - NCTX) & (LSEQ - 1)) == LSEQ - 1) : (((row - NCTX) & (LSEQ - 1)) == 0));
        const int nr = seq_edge ? row : nrow;
        const int npm = nr >> 8, nb = (nr >> 6) & 3;
        const float* gp = edge + ((size_t)(npm * 8 + 2 * nb + (last ? 0 : 1)) * 3) * DFF + ch;
        const float* ep = edge + ((size_t)(pm * 8 + idx) * 3) * DFF + ch;
        const float* wp = cw + (last ? 2 : 0) * DFF + ch;
        f32x4 g0 = *(const f32x4*)gp, g1 = *(const f32x4*)(gp + 4), p0 = *(const f32x4*)(ep + DFF), p1 = *(const f32x4*)(ep + DFF + 4);
        const f32x4 v0 = *(const f32x4*)(ep + 2 * DFF), v1 = *(const f32x4*)(ep + 2 * DFF + 4), w0 = *(const f32x4*)wp, w1 = *(const f32x4*)(wp + 4);
        const float nz = seq_edge ? 0.f : 1.f;
        p0 = p0 + w0 * g0 * nz; p1 = p1 + w1 * g1 * nz;
        float o[8];
#pragma unroll
        for (int j = 0; j < 4; ++j) { o[j] = gelu_tanh(p0[j]) * v0[j]; o[4 + j] = gelu_tanh(p1[j]) * v1[j]; }
        *(u32x4*)(ACT + (size_t)row * DFF + ch) = pack8(o);
    }
}

constexpr int N_PHASES = 25;
__global__ void __launch_bounds__(NTHREADS, 2) fwd_kernel(Args args) {
    extern __shared__ __attribute__((aligned(16))) unsigned char lds_raw[];
    Frame F;
    F.lds = (LAS unsigned char*)lds_raw;
    F.tid = threadIdx.x; F.lane = F.tid & 63; F.wave = __builtin_amdgcn_readfirstlane(F.tid >> 6);
    F.G0 = gridDim.x; { const int bx = blockIdx.x; F.vcu0 = (F.G0 % 8 == 0) ? (bx % 8) * (F.G0 / 8) + bx / 8 : bx; }
    F.out0 = args.out; F.ws0 = args.ws; F.refresh();
    volatile LAS unsigned* MISC = (volatile LAS unsigned*)(F.lds + MISC_OFF);
    for (int u = F.tid; u < (LDS_BYTES - LDSCTL_OFF) / 4; u += NTHREADS) ((LAS unsigned*)(F.lds + LDSCTL_OFF))[u] = 0u;
    __syncthreads();
#if !MK_PER_PHASE
    XcdBarrier bar = xcd_barrier_post((unsigned*)(F.ws + WS_CTL) + CW_BAR, MISC + 8);
#define GRID_BAR() xcd_barrier(bar)
#else
    (void)MISC;
#define GRID_BAR() do { } while (0)
#endif
#if MK_PER_PHASE
    const int lo = args.ph_lo, hi_ph = args.ph_hi;
#else
    constexpr int lo = 0, hi_ph = N_PHASES;
#endif
#if defined(TIME_PH)
#ifndef TIME_AMP
#define TIME_AMP 8
#endif
    unsigned long long t_acc = 0, t_0 = 0;
#define TSTART(k) do { TSL_PHASE(F.lds, (k)); if ((k) == TIME_PH) t_0 = __builtin_amdgcn_s_memrealtime(); } while (0)
#define TSTOP(k) do { if ((k) == TIME_PH) t_acc += __builtin_amdgcn_s_memrealtime() - t_0; } while (0)
#else
#define TSTART(k) do { TSL_PHASE(F.lds, (k)); } while (0)
#define TSTOP(k) do { } while (0)
#endif
#define IN(k) (lo <= (k) && (k) < hi_ph)
#define SEAM(k) do { if (IN((k) + 1)) GRID_BAR(); } while (0)
    { constexpr int l = 0; constexpr int pb = 12 * l;
        if (IN(pb + 0)) { TSTART(0); F.refresh(); phase_convert_weights(F, l); if (l == 0) phase_prep_misc(F); SEAM(pb + 0); TSTOP(0); }
        if (IN(pb + 1)) { TSTART(1); F.refresh();
            if (l == 0) phase_norm0(F, F.inp(I_N1G), (const float*)(F.ws + WS_MOD), (float*)(F.ws + WS_SS));
            phase_cvec(F, l);
            SEAM(pb + 1); TSTOP(1); }
        if (IN(pb + 2)) { TSTART(2); F.refresh();
            pg8::Gemm g{(const h16*)(F.ws + WS_H), (const h16*)(F.ws + WS_W + W_IN), NTOK, NMAIN, DM, DM}; pg8::StaticOrder S; S.init(NTOK, NMAIN, F.G, F.bid);
            pg8::EpiF16<0> E{(h16*)(F.ws + WS_ZU), NMAIN, (const float*)(F.ws + WS_SS) + (size_t)(2 * l) * NTOK, (const float*)(F.ws + WS_CV) + (size_t)l * 3 * (DIN + DUP), DIN + DUP};
            pg8::gemm_phase<pg8::EpiF16<0>, pg8::StaticOrder, true, true>(F.lds, g, S, E);
            SEAM(pb + 2); TSTOP(2); }
        if (IN(pb + 3)) { TSTART(3); F.refresh();
            phase_qk(F, l);
            for (int u = F.vcu; u < 512; u += F.G) {
                if (u < 256) lru_unit<0>(F, l, (u >> 3) * 256, u & 7, 1, 1, 0, 0, u >> 3);
                else { const int v = u - 256, b = v >> 7, ch = (v >> 3) & 15; lru_unit<1>(F, l, NCTX + b * LSEQ + ch * 256, v & 7, ch == 0, ch == 15, b, ch, 0); }
            }
            SEAM(pb + 3); TSTOP(3); }
        if (IN(pb + 4)) { TSTART(4); F.refresh();
            for (int type = 0; type < 4; ++type) { TSL_START(F.lds, 20 + type); for (int u = F.vcu; u < 256; u += F.G) attn_dispatch(F, l, type, u); TSL_STOP(F.lds, 20 + type); }
            TSL_START(F.lds, 24);
            for (int v = F.vcu; v < 256; v += F.G) { const int b = v >> 7, ch = (v >> 3) & 15; lru_unit<3>(F, l, NCTX + b * LSEQ + ch * 256, v & 7, ch == 0, ch == 15, b, ch, 0); }
            TSL_STOP(F.lds, 24);
            SEAM(pb + 4); TSTOP(4); }
        if (IN(pb + 6)) { TSTART(6); F.refresh();
            pg8::StaticOrder S; S.init(NTOK, DM, F.G, F.bid);
            pg8::GateMergeJobs jobs{S, F.ws};
            pg8::EpiGM E{(h16*)(F.ws + WS_STASH), (h16*)(F.ws + WS_ZU) + (size_t)F.bid * 256 * 256, (const float*)(F.ws + WS_SS) + (size_t)(2 * l) * NTOK,
                         (const float*)(F.ws + WS_CV) + (size_t)l * 3 * (DIN + DUP) + NMAIN, DIN + DUP};
            pg8::gemm_multi(F.lds, jobs, E);
            SEAM(pb + 6); TSTOP(6); }
        if (IN(pb + 7)) { TSTART(7); F.refresh();
            pg8::Gemm g{(const h16*)(F.ws + WS_STASH), (const h16*)(F.ws + WS_W + W_OUT), NTOK, DM, DM, DM}; pg8::StaticOrder S; S.init(NTOK, DM, F.G, F.bid);
            pg8::EpiRes E{l == 0 ? F.inp(I_XP) : F.out + O_Y, l == 0 ? F.inp(I_XS) : F.out + O_Y + (size_t)NCTX * DM, F.out + O_Y, (const float*)(F.ws + WS_MOD) + (size_t)l * 3 * 6144 + 2 * 1024,
                          (h16*)(F.ws + WS_H2), F.inp(I_N2G) + l * DM, (const float*)(F.ws + WS_MOD) + (size_t)l * 3 * 6144 + 4 * 1024, (float*)(F.ws + WS_SS) + (size_t)(2 * l + 1) * NTOK, F.lds + EPI_SCR_OFF};
            pg8::gemm_phase<pg8::EpiRes, pg8::StaticOrder, true, true>(F.lds, g, S, E);
            SEAM(pb + 7); TSTOP(7); }
        if (IN(pb + 9)) { TSTART(9); F.refresh();
            pg8::Gemm g{(const h16*)(F.ws + WS_H2), (const h16*)(F.ws + WS_W + W_UP), NTOK, DUP, DM, DM}; pg8::StaticOrder S; S.init(NTOK, DUP, F.G, F.bid);
            pg8::EpiAct E{(h16*)(F.ws + WS_ZU), (const float*)(F.ws + WS_SS) + (size_t)(2 * l + 1) * NTOK, (const float*)(F.ws + WS_CV) + (size_t)l * 3 * (DIN + DUP) + DIN, DIN + DUP,
                          F.inp(I_FCW) + (size_t)l * 3 * DFF, F.inp(I_FCB) + (size_t)l * DFF, (float*)(F.ws + WS_EDGE)};
            pg8::gemm_phase<pg8::EpiAct, pg8::StaticOrder, true, true>(F.lds, g, S, E);
            SEAM(pb + 9); TSTOP(9); }
        if (IN(pb + 10)) { TSTART(10); F.refresh(); phase_act_fixup(F, l); SEAM(pb + 10); TSTOP(10); }
        if (IN(pb + 11)) { TSTART(11); F.refresh();
            pg8::Gemm g{(const h16*)(F.ws + WS_ZU), (const h16*)(F.ws + WS_W + W_DOWN), NTOK, DM, DFF, DFF}; pg8::StaticOrder S; S.init(NTOK, DM, F.G, F.bid);
            const bool nx = l + 1 < DEPTH;
            pg8::EpiRes E{F.out + O_Y, F.out + O_Y + (size_t)NCTX * DM, F.out + O_Y, (const float*)(F.ws + WS_MOD) + (size_t)l * 3 * 6144 + 5 * 1024,
                          nx ? (h16*)(F.ws + WS_H) : (h16*)nullptr, F.inp(I_N1G) + (nx ? l + 1 : l) * DM, (const float*)(F.ws + WS_MOD) + (size_t)(nx ? l + 1 : l) * 3 * 6144 + 1 * 1024,
                          nx ? (float*)(F.ws + WS_SS) + (size_t)(2 * (l + 1)) * NTOK : (float*)nullptr, F.lds + EPI_SCR_OFF};
            pg8::gemm_phase<pg8::EpiRes, pg8::StaticOrder, true, true>(F.lds, g, S, E);
            SEAM(pb + 11); TSTOP(11); }
    }
    { constexpr int l = 1; constexpr int pb = 12 * l;
        if (IN(pb + 0)) { TSTART(0); F.refresh(); phase_convert_weights(F, l); if (l == 0) phase_prep_misc(F); SEAM(pb + 0); TSTOP(0); }
        if (IN(pb + 1)) { TSTART(1); F.refresh();
            if (l == 0) phase_norm0(F, F.inp(I_N1G), (const float*)(F.ws + WS_MOD), (float*)(F.ws + WS_SS));
            phase_cvec(F, l);
            SEAM(pb + 1); TSTOP(1); }
        if (IN(pb + 2)) { TSTART(2); F.refresh();
            pg8::Gemm g{(const h16*)(F.ws + WS_H), (const h16*)(F.ws + WS_W + W_IN), NTOK, NMAIN, DM, DM}; pg8::StaticOrder S; S.init(NTOK, NMAIN, F.G, F.bid);
            pg8::EpiF16<0> E{(h16*)(F.ws + WS_ZU), NMAIN, (const float*)(F.ws + WS_SS) + (size_t)(2 * l) * NTOK, (const float*)(F.ws + WS_CV) + (size_t)l * 3 * (DIN + DUP), DIN + DUP};
            pg8::gemm_phase<pg8::EpiF16<0>, pg8::StaticOrder, true, true>(F.lds, g, S, E);
            SEAM(pb + 2); TSTOP(2); }
        if (IN(pb + 3)) { TSTART(3); F.refresh();
            phase_qk(F, l);
            for (int u = F.vcu; u < 512; u += F.G) {
                if (u < 256) lru_unit<0>(F, l, (u >> 3) * 256, u & 7, 1, 1, 0, 0, u >> 3);
                else { const int v = u - 256, b = v >> 7, ch = (v >> 3) & 15; lru_unit<1>(F, l, NCTX + b * LSEQ + ch * 256, v & 7, ch == 0, ch == 15, b, ch, 0); }
            }
            SEAM(pb + 3); TSTOP(3); }
        if (IN(pb + 4)) { TSTART(4); F.refresh();
            for (int type = 0; type < 4; ++type) { TSL_START(F.lds, 20 + type); for (int u = F.vcu; u < 256; u += F.G) attn_dispatch(F, l, type, u); TSL_STOP(F.lds, 20 + type); }
            TSL_START(F.lds, 24);
            for (int v = F.vcu; v < 256; v += F.G) { const int b = v >> 7, ch = (v >> 3) & 15; lru_unit<3>(F, l, NCTX + b * LSEQ + ch * 256, v & 7, ch == 0, ch == 15, b, ch, 0); }
            TSL_STOP(F.lds, 24);
            SEAM(pb + 4); TSTOP(4); }
        if (IN(pb + 6)) { TSTART(6); F.refresh();
            pg8::StaticOrder S; S.init(NTOK, DM, F.G, F.bid);
            pg8::GateMergeJobs jobs{S, F.ws};
            pg8::EpiGM E{(h16*)(F.ws + WS_STASH), (h16*)(F.ws + WS_ZU) + (size_t)F.bid * 256 * 256, (const float*)(F.ws + WS_SS) + (size_t)(2 * l) * NTOK,
                         (const float*)(F.ws + WS_CV) + (size_t)l * 3 * (DIN + DUP) + NMAIN, DIN + DUP};
            pg8::gemm_multi(F.lds, jobs, E);
            SEAM(pb + 6); TSTOP(6); }
        if (IN(pb + 7)) { TSTART(7); F.refresh();
            pg8::Gemm g{(const h16*)(F.ws + WS_STASH), (const h16*)(F.ws + WS_W + W_OUT), NTOK, DM, DM, DM}; pg8::StaticOrder S; S.init(NTOK, DM, F.G, F.bid);
            pg8::EpiRes E{l == 0 ? F.inp(I_XP) : F.out + O_Y, l == 0 ? F.inp(I_XS) : F.out + O_Y + (size_t)NCTX * DM, F.out + O_Y, (const float*)(F.ws + WS_MOD) + (size_t)l * 3 * 6144 + 2 * 1024,
                          (h16*)(F.ws + WS_H2), F.inp(I_N2G) + l * DM, (const float*)(F.ws + WS_MOD) + (size_t)l * 3 * 6144 + 4 * 1024, (float*)(F.ws + WS_SS) + (size_t)(2 * l + 1) * NTOK, F.lds + EPI_SCR_OFF};
            pg8::gemm_phase<pg8::EpiRes, pg8::StaticOrder, true, true>(F.lds, g, S, E);
            SEAM(pb + 7); TSTOP(7); }
        if (IN(pb + 9)) { TSTART(9); F.refresh();
            pg8::Gemm g{(const h16*)(F.ws + WS_H2), (const h16*)(F.ws + WS_W + W_UP), NTOK, DUP, DM, DM}; pg8::StaticOrder S; S.init(NTOK, DUP, F.G, F.bid);
            pg8::EpiAct E{(h16*)(F.ws + WS_ZU), (const float*)(F.ws + WS_SS) + (size_t)(2 * l + 1) * NTOK, (const float*)(F.ws + WS_CV) + (size_t)l * 3 * (DIN + DUP) + DIN, DIN + DUP,
                          F.inp(I_FCW) + (size_t)l * 3 * DFF, F.inp(I_FCB) + (size_t)l * DFF, (float*)(F.ws + WS_EDGE)};
            pg8::gemm_phase<pg8::EpiAct, pg8::StaticOrder, true, true>(F.lds, g, S, E);
            SEAM(pb + 9); TSTOP(9); }
        if (IN(pb + 10)) { TSTART(10); F.refresh(); phase_act_fixup(F, l); SEAM(pb + 10); TSTOP(10); }
        if (IN(pb + 11)) { TSTART(11); F.refresh();
            pg8::Gemm g{(const h16*)(F.ws + WS_ZU), (const h16*)(F.ws + WS_W + W_DOWN), NTOK, DM, DFF, DFF}; pg8::StaticOrder S; S.init(NTOK, DM, F.G, F.bid);
            const bool nx = l + 1 < DEPTH;
            pg8::EpiRes E{F.out + O_Y, F.out + O_Y + (size_t)NCTX * DM, F.out + O_Y, (const float*)(F.ws + WS_MOD) + (size_t)l * 3 * 6144 + 5 * 1024,
                          nx ? (h16*)(F.ws + WS_H) : (h16*)nullptr, F.inp(I_N1G) + (nx ? l + 1 : l) * DM, (const float*)(F.ws + WS_MOD) + (size_t)(nx ? l + 1 : l) * 3 * 6144 + 1 * 1024,
                          nx ? (float*)(F.ws + WS_SS) + (size_t)(2 * (l + 1)) * NTOK : (float*)nullptr, F.lds + EPI_SCR_OFF};
            pg8::gemm_phase<pg8::EpiRes, pg8::StaticOrder, true, true>(F.lds, g, S, E);
            SEAM(pb + 11); TSTOP(11); }
    }
    if (IN(24)) { TSTART(12); F.refresh(); phase_final_norm(F); TSTOP(12); }
#if defined(TIME_SUB)
    if (blockIdx.x == 0 && threadIdx.x == 0) { const unsigned long long ta = *(volatile LAS unsigned long long*)(F.lds + MISC_OFF + 64); const unsigned long long t1 = __builtin_amdgcn_s_memrealtime(); while (__builtin_amdgcn_s_memrealtime() - t1 < 8ull * ta) __builtin_amdgcn_s_sleep(8); }
#endif
#if defined(TIME_PH)
    if (blockIdx.x == 0 && threadIdx.x == 0) { const unsigned long long t1 = __builtin_amdgcn_s_memrealtime(); while (__builtin_amdgcn_s_memrealtime() - t1 < (unsigned long long)TIME_AMP * t_acc) __builtin_amdgcn_s_sleep(8); }
#endif
#if defined(PROBE_PH)
#ifndef PROBE_N
#define PROBE_N 4
#endif
#ifndef PROBE_SUB
#define PROBE_SUB 0xFF
#endif
#ifndef PROBE_VAR
#define PROBE_VAR 0
#endif
    if (IN(24)) {
        const int l = 1;
        for (int rep = 0; rep < PROBE_N; ++rep) {
            GRID_BAR(); F.refresh();
            if (PROBE_PH == 0) { phase_convert_weights(F, l); }
            if (PROBE_PH == 12) { phase_prep_misc(F); }
            if (PROBE_PH == 1) { phase_norm_mod(F, 0, F.inp(I_N1G) + l * DM, (const float*)(F.ws + WS_MOD) + (size_t)l * 3 * 6144, 0); }
            if (PROBE_PH == 2) { pg8::Gemm g{(const h16*)(F.ws + WS_H), (const h16*)(F.ws + WS_W + W_IN), NTOK, NMAIN, DM, DM}; pg8::StaticOrder S; S.init(NTOK, NMAIN, F.G, F.bid);
                pg8::EpiF16<0> E{(h16*)(F.ws + WS_ZU), NMAIN}; pg8::gemm_phase<pg8::EpiF16<0>, pg8::StaticOrder, true, true>(F.lds, g, S, E); }
            if (PROBE_PH == 3) {
                if (PROBE_SUB & 1) phase_qk(F, l, false);
                for (int u = F.vcu; u < 512; u += F.G) {
                    if (u < 256) { if (PROBE_SUB & 2) lru_unit<0>(F, l, (u >> 3) * 256, u & 7, 1, 1, 0, 0, u >> 3, false); }
                    else if (PROBE_SUB & 4) { const int v = u - 256, b = v >> 7, ch = (v >> 3) & 15; lru_unit<1>(F, l, NCTX + b * LSEQ + ch * 256, v & 7, ch == 0, ch == 15, b, ch, 0); }
                } }
            if (PROBE_PH == 4) {
                for (int type = 0; type < 4; ++type) if ((PROBE_SUB >> type) & 1) for (int u = F.vcu; u < 256; u += F.G) attn_dispatch(F, l, type, u);
                if (PROBE_SUB & 16) for (int v = F.vcu; v < 256; v += F.G) { const int b = v >> 7, ch = (v >> 3) & 15; lru_unit<2>(F, l, NCTX + b * LSEQ + ch * 256, v & 7, ch == 0, ch == 15, b, ch, 0, true, PROBE_VAR); } }
            if (PROBE_PH == 5) { pg8::Gemm g{(const h16*)(F.ws + WS_H), (const h16*)(F.ws + WS_W + W_IN) + (size_t)NMAIN * DM, NTOK, NGATE, DM, DM}; pg8::StaticOrder S; S.init(NTOK, NGATE, F.G, F.bid);
                pg8::EpiF16<1> E{(h16*)(F.ws + WS_ZU), NGATE}; pg8::gemm_phase<pg8::EpiF16<1>, pg8::StaticOrder, true, true>(F.lds, g, S, E); }
            if (PROBE_PH == 6) { pg8::StaticOrder S; S.init(NTOK, DM, F.G, F.bid);
                h16* Hb = (h16*)(F.ws + WS_H); const h16* Gb = (const h16*)(F.ws + WS_ZU);
                { pg8::Gemm g{(const h16*)(F.ws + WS_ZU + ZU_OA), (const h16*)(F.ws + WS_W + W_OA), NTOK, DM, 1024, 1024}; pg8::EpiGateMul<0> E{Hb, Gb, 0};
                  pg8::gemm_phase<pg8::EpiGateMul<0>, pg8::StaticOrder, true, true>(F.lds, g, S, E); }
                { pg8::Gemm g{(const h16*)(F.ws + WS_ZU + ZU_OB), (const h16*)(F.ws + WS_W + W_OB), NTOK, DM, 512, 512}; pg8::EpiGateMul<1> E{Hb, Gb, 1024};
                  pg8::gemm_phase<pg8::EpiGateMul<1>, pg8::StaticOrder, true, true>(F.lds, g, S, E); }
                { pg8::Gemm g{(const h16*)(F.ws + WS_ZU + ZU_OC), (const h16*)(F.ws + WS_W + W_OC), NTOK, DM, 512, 512}; pg8::EpiGateMul<1> E{Hb, Gb, 2048};
                  pg8::gemm_phase<pg8::EpiGateMul<1>, pg8::StaticOrder, true, true>(F.lds, g, S, E); } }
            if (PROBE_PH == 7) { pg8::Gemm g{(const h16*)(F.ws + WS_H), (const h16*)(F.ws + WS_W + W_OUT), NTOK, DM, DM, DM}; pg8::StaticOrder S; S.init(NTOK, DM, F.G, F.bid);
                pg8::EpiRes E{F.out + O_Y, F.out + O_Y + (size_t)NCTX * DM, (float*)(F.ws + WS_ZU), (const float*)(F.ws + WS_MOD) + (size_t)l * 3 * 6144 + 2 * 1024, nullptr, nullptr, nullptr, nullptr, F.lds + EPI_SCR_OFF};
                pg8::gemm_phase<pg8::EpiRes, pg8::StaticOrder, true, true>(F.lds, g, S, E); }
            if (PROBE_PH == 9) { pg8::Gemm g{(const h16*)(F.ws + WS_H), (const h16*)(F.ws + WS_W + W_UP), NTOK, DUP, DM, DM}; pg8::StaticOrder S; S.init(NTOK, DUP, F.G, F.bid);
                pg8::EpiF16<0> E{(h16*)(F.ws + WS_ZU), DUP}; pg8::gemm_phase<pg8::EpiF16<0>, pg8::StaticOrder, true, true>(F.lds, g, S, E); }
            if (PROBE_PH == 10) { phase_ffn_act(F, l); }
            if (PROBE_PH == 11) { pg8::Gemm g{(const h16*)(F.ws + WS_ZU) + DFF, (const h16*)(F.ws + WS_W + W_DOWN), NTOK, DM, DFF, DUP}; pg8::StaticOrder S; S.init(NTOK, DM, F.G, F.bid);
                pg8::EpiRes E{F.out + O_Y, F.out + O_Y + (size_t)NCTX * DM, (float*)(F.ws + WS_H), (const float*)(F.ws + WS_MOD) + (size_t)l * 3 * 6144 + 5 * 1024, nullptr, nullptr, nullptr, nullptr, F.lds + EPI_SCR_OFF};
                pg8::gemm_phase<pg8::EpiRes, pg8::StaticOrder, true, true>(F.lds, g, S, E); }
            if (PROBE_PH == 13) { }
        }
    }
#endif
#undef IN
#undef SEAM
}

extern "C" void kernel_launch(void* const* d_in, const int* in_sizes, int n_in, void* d_out, int out_size, void* d_ws, size_t ws_size, hipStream_t stream) {
    static int grid = 0;
    if (grid == 0) {
        if (n_in != 33 || out_size != (int)O_END || ws_size < WS_END) { fprintf(stderr, "kernel_launch: unexpected shapes: n_in %d out %d ws %zu (need %zu)\n", n_in, out_size, ws_size, (size_t)WS_END); grid = -1; return; }
        int dev = 0, cus = 0;
        if (hipGetDevice(&dev) != hipSuccess || hipDeviceGetAttribute(&cus, hipDeviceAttributeMultiprocessorCount, dev) != hipSuccess) { grid = -1; return; }
        if (hipFuncSetAttribute((const void*)fwd_kernel, hipFuncAttributeMaxDynamicSharedMemorySize, LDS_BYTES) != hipSuccess) { fprintf(stderr, "kernel_launch: hipFuncSetAttribute failed\n"); grid = -1; return; }
        (void)hipGetLastError();
        grid = cus;
    }
    if (grid < 0) return;
    (void)hipMemsetAsync((char*)d_ws + WS_CTL, 0, CTL_ZERO_BYTES, stream);
    Args a{};
    for (int i = 0; i < 33; ++i) a.in[i] = (const float*)d_in[i];
    a.out = (float*)d_out; a.ws = (unsigned char*)d_ws;
#if MK_PER_PHASE
    for (int ph = 0; ph < N_PHASES; ++ph) { a.ph_lo = ph; a.ph_hi = ph + 1; hipLaunchKernelGGL(fwd_kernel, dim3(grid), dim3(NTHREADS), LDS_BYTES, stream, a); }
#else
    a.ph_lo = 0; a.ph_hi = N_PHASES;
    hipLaunchKernelGGL(fwd_kernel, dim3(grid), dim3(NTHREADS), LDS_BYTES, stream, a);
#endif
}
```

```cpp
#include <hip/hip_runtime.h>
#include <cstdio>
#include <cstdint>
#include <cmath>

#ifndef MK_PER_PHASE
#define MK_PER_PHASE 0
#endif

#define LAS __attribute__((address_space(3)))
#define GAS __attribute__((address_space(1)))
typedef _Float16 h16;
typedef _Float16 h16x8 __attribute__((ext_vector_type(8)));
typedef _Float16 h16x4 __attribute__((ext_vector_type(4)));
typedef _Float16 h16x2 __attribute__((ext_vector_type(2)));
typedef short s16x4 __attribute__((ext_vector_type(4)));
typedef float f32x2 __attribute__((ext_vector_type(2)));
typedef float f32x4 __attribute__((ext_vector_type(4)));
typedef float f32x16 __attribute__((ext_vector_type(16)));
typedef unsigned u32x2 __attribute__((ext_vector_type(2)));
typedef unsigned u32x4 __attribute__((ext_vector_type(4)));

constexpr int DM = 1024, NTOK = 16384, NCTX = 8192, SEQ = 256, LSEQ = 4096, NB_CTX = 32, NB_LAT = 2, DEPTH = 2;
constexpr int DIN = 6656, NMAIN = 3584, NGATE = 3072, DFF = 2816, DUP = 5632, DLRU = 1024;
constexpr int C_XA = 0, C_YA = 1024, C_QB = 2048, C_KB = 2560, C_VB = 2688, C_QC = 2816, C_KC = 3328, C_VC = 3456;
constexpr float NORM_EPS = 1e-6f;
constexpr float LOG2E = 1.4426950408889634f;
constexpr float QSCALE = 0.125f * LOG2E;
constexpr size_t O_Y = 0, O_KB = 16777216, O_VB = 18874368, O_KC = 20971520, O_VC = 23068672, O_LRU = 25165824, O_END = 25296896;
constexpr size_t MiB = 1u << 20;
constexpr size_t WS_CTL = 0, WS_SS = 64 * 1024, CTL_ZERO_BYTES = 64 * 1024 + 4 * NTOK * 4;
constexpr size_t WS_MOD = 1 * MiB;
constexpr size_t WS_ROPE = 1 * MiB + 256 * 1024;
constexpr size_t WS_AGG = 1 * MiB + 320 * 1024;
constexpr size_t WS_CACHE = 2 * MiB;
constexpr size_t WS_W = 3 * MiB;
constexpr size_t W_IN = 0, W_OA = W_IN + (size_t)DIN * DM * 2, W_OB = W_OA + (size_t)DM * 1024 * 2, W_OC = W_OB + (size_t)DM * 512 * 2,
                 W_OUT = W_OC + (size_t)DM * 512 * 2, W_UP = W_OUT + (size_t)DM * DM * 2, W_DOWN = W_UP + (size_t)DUP * DM * 2,
                 W_LRU = W_DOWN + (size_t)DM * DFF * 2, W_END = W_LRU + (size_t)2 * 2 * 8 * 128 * 128 * 2;
static_assert(W_END <= 37 * MiB, "weights region");
constexpr size_t WS_H = 40 * MiB;
constexpr size_t WS_ZU = 72 * MiB;
constexpr size_t ZU_OA = (size_t)NTOK * NMAIN * 2, ZU_OB = ZU_OA + (size_t)NTOK * 1024 * 2, ZU_OC = ZU_OB + (size_t)NTOK * 512 * 2;
constexpr size_t WS_STASH = WS_ZU + (size_t)NTOK * DUP * 2;
static_assert(WS_STASH == 248 * MiB, "ws map");
constexpr size_t WS_MG = WS_STASH;
constexpr size_t WS_H2 = WS_STASH + (size_t)NTOK * DM * 2;
constexpr size_t WS_CV = WS_STASH + (size_t)NB_LAT * 2 * LSEQ * DLRU * 4;
constexpr size_t WS_EDGE = WS_CV + MiB;
constexpr size_t WS_W2 = WS_EDGE + (size_t)64 * 8 * 3 * DFF * 4 + 4096;
constexpr size_t WS_END = WS_W2 + 37 * MiB;
__host__ __device__ constexpr size_t wsw(int l) { return l == 0 ? WS_W : WS_W2; }

__device__ __forceinline__ unsigned pk_h2(float lo, float hi) { f32x2 v = {lo, hi}; h16x2 h = __builtin_convertvector(v, h16x2); return __builtin_bit_cast(unsigned, h); }
__device__ __forceinline__ void unpack8(u32x4 w, float* x) { h16x8 h = __builtin_bit_cast(h16x8, w);
#pragma unroll
    for (int j = 0; j < 8; ++j) x[j] = (float)h[j]; }
__device__ __forceinline__ u32x4 pack8(const float* x) { u32x4 w; w.x = pk_h2(x[0], x[1]); w.y = pk_h2(x[2], x[3]); w.z = pk_h2(x[4], x[5]); w.w = pk_h2(x[6], x[7]); return w; }
__device__ __forceinline__ float fast_exp2(float x) { return __builtin_amdgcn_exp2f(x); }
__device__ __forceinline__ float fast_rcp(float x) { return __builtin_amdgcn_rcpf(x); }
__device__ __forceinline__ float sigmoidf_(float x) { return fast_rcp(1.0f + fast_exp2(-LOG2E * x)); }
__device__ __forceinline__ float gelu_tanh(float x) { const float t = x + 0.044715f * x * x * x; return x * fast_rcp(1.0f + fast_exp2(-2.0f * 0.7978845608028654f * LOG2E * t)); }
template <int CTRL> __device__ __forceinline__ float dpp_f(float v) { return __int_as_float(__builtin_amdgcn_update_dpp(0, __float_as_int(v), CTRL, 0xf, 0xf, true)); }
__device__ __forceinline__ float sum8(float v) { v += dpp_f<0xB1>(v); v += dpp_f<0x4E>(v); v += dpp_f<0x141>(v); return v; }
__device__ __forceinline__ float wave_sum(float v) { v = sum8(v); v += dpp_f<0x140>(v); v += __shfl_xor(v, 16); v += __shfl_xor(v, 32); return v; }

constexpr int RING_BYTES = 131072;
constexpr int LDSCTL_OFF = RING_BYTES, MISC_OFF = LDSCTL_OFF + 320;
constexpr int LDS_BYTES = 163840;
constexpr int EPI_SCR_OFF = RING_BYTES + 2048, EPI_SCR_WAVE = 2304;
#if defined(TIME_SUB)
#ifndef TIME_FILTER
#define TIME_FILTER -1
#endif
#define TSL_OK(l_) (blockIdx.x == 0 && threadIdx.x == 0 && (TIME_FILTER < 0 || *(volatile LAS int*)((l_) + MISC_OFF + 96) == TIME_FILTER))
#define TSL_START(l_, id) do { if ((id) == TIME_SUB && TSL_OK(l_)) *(volatile LAS unsigned long long*)((l_) + MISC_OFF + 72) = __builtin_amdgcn_s_memrealtime(); } while (0)
#define TSL_STOP(l_, id) do { if ((id) == TIME_SUB && TSL_OK(l_)) { volatile LAS unsigned long long* a_ = (volatile LAS unsigned long long*)((l_) + MISC_OFF + 64); a_[0] = a_[0] + (__builtin_amdgcn_s_memrealtime() - a_[1]); } } while (0)
#define TSL_PHASE(l_, k) do { if (blockIdx.x == 0 && threadIdx.x == 0) *(volatile LAS int*)((l_) + MISC_OFF + 96) = (k); } while (0)
#else
#define TSL_START(l_, id) do { } while (0)
#define TSL_STOP(l_, id) do { } while (0)
#define TSL_PHASE(l_, k) do { } while (0)
#endif
namespace pg8 {
constexpr int BM = 256, BK = 64, HALF = 128, HTB = HALF * BK * 2, STAGE_BYTES = 8 * HTB, NXCD = 8, WGM = 8;
__host__ __device__ __forceinline__ int lds_byte(int r, int c) { const int st = (r >> 4) * 2 + (c >> 5), rr = r & 15, cc = c & 31, ob = rr * 64 + cc * 2; return st * 1024 + (ob ^ (((ob >> 9) & 1) << 5)); }
__host__ __device__ __forceinline__ void stage_rc(int b, int& R, int& C) { const int st = b / 1024, sb = b % 1024, swz = sb ^ (((sb >> 9) & 1) << 5); R = (st >> 1) * 16 + swz / 64; C = (st & 1) * 32 + (swz % 64) / 2; }
__host__ __device__ __forceinline__ int perm32(int rho) { const int n = rho >> 4, i = rho & 15; return 8 * (i >> 2) + 4 * n + (i & 3); }
struct Unit { int pm, pn; };
struct Gemm { const h16* A; const h16* Bt; int M, N, K, lda; };
struct StaticOrder {
    int nM, nN, nwg, G, c;
    __host__ __device__ void init(int M, int N, int G_, int c_) { nM = M / BM; nN = N / BM; nwg = nM * nN; G = G_; c = c_; }
    __host__ __device__ bool next(int i, Unit& u) const {
        const long L = (long)i * G + c; if (L >= nwg) return false;
        int wgid = (int)L; { const int q = nwg / NXCD, r = nwg % NXCD, xcd = wgid % NXCD, off = wgid / NXCD; wgid = (xcd < r ? xcd * (q + 1) : r * (q + 1) + (xcd - r) * q) + off; }
        const int nig = WGM * nN, gid = wgid / nig, fm = gid * WGM, gsz = (nM - fm) < WGM ? (nM - fm) : WGM;
        u.pm = fm + ((wgid % nig) % gsz); u.pn = (wgid % nig) / gsz; return true;
    }
    __device__ __forceinline__ void a_ready(const Unit&) const {}
    __device__ __forceinline__ void done(const Unit&) const {}
};

template <int ACT> struct EpiF16 {
    static constexpr bool PERM = true, AFTER_DRAIN = false;
    h16* O; int ldc;
    const float* ss; const float* cv;
    int cvld;
    __device__ __forceinline__ void operator()(const f32x4 (&acc)[2][2][4][2], const Unit& u, int wr, int wc, int fr, int fq) const {
        const int row0 = u.pm * BM + wr * 64 + fr, col0 = u.pn * BM + wc * 32 + 8 * fq;
        const int cond = u.pm < 32 ? 0 : (u.pm < 48 ? 1 : 2);
        f32x4 c0[2], c1[2];
#pragma unroll
        for (int bj = 0; bj < 2; ++bj) { const float* cp = cv + (size_t)cond * cvld + col0 + bj * HALF; c0[bj] = *(const f32x4*)cp; c1[bj] = *(const f32x4*)(cp + 4); }
#pragma unroll
        for (int ai = 0; ai < 2; ++ai)
#pragma unroll
            for (int m = 0; m < 4; ++m) { const int row = row0 + ai * HALF + m * 16; h16* rowp = O + (size_t)row * ldc + col0;
                const float rstd = 1.0f / sqrtf(ss[row] * (1.0f / DM) + NORM_EPS);
#pragma unroll
                for (int bj = 0; bj < 2; ++bj) { f32x4 v0 = acc[ai][bj][m][0] * rstd + c0[bj], v1 = acc[ai][bj][m][1] * rstd + c1[bj];
                    if (ACT == 1) {
#pragma unroll
                        for (int j = 0; j < 4; ++j) { v0[j] = sigmoidf_(v0[j]); v1[j] = sigmoidf_(v1[j]); } }
                    u32x4 w; w.x = pk_h2(v0[0], v0[1]); w.y = pk_h2(v0[2], v0[3]); w.z = pk_h2(v1[0], v1[1]); w.w = pk_h2(v1[2], v1[3]);
                    *(u32x4*)(rowp + bj * HALF) = w; } }
    }
};
template <int ACCUM> struct EpiGateMul {
    static constexpr bool PERM = true, AFTER_DRAIN = false;
    h16* Mg; const h16* G; int gcol0;
    __device__ __forceinline__ void operator()(const f32x4 (&acc)[2][2][4][2], const Unit& u, int wr, int wc, int fr, int fq) const {
        const int row0 = u.pm * BM + wr * 64 + fr, col0 = u.pn * BM + wc * 32 + 8 * fq;
#pragma unroll
        for (int ai = 0; ai < 2; ++ai) {
            u32x4 gw[4][2], mw[4][2];
#pragma unroll
            for (int m = 0; m < 4; ++m) { const size_t row = (size_t)(row0 + ai * HALF + m * 16);
#pragma unroll
                for (int bj = 0; bj < 2; ++bj) { gw[m][bj] = *(const u32x4*)(G + row * NGATE + gcol0 + col0 + bj * HALF);
                    if (ACCUM) mw[m][bj] = *(const u32x4*)(Mg + row * DM + col0 + bj * HALF); } }
#pragma unroll
            for (int m = 0; m < 4; ++m) { const size_t row = (size_t)(row0 + ai * HALF + m * 16);
#pragma unroll
                for (int bj = 0; bj < 2; ++bj) {
                    float g[8]; unpack8(gw[m][bj], g);
                    float o[8];
                    if (ACCUM) unpack8(mw[m][bj], o);
                    else {
#pragma unroll
                        for (int j = 0; j < 8; ++j) o[j] = 0.f; }
                    const f32x4 v0 = acc[ai][bj][m][0], v1 = acc[ai][bj][m][1];
#pragma unroll
                    for (int j = 0; j < 4; ++j) { o[j] += g[j] * v0[j]; o[4 + j] += g[4 + j] * v1[j]; }
                    *(u32x4*)(Mg + row * DM + col0 + bj * HALF) = pack8(o); } }
            asm volatile("" ::: "memory"); }
    }
};
template <int CTRL> __device__ __forceinline__ float dpp_old(float old, float v) { return __int_as_float(__builtin_amdgcn_update_dpp(__float_as_int(old), __float_as_int(v), CTRL, 0xf, 0xf, false)); }
struct EpiAct {
    static constexpr bool PERM = true, AFTER_DRAIN = false;
    h16* ACT; const float* ss; const float* cv; int cvld; const float* cw; const float* cb; float* edge;
    __device__ __forceinline__ void operator()(const f32x4 (&acc)[2][2][4][2], const Unit& u, int wr, int wc, int fr, int fq) const {
        const int cond = u.pm < 32 ? 0 : (u.pm < 48 ? 1 : 2);
        const int chb = u.pn * 128 + wc * 32 + 8 * fq;
        const int colg = u.pn * BM + wc * 32 + 8 * fq;
        float cg[8], cvv[8], w0[8], w1[8], w2[8], bb[8];
#pragma unroll
        for (int e = 0; e < 8; ++e) { cg[e] = cv[(size_t)cond * cvld + colg + e]; cvv[e] = cv[(size_t)cond * cvld + colg + HALF + e];
            w0[e] = cw[chb + e]; w1[e] = cw[DFF + chb + e]; w2[e] = cw[2 * DFF + chb + e]; bb[e] = cb[chb + e]; }
#pragma unroll
        for (int ai = 0; ai < 2; ++ai) {
            float rs[4]; float g[4][8];
#pragma unroll
            for (int m = 0; m < 4; ++m) { rs[m] = 1.0f / sqrtf(ss[u.pm * BM + ai * HALF + wr * 64 + m * 16 + fr] * (1.0f / DM) + NORM_EPS);
#pragma unroll
                for (int e = 0; e < 8; ++e) g[m][e] = acc[ai][0][m][e >> 2][e & 3] * rs[m] + cg[e]; }
#pragma unroll
            for (int m = 0; m < 4; ++m) {
                const int row = u.pm * BM + ai * HALF + wr * 64 + m * 16 + fr;
                float o[8], pre[8], vv[8];
#pragma unroll
                for (int e = 0; e < 8; ++e) {
                    const float pe = m > 0 ? dpp_f<0x121>(g[m > 0 ? m - 1 : 0][e]) : 0.f;
                    const float prev = dpp_old<0x111>(pe, g[m][e]);
                    const float ne = m < 3 ? dpp_f<0x12F>(g[m < 3 ? m + 1 : 3][e]) : 0.f;
                    const float next = dpp_old<0x101>(ne, g[m][e]);
                    vv[e] = acc[ai][1][m][e >> 2][e & 3] * rs[m] + cvv[e];
                    pre[e] = bb[e] + w0[e] * prev + w1[e] * g[m][e] + w2[e] * next;
                    o[e] = gelu_tanh(pre[e]) * vv[e];
                }
                *(u32x4*)(ACT + (size_t)row * DFF + chb) = pack8(o);
                if ((m == 0 && fr == 0) || (m == 3 && fr == 15)) {
                    float* ep = edge + ((size_t)(u.pm * 8 + 2 * (2 * ai + wr) + (m == 3 ? 1 : 0)) * 3) * DFF + chb;
#pragma unroll
                    for (int e = 0; e < 8; ++e) { ep[e] = g[m][e]; ep[DFF + e] = pre[e]; ep[2 * DFF + e] = vv[e]; }
                }
            }
        }
    }
};
struct EpiRes {
    static constexpr bool PERM = false, AFTER_DRAIN = false;
    const float* base_ctx; const float* base_lat; float* X; const float* gate;
    h16* Hn; const float* gn; const float* scn; float* ssn;
    LAS unsigned char* scr;
    __device__ __forceinline__ void operator()(const f32x4 (&acc)[2][2][4][2], const Unit& u, int wr, int wc, int fr, int fq) const {
        const int cond = u.pm < 32 ? 0 : (u.pm < 48 ? 1 : 2);
        const float* gp = gate + (size_t)cond * 6144;
        const float* bp = u.pm < 32 ? base_ctx + (size_t)u.pm * BM * DM : base_lat + (size_t)(u.pm - 32) * BM * DM;
        float* xp = X + (size_t)u.pm * BM * DM;
        const int lane = fq * 16 + fr, wave = wr * 4 + wc;
        LAS unsigned char* my = scr + wave * EPI_SCR_WAVE;
        const int wofs = fr * 144 + fq * 16;
        const int rrow = lane >> 3, rc4 = (lane & 7) * 4;
        const int rofs = rrow * 144 + rc4 * 4;
        const int colw = u.pn * BM + wc * 32 + rc4;
        const unsigned loff = (unsigned)((wr * 64 + rrow) * DM + colw);
        f32x4 gv[2], gsn[2];
#pragma unroll
        for (int bj = 0; bj < 2; ++bj) { gv[bj] = *(const f32x4*)(gp + colw + bj * HALF);
            if (Hn) gsn[bj] = *(const f32x4*)(gn + colw + bj * HALF) * (*(const f32x4*)(scn + (size_t)cond * 6144 + colw + bj * HALF) + 1.0f); }
        h16* hp = Hn ? Hn + (size_t)u.pm * BM * DM : nullptr;
        float* sp = ssn ? ssn + u.pm * BM : nullptr;
#pragma unroll
        for (int ai = 0; ai < 2; ++ai)
#pragma unroll
        for (int mh = 0; mh < 2; ++mh) {
            f32x4 b[2][2][2];
#pragma unroll
            for (int m2 = 0; m2 < 2; ++m2)
#pragma unroll
                for (int k = 0; k < 2; ++k) { const float* rb = bp + (size_t)(ai * HALF + (2 * mh + m2) * 16 + 8 * k) * DM;
#pragma unroll
                    for (int bj = 0; bj < 2; ++bj) b[m2][bj][k] = *(const f32x4*)(rb + loff + bj * HALF); }
#pragma unroll
            for (int m2 = 0; m2 < 2; ++m2)
            { float q[2] = {0.f, 0.f};
#pragma unroll
                for (int bj = 0; bj < 2; ++bj) { const int m = 2 * mh + m2;
                    *(LAS f32x4*)(my + wofs) = acc[ai][bj][m][0]; *(LAS f32x4*)(my + wofs + 64) = acc[ai][bj][m][1];
#pragma unroll
                    for (int k = 0; k < 2; ++k) { const f32x4 a = *(const LAS f32x4*)(my + rofs + k * 8 * 144);
                        float* xb = xp + (size_t)(ai * HALF + m * 16 + 8 * k) * DM;
                        const f32x4 xn = b[m2][bj][k] + gv[bj] * a;
                        *(f32x4*)(xb + loff + bj * HALF) = xn;
                        if (Hn) { const f32x4 hv = xn * gsn[bj]; u32x2 w; w.x = pk_h2(hv[0], hv[1]); w.y = pk_h2(hv[2], hv[3]);
                            *(u32x2*)(hp + (size_t)(ai * HALF + m * 16 + 8 * k) * DM + loff + bj * HALF) = w;
                            q[k] += (xn[0] * xn[0] + xn[1] * xn[1]) + (xn[2] * xn[2] + xn[3] * xn[3]); } }
                }
                if (Hn) {
#pragma unroll
                    for (int k = 0; k < 2; ++k) { float t = sum8(q[k]);
                        if ((lane & 7) == 0) atomicAdd(sp + wr * 64 + ai * HALF + (2 * mh + m2) * 16 + 8 * k + rrow, t); } }
            }
            asm volatile("" ::: "memory"); }
    }
};

template <class Epi, class Sched, bool ALIGN_EPI = false, bool SP2 = false>
__device__ __forceinline__ void gemm_phase(LAS unsigned char* lds, const Gemm g, const Sched& S, const Epi& E) {
    int tid_ = threadIdx.x; asm volatile("" : "+v"(tid_));
    const int tid = tid_, wid = __builtin_amdgcn_readfirstlane(tid >> 6), lane = tid & 63, wr = wid >> 2, wc = wid & 3, fr = lane & 15, fq = lane >> 4;
    const int K = g.K, nt = K / BK, lda = g.lda;
    unsigned voffA[2], voffB[2];
#pragma unroll
    for (int i = 0; i < 2; ++i) { int R, C; stage_rc(tid * 16 + i * 8192, R, C); const int Rb = Epi::PERM ? ((R & ~31) + perm32(R & 31)) : R;
        voffA[i] = (unsigned)(R * lda + C) * 2u; voffB[i] = (unsigned)(Rb * K + C) * 2u; }
    const size_t kstep = (size_t)(BK * 2);
    const size_t hstepA = (size_t)HALF * lda * 2, hstepB = (size_t)HALF * K * 2;
    const size_t tstepA = 2 * hstepA, tstepB = 2 * hstepB;
    const unsigned ldsw = (unsigned)wid * 1024u;
    const int aoff = lds_byte(wr * 64 + fr, fq * 8), boff = lds_byte(wc * 32 + fr, fq * 8);
#define PG8_SA(b, h) (((b) * 2 + (h)) * HTB)
#define PG8_SB(b, h) ((4 + (b) * 2 + (h)) * HTB)
#define PG8_STAGE(bufoff, gbase, voff) do { _Pragma("unroll") for (int _i = 0; _i < 2; ++_i) \
        __builtin_amdgcn_global_load_lds((const unsigned*)((const char*)(gbase) + (voff)[_i]), (LAS unsigned*)(lds + (bufoff) + ldsw + _i * 8192), 16, 0, 0); } while (0)
#define PG8_LDA(dst, b, h) do { _Pragma("unroll") for (int m = 0; m < 4; ++m) _Pragma("unroll") for (int k = 0; k < 2; ++k) dst[m][k] = *(const LAS h16x8*)(lds + PG8_SA(b, h) + aoff + m * 2048 + k * 1024); } while (0)
#define PG8_LDB(dst, b, h) do { _Pragma("unroll") for (int n = 0; n < 2; ++n) _Pragma("unroll") for (int k = 0; k < 2; ++k) dst[n][k] = *(const LAS h16x8*)(lds + PG8_SB(b, h) + boff + n * 2048 + k * 1024); } while (0)
#define PG8_MMA(ai, bj, At, Bt) do { __builtin_amdgcn_s_setprio(1); _Pragma("unroll") for (int m = 0; m < 4; ++m) _Pragma("unroll") for (int n = 0; n < 2; ++n) _Pragma("unroll") for (int k = 0; k < 2; ++k) \
        acc[ai][bj][m][n] = __builtin_amdgcn_mfma_f32_16x16x32_f16(Bt[n][k], At[m][k], acc[ai][bj][m][n], 0, 0, 0); __builtin_amdgcn_s_setprio(0); } while (0)
#define PG8_WAIT_V(n) asm volatile("s_waitcnt vmcnt(" #n ")" ::: "memory")
#define PG8_WAIT_L(n) asm volatile("s_waitcnt lgkmcnt(" #n ")" ::: "memory")
#define PG8_BAR __builtin_amdgcn_s_barrier()
#define PG8_SCHED __builtin_amdgcn_sched_barrier(0)
    Unit cur, nxt; int ui = 0;
    if (!S.next(0, cur)) return;
    TSL_START(lds, 10);
    f32x4 acc[2][2][4][2];
#pragma unroll
    for (int a = 0; a < 2; ++a)
#pragma unroll
        for (int b = 0; b < 2; ++b)
#pragma unroll
            for (int m = 0; m < 4; ++m)
#pragma unroll
                for (int n = 0; n < 2; ++n) acc[a][b][m][n] = (f32x4){0.f, 0.f, 0.f, 0.f};
    h16x8 At[4][2], B0[2][2], B1[2][2];
    const char* cA = (const char*)g.A + (size_t)cur.pm * tstepA; const char* cB = (const char*)g.Bt + (size_t)cur.pn * tstepB;
    S.a_ready(cur);
    if constexpr (SP2) {
        PG8_STAGE(PG8_SB(0, 0), cB, voffB); PG8_STAGE(PG8_SB(0, 1), cB + hstepB, voffB); PG8_STAGE(PG8_SA(0, 0), cA, voffA); PG8_STAGE(PG8_SA(0, 1), cA + hstepA, voffA);
        if (wr == 1) PG8_BAR;
        PG8_WAIT_V(2); PG8_BAR;
        PG8_STAGE(PG8_SB(1, 0), cB + kstep, voffB); PG8_STAGE(PG8_SA(1, 0), cA + kstep, voffA); PG8_STAGE(PG8_SB(1, 1), cB + hstepB + kstep, voffB);
        PG8_WAIT_V(6); PG8_BAR;
    } else {
        PG8_STAGE(PG8_SB(0, 0), cB, voffB); PG8_STAGE(PG8_SA(0, 0), cA, voffA); PG8_STAGE(PG8_SB(0, 1), cB + hstepB, voffB); PG8_STAGE(PG8_SA(0, 1), cA + hstepA, voffA);
        if (wr == 1) PG8_BAR;
        PG8_WAIT_V(4); PG8_BAR;
        PG8_STAGE(PG8_SB(1, 0), cB + kstep, voffB); PG8_STAGE(PG8_SA(1, 0), cA + kstep, voffA); PG8_STAGE(PG8_SB(1, 1), cB + hstepB + kstep, voffB);
        PG8_WAIT_V(6); PG8_BAR;
    }
    for (;;) {
        const bool has_next = S.next(ui + 1, nxt);
        const char* nA = has_next ? (const char*)g.A + (size_t)nxt.pm * tstepA : cA; const char* nB = has_next ? (const char*)g.Bt + (size_t)nxt.pn * tstepB : cB;
        for (int t = 0; t < nt; t += 2) {
            const bool last = (t == nt - 2);
            const char* a1 = cA + (size_t)(t + 1) * kstep;
            const char* a2 = last ? nA : cA + (size_t)(t + 2) * kstep; const char* b2 = last ? nB : cB + (size_t)(t + 2) * kstep;
            const char* a3 = a2 + kstep; const char* b3 = b2 + kstep;
            if (last && has_next) S.a_ready(nxt);
            if constexpr (SP2) {
            PG8_LDB(B0, 0, 0); PG8_LDB(B1, 0, 1); PG8_SCHED; PG8_LDA(At, 0, 0); PG8_STAGE(PG8_SA(1, 1), a1 + hstepA, voffA);
            PG8_WAIT_V(8); PG8_WAIT_L(0); PG8_BAR; PG8_MMA(0, 0, At, B0); PG8_MMA(0, 1, At, B1); PG8_BAR; PG8_SCHED;
            PG8_LDA(At, 0, 1); PG8_STAGE(PG8_SB(0, 0), b2, voffB); PG8_STAGE(PG8_SB(0, 1), b2 + hstepB, voffB); PG8_STAGE(PG8_SA(0, 0), a2, voffA);
            PG8_WAIT_V(8); PG8_WAIT_L(0); PG8_BAR; PG8_MMA(1, 0, At, B0); PG8_MMA(1, 1, At, B1); PG8_BAR; PG8_SCHED;
            PG8_LDB(B0, 1, 0); PG8_LDB(B1, 1, 1); PG8_SCHED; PG8_LDA(At, 1, 0); PG8_STAGE(PG8_SA(0, 1), a2 + hstepA, voffA);
            PG8_WAIT_V(8); PG8_WAIT_L(0); PG8_BAR; PG8_MMA(0, 0, At, B0); PG8_MMA(0, 1, At, B1); PG8_BAR; PG8_SCHED;
            PG8_LDA(At, 1, 1); PG8_STAGE(PG8_SB(1, 0), b3, voffB); PG8_STAGE(PG8_SB(1, 1), b3 + hstepB, voffB); PG8_STAGE(PG8_SA(1, 0), a3, voffA);
            PG8_WAIT_V(8); PG8_WAIT_L(0); PG8_BAR; PG8_MMA(1, 0, At, B0); PG8_MMA(1, 1, At, B1); PG8_BAR; PG8_SCHED;
            } else {
            PG8_LDB(B0, 0, 0); PG8_SCHED; PG8_LDA(At, 0, 0); PG8_STAGE(PG8_SA(1, 1), a1 + hstepA, voffA);
            PG8_WAIT_L(8); PG8_BAR; PG8_WAIT_L(0); PG8_MMA(0, 0, At, B0); PG8_BAR; PG8_SCHED;
            PG8_LDB(B1, 0, 1); PG8_STAGE(PG8_SB(0, 0), b2, voffB);
            PG8_BAR; PG8_WAIT_L(0); PG8_MMA(0, 1, At, B1); PG8_BAR;
            PG8_LDA(At, 0, 1); PG8_STAGE(PG8_SA(0, 0), a2, voffA);
            PG8_BAR; PG8_WAIT_L(0); PG8_MMA(1, 0, At, B0); PG8_BAR; PG8_SCHED;
            PG8_STAGE(PG8_SB(0, 1), b2 + hstepB, voffB);
            PG8_WAIT_V(6); PG8_BAR; PG8_MMA(1, 1, At, B1); PG8_BAR;
            PG8_LDB(B0, 1, 0); PG8_SCHED; PG8_LDA(At, 1, 0); PG8_STAGE(PG8_SA(0, 1), a2 + hstepA, voffA);
            PG8_WAIT_L(8); PG8_BAR; PG8_WAIT_L(0); PG8_MMA(0, 0, At, B0); PG8_BAR; PG8_SCHED;
            PG8_LDB(B1, 1, 1); PG8_STAGE(PG8_SB(1, 0), b3, voffB);
            PG8_BAR; PG8_WAIT_L(0); PG8_MMA(0, 1, At, B1); PG8_BAR;
            PG8_LDA(At, 1, 1); PG8_STAGE(PG8_SA(1, 0), a3, voffA);
            PG8_BAR; PG8_WAIT_L(0); PG8_MMA(1, 0, At, B0); PG8_BAR; PG8_SCHED;
            PG8_STAGE(PG8_SB(1, 1), b3 + hstepB, voffB);
            PG8_WAIT_V(6); PG8_BAR; PG8_MMA(1, 1, At, B1); PG8_BAR;
            }
        }
        if constexpr (ALIGN_EPI) { if (wr == 0) PG8_BAR; }
        TSL_STOP(lds, 10); TSL_START(lds, 11);
        if constexpr (!Epi::AFTER_DRAIN) { E(acc, cur, wr, wc, fr, fq); S.done(cur); }
        TSL_STOP(lds, 11); TSL_START(lds, 10);
        if (!has_next) break;
#pragma unroll
        for (int a = 0; a < 2; ++a)
#pragma unroll
            for (int b = 0; b < 2; ++b)
#pragma unroll
                for (int m = 0; m < 4; ++m)
#pragma unroll
                    for (int n = 0; n < 2; ++n) acc[a][b][m][n] = (f32x4){0.f, 0.f, 0.f, 0.f};
        cur = nxt; cA = nA; cB = nB; ++ui;
        if constexpr (ALIGN_EPI) { if (wr == 1) PG8_BAR; }
    }
    PG8_WAIT_V(0);
    if constexpr (!ALIGN_EPI) { if (wr == 0) PG8_BAR; }
    PG8_BAR;
    TSL_STOP(lds, 10);
#undef PG8_SA
#undef PG8_SB
#undef PG8_STAGE
#undef PG8_LDA
#undef PG8_LDB
#undef PG8_MMA
#undef PG8_WAIT_V
#undef PG8_WAIT_L
#undef PG8_BAR
#undef PG8_SCHED
}

struct EpiGM {
    static constexpr bool PERM = true, AFTER_DRAIN = false;
    h16* Mg; h16* S; const float* ss; const float* cv; int cvld;
    __device__ __forceinline__ void operator()(const f32x4 (&acc)[2][2][4][2], const Unit& u, int kind, int wr, int wc, int fr_, int fq_) const {
        int fr = fr_, fq = fq_; asm volatile("" : "+v"(fr), "+v"(fq));
        const int r0 = wr * 64 + fr, c0 = wc * 32 + 8 * fq;
        if ((kind & 15) == 0) {
            const int gi = kind >> 4, cond = u.pm < 32 ? 0 : (u.pm < 48 ? 1 : 2);
            f32x4 ca[2], cb[2];
#pragma unroll
            for (int bj = 0; bj < 2; ++bj) { const float* cp = cv + (size_t)cond * cvld + gi * 1024 + u.pn * BM + c0 + bj * HALF; ca[bj] = *(const f32x4*)cp; cb[bj] = *(const f32x4*)(cp + 4); }
#pragma unroll
            for (int ai = 0; ai < 2; ++ai)
#pragma unroll
                for (int m = 0; m < 4; ++m) { const int rt = r0 + ai * HALF + m * 16;
                    const float rstd = 1.0f / sqrtf(ss[u.pm * BM + rt] * (1.0f / DM) + NORM_EPS);
#pragma unroll
                    for (int bj = 0; bj < 2; ++bj) { f32x4 v0 = acc[ai][bj][m][0] * rstd + ca[bj], v1 = acc[ai][bj][m][1] * rstd + cb[bj];
#pragma unroll
                        for (int j = 0; j < 4; ++j) { v0[j] = sigmoidf_(v0[j]); v1[j] = sigmoidf_(v1[j]); }
                        u32x4 w; w.x = pk_h2(v0[0], v0[1]); w.y = pk_h2(v0[2], v0[3]); w.z = pk_h2(v1[0], v1[1]); w.w = pk_h2(v1[2], v1[3]);
                        *(u32x4*)(S + rt * BM + c0 + bj * HALF) = w; } }
        } else {
            const bool accum = kind == 2;
#pragma unroll
            for (int ai = 0; ai < 2; ++ai)
#pragma unroll
            for (int mh = 0; mh < 2; ++mh) {
                u32x4 gw[2][2], mw[2][2];
#pragma unroll
                for (int m2 = 0; m2 < 2; ++m2) { const int rt = r0 + ai * HALF + (2 * mh + m2) * 16;
#pragma unroll
                    for (int bj = 0; bj < 2; ++bj) { gw[m2][bj] = *(const u32x4*)(S + rt * BM + c0 + bj * HALF);
                        mw[m2][bj] = accum ? *(const u32x4*)(Mg + (size_t)(u.pm * BM + rt) * DM + u.pn * BM + c0 + bj * HALF) : (u32x4){0u, 0u, 0u, 0u}; } }
#pragma unroll
                for (int m2 = 0; m2 < 2; ++m2) { const int m = 2 * mh + m2; const int rt = r0 + ai * HALF + m * 16;
#pragma unroll
                    for (int bj = 0; bj < 2; ++bj) {
                        float g[8], o[8]; unpack8(gw[m2][bj], g); unpack8(mw[m2][bj], o);
                        const f32x4 v0 = acc[ai][bj][m][0], v1 = acc[ai][bj][m][1];
#pragma unroll
                        for (int j = 0; j < 4; ++j) { o[j] += g[j] * v0[j]; o[4 + j] += g[4 + j] * v1[j]; }
                        *(u32x4*)(Mg + (size_t)(u.pm * BM + rt) * DM + u.pn * BM + c0 + bj * HALF) = pack8(o); } }
                asm volatile("" ::: "memory"); }
        }
    }
};
struct Sub { const h16* A; const h16* Bt; int K, lda, kind; };
template <class Jobs, class Epi>
__device__ __forceinline__ void gemm_multi(LAS unsigned char* lds, const Jobs& J, const Epi& E) {
    int tid_ = threadIdx.x; asm volatile("" : "+v"(tid_));
    const int tid = tid_, wid = __builtin_amdgcn_readfirstlane(tid >> 6), lane = tid & 63, wr = wid >> 2, wc = wid & 3, fr = lane & 15, fq = lane >> 4;
    unsigned rA2[2], rB2[2], c2[2];
#pragma unroll
    for (int i = 0; i < 2; ++i) { int R, C; stage_rc(tid * 16 + i * 8192, R, C); const int Rb = Epi::PERM ? ((R & ~31) + perm32(R & 31)) : R;
        rA2[i] = (unsigned)R * 2u; rB2[i] = (unsigned)Rb * 2u; c2[i] = (unsigned)C * 2u; }
    const size_t kstep = (size_t)(BK * 2);
    const unsigned ldsw = (unsigned)wid * 1024u;
    const int aoff = lds_byte(wr * 64 + fr, fq * 8), boff = lds_byte(wc * 32 + fr, fq * 8);
#define PG8_SA(b, h) (((b) * 2 + (h)) * HTB)
#define PG8_SB(b, h) ((4 + (b) * 2 + (h)) * HTB)
#define PG8_STAGE2(bufoff, gbase, rr, ld) do { _Pragma("unroll") for (int _i = 0; _i < 2; ++_i) \
        __builtin_amdgcn_global_load_lds((const unsigned*)((const char*)(gbase) + ((rr)[_i] * (unsigned)(ld) + c2[_i])), (LAS unsigned*)(lds + (bufoff) + ldsw + _i * 8192), 16, 0, 0); } while (0)
#define PG8_LDA(dst, b, h) do { _Pragma("unroll") for (int m = 0; m < 4; ++m) _Pragma("unroll") for (int k = 0; k < 2; ++k) dst[m][k] = *(const LAS h16x8*)(lds + PG8_SA(b, h) + aoff + m * 2048 + k * 1024); } while (0)
#define PG8_LDB(dst, b, h) do { _Pragma("unroll") for (int n = 0; n < 2; ++n) _Pragma("unroll") for (int k = 0; k < 2; ++k) dst[n][k] = *(const LAS h16x8*)(lds + PG8_SB(b, h) + boff + n * 2048 + k * 1024); } while (0)
#define PG8_MMA(ai, bj, At, Bt) do { __builtin_amdgcn_s_setprio(1); _Pragma("unroll") for (int m = 0; m < 4; ++m) _Pragma("unroll") for (int n = 0; n < 2; ++n) _Pragma("unroll") for (int k = 0; k < 2; ++k) \
        acc[ai][bj][m][n] = __builtin_amdgcn_mfma_f32_16x16x32_f16(Bt[n][k], At[m][k], acc[ai][bj][m][n], 0, 0, 0); __builtin_amdgcn_s_setprio(0); } while (0)
#define PG8_WAIT_V(n) asm volatile("s_waitcnt vmcnt(" #n ")" ::: "memory")
#define PG8_WAIT_L(n) asm volatile("s_waitcnt lgkmcnt(" #n ")" ::: "memory")
#define PG8_BAR __builtin_amdgcn_s_barrier()
#define PG8_SCHED __builtin_amdgcn_sched_barrier(0)
    const int njobs = J.count(); if (njobs == 0) return;
    int ui = 0; Unit cur = J.unit(0); Sub cs = J.sub(0);
    f32x4 acc[2][2][4][2];
#pragma unroll
    for (int a = 0; a < 2; ++a)
#pragma unroll
        for (int b = 0; b < 2; ++b)
#pragma unroll
            for (int m = 0; m < 4; ++m)
#pragma unroll
                for (int n = 0; n < 2; ++n) acc[a][b][m][n] = (f32x4){0.f, 0.f, 0.f, 0.f};
    h16x8 At[4][2], B0[2][2], B1[2][2];
    int ldA = cs.lda, ldB = cs.K;
    size_t hA = (size_t)HALF * ldA * 2, hB = (size_t)HALF * ldB * 2;
    const char* cA = (const char*)cs.A + (size_t)cur.pm * 2 * hA; const char* cB = (const char*)cs.Bt + (size_t)cur.pn * 2 * hB;
    PG8_STAGE2(PG8_SB(0, 0), cB, rB2, ldB); PG8_STAGE2(PG8_SB(0, 1), cB + hB, rB2, ldB); PG8_STAGE2(PG8_SA(0, 0), cA, rA2, ldA); PG8_STAGE2(PG8_SA(0, 1), cA + hA, rA2, ldA);
    if (wr == 1) PG8_BAR;
    PG8_WAIT_V(2); PG8_BAR;
    PG8_STAGE2(PG8_SB(1, 0), cB + kstep, rB2, ldB); PG8_STAGE2(PG8_SA(1, 0), cA + kstep, rA2, ldA); PG8_STAGE2(PG8_SB(1, 1), cB + hB + kstep, rB2, ldB);
    PG8_WAIT_V(6); PG8_BAR;
    for (;;) {
        const bool has_next = ui + 1 < njobs;
        const Unit nxt = J.unit(has_next ? ui + 1 : ui); const Sub ns = J.sub(has_next ? ui + 1 : ui);
        const int nldA = has_next ? ns.lda : ldA, nldB = has_next ? ns.K : ldB;
        const size_t nhA = (size_t)HALF * nldA * 2, nhB = (size_t)HALF * nldB * 2;
        const char* nA = has_next ? (const char*)ns.A + (size_t)nxt.pm * 2 * nhA : cA; const char* nB = has_next ? (const char*)ns.Bt + (size_t)nxt.pn * 2 * nhB : cB;
        const int nt = cs.K / BK;
        for (int t = 0; t < nt; t += 2) {
            const bool last = (t == nt - 2);
            const char* a1 = cA + (size_t)(t + 1) * kstep;
            const char* a2 = last ? nA : cA + (size_t)(t + 2) * kstep; const char* b2 = last ? nB : cB + (size_t)(t + 2) * kstep;
            const char* a3 = a2 + kstep; const char* b3 = b2 + kstep;
            const int l2A = last ? nldA : ldA, l2B = last ? nldB : ldB; const size_t h2A = last ? nhA : hA, h2B = last ? nhB : hB;
            PG8_LDB(B0, 0, 0); PG8_LDB(B1, 0, 1); PG8_SCHED; PG8_LDA(At, 0, 0); PG8_STAGE2(PG8_SA(1, 1), a1 + hA, rA2, ldA);
            PG8_WAIT_V(8); PG8_WAIT_L(0); PG8_BAR; PG8_MMA(0, 0, At, B0); PG8_MMA(0, 1, At, B1); PG8_BAR; PG8_SCHED;
            PG8_LDA(At, 0, 1); PG8_STAGE2(PG8_SB(0, 0), b2, rB2, l2B); PG8_STAGE2(PG8_SB(0, 1), b2 + h2B, rB2, l2B); PG8_STAGE2(PG8_SA(0, 0), a2, rA2, l2A);
            PG8_WAIT_V(8); PG8_WAIT_L(0); PG8_BAR; PG8_MMA(1, 0, At, B0); PG8_MMA(1, 1, At, B1); PG8_BAR; PG8_SCHED;
            PG8_LDB(B0, 1, 0); PG8_LDB(B1, 1, 1); PG8_SCHED; PG8_LDA(At, 1, 0); PG8_STAGE2(PG8_SA(0, 1), a2 + h2A, rA2, l2A);
            PG8_WAIT_V(8); PG8_WAIT_L(0); PG8_BAR; PG8_MMA(0, 0, At, B0); PG8_MMA(0, 1, At, B1); PG8_BAR; PG8_SCHED;
            PG8_LDA(At, 1, 1); PG8_STAGE2(PG8_SB(1, 0), b3, rB2, l2B); PG8_STAGE2(PG8_SB(1, 1), b3 + h2B, rB2, l2B); PG8_STAGE2(PG8_SA(1, 0), a3, rA2, l2A);
            PG8_WAIT_V(8); PG8_WAIT_L(0); PG8_BAR; PG8_MMA(1, 0, At, B0); PG8_MMA(1, 1, At, B1); PG8_BAR; PG8_SCHED;
        }
        if (wr == 0) PG8_BAR;
        E(acc, cur, cs.kind, wr, wc, fr, fq);
        if (!has_next) break;
#pragma unroll
        for (int a = 0; a < 2; ++a)
#pragma unroll
            for (int b = 0; b < 2; ++b)
#pragma unroll
                for (int m = 0; m < 4; ++m)
#pragma unroll
                    for (int n = 0; n < 2; ++n) acc[a][b][m][n] = (f32x4){0.f, 0.f, 0.f, 0.f};
        cur = nxt; cs = ns; cA = nA; cB = nB; ldA = nldA; ldB = nldB; hA = nhA; hB = nhB; ++ui;
        if (wr == 1) PG8_BAR;
    }
    PG8_WAIT_V(0);
    PG8_BAR;
#undef PG8_SA
#undef PG8_SB
#undef PG8_STAGE2
#undef PG8_LDA
#undef PG8_LDB
#undef PG8_MMA
#undef PG8_WAIT_V
#undef PG8_WAIT_L
#undef PG8_BAR
#undef PG8_SCHED
}
struct GateMergeJobs {
    StaticOrder S; const unsigned char* ws; size_t wbase;
    __device__ __forceinline__ int count() const { int n = 0; Unit u; while (S.next(n, u)) ++n; return 6 * n; }
    __device__ __forceinline__ Unit unit(int i) const { Unit u; u.pm = 0; u.pn = 0; (void)S.next(i / 6, u); return u; }
    __device__ __forceinline__ Sub sub(int i) const {
        const int k = i % 6, br = k >> 1; const bool gate = (k & 1) == 0; Sub sb;
        const size_t a_off = gate ? WS_H : WS_ZU + (br == 0 ? ZU_OA : (br == 1 ? ZU_OB : ZU_OC));
        const size_t b_off = wbase + (gate ? W_IN + ((size_t)NMAIN + (size_t)br * 1024) * DM * 2 : (br == 0 ? W_OA : (br == 1 ? W_OB : W_OC)));
        sb.A = (const h16*)(ws + a_off); sb.Bt = (const h16*)(ws + b_off);
        sb.K = (gate || br == 0) ? 1024 : 512; sb.lda = sb.K; sb.kind = gate ? (br << 4) : (br == 0 ? 1 : 2);
        return sb;
    }
};
}

constexpr int NWAVES = 8, NTHREADS = 512;

typedef GAS unsigned gu32;
#define RLX_AGENT __ATOMIC_RELAXED, __HIP_MEMORY_SCOPE_AGENT
#define LDS_WAIT() asm volatile("s_waitcnt lgkmcnt(0)" ::: "memory")
#define VM_WAIT() asm volatile("s_waitcnt vmcnt(0)" ::: "memory")

#define XB_TMO      128
#define XB_XCNT(j)  (256  + 64 * (j))
#define XB_XSUB(j)  (1280 + 64 * (j))
#define XB_XGEN(j)  (2304 + 64 * (j))
#define XB_TOP      3328
#define XB_TOPGEN   3392
#define XCD_BAR_WORDS 3456
#define XB_SPIN_CAP (1u << 18)
__device__ __forceinline__ unsigned xb_ld(unsigned* p)              { return __hip_atomic_load(p, __ATOMIC_RELAXED, __HIP_MEMORY_SCOPE_AGENT); }
__device__ __forceinline__ unsigned xb_add(unsigned* p, unsigned v) { return __hip_atomic_fetch_add(p, v, __ATOMIC_RELAXED, __HIP_MEMORY_SCOPE_AGENT); }
__device__ __forceinline__ unsigned xb_xcc_id() { return (unsigned)__builtin_amdgcn_s_getreg((3 << 11) | 20) & 0xFu; }
#define XB_SPIN(cond, bar) do { unsigned _sp = 0; while (cond) { __builtin_amdgcn_s_sleep(1); \
    if ((++_sp & 255u) == 0u) { if (xb_ld(&(bar)[XB_TMO])) break; if (_sp > XB_SPIN_CAP) { atomicAdd(&(bar)[XB_TMO], 1u); break; } } } } while (0)
struct XcdBarrier { unsigned* bar; unsigned x; volatile LAS unsigned* st; };
__device__ __forceinline__ XcdBarrier xcd_barrier_post(unsigned* bar, volatile LAS unsigned* st) {
    XcdBarrier b; b.bar = bar; b.x = xb_xcc_id(); b.st = st;
    if (threadIdx.x == 0) (void)xb_add(&bar[XB_XCNT(b.x)], 1u);
    return b;
}
__device__ __forceinline__ void xcd_barrier_complete(unsigned* bar, unsigned x, unsigned& nloc, unsigned& nx) {
    const unsigned G = gridDim.x * gridDim.y * gridDim.z;
    unsigned sum, cnt, mine, sp = 0u;
    for (;;) {
        sum = 0u; cnt = 0u; mine = 0u;
#pragma unroll
        for (unsigned j = 0; j < 16; ++j) { const unsigned c = xb_ld(&bar[XB_XCNT(j)]); sum += c; cnt += (c > 0u) ? 1u : 0u; mine = (j == x) ? c : mine; }
        if (sum == G) break;
        __builtin_amdgcn_s_sleep(1);
        if ((++sp & 255u) == 0u) { if (xb_ld(&bar[XB_TMO])) break; if (sp > XB_SPIN_CAP) { atomicAdd(&bar[XB_TMO], 1u); break; } }
    }
    nloc = mine > 0u ? mine : 1u; nx = cnt > 0u ? cnt : 1u;
}
__device__ __forceinline__ void xcd_barrier(const XcdBarrier& b) {
    asm volatile("s_waitcnt vmcnt(0)" ::: "memory");
    __syncthreads();
    if (threadIdx.x == 0) {
        unsigned* bar = b.bar;
        __builtin_amdgcn_s_waitcnt(0);
        unsigned nloc = b.st[0], nx = b.st[1];
        if (nloc == 0u) { xcd_barrier_complete(bar, b.x, nloc, nx); b.st[0] = nloc; b.st[1] = nx; }
        const unsigned old = xb_add(&bar[XB_XSUB(b.x)], 1u);
        const unsigned gen = old / nloc;
        if (old + 1u == (gen + 1u) * nloc) {
            __builtin_amdgcn_fence(__ATOMIC_RELEASE, "agent");
            asm volatile("s_waitcnt vmcnt(0)" ::: "memory");
            const unsigned og = xb_add(&bar[XB_TOP], 1u);
            const unsigned tg = og / nx;
            if (og + 1u == (tg + 1u) * nx) xb_add(&bar[XB_TOPGEN], 1u);
            else XB_SPIN(xb_ld(&bar[XB_TOPGEN]) == tg, bar);
            __builtin_amdgcn_fence(__ATOMIC_ACQUIRE, "agent");
            xb_add(&bar[XB_XGEN(b.x)], 1u);
            asm volatile("s_waitcnt vmcnt(0)" ::: "memory");
        } else {
            XB_SPIN(xb_ld(&bar[XB_XGEN(b.x)]) == gen, bar);
            __builtin_amdgcn_fence(__ATOMIC_ACQUIRE, "agent");
            asm volatile("s_waitcnt vmcnt(0)" ::: "memory");
        }
    }
    __syncthreads();
}
constexpr int CW_BAR = 4096;
static_assert((CW_BAR + XCD_BAR_WORDS) * 4 <= (int)CTL_ZERO_BYTES, "ctl");

struct Args {
    const float* in[33]; float* out; unsigned char* ws; int ph_lo, ph_hi;
};
typedef const GAS float* cfp_t;
struct Frame {
    LAS unsigned char* lds;
    int tid, lane, wave, vcu, G, bid, vcu0, G0;
    const __attribute__((address_space(4))) cfp_t* in; float* out; unsigned char* ws; float* out0; unsigned char* ws0;
    __device__ __forceinline__ const float* inp(int i) const { return (const float*)in[i]; }
    __device__ __forceinline__ void refresh() { int t = threadIdx.x; asm volatile("" : "+v"(t)); tid = t; lane = t & 63; wave = __builtin_amdgcn_readfirstlane(t >> 6);
        { int b_ = blockIdx.x, v_ = vcu0, g_ = G0; asm volatile("" : "+s"(b_), "+s"(v_), "+s"(g_)); bid = b_; vcu = v_; G = g_; }
        const __attribute__((address_space(4))) cfp_t* p = (const __attribute__((address_space(4))) cfp_t*)__builtin_amdgcn_kernarg_segment_ptr(); asm volatile("" : "+s"(p)); in = p;
        GAS float* o_ = (GAS float*)out0; GAS unsigned char* w_ = (GAS unsigned char*)ws0; asm volatile("" : "+s"(o_), "+s"(w_)); out = (float*)o_; ws = (unsigned char*)w_; }
};
enum { I_XP = 0, I_XS, I_C, I_CKB, I_CVB, I_CKC, I_CVC, I_STATE, I_CCTX, I_N1G, I_N2G, I_WMOD, I_BMOD, I_WIN, I_LCW, I_LCB, I_LWA, I_LBA, I_LWX, I_LBX, I_LAM,
       I_QNG, I_KNG, I_SINK, I_WOA, I_WOB, I_WOC, I_WOUT, I_WUP, I_FCW, I_FCB, I_WDOWN, I_FING };

__device__ __forceinline__ void transpose_item(const float* W, int K, int N, h16* WT, LAS float* scr, int item, int lane, bool upmap = false) {
    const int nblk = N / 32, kb = item / nblk, nb = item % nblk, k0 = 64 * kb, n0 = 32 * nb;
    const int d0 = !upmap ? n0 : (n0 < DFF ? (n0 / 128) * 256 + n0 % 128 : ((n0 - DFF) / 128) * 256 + 128 + (n0 - DFF) % 128);
    f32x4 v[8];
#pragma unroll
    for (int i = 0; i < 8; ++i) v[i] = *(const f32x4*)(W + (size_t)(k0 + 8 * i + (lane >> 3)) * N + n0 + 4 * (lane & 7));
#pragma unroll
    for (int i = 0; i < 8; ++i) { LAS float* d = scr + (8 * i + (lane >> 3)) * 33 + 4 * (lane & 7); d[0] = v[i].x; d[1] = v[i].y; d[2] = v[i].z; d[3] = v[i].w; }
    LDS_WAIT(); asm volatile("" ::: "memory");
    const int c = lane & 7;
#pragma unroll
    for (int j = 0; j < 4; ++j) { const int n = (lane >> 3) + 8 * j; const LAS float* sp = scr + (8 * c) * 33 + n;
        u32x4 o; o.x = pk_h2(sp[0 * 33], sp[1 * 33]); o.y = pk_h2(sp[2 * 33], sp[3 * 33]); o.z = pk_h2(sp[4 * 33], sp[5 * 33]); o.w = pk_h2(sp[6 * 33], sp[7 * 33]);
        *(u32x4*)(WT + (size_t)(d0 + n) * K + k0 + 8 * c) = o; }
    LDS_WAIT(); asm volatile("" ::: "memory");
}
__device__ __forceinline__ void phase_convert_weights(Frame& F, int l, int part = 0, int wg0 = 0) {
    LAS float* scr = (LAS float*)(F.lds + F.wave * 16384);
    const int gw = (part == 0 ? F.vcu : F.bid - wg0) * NWAVES + F.wave, NGW = (part == 0 ? F.G : F.G - wg0) * NWAVES;
    unsigned char* wb = F.ws + wsw(l);
    constexpr int IT_IN = (DM / 64) * (DIN / 32), IT_OA = (1024 / 64) * (DM / 32), IT_OB = (512 / 64) * (DM / 32), IT_OUT = (DM / 64) * (DM / 32),
                  IT_UP = (DM / 64) * (DUP / 32), IT_DOWN = (DFF / 64) * (DM / 32), IT_LRU1 = (128 / 64) * (128 / 32), IT_LRU = 32 * IT_LRU1;
    constexpr int NITEMS = IT_IN + IT_OA + 2 * IT_OB + IT_OUT + IT_UP + IT_DOWN + IT_LRU;
    const int it_lo = part == 2 ? NITEMS / 2 : 0, it_hi = part == 1 ? NITEMS / 2 : NITEMS;
    for (int it = it_lo + gw; it < it_hi; it += NGW) {
        int r = it;
        if (r < IT_IN) { transpose_item(F.inp(I_WIN) + (size_t)l * DM * DIN, DM, DIN, (h16*)(wb + W_IN), scr, r, F.lane); continue; } r -= IT_IN;
        if (r < IT_OA) { transpose_item(F.inp(I_WOA) + (size_t)l * 1024 * DM, 1024, DM, (h16*)(wb + W_OA), scr, r, F.lane); continue; } r -= IT_OA;
        if (r < IT_OB) { transpose_item(F.inp(I_WOB) + (size_t)l * 512 * DM, 512, DM, (h16*)(wb + W_OB), scr, r, F.lane); continue; } r -= IT_OB;
        if (r < IT_OB) { transpose_item(F.inp(I_WOC) + (size_t)l * 512 * DM, 512, DM, (h16*)(wb + W_OC), scr, r, F.lane); continue; } r -= IT_OB;
        if (r < IT_OUT) { transpose_item(F.inp(I_WOUT) + (size_t)l * DM * DM, DM, DM, (h16*)(wb + W_OUT), scr, r, F.lane); continue; } r -= IT_OUT;
        if (r < IT_UP) { transpose_item(F.inp(I_WUP) + (size_t)l * DM * DUP, DM, DUP, (h16*)(wb + W_UP), scr, r, F.lane, true); continue; } r -= IT_UP;
        if (r < IT_DOWN) { transpose_item(F.inp(I_WDOWN) + (size_t)l * DFF * DM, DFF, DM, (h16*)(wb + W_DOWN), scr, r, F.lane); continue; } r -= IT_DOWN;
        {
            const int mi = r / IT_LRU1, sub = r % IT_LRU1, dir = mi >> 4, gate = (mi >> 3) & 1, n = mi & 7;
            const float* src = (gate ? F.inp(I_LWX) : F.inp(I_LWA)) + ((size_t)((l * 2 + dir) * 8 + n)) * 128 * 128;
            transpose_item(src, 128, 128, (h16*)(wb + W_LRU) + (size_t)mi * 128 * 128, scr, sub, F.lane);
        }
    }
}
__device__ __forceinline__ void phase_prep_misc(Frame& F) {
    LAS float* sil = (LAS float*)F.lds;
    LAS float* part = (LAS float*)(F.lds + 16384);
    float* mod = (float*)(F.ws + WS_MOD);
    for (int item = F.vcu; item < 192; item += F.G) {
        const int l = item / 96, n0 = (item % 96) * 64;
        __syncthreads();
        for (int i = F.tid; i < 3 * 1024; i += NTHREADS) { const int j = i >> 10, k = i & 1023;
            const float v = j == 0 ? F.inp(I_CCTX)[k] : F.inp(I_C)[(j - 1) * 1024 + k]; sil[i] = v * sigmoidf_(v); }
        __syncthreads();
        const float* wp = F.inp(I_WMOD) + (size_t)l * DM * 6144 + n0 + F.lane;
        float a0 = 0.f, a1 = 0.f, a2 = 0.f;
        const int kb = F.wave * 128;
#pragma unroll 8
        for (int k = 0; k < 128; ++k) { const float w = wp[(size_t)(kb + k) * 6144]; a0 += w * sil[kb + k]; a1 += w * sil[1024 + kb + k]; a2 += w * sil[2048 + kb + k]; }
        part[(F.wave * 3 + 0) * 64 + F.lane] = a0; part[(F.wave * 3 + 1) * 64 + F.lane] = a1; part[(F.wave * 3 + 2) * 64 + F.lane] = a2;
        __syncthreads();
        if (F.tid < 192) { const int j = F.tid >> 6, c = F.tid & 63; float s = F.inp(I_BMOD)[l * 6144 + n0 + c];
#pragma unroll
            for (int w = 0; w < 8; ++w) s += part[(w * 3 + j) * 64 + c];
            mod[((size_t)l * 3 + j) * 6144 + n0 + c] = s; }
    }
    __syncthreads();
    const int gt = F.vcu * NTHREADS + F.tid, NGT = F.G * NTHREADS;
    float* rope = (float*)(F.ws + WS_ROPE);
    for (int i = gt; i < 64 * 16; i += NGT) { const int pos = i >> 4, fi = i & 15; const float inv = expf(-(float)fi * (1.0f / 16.0f) * 9.210340371976184f);
        const float ang = (float)pos * inv; rope[2 * i] = cosf(ang); rope[2 * i + 1] = sinf(ang); }
    h16* cache = (h16*)(F.ws + WS_CACHE);
    for (int i = gt; i < 4 * 131072 / 4; i += NGT) { const int kind = i / 32768, e = (i % 32768) * 4;
        const float* src = kind == 0 ? F.inp(I_CKB) : kind == 1 ? F.inp(I_CVB) : kind == 2 ? F.inp(I_CKC) : F.inp(I_CVC);
        const f32x4 v = *(const f32x4*)(src + e); u32x2 w; w.x = pk_h2(v[0], v[1]); w.y = pk_h2(v[2], v[3]); *(u32x2*)(cache + (size_t)kind * 131072 + e) = w; }
}

__device__ __forceinline__ const float* xrow_ptr(const Frame& F, int layer_src_is_input, int row) {
    if (layer_src_is_input) return row < NCTX ? F.inp(I_XP) + (size_t)row * DM : F.inp(I_XS) + (size_t)(row - NCTX) * DM;
    return F.out + O_Y + (size_t)row * DM;
}
__device__ __forceinline__ void phase_norm0(Frame& F, const float* g, const float* mod_l, float* ss) {
    const int gw = F.vcu * NWAVES + F.wave, NGW = F.G * NWAVES;
    h16* H = (h16*)(F.ws + WS_H);
    for (int grp = gw; grp < NTOK / 4; grp += NGW) {
        const int row0 = grp * 4;
        const int cond = row0 < NCTX ? 0 : (row0 < NCTX + LSEQ ? 1 : 2);
        const float* mp = mod_l + (size_t)cond * 6144;
        f32x4 v[4][4];
#pragma unroll
        for (int i = 0; i < 4; ++i) { const f32x4* xr = (const f32x4*)xrow_ptr(F, 1, row0 + i) + F.lane;
#pragma unroll
            for (int j = 0; j < 4; ++j) v[i][j] = xr[64 * j]; }
        f32x4 gs[4];
#pragma unroll
        for (int j = 0; j < 4; ++j) { const int c = F.lane * 4 + 256 * j; gs[j] = *(const f32x4*)(g + c) * (*(const f32x4*)(mp + 1024 + c) + 1.0f); }
#pragma unroll
        for (int i = 0; i < 4; ++i) {
            float sq = 0.f;
#pragma unroll
            for (int j = 0; j < 4; ++j) sq += (v[i][j].x * v[i][j].x + v[i][j].y * v[i][j].y) + (v[i][j].z * v[i][j].z + v[i][j].w * v[i][j].w);
            sq = wave_sum(sq);
            if (F.lane == 0) ss[row0 + i] = sq;
            u32x2* o8 = (u32x2*)(H + (size_t)(row0 + i) * DM) + F.lane;
#pragma unroll
            for (int j = 0; j < 4; ++j) { const f32x4 y = v[i][j] * gs[j]; u32x2 w; w.x = pk_h2(y.x, y.y); w.y = pk_h2(y.z, y.w); o8[64 * j] = w; }
        }
    }
}
__device__ __forceinline__ void phase_cvec(Frame& F, int l) {
    const int gw = F.vcu * NWAVES + F.wave, NGW = F.G * NWAVES, lane = F.lane;
    const float* mod_l = (const float*)(F.ws + WS_MOD) + (size_t)l * 3 * 6144;
    float* cv = (float*)(F.ws + WS_CV) + (size_t)l * 3 * (DIN + DUP);
    for (int kind = 0; kind < 2; ++kind) {
        const int N = kind == 0 ? DIN : DUP, sc = kind == 0 ? 0 : 3;
        const h16* Wt = (const h16*)(F.ws + wsw(l) + (kind == 0 ? W_IN : W_UP));
        float sh[3][16];
#pragma unroll
        for (int c = 0; c < 3; ++c)
#pragma unroll
            for (int j = 0; j < 2; ++j)
#pragma unroll
                for (int e = 0; e < 8; ++e) sh[c][8 * j + e] = mod_l[(size_t)c * 6144 + sc * 1024 + 8 * lane + 512 * j + e];
        for (int n0 = gw * 4; n0 < N; n0 += NGW * 4) {
            u32x4 raw[4][2];
#pragma unroll
            for (int i = 0; i < 4; ++i) { raw[i][0] = *(const u32x4*)(Wt + (size_t)(n0 + i) * DM + 8 * lane); raw[i][1] = *(const u32x4*)(Wt + (size_t)(n0 + i) * DM + 512 + 8 * lane); }
#pragma unroll
            for (int i = 0; i < 4; ++i) {
                float w[16]; unpack8(raw[i][0], w); unpack8(raw[i][1], w + 8);
                float a0 = 0.f, a1 = 0.f, a2 = 0.f;
#pragma unroll
                for (int e = 0; e < 16; ++e) { a0 += w[e] * sh[0][e]; a1 += w[e] * sh[1][e]; a2 += w[e] * sh[2][e]; }
                a0 = wave_sum(a0); a1 = wave_sum(a1); a2 = wave_sum(a2);
                if (lane == 0) { float* o = cv + (kind == 0 ? 0 : DIN) + n0 + i; o[0] = a0; o[DIN + DUP] = a1; o[2 * (DIN + DUP)] = a2; }
            }
        }
    }
}
__device__ __forceinline__ void phase_final_norm(Frame& F) {
    const int gw = F.vcu * NWAVES + F.wave, NGW = F.G * NWAVES;
    f32x4 gg[4];
#pragma unroll
    for (int j = 0; j < 4; ++j) gg[j] = *(const f32x4*)(F.inp(I_FING) + F.lane * 4 + 256 * j);
    for (int grp = gw; grp < NTOK / 4; grp += NGW) {
        const int row0 = grp * 4;
        f32x4 v[4][4];
#pragma unroll
        for (int i = 0; i < 4; ++i) { const f32x4* xr = (const f32x4*)(F.out + O_Y + (size_t)(row0 + i) * DM) + F.lane;
#pragma unroll
            for (int j = 0; j < 4; ++j) v[i][j] = xr[64 * j]; }
#pragma unroll
        for (int i = 0; i < 4; ++i) {
            float s = 0.f;
#pragma unroll
            for (int j = 0; j < 4; ++j) s += (v[i][j].x * v[i][j].x + v[i][j].y * v[i][j].y) + (v[i][j].z * v[i][j].z + v[i][j].w * v[i][j].w);
            const float rstd = 1.0f / sqrtf(wave_sum(s) * (1.0f / DM) + NORM_EPS);
            f32x4* xo = (f32x4*)(F.out + O_Y + (size_t)(row0 + i) * DM) + F.lane;
#pragma unroll
            for (int j = 0; j < 4; ++j) xo[64 * j] = v[i][j] * rstd * gg[j];
        }
    }
}

__device__ __forceinline__ void phase_qk(Frame& F, int l, bool write_out = true) {
    const int gw = F.vcu * NWAVES + F.wave, NGW = F.G * NWAVES, lane = F.lane;
    h16* Z = (h16*)(F.ws + WS_ZU);
    const float* rope = (const float*)(F.ws + WS_ROPE);
    const float* qg = F.inp(I_QNG) + l * 64; const float* kg = F.inp(I_KNG) + l * 64;
    const int hl = lane & 7, hc0 = hl * 8;
    float qgv[8], kgv[8];
#pragma unroll
    for (int j = 0; j < 8; ++j) { qgv[j] = qg[hc0 + j]; kgv[j] = kg[hc0 + j]; }
    for (int row = gw; row < NTOK; row += NGW) {
        const bool is_ctx = row < NCTX;
        int rpos = 0, cpos = 0, b = 0, t = 0;
        if (is_ctx) { b = row >> 8; t = row & 255; } else { const int tt = (row - NCTX) & (LSEQ - 1); rpos = tt >> 6; cpos = tt & 63; }
        h16* zr = Z + (size_t)row * NMAIN;
#pragma unroll
        for (int pass = 0; pass < 3; ++pass) {
            const int col = C_QB + pass * 512 + lane * 8;
            int kind;
            if (pass == 0) kind = 0; else if (pass == 1) kind = lane < 8 * 2 ? 1 : (lane < 8 * 4 ? 2 : 3); else kind = lane < 32 ? 3 : (lane < 48 ? 4 : 5);
            const u32x4 w = *(const u32x4*)(zr + col);
            float x[8]; unpack8(w, x);
            if (kind <= 1) {
                float s = 0.f;
#pragma unroll
                for (int j = 0; j < 8; ++j) s += x[j] * x[j];
                s = sum8(s);
                const float rstd = 1.0f / sqrtf(s * (1.0f / 64.0f) + NORM_EPS);
#pragma unroll
                for (int j = 0; j < 8; ++j) x[j] = x[j] * rstd * (kind == 0 ? qgv[j] : kgv[j]);
            }
            if (!is_ctx) {
                float p[8];
#pragma unroll
                for (int j = 0; j < 8; ++j) p[j] = __shfl_xor(x[j], 2);
                if (kind == 0 || kind == 1 || kind == 3 || kind == 4) {
                    const int half = hl >> 2, second = (hl >> 1) & 1, f0 = (hl & 1) * 8, pos = half ? cpos : rpos;
                    const float* tp = rope + ((size_t)pos * 16 + f0) * 2;
#pragma unroll
                    for (int j = 0; j < 8; ++j) { const float cs = tp[2 * j], sn = tp[2 * j + 1]; x[j] = second ? (p[j] * sn + x[j] * cs) : (x[j] * cs - p[j] * sn); }
                }
            }
            if (kind == 0 || kind == 3) {
#pragma unroll
                for (int j = 0; j < 8; ++j) x[j] *= QSCALE;
            }
            if (kind != 2 && kind != 5) *(u32x4*)(zr + col) = pack8(x);
            if (write_out && is_ctx && (kind == 1 || kind == 2 || kind == 4 || kind == 5)) {
                const size_t ob = kind == 1 ? O_KB : kind == 2 ? O_VB : kind == 4 ? O_KC : O_VC;
                const int c128 = (kind == 1 || kind == 2) ? (col - (kind == 1 ? C_KB : C_VB)) : (col - (kind == 4 ? C_KC : C_VC));
                float* op = F.out + ob + ((size_t)((b * 2 + l) * 256 + t)) * 128 + c128;
                *(f32x4*)op = (f32x4){x[0], x[1], x[2], x[3]}; *(f32x4*)(op + 4) = (f32x4){x[4], x[5], x[6], x[7]};
            }
        }
    }
}

__device__ __forceinline__ int img_off(int row, int ch) { return row * 256 + ((((ch >> 3) ^ (row & 15)) << 4) | ((ch & 7) << 1)); }
template <int MODE, int DIR>
__device__ __forceinline__ void lru_scan(Frame& F, int l, int row0, int n, int lat_b, int lat_chunk, int ctx_b, bool write_out, int cb) {
    LAS unsigned char* img = F.lds; LAS unsigned char* hx = F.lds + 65536;
    const int lane = F.lane, r32 = lane & 31, hi = lane >> 5, hm = hi ^ DIR;
    const int C = n * 128 + cb * 32 + r32;
    h16x8 Br[8], Bi[8];
    if (MODE != 3) {
        const h16* wr_ = (const h16*)(F.ws + wsw(l) + W_LRU) + ((size_t)((DIR * 2 + 0) * 8 + n) * 128 + cb * 32 + r32) * 128 + 8 * hi;
        const h16* wi_ = (const h16*)(F.ws + wsw(l) + W_LRU) + ((size_t)((DIR * 2 + 1) * 8 + n) * 128 + cb * 32 + r32) * 128 + 8 * hi;
#pragma unroll
        for (int ks = 0; ks < 8; ++ks) { Br[ks] = *(const h16x8*)(wr_ + 16 * ks); Bi[ks] = *(const h16x8*)(wi_ + 16 * ks); }
    }
    float k8 = 0.f, nba = 0.f, nbx = 0.f;
    if (MODE != 3) {
        const float ba = F.inp(I_LBA)[(size_t)(l * 2 + DIR) * DLRU + C], bx = F.inp(I_LBX)[(size_t)(l * 2 + DIR) * DLRU + C];
        const float lam = F.inp(I_LAM)[(size_t)(l * 2 + DIR) * DLRU + C];
        const float sp = (-lam > 20.f) ? -lam : log1pf(expf(-lam));
        k8 = -8.0f * sp * LOG2E;
        nba = -LOG2E * ba; nbx = -LOG2E * bx;
    }
    u32x4* stash_u = (u32x4*)(F.ws + WS_STASH) + (size_t)(((lat_b * 2 + DIR) * 16 + lat_chunk) * 8) * (DLRU * 2 * 4);
    const unsigned sl = (unsigned)((C * 2 + hi) * 4);
    unsigned nxt[16];
    if (MODE == 3) { const int rb0 = DIR == 0 ? 0 : 7;
#pragma unroll
        for (int q = 0; q < 4; ++q) { const u32x4 t = stash_u[(size_t)rb0 * (DLRU * 2 * 4) + sl + q]; nxt[4 * q] = t.x; nxt[4 * q + 1] = t.y; nxt[4 * q + 2] = t.z; nxt[4 * q + 3] = t.w; } }
    float H = 0.f, aggP = 1.f;
    if (MODE == 2 || MODE == 3) {
        const float* agg = (const float*)(F.ws + WS_AGG);
        H = F.inp(I_STATE)[(size_t)((lat_b * 2 + l) * 2 + DIR) * DLRU + C];
        float ap[15], au[15];
#pragma unroll
        for (int k = 0; k < 15; ++k) { const int ch = DIR == 0 ? k : 15 - k; const bool use = DIR == 0 ? (ch < lat_chunk) : (ch > lat_chunk);
            const float* p = agg + ((size_t)((lat_b * 16 + (use ? ch : 0)) * 2 + DIR) * DLRU + C) * 2; ap[k] = use ? p[0] : 1.f; au[k] = use ? p[1] : 0.f; }
#pragma unroll
        for (int k = 0; k < 15; ++k) H = ap[k] * H + au[k];
    }
    const int xch = cb * 4 + (r32 >> 3), xel = (r32 & 7) * 2;
    int lo8[8];
#pragma unroll
    for (int ci = 0; ci < 8; ++ci) { const int c = (ci & 3) + 8 * (ci >> 2); lo8[ci] = (((xch ^ (4 * hi)) ^ c) << 4) + xel + (4 * hi) * 256; }
#define LOFF(rn) (lo8s[((rn) & 3) + 4 * (((rn) >> 2) & 1)] + (8 * ((rn) >> 2) + ((rn) & 3)) * 256)
#pragma unroll 1
    for (int step = 0; step < 8; ++step) {
        if (step == 4) __syncthreads();
        const int rb = DIR == 0 ? step : 7 - step;
        int lo8s[8];
#pragma unroll
        for (int ci = 0; ci < 8; ++ci) lo8s[ci] = lo8[ci] + rb * 8192;
        float an[16], un[16];
        if (MODE == 3) {
#pragma unroll
            for (int r = 0; r < 16; ++r) { const h16x2 w = __builtin_bit_cast(h16x2, nxt[r]); an[r] = fast_exp2((float)w[0]); un[r] = (float)w[1]; }
            if (step < 7) { const int rbn = DIR == 0 ? step + 1 : 6 - step;
#pragma unroll
                for (int q = 0; q < 4; ++q) { const u32x4 t = stash_u[(size_t)rbn * (DLRU * 2 * 4) + sl + q]; nxt[4 * q] = t.x; nxt[4 * q + 1] = t.y; nxt[4 * q + 2] = t.z; nxt[4 * q + 3] = t.w; } }
        } else {
        unsigned sw[16];
        f32x16 ar = {}, ai = {};
#pragma unroll
        for (int ks = 0; ks < 8; ++ks) {
            const h16x8 af = *(const LAS h16x8*)(img + (rb * 32 + r32) * 256 + (((2 * ks + hi) ^ (r32 & 15)) << 4));
            ar = __builtin_amdgcn_mfma_f32_32x32x16_f16(af, Br[ks], ar, 0, 0, 0);
            ai = __builtin_amdgcn_mfma_f32_32x32x16_f16(af, Bi[ks], ai, 0, 0, 0);
        }
#pragma unroll
        for (int r = 0; r < 16; ++r) {
            const float xv = (float)*(const LAS h16*)(img + LOFF(r));
            const float d1 = 1.0f + fast_exp2(__builtin_fmaf(ar[r], -LOG2E, nba)), d2 = 1.0f + fast_exp2(__builtin_fmaf(ai[r], -LOG2E, nbx));
            const float R = fast_rcp(d1 * d2);
            const float rr = R * d2, ii = R * d1;
            const float e2 = k8 * rr;
            const float av = fast_exp2(e2);
            an[r] = av;
            un[r] = __builtin_amdgcn_sqrtf(__builtin_fmaf(-av, av, 1.0f)) * (ii * xv);
            if (MODE == 1) sw[r] = pk_h2(e2, un[r]);
        }
        if (MODE == 1) {
#pragma unroll
            for (int q = 0; q < 4; ++q) stash_u[(size_t)rb * (DLRU * 2 * 4) + sl + q] = (u32x4){sw[4 * q], sw[4 * q + 1], sw[4 * q + 2], sw[4 * q + 3]}; }
        }
#define SA(r) (DIR ? an[15 - (r)] : an[(r)])
#define SU(r) (DIR ? un[15 - (r)] : un[(r)])
        float Pe[4], Ue[4], Po[4], Uo[4];
#pragma unroll
        for (int g = 0; g < 4; ++g) {
            float p = 1.f, uu = 0.f;
#pragma unroll
            for (int i = 0; i < 4; ++i) { uu = SA(4 * g + i) * uu + SU(4 * g + i); p *= SA(4 * g + i); }
            const auto sp_ = __builtin_amdgcn_permlane32_swap(__float_as_uint(p), __float_as_uint(p), false, false);
            const auto su_ = __builtin_amdgcn_permlane32_swap(__float_as_uint(uu), __float_as_uint(uu), false, false);
            Pe[g] = __uint_as_float(sp_[DIR]); Po[g] = __uint_as_float(sp_[1 - DIR]); Ue[g] = __uint_as_float(su_[DIR]); Uo[g] = __uint_as_float(su_[1 - DIR]);
        }
        float Hs[4];
        {
            float h = H;
#pragma unroll
            for (int g = 0; g < 4; ++g) { const float he = h; h = Pe[g] * h + Ue[g]; const float ho = h; h = Po[g] * h + Uo[g]; Hs[g] = hm ? ho : he; }
            H = h;
        }
        if (MODE == 1) { float p = 1.f;
#pragma unroll
            for (int g = 0; g < 4; ++g) p *= Pe[g] * Po[g];
            aggP *= p; }
        if (MODE != 1) {
#pragma unroll
            for (int g = 0; g < 4; ++g) { float h = Hs[g];
                float old[4];
#pragma unroll
                for (int i = 0; i < 4; ++i) old[i] = (float)*(const LAS h16*)(hx + LOFF(DIR ? 15 - (4 * g + i) : (4 * g + i)));
#pragma unroll
                for (int i = 0; i < 4; ++i) { const int r = 4 * g + i; h = SA(r) * h + SU(r);
                    const float o = step < 4 ? 0.f : old[i];
                    *(LAS h16*)(hx + LOFF(DIR ? 15 - r : r)) = (h16)(h + o); } }
        }
#undef SA
#undef SU
    }
#undef LOFF
    if (MODE == 0 && hi == 0 && write_out) F.out[O_LRU + (size_t)((ctx_b * 2 + l) * 2 + DIR) * DLRU + C] = H;
    if (MODE == 1 && hi == 0) { float* agg = (float*)(F.ws + WS_AGG) + ((size_t)((lat_b * 16 + lat_chunk) * 2 + DIR) * DLRU + C) * 2; agg[0] = aggP; agg[1] = H; }
}
template <int MODE>
__device__ __forceinline__ void lru_unit(Frame& F, int l, int row0, int n, int seq_first, int seq_last, int lat_b, int lat_chunk, int ctx_b, bool write_out = true, int pv = 0) {
    LAS unsigned char* img = F.lds; LAS unsigned char* hx = F.lds + 65536;
    const h16* Z = (const h16*)(F.ws + WS_ZU);
    const int tid = F.tid;
    __syncthreads();
    if (MODE != 3 && !(pv & 1)) {
        const int cc = tid & 15, tg = tid >> 4; const int ch0 = n * 128 + cc * 8;
        float w0[8], w1[8], w2[8], w3[8], bb[8];
        const float* cw = F.inp(I_LCW) + (size_t)l * 4 * DLRU + ch0; const float* cb = F.inp(I_LCB) + (size_t)l * DLRU + ch0;
#pragma unroll
        for (int j = 0; j < 8; ++j) { w0[j] = cw[j]; w1[j] = cw[DLRU + j]; w2[j] = cw[2 * DLRU + j]; w3[j] = cw[3 * DLRU + j]; bb[j] = cb[j]; }
        const int t0 = tg * 8;
        u32x4 raw[11];
#pragma unroll
        for (int i = 0; i < 11; ++i) { const int t = t0 - 2 + i; const bool ok = (t >= 0 || !seq_first) && (t < 256 || !seq_last);
            const int tc = ok ? t : (t < 0 ? 0 : 255);
            const u32x4 v = *(const u32x4*)(Z + (size_t)(row0 + tc) * NMAIN + C_XA + ch0);
            raw[i].x = ok ? v.x : 0u; raw[i].y = ok ? v.y : 0u; raw[i].z = ok ? v.z : 0u; raw[i].w = ok ? v.w : 0u; }
        float xm2[8], xm1[8], x0[8], xp1[8];
        unpack8(raw[0], xm2); unpack8(raw[1], xm1); unpack8(raw[2], x0);
#pragma unroll
        for (int i = 0; i < 8; ++i) {
            unpack8(raw[3 + i], xp1);
            float y[8];
#pragma unroll
            for (int j = 0; j < 8; ++j) y[j] = bb[j] + w0[j] * xm2[j] + w1[j] * xm1[j] + w2[j] * x0[j] + w3[j] * xp1[j];
            *(LAS u32x4*)(img + img_off(t0 + i, cc * 8)) = pack8(y);
#pragma unroll
            for (int j = 0; j < 8; ++j) { xm2[j] = xm1[j]; xm1[j] = x0[j]; x0[j] = xp1[j]; }
        }
    }
    __syncthreads();
    const int dir = F.wave >> 2, cb = F.wave & 3;
    if (!(pv & 2)) {
    if (dir == 0) lru_scan<MODE, 0>(F, l, row0, n, lat_b, lat_chunk, ctx_b, write_out, cb);
    else          lru_scan<MODE, 1>(F, l, row0, n, lat_b, lat_chunk, ctx_b, write_out, cb);
    }
    if (MODE != 1 && !(pv & 4)) {
        __syncthreads();
        h16* OA = (h16*)(F.ws + WS_ZU + ZU_OA);
#pragma unroll
        for (int k = 0; k < 8; ++k) { const int i = tid + NTHREADS * k, tk = i >> 4, cc = i & 15;
            float hs[8], ya[8], o[8];
            unpack8(*(const LAS u32x4*)(hx + img_off(tk, cc * 8)), hs);
            unpack8(*(const u32x4*)(Z + (size_t)(row0 + tk) * NMAIN + C_YA + n * 128 + cc * 8), ya);
#pragma unroll
            for (int j = 0; j < 8; ++j) o[j] = hs[j] * gelu_tanh(ya[j]);
            *(u32x4*)(OA + (size_t)(row0 + tk) * 1024 + n * 128 + cc * 8) = pack8(o); }
    }
}

struct AttnDesc {
    const h16* Qz; h16* O;
    const h16* Kc; const h16* Vc;
    const h16* Kz; const h16* Vz;
    int nc, zt0, nz;
    int windowed;
    const float* sink;
    int kvh, q0;
};
__device__ __forceinline__ void attn_unit(Frame& F, const AttnDesc& D, const h16* Qrow0  , h16* Orow0  ) {
    LAS unsigned char* lds = F.lds;
    const int tid = F.tid, lane = F.lane, wave = F.wave, r32 = lane & 31, hi = lane >> 5;
    const int head = D.kvh * 4 + (wave >> 1);
    const int qpos = D.q0 + (wave & 1) * 32 + r32;
    const int NT = D.nc + D.nz;
    h16x8 qr[4];
    { const h16* qp = Qrow0 + (size_t)qpos * NMAIN + head * 64 + 8 * hi;
#pragma unroll
      for (int d0 = 0; d0 < 4; ++d0) qr[d0] = *(const h16x8*)(qp + 16 * d0); }
    const int krow = tid >> 3, kch = tid & 7; const int kdst = krow * 128 + ((kch ^ ((krow >> 1) & 7)) << 4);
    const int vrow = 16 * (wave & 3) + (lane >> 2), vcol = (wave >> 2) * 32 + (lane & 3) * 8; const int vdst = wave * 1024 + lane * 16;
    auto ktile_ptr = [&](int j, int row, int col, bool isV) -> const h16* {
        if (j < D.nc) return (isV ? D.Vc : D.Kc) + (size_t)(64 * j + row) * 128 + col;
        return (isV ? D.Vz : D.Kz) + (size_t)((D.zt0 + (j - D.nc)) * 64 + row) * NMAIN + col;
    };
    u32x4 kreg, vreg;
    kreg = *(const u32x4*)ktile_ptr(0, krow, kch * 8, false); vreg = *(const u32x4*)ktile_ptr(0, vrow, vcol, true);
    __syncthreads();
    *(LAS u32x4*)(lds + kdst) = kreg; *(LAS u32x4*)(lds + 16384 + vdst) = vreg;
    __syncthreads();
    float mhat, l_run;
    const bool has_sink = D.sink != nullptr;
    if (has_sink) { mhat = D.sink[head] * LOG2E; l_run = hi == 0 ? 1.f : 0.f; } else { mhat = 0.f; l_run = 0.f; }
    f32x16 negm;
#pragma unroll
    for (int r = 0; r < 16; ++r) negm[r] = -mhat;
    f32x16 o0 = {}, o1 = {};
    LAS float* wsf = (LAS float*)(lds + 32768) + wave * 64;
    const int kfoff = r32 * 128;
    const int ksw = (r32 >> 1) & 7;
    const int vp0 = ((lane >> 4) & 1) * 32 + (lane & 3) * 8 + (4 * hi + ((lane & 15) >> 2)) * 64;
#pragma unroll 1
    for (int j = 0; j < NT; ++j) {
        const int buf = j & 1;
        if (j + 1 < NT) { kreg = *(const u32x4*)ktile_ptr(j + 1, krow, kch * 8, false); vreg = *(const u32x4*)ktile_ptr(j + 1, vrow, vcol, true); }
        LAS unsigned char* Kb = lds + buf * 8192; LAS unsigned char* Vb = lds + 16384 + buf * 8192;
        f32x16 p0, p1;
#pragma unroll
        for (int d0 = 0; d0 < 4; ++d0) {
            const int co = ((2 * d0 + hi) ^ ksw) << 4;
            const h16x8 k0 = *(const LAS h16x8*)(Kb + kfoff + co);
            const h16x8 k1 = *(const LAS h16x8*)(Kb + 4096 + kfoff + co);
            p0 = __builtin_amdgcn_mfma_f32_32x32x16_f16(k0, qr[d0], d0 == 0 ? negm : p0, 0, 0, 0);
            p1 = __builtin_amdgcn_mfma_f32_32x32x16_f16(k1, qr[d0], d0 == 0 ? negm : p1, 0, 0, 0);
        }
        if (D.windowed && j >= D.nc) {
            const int kb0 = (D.zt0 + (j - D.nc)) * 64 + 4 * hi;
#pragma unroll
            for (int r = 0; r < 16; ++r) { const int kp = kb0 + (r & 3) + 8 * (r >> 2);
                const int d0_ = qpos - kp, d1_ = qpos - (kp + 32);
                if (d0_ > 128 || d0_ < -128) p0[r] = -1e30f;
                if (d1_ > 128 || d1_ < -128) p1[r] = -1e30f; }
        }
        if (j == 0) {
            float mx = fmaxf(p0[0], p1[0]);
#pragma unroll
            for (int r = 1; r < 16; ++r) mx = fmaxf(mx, fmaxf(p0[r], p1[r]));
            mx = fmaxf(mx, __shfl_xor(mx, 32));
            const float dl = has_sink ? fmaxf(mx, 0.f) : mx;
#pragma unroll
            for (int r = 0; r < 16; ++r) { p0[r] -= dl; p1[r] -= dl; }
            mhat += dl; if (has_sink) l_run *= fast_exp2(-dl);
#pragma unroll
            for (int r = 0; r < 16; ++r) negm[r] = -mhat;
        }
        float rs = 0.f;
#pragma unroll
        for (int r = 0; r < 16; ++r) { p0[r] = fast_exp2(p0[r]); p1[r] = fast_exp2(p1[r]); rs += p0[r] + p1[r]; }
        if (__builtin_expect(__any(rs > 256.f), 0)) {
            const float rsm = fmaxf(rs, __shfl_xor(rs, 32));
            const float dl = rsm > 256.f ? ceilf(__builtin_log2f(rsm)) : 0.f;
            const float f = fast_exp2(-dl);
#pragma unroll
            for (int r = 0; r < 16; ++r) { p0[r] *= f; p1[r] *= f; }
            rs *= f; l_run *= f; mhat += dl;
#pragma unroll
            for (int r = 0; r < 16; ++r) negm[r] = -mhat;
            if (hi == 0) wsf[r32] = f;
            LDS_WAIT();
#pragma unroll
            for (int r = 0; r < 16; ++r) { const float g = wsf[(r & 3) + 8 * (r >> 2) + 4 * hi]; o0[r] *= g; o1[r] *= g; }
        }
        l_run += rs;
        u32x4 pw[4];
        pw[0] = (u32x4){pk_h2(p0[0], p0[1]), pk_h2(p0[2], p0[3]), pk_h2(p0[4], p0[5]), pk_h2(p0[6], p0[7])};
        pw[1] = (u32x4){pk_h2(p0[8], p0[9]), pk_h2(p0[10], p0[11]), pk_h2(p0[12], p0[13]), pk_h2(p0[14], p0[15])};
        pw[2] = (u32x4){pk_h2(p1[0], p1[1]), pk_h2(p1[2], p1[3]), pk_h2(p1[4], p1[5]), pk_h2(p1[6], p1[7])};
        pw[3] = (u32x4){pk_h2(p1[8], p1[9]), pk_h2(p1[10], p1[11]), pk_h2(p1[12], p1[13]), pk_h2(p1[14], p1[15])};
#pragma unroll
        for (int ks = 0; ks < 4; ++ks) {
            const h16x8 pa = __builtin_bit_cast(h16x8, pw[ks]);
#pragma unroll
            for (int d0 = 0; d0 < 2; ++d0) {
                const s16x4 lo = __builtin_amdgcn_ds_read_tr16_b64_v4i16((LAS s16x4*)(Vb + vp0 + d0 * 4096 + ks * 1024));
                const s16x4 hh = __builtin_amdgcn_ds_read_tr16_b64_v4i16((LAS s16x4*)(Vb + vp0 + d0 * 4096 + ks * 1024 + 512));
                typedef short s16x8 __attribute__((ext_vector_type(8)));
                const s16x8 vv = {lo[0], lo[1], lo[2], lo[3], hh[0], hh[1], hh[2], hh[3]};
                const h16x8 vf = __builtin_bit_cast(h16x8, vv);
                if (d0 == 0) o0 = __builtin_amdgcn_mfma_f32_32x32x16_f16(pa, vf, o0, 0, 0, 0);
                else         o1 = __builtin_amdgcn_mfma_f32_32x32x16_f16(pa, vf, o1, 0, 0, 0);
            }
        }
        if (j + 1 < NT) { *(LAS u32x4*)(lds + (buf ^ 1) * 8192 + kdst) = kreg; *(LAS u32x4*)(lds + 16384 + (buf ^ 1) * 8192 + vdst) = vreg; }
        __syncthreads();
    }
    l_run += __shfl_xor(l_run, 32);
    if (hi == 0) wsf[32 + r32] = l_run;
    LDS_WAIT();
    h16* op = Orow0 + (size_t)(D.q0 + (wave & 1) * 32) * 512 + head * 64 + r32;
#pragma unroll
    for (int r = 0; r < 16; ++r) { const int q = (r & 3) + 8 * (r >> 2) + 4 * hi; const float rl = fast_rcp(wsf[32 + q]);
        op[(size_t)q * 512] = (h16)(o0[r] * rl); op[(size_t)q * 512 + 32] = (h16)(o1[r] * rl); }
}
__device__ __forceinline__ void attn_dispatch(Frame& F, int l, int type, int u) {
    const h16* Z = (const h16*)(F.ws + WS_ZU);
    const h16* cache = (const h16*)(F.ws + WS_CACHE);
    AttnDesc D; D.sink = nullptr; D.windowed = 0; D.Kc = nullptr; D.Vc = nullptr; D.nc = 0;
    const bool isC = type & 1;
    const int qcol = isC ? C_QC : C_QB, kcol = isC ? C_KC : C_KB, vcol = isC ? C_VC : C_VB;
    h16* Obase = (h16*)(F.ws + WS_ZU + (isC ? ZU_OC : ZU_OB));
    size_t row_seq0;
    if (type < 2) {
        const int b = u >> 7, kvh = (u >> 6) & 1, qb = u & 63;
        row_seq0 = (size_t)NCTX + (size_t)b * LSEQ; D.kvh = kvh; D.q0 = qb * 64;
        D.Kc = cache + ((size_t)(isC ? 2 : 0) * 131072) + (size_t)((b * 2 + l) * 256) * 128 + kvh * 64;
        D.Vc = cache + ((size_t)(isC ? 3 : 1) * 131072) + (size_t)((b * 2 + l) * 256) * 128 + kvh * 64;
        D.nc = 4;
        if (!isC) { D.zt0 = 0; D.nz = 64; }
        else { int lo = qb - 2; if (lo < 0) lo = 0; int hi_ = qb + 2; if (hi_ > 63) hi_ = 63; D.zt0 = lo; D.nz = hi_ - lo + 1; D.windowed = 1; }
    } else {
        const int b = u >> 3, kvh = (u >> 2) & 1, qb = u & 3;
        row_seq0 = (size_t)b * SEQ; D.kvh = kvh; D.q0 = qb * 64; D.zt0 = 0; D.nz = 4;
    }
    if (isC) D.sink = F.inp(I_SINK) + l * 8;
    D.Kz = Z + row_seq0 * NMAIN + kcol + D.kvh * 64; D.Vz = Z + row_seq0 * NMAIN + vcol + D.kvh * 64;
    attn_unit(F, D, Z + row_seq0 * NMAIN + qcol, Obase + row_seq0 * 512);
}

__device__ __forceinline__ void phase_ffn_act(Frame& F, int l) {
    h16* U = (h16*)(F.ws + WS_ZU);
    const int gt = F.vcu * NTHREADS + F.tid, NGT = F.G * NTHREADS;
    constexpr int NCC = DFF / 8, RUN = 16, NRUN = NTOK / RUN;
    for (int it = gt; it < NCC * NRUN; it += NGT) {
        const int cc = it % NCC, run = it / NCC; const int c0 = cc * 8, r0 = run * RUN;
        const bool first = (r0 < NCTX) ? ((r0 & 255) == 0) : (((r0 - NCTX) & (LSEQ - 1)) == 0);
        const bool last = (r0 < NCTX) ? (((r0 + RUN) & 255) == 0) : ((((r0 + RUN) - NCTX) & (LSEQ - 1)) == 0);
        float w0[8], w1[8], w2[8], bb[8];
        const float* cw = F.inp(I_FCW) + (size_t)l * 3 * DFF + c0; const float* cb = F.inp(I_FCB) + (size_t)l * DFF + c0;
#pragma unroll
        for (int j = 0; j < 8; ++j) { w0[j] = cw[j]; w1[j] = cw[DFF + j]; w2[j] = cw[2 * DFF + j]; bb[j] = cb[j]; }
        u32x4 gr[RUN + 2], vr[RUN];
#pragma unroll
        for (int i = 0; i < RUN + 2; ++i) { const int r = r0 - 1 + i; const bool ok = !((i == 0 && first) || (i == RUN + 1 && last));
            const int rc = ok ? r : r0; const u32x4 v = *(const u32x4*)(U + (size_t)rc * DUP + c0);
            gr[i].x = ok ? v.x : 0u; gr[i].y = ok ? v.y : 0u; gr[i].z = ok ? v.z : 0u; gr[i].w = ok ? v.w : 0u; }
#pragma unroll
        for (int i = 0; i < RUN; ++i) vr[i] = *(const u32x4*)(U + (size_t)(r0 + i) * DUP + DFF + c0);
        float gp[8], gc[8], gn[8];
        unpack8(gr[0], gp); unpack8(gr[1], gc);
#pragma unroll
        for (int i = 0; i < RUN; ++i) {
            unpack8(gr[i + 2], gn);
            float v[8]; unpack8(vr[i], v);
            float o[8];
#pragma unroll
            for (int j = 0; j < 8; ++j) { const float g = bb[j] + w0[j] * gp[j] + w1[j] * gc[j] + w2[j] * gn[j]; o[j] = gelu_tanh(g) * v[j]; gp[j] = gc[j]; gc[j] = gn[j]; }
            *(u32x4*)(U + (size_t)(r0 + i) * DUP + DFF + c0) = pack8(o);
        }
    }
}

__device__ __forceinline__ void phase_act_fixup(Frame& F, int l) {
    h16* ACT = (h16*)(F.ws + WS_ZU);
    const float* edge = (const float*)(F.ws + WS_EDGE);
    const float* cw = F.inp(I_FCW) + (size_t)l * 3 * DFF;
    const int gt = F.vcu * NTHREADS + F.tid, NGT = F.G * NTHREADS;
    constexpr int NC8 = DFF / 8;
    for (int it = gt; it < 64 * 8 * NC8; it += NGT) {
        const int ch = (it % NC8) * 8, ri = it / NC8, pm = ri >> 3, idx = ri & 7, b = idx >> 1, last = idx & 1;
        const int row = pm * 256 + b * 64 + (last ? 63 : 0);
        const int nrow = last ? row + 1 : row - 1;
        const bool seq_edge = (row < NCTX) ? (last ? ((row & 255) == 255) : ((row & 255) == 0)) : (last ? (((row - NCTX) & (LSEQ - 1)) == LSEQ - 1) : (((row - NCTX) & (LSEQ - 1)) == 0));
        const int nr = seq_edge ? row : nrow;
        const int npm = nr >> 8, nb = (nr >> 6) & 3;
        const float* gp = edge + ((size_t)(npm * 8 + 2 * nb + (last ? 0 : 1)) * 3) * DFF + ch;
        const float* ep = edge + ((size_t)(pm * 8 + idx) * 3) * DFF + ch;
        const float* wp = cw + (last ? 2 : 0) * DFF + ch;
        f32x4 g0 = *(const f32x4*)gp, g1 = *(const f32x4*)(gp + 4), p0 = *(const f32x4*)(ep + DFF), p1 = *(const f32x4*)(ep + DFF + 4);
        const f32x4 v0 = *(const f32x4*)(ep + 2 * DFF), v1 = *(const f32x4*)(ep + 2 * DFF + 4), w0 = *(const f32x4*)wp, w1 = *(const f32x4*)(wp + 4);
        const float nz = seq_edge ? 0.f : 1.f;
        p0 = p0 + w0 * g0 * nz; p1 = p1 + w1 * g1 * nz;
        float o[8];
#pragma unroll
        for (int j = 0; j < 4; ++j) { o[j] = gelu_tanh(p0[j]) * v0[j]; o[4 + j] = gelu_tanh(p1[j]) * v1[j]; }
        *(u32x4*)(ACT + (size_t)row * DFF + ch) = pack8(o);
    }
}

constexpr int N_PHASES = 25;
__global__ void __launch_bounds__(NTHREADS, 2) fwd_kernel(Args args) {
    extern __shared__ __attribute__((aligned(16))) unsigned char lds_raw[];
    Frame F;
    F.lds = (LAS unsigned char*)lds_raw;
    F.tid = threadIdx.x; F.lane = F.tid & 63; F.wave = __builtin_amdgcn_readfirstlane(F.tid >> 6);
    F.G0 = gridDim.x; { const int bx = blockIdx.x; F.vcu0 = (F.G0 % 8 == 0) ? (bx % 8) * (F.G0 / 8) + bx / 8 : bx; }
    F.out0 = args.out; F.ws0 = args.ws; F.refresh();
    volatile LAS unsigned* MISC = (volatile LAS unsigned*)(F.lds + MISC_OFF);
    for (int u = F.tid; u < (LDS_BYTES - LDSCTL_OFF) / 4; u += NTHREADS) ((LAS unsigned*)(F.lds + LDSCTL_OFF))[u] = 0u;
    __syncthreads();
#if !MK_PER_PHASE
    XcdBarrier bar = xcd_barrier_post((unsigned*)(F.ws + WS_CTL) + CW_BAR, MISC + 8);
#define GRID_BAR() xcd_barrier(bar)
#else
    (void)MISC;
#define GRID_BAR() do { } while (0)
#endif
#if MK_PER_PHASE
    const int lo = args.ph_lo, hi_ph = args.ph_hi;
#else
    constexpr int lo = 0, hi_ph = N_PHASES;
#endif
#if defined(TIME_PH)
#ifndef TIME_AMP
#define TIME_AMP 8
#endif
    unsigned long long t_acc = 0, t_0 = 0;
#define TSTART(k) do { TSL_PHASE(F.lds, (k)); if ((k) == TIME_PH) t_0 = __builtin_amdgcn_s_memrealtime(); } while (0)
#define TSTOP(k) do { if ((k) == TIME_PH) t_acc += __builtin_amdgcn_s_memrealtime() - t_0; } while (0)
#else
#define TSTART(k) do { TSL_PHASE(F.lds, (k)); } while (0)
#define TSTOP(k) do { } while (0)
#endif
#define IN(k) (lo <= (k) && (k) < hi_ph)
#define SEAM(k) do { if (IN((k) + 1)) GRID_BAR(); } while (0)
    { constexpr int l = 0; constexpr int pb = 12 * l;
        if (l == 0 && IN(pb + 0)) { TSTART(0); F.refresh(); phase_convert_weights(F, l); phase_prep_misc(F); SEAM(pb + 0); TSTOP(0); }
        if (IN(pb + 1)) { TSTART(1); F.refresh();
            if (l == 0) phase_norm0(F, F.inp(I_N1G), (const float*)(F.ws + WS_MOD), (float*)(F.ws + WS_SS));
            phase_cvec(F, l);
            SEAM(pb + 1); TSTOP(1); }
        if (IN(pb + 2)) { TSTART(2); F.refresh();
            pg8::Gemm g{(const h16*)(F.ws + WS_H), (const h16*)(F.ws + wsw(l) + W_IN), NTOK, NMAIN, DM, DM}; pg8::StaticOrder S; S.init(NTOK, NMAIN, F.G, F.bid);
            pg8::EpiF16<0> E{(h16*)(F.ws + WS_ZU), NMAIN, (const float*)(F.ws + WS_SS) + (size_t)(2 * l) * NTOK, (const float*)(F.ws + WS_CV) + (size_t)l * 3 * (DIN + DUP), DIN + DUP};
            pg8::gemm_phase<pg8::EpiF16<0>, pg8::StaticOrder, true, true>(F.lds, g, S, E);
            if (l + 1 < DEPTH && F.bid >= F.G / 2) phase_convert_weights(F, l + 1, 1, F.G / 2);
            SEAM(pb + 2); TSTOP(2); }
        if (IN(pb + 3)) { TSTART(3); F.refresh();
            phase_qk(F, l);
            for (int u = F.vcu; u < 512; u += F.G) {
                if (u < 256) lru_unit<0>(F, l, (u >> 3) * 256, u & 7, 1, 1, 0, 0, u >> 3);
                else { const int v = u - 256, b = v >> 7, ch = (v >> 3) & 15; lru_unit<1>(F, l, NCTX + b * LSEQ + ch * 256, v & 7, ch == 0, ch == 15, b, ch, 0); }
            }
            SEAM(pb + 3); TSTOP(3); }
        if (IN(pb + 4)) { TSTART(4); F.refresh();
            for (int type = 0; type < 4; ++type) { TSL_START(F.lds, 20 + type); for (int u = F.vcu; u < 256; u += F.G) attn_dispatch(F, l, type, u); TSL_STOP(F.lds, 20 + type); }
            TSL_START(F.lds, 24);
            for (int v = F.vcu; v < 256; v += F.G) { const int b = v >> 7, ch = (v >> 3) & 15; lru_unit<3>(F, l, NCTX + b * LSEQ + ch * 256, v & 7, ch == 0, ch == 15, b, ch, 0); }
            TSL_STOP(F.lds, 24);
            SEAM(pb + 4); TSTOP(4); }
        if (IN(pb + 6)) { TSTART(6); F.refresh();
            pg8::StaticOrder S; S.init(NTOK, DM, F.G, F.bid);
            pg8::GateMergeJobs jobs{S, F.ws, wsw(l)};
            pg8::EpiGM E{(h16*)(F.ws + WS_MG), (h16*)(F.ws + WS_ZU) + (size_t)F.bid * 256 * 256, (const float*)(F.ws + WS_SS) + (size_t)(2 * l) * NTOK,
                         (const float*)(F.ws + WS_CV) + (size_t)l * 3 * (DIN + DUP) + NMAIN, DIN + DUP};
            pg8::gemm_multi(F.lds, jobs, E);
            SEAM(pb + 6); TSTOP(6); }
        if (IN(pb + 7)) { TSTART(7); F.refresh();
            pg8::Gemm g{(const h16*)(F.ws + WS_MG), (const h16*)(F.ws + wsw(l) + W_OUT), NTOK, DM, DM, DM}; pg8::StaticOrder S; S.init(NTOK, DM, F.G, F.bid);
            pg8::EpiRes E{l == 0 ? F.inp(I_XP) : F.out + O_Y, l == 0 ? F.inp(I_XS) : F.out + O_Y + (size_t)NCTX * DM, F.out + O_Y, (const float*)(F.ws + WS_MOD) + (size_t)l * 3 * 6144 + 2 * 1024,
                          (h16*)(F.ws + WS_H2), F.inp(I_N2G) + l * DM, (const float*)(F.ws + WS_MOD) + (size_t)l * 3 * 6144 + 4 * 1024, (float*)(F.ws + WS_SS) + (size_t)(2 * l + 1) * NTOK, F.lds + EPI_SCR_OFF};
            pg8::gemm_phase<pg8::EpiRes, pg8::StaticOrder, true, true>(F.lds, g, S, E);
            SEAM(pb + 7); TSTOP(7); }
        if (IN(pb + 9)) { TSTART(9); F.refresh();
            pg8::Gemm g{(const h16*)(F.ws + WS_H2), (const h16*)(F.ws + wsw(l) + W_UP), NTOK, DUP, DM, DM}; pg8::StaticOrder S; S.init(NTOK, DUP, F.G, F.bid);
            pg8::EpiAct E{(h16*)(F.ws + WS_ZU), (const float*)(F.ws + WS_SS) + (size_t)(2 * l + 1) * NTOK, (const float*)(F.ws + WS_CV) + (size_t)l * 3 * (DIN + DUP) + DIN, DIN + DUP,
                          F.inp(I_FCW) + (size_t)l * 3 * DFF, F.inp(I_FCB) + (size_t)l * DFF, (float*)(F.ws + WS_EDGE)};
            pg8::gemm_phase<pg8::EpiAct, pg8::StaticOrder, true, true>(F.lds, g, S, E);
            if (l + 1 < DEPTH && F.bid >= F.G / 2) phase_convert_weights(F, l + 1, 2, F.G / 2);
            SEAM(pb + 9); TSTOP(9); }
        if (IN(pb + 10)) { TSTART(10); F.refresh(); phase_act_fixup(F, l); SEAM(pb + 10); TSTOP(10); }
        if (IN(pb + 11)) { TSTART(11); F.refresh();
            pg8::Gemm g{(const h16*)(F.ws + WS_ZU), (const h16*)(F.ws + wsw(l) + W_DOWN), NTOK, DM, DFF, DFF}; pg8::StaticOrder S; S.init(NTOK, DM, F.G, F.bid);
            const bool nx = l + 1 < DEPTH;
            pg8::EpiRes E{F.out + O_Y, F.out + O_Y + (size_t)NCTX * DM, F.out + O_Y, (const float*)(F.ws + WS_MOD) + (size_t)l * 3 * 6144 + 5 * 1024,
                          nx ? (h16*)(F.ws + WS_H) : (h16*)nullptr, F.inp(I_N1G) + (nx ? l + 1 : l) * DM, (const float*)(F.ws + WS_MOD) + (size_t)(nx ? l + 1 : l) * 3 * 6144 + 1 * 1024,
                          nx ? (float*)(F.ws + WS_SS) + (size_t)(2 * (l + 1)) * NTOK : (float*)nullptr, F.lds + EPI_SCR_OFF};
            pg8::gemm_phase<pg8::EpiRes, pg8::StaticOrder, true, true>(F.lds, g, S, E);
            SEAM(pb + 11); TSTOP(11); }
    }
    { constexpr int l = 1; constexpr int pb = 12 * l;
        if (l == 0 && IN(pb + 0)) { TSTART(0); F.refresh(); phase_convert_weights(F, l); phase_prep_misc(F); SEAM(pb + 0); TSTOP(0); }
        if (IN(pb + 1)) { TSTART(1); F.refresh();
            if (l == 0) phase_norm0(F, F.inp(I_N1G), (const float*)(F.ws + WS_MOD), (float*)(F.ws + WS_SS));
            phase_cvec(F, l);
            SEAM(pb + 1); TSTOP(1); }
        if (IN(pb + 2)) { TSTART(2); F.refresh();
            pg8::Gemm g{(const h16*)(F.ws + WS_H), (const h16*)(F.ws + wsw(l) + W_IN), NTOK, NMAIN, DM, DM}; pg8::StaticOrder S; S.init(NTOK, NMAIN, F.G, F.bid);
            pg8::EpiF16<0> E{(h16*)(F.ws + WS_ZU), NMAIN, (const float*)(F.ws + WS_SS) + (size_t)(2 * l) * NTOK, (const float*)(F.ws + WS_CV) + (size_t)l * 3 * (DIN + DUP), DIN + DUP};
            pg8::gemm_phase<pg8::EpiF16<0>, pg8::StaticOrder, true, true>(F.lds, g, S, E);
            if (l + 1 < DEPTH && F.bid >= F.G / 2) phase_convert_weights(F, l + 1, 1, F.G / 2);
            SEAM(pb + 2); TSTOP(2); }
        if (IN(pb + 3)) { TSTART(3); F.refresh();
            phase_qk(F, l);
            for (int u = F.vcu; u < 512; u += F.G) {
                if (u < 256) lru_unit<0>(F, l, (u >> 3) * 256, u & 7, 1, 1, 0, 0, u >> 3);
                else { const int v = u - 256, b = v >> 7, ch = (v >> 3) & 15; lru_unit<1>(F, l, NCTX + b * LSEQ + ch * 256, v & 7, ch == 0, ch == 15, b, ch, 0); }
            }
            SEAM(pb + 3); TSTOP(3); }
        if (IN(pb + 4)) { TSTART(4); F.refresh();
            for (int type = 0; type < 4; ++type) { TSL_START(F.lds, 20 + type); for (int u = F.vcu; u < 256; u += F.G) attn_dispatch(F, l, type, u); TSL_STOP(F.lds, 20 + type); }
            TSL_START(F.lds, 24);
            for (int v = F.vcu; v < 256; v += F.G) { const int b = v >> 7, ch = (v >> 3) & 15; lru_unit<3>(F, l, NCTX + b * LSEQ + ch * 256, v & 7, ch == 0, ch == 15, b, ch, 0); }
            TSL_STOP(F.lds, 24);
            SEAM(pb + 4); TSTOP(4); }
        if (IN(pb + 6)) { TSTART(6); F.refresh();
            pg8::StaticOrder S; S.init(NTOK, DM, F.G, F.bid);
            pg8::GateMergeJobs jobs{S, F.ws, wsw(l)};
            pg8::EpiGM E{(h16*)(F.ws + WS_MG), (h16*)(F.ws + WS_ZU) + (size_t)F.bid * 256 * 256, (const float*)(F.ws + WS_SS) + (size_t)(2 * l) * NTOK,
                         (const float*)(F.ws + WS_CV) + (size_t)l * 3 * (DIN + DUP) + NMAIN, DIN + DUP};
            pg8::gemm_multi(F.lds, jobs, E);
            SEAM(pb + 6); TSTOP(6); }
        if (IN(pb + 7)) { TSTART(7); F.refresh();
            pg8::Gemm g{(const h16*)(F.ws + WS_MG), (const h16*)(F.ws + wsw(l) + W_OUT), NTOK, DM, DM, DM}; pg8::StaticOrder S; S.init(NTOK, DM, F.G, F.bid);
            pg8::EpiRes E{l == 0 ? F.inp(I_XP) : F.out + O_Y, l == 0 ? F.inp(I_XS) : F.out + O_Y + (size_t)NCTX * DM, F.out + O_Y, (const float*)(F.ws + WS_MOD) + (size_t)l * 3 * 6144 + 2 * 1024,
                          (h16*)(F.ws + WS_H2), F.inp(I_N2G) + l * DM, (const float*)(F.ws + WS_MOD) + (size_t)l * 3 * 6144 + 4 * 1024, (float*)(F.ws + WS_SS) + (size_t)(2 * l + 1) * NTOK, F.lds + EPI_SCR_OFF};
            pg8::gemm_phase<pg8::EpiRes, pg8::StaticOrder, true, true>(F.lds, g, S, E);
            SEAM(pb + 7); TSTOP(7); }
        if (IN(pb + 9)) { TSTART(9); F.refresh();
            pg8::Gemm g{(const h16*)(F.ws + WS_H2), (const h16*)(F.ws + wsw(l) + W_UP), NTOK, DUP, DM, DM}; pg8::StaticOrder S; S.init(NTOK, DUP, F.G, F.bid);
            pg8::EpiAct E{(h16*)(F.ws + WS_ZU), (const float*)(F.ws + WS_SS) + (size_t)(2 * l + 1) * NTOK, (const float*)(F.ws + WS_CV) + (size_t)l * 3 * (DIN + DUP) + DIN, DIN + DUP,
                          F.inp(I_FCW) + (size_t)l * 3 * DFF, F.inp(I_FCB) + (size_t)l * DFF, (float*)(F.ws + WS_EDGE)};
            pg8::gemm_phase<pg8::EpiAct, pg8::StaticOrder, true, true>(F.lds, g, S, E);
            if (l + 1 < DEPTH && F.bid >= F.G / 2) phase_convert_weights(F, l + 1, 2, F.G / 2);
            SEAM(pb + 9); TSTOP(9); }
        if (IN(pb + 10)) { TSTART(10); F.refresh(); phase_act_fixup(F, l); SEAM(pb + 10); TSTOP(10); }
        if (IN(pb + 11)) { TSTART(11); F.refresh();
            pg8::Gemm g{(const h16*)(F.ws + WS_ZU), (const h16*)(F.ws + wsw(l) + W_DOWN), NTOK, DM, DFF, DFF}; pg8::StaticOrder S; S.init(NTOK, DM, F.G, F.bid);
            const bool nx = l + 1 < DEPTH;
            pg8::EpiRes E{F.out + O_Y, F.out + O_Y + (size_t)NCTX * DM, F.out + O_Y, (const float*)(F.ws + WS_MOD) + (size_t)l * 3 * 6144 + 5 * 1024,
                          nx ? (h16*)(F.ws + WS_H) : (h16*)nullptr, F.inp(I_N1G) + (nx ? l + 1 : l) * DM, (const float*)(F.ws + WS_MOD) + (size_t)(nx ? l + 1 : l) * 3 * 6144 + 1 * 1024,
                          nx ? (float*)(F.ws + WS_SS) + (size_t)(2 * (l + 1)) * NTOK : (float*)nullptr, F.lds + EPI_SCR_OFF};
            pg8::gemm_phase<pg8::EpiRes, pg8::StaticOrder, true, true>(F.lds, g, S, E);
            SEAM(pb + 11); TSTOP(11); }
    }
    if (IN(24)) { TSTART(12); F.refresh(); phase_final_norm(F); TSTOP(12); }
#if defined(TIME_SUB)
    if (blockIdx.x == 0 && threadIdx.x == 0) { const unsigned long long ta = *(volatile LAS unsigned long long*)(F.lds + MISC_OFF + 64); const unsigned long long t1 = __builtin_amdgcn_s_memrealtime(); while (__builtin_amdgcn_s_memrealtime() - t1 < 8ull * ta) __builtin_amdgcn_s_sleep(8); }
#endif
#if defined(TIME_PH)
    if (blockIdx.x == 0 && threadIdx.x == 0) { const unsigned long long t1 = __builtin_amdgcn_s_memrealtime(); while (__builtin_amdgcn_s_memrealtime() - t1 < (unsigned long long)TIME_AMP * t_acc) __builtin_amdgcn_s_sleep(8); }
#endif
#undef IN
#undef SEAM
}

extern "C" void kernel_launch(void* const* d_in, const int* in_sizes, int n_in, void* d_out, int out_size, void* d_ws, size_t ws_size, hipStream_t stream) {
    static int grid = 0;
    if (grid == 0) {
        if (n_in != 33 || out_size != (int)O_END || ws_size < WS_END) { fprintf(stderr, "kernel_launch: unexpected shapes: n_in %d out %d ws %zu (need %zu)\n", n_in, out_size, ws_size, (size_t)WS_END); grid = -1; return; }
        int dev = 0, cus = 0;
        if (hipGetDevice(&dev) != hipSuccess || hipDeviceGetAttribute(&cus, hipDeviceAttributeMultiprocessorCount, dev) != hipSuccess) { grid = -1; return; }
        if (hipFuncSetAttribute((const void*)fwd_kernel, hipFuncAttributeMaxDynamicSharedMemorySize, LDS_BYTES) != hipSuccess) { fprintf(stderr, "kernel_launch: hipFuncSetAttribute failed\n"); grid = -1; return; }
        (void)hipGetLastError();
        grid = cus;
    }
    if (grid < 0) return;
    (void)hipMemsetAsync((char*)d_ws + WS_CTL, 0, CTL_ZERO_BYTES, stream);
    Args a{};
    for (int i = 0; i < 33; ++i) a.in[i] = (const float*)d_in[i];
    a.out = (float*)d_out; a.ws = (unsigned char*)d_ws;
#if MK_PER_PHASE
    for (int ph = 0; ph < N_PHASES; ++ph) { a.ph_lo = ph; a.ph_hi = ph + 1; hipLaunchKernelGGL(fwd_kernel, dim3(grid), dim3(NTHREADS), LDS_BYTES, stream, a); }
#else
    a.ph_lo = 0; a.ph_hi = N_PHASES;
    hipLaunchKernelGGL(fwd_kernel, dim3(grid), dim3(NTHREADS), LDS_BYTES, stream, a);
#endif
}
```

```cpp
#include <hip/hip_runtime.h>
#include <cstdio>
#include <cstdint>
#include <cmath>

#ifndef MK_PER_PHASE
#define MK_PER_PHASE 0
#endif

#define LAS __attribute__((address_space(3)))
#define GAS __attribute__((address_space(1)))
typedef _Float16 h16;
typedef _Float16 h16x8 __attribute__((ext_vector_type(8)));
typedef _Float16 h16x4 __attribute__((ext_vector_type(4)));
typedef _Float16 h16x2 __attribute__((ext_vector_type(2)));
typedef short s16x4 __attribute__((ext_vector_type(4)));
typedef float f32x2 __attribute__((ext_vector_type(2)));
typedef float f32x4 __attribute__((ext_vector_type(4)));
typedef float f32x16 __attribute__((ext_vector_type(16)));
typedef unsigned u32x2 __attribute__((ext_vector_type(2)));
typedef unsigned u32x4 __attribute__((ext_vector_type(4)));

constexpr int DM = 1024, NTOK = 16384, NCTX = 8192, SEQ = 256, LSEQ = 4096, NB_CTX = 32, NB_LAT = 2, DEPTH = 2;
constexpr int DIN = 6656, NMAIN = 3584, NGATE = 3072, DFF = 2816, DUP = 5632, DLRU = 1024;
constexpr int C_XA = 0, C_YA = 1024, C_QB = 2048, C_KB = 2560, C_VB = 2688, C_QC = 2816, C_KC = 3328, C_VC = 3456;
constexpr float NORM_EPS = 1e-6f;
constexpr float LOG2E = 1.4426950408889634f;
constexpr float QSCALE = 0.125f * LOG2E;
constexpr size_t O_Y = 0, O_KB = 16777216, O_VB = 18874368, O_KC = 20971520, O_VC = 23068672, O_LRU = 25165824, O_END = 25296896;
constexpr size_t MiB = 1u << 20;
constexpr size_t WS_CTL = 0, WS_SS = 64 * 1024, CTL_ZERO_BYTES = 64 * 1024 + 4 * NTOK * 4;
constexpr size_t WS_MOD = 1 * MiB;
constexpr size_t WS_ROPE = 1 * MiB + 256 * 1024;
constexpr size_t WS_AGG = 1 * MiB + 320 * 1024;
constexpr size_t WS_CACHE = 2 * MiB;
constexpr size_t WS_W = 3 * MiB;
constexpr size_t W_IN = 0, W_OA = W_IN + (size_t)DIN * DM * 2, W_OB = W_OA + (size_t)DM * 1024 * 2, W_OC = W_OB + (size_t)DM * 512 * 2,
                 W_OUT = W_OC + (size_t)DM * 512 * 2, W_UP = W_OUT + (size_t)DM * DM * 2, W_DOWN = W_UP + (size_t)DUP * DM * 2,
                 W_LRU = W_DOWN + (size_t)DM * DFF * 2, W_END = W_LRU + (size_t)2 * 2 * 8 * 128 * 128 * 2;
static_assert(W_END <= 37 * MiB, "weights region");
constexpr size_t WS_H = 40 * MiB;
constexpr size_t WS_ZU = 72 * MiB;
constexpr size_t ZU_OA = (size_t)NTOK * NMAIN * 2, ZU_OB = ZU_OA + (size_t)NTOK * 1024 * 2, ZU_OC = ZU_OB + (size_t)NTOK * 512 * 2;
constexpr size_t WS_STASH = WS_ZU + (size_t)NTOK * DUP * 2;
static_assert(WS_STASH == 248 * MiB, "ws map");
constexpr size_t WS_MG = WS_STASH;
constexpr size_t WS_H2 = WS_STASH + (size_t)NTOK * DM * 2;
constexpr size_t WS_CV = WS_STASH + (size_t)NB_LAT * 2 * LSEQ * DLRU * 4;
constexpr size_t WS_EDGE = WS_CV + MiB;
constexpr size_t WS_W2 = WS_EDGE + (size_t)64 * 8 * 3 * DFF * 4 + 4096;
constexpr size_t WS_END = WS_W2 + 37 * MiB;
__host__ __device__ constexpr size_t wsw(int l) { return l == 0 ? WS_W : WS_W2; }

__device__ __forceinline__ unsigned pk_h2(float lo, float hi) { f32x2 v = {lo, hi}; h16x2 h = __builtin_convertvector(v, h16x2); return __builtin_bit_cast(unsigned, h); }
__device__ __forceinline__ void unpack8(u32x4 w, float* x) { h16x8 h = __builtin_bit_cast(h16x8, w);
#pragma unroll
    for (int j = 0; j < 8; ++j) x[j] = (float)h[j]; }
__device__ __forceinline__ u32x4 pack8(const float* x) { u32x4 w; w.x = pk_h2(x[0], x[1]); w.y = pk_h2(x[2], x[3]); w.z = pk_h2(x[4], x[5]); w.w = pk_h2(x[6], x[7]); return w; }
__device__ __forceinline__ float fast_exp2(float x) { return __builtin_amdgcn_exp2f(x); }
__device__ __forceinline__ float fast_rcp(float x) { return __builtin_amdgcn_rcpf(x); }
__device__ __forceinline__ float sigmoidf_(float x) { return fast_rcp(1.0f + fast_exp2(-LOG2E * x)); }
__device__ __forceinline__ float gelu_tanh(float x) { const float t = x + 0.044715f * x * x * x; return x * fast_rcp(1.0f + fast_exp2(-2.0f * 0.7978845608028654f * LOG2E * t)); }
template <int CTRL> __device__ __forceinline__ float dpp_f(float v) { return __int_as_float(__builtin_amdgcn_update_dpp(0, __float_as_int(v), CTRL, 0xf, 0xf, true)); }
__device__ __forceinline__ float sum8(float v) { v += dpp_f<0xB1>(v); v += dpp_f<0x4E>(v); v += dpp_f<0x141>(v); return v; }
__device__ __forceinline__ float wave_sum(float v) { v = sum8(v); v += dpp_f<0x140>(v); v += __shfl_xor(v, 16); v += __shfl_xor(v, 32); return v; }

constexpr int RING_BYTES = 131072;
constexpr int LDSCTL_OFF = RING_BYTES, MISC_OFF = LDSCTL_OFF + 320;
constexpr int LDS_BYTES = 163840;
constexpr int EPI_SCR_OFF = RING_BYTES + 2048, EPI_SCR_WAVE = 2304;
#if defined(TIME_SUB)
#ifndef TIME_FILTER
#define TIME_FILTER -1
#endif
#define TSL_OK(l_) (blockIdx.x == 0 && threadIdx.x == 0 && (TIME_FILTER < 0 || *(volatile LAS int*)((l_) + MISC_OFF + 96) == TIME_FILTER))
#define TSL_START(l_, id) do { if ((id) == TIME_SUB && TSL_OK(l_)) *(volatile LAS unsigned long long*)((l_) + MISC_OFF + 72) = __builtin_amdgcn_s_memrealtime(); } while (0)
#define TSL_STOP(l_, id) do { if ((id) == TIME_SUB && TSL_OK(l_)) { volatile LAS unsigned long long* a_ = (volatile LAS unsigned long long*)((l_) + MISC_OFF + 64); a_[0] = a_[0] + (__builtin_amdgcn_s_memrealtime() - a_[1]); } } while (0)
#define TSL_PHASE(l_, k) do { if (blockIdx.x == 0 && threadIdx.x == 0) *(volatile LAS int*)((l_) + MISC_OFF + 96) = (k); } while (0)
#else
#define TSL_START(l_, id) do { } while (0)
#define TSL_STOP(l_, id) do { } while (0)
#define TSL_PHASE(l_, k) do { } while (0)
#endif
namespace pg8 {
constexpr int BM = 256, BK = 64, HALF = 128, HTB = HALF * BK * 2, STAGE_BYTES = 8 * HTB, NXCD = 8, WGM = 8;
__host__ __device__ __forceinline__ int lds_byte(int r, int c) { const int st = (r >> 4) * 2 + (c >> 5), rr = r & 15, cc = c & 31, ob = rr * 64 + cc * 2; return st * 1024 + (ob ^ (((ob >> 9) & 1) << 5)); }
__host__ __device__ __forceinline__ void stage_rc(int b, int& R, int& C) { const int st = b / 1024, sb = b % 1024, swz = sb ^ (((sb >> 9) & 1) << 5); R = (st >> 1) * 16 + swz / 64; C = (st & 1) * 32 + (swz % 64) / 2; }
__host__ __device__ __forceinline__ int perm32(int rho) { const int n = rho >> 4, i = rho & 15; return 8 * (i >> 2) + 4 * n + (i & 3); }
struct Unit { int pm, pn; };
struct Gemm { const h16* A; const h16* Bt; int M, N, K, lda; };
struct StaticOrder {
    int nM, nN, nwg, G, c;
    __host__ __device__ void init(int M, int N, int G_, int c_) { nM = M / BM; nN = N / BM; nwg = nM * nN; G = G_; c = c_; }
    __host__ __device__ bool next(int i, Unit& u) const {
        const long L = (long)i * G + c; if (L >= nwg) return false;
        int wgid = (int)L; { const int q = nwg / NXCD, r = nwg % NXCD, xcd = wgid % NXCD, off = wgid / NXCD; wgid = (xcd < r ? xcd * (q + 1) : r * (q + 1) + (xcd - r) * q) + off; }
        const int nig = WGM * nN, gid = wgid / nig, fm = gid * WGM, gsz = (nM - fm) < WGM ? (nM - fm) : WGM;
        u.pm = fm + ((wgid % nig) % gsz); u.pn = (wgid % nig) / gsz; return true;
    }
    __device__ __forceinline__ void a_ready(const Unit&) const {}
    __device__ __forceinline__ void done(const Unit&) const {}
};

template <int ACT> struct EpiF16 {
    static constexpr bool PERM = true, AFTER_DRAIN = false;
    h16* O; int ldc;
    const float* ss; const float* cv;
    int cvld;
    __device__ __forceinline__ void operator()(const f32x4 (&acc)[2][2][4][2], const Unit& u, int wr, int wc, int fr, int fq) const {
        const int row0 = u.pm * BM + wr * 64 + fr, col0 = u.pn * BM + wc * 32 + 8 * fq;
        const int cond = u.pm < 32 ? 0 : (u.pm < 48 ? 1 : 2);
        f32x4 c0[2], c1[2];
#pragma unroll
        for (int bj = 0; bj < 2; ++bj) { const float* cp = cv + (size_t)cond * cvld + col0 + bj * HALF; c0[bj] = *(const f32x4*)cp; c1[bj] = *(const f32x4*)(cp + 4); }
#pragma unroll
        for (int ai = 0; ai < 2; ++ai)
#pragma unroll
            for (int m = 0; m < 4; ++m) { const int row = row0 + ai * HALF + m * 16; h16* rowp = O + (size_t)row * ldc + col0;
                const float rstd = 1.0f / sqrtf(ss[row] * (1.0f / DM) + NORM_EPS);
#pragma unroll
                for (int bj = 0; bj < 2; ++bj) { f32x4 v0 = acc[ai][bj][m][0] * rstd + c0[bj], v1 = acc[ai][bj][m][1] * rstd + c1[bj];
                    if (ACT == 1) {
#pragma unroll
                        for (int j = 0; j < 4; ++j) { v0[j] = sigmoidf_(v0[j]); v1[j] = sigmoidf_(v1[j]); } }
                    u32x4 w; w.x = pk_h2(v0[0], v0[1]); w.y = pk_h2(v0[2], v0[3]); w.z = pk_h2(v1[0], v1[1]); w.w = pk_h2(v1[2], v1[3]);
                    *(u32x4*)(rowp + bj * HALF) = w; } }
    }
};
template <int ACCUM> struct EpiGateMul {
    static constexpr bool PERM = true, AFTER_DRAIN = false;
    h16* Mg; const h16* G; int gcol0;
    __device__ __forceinline__ void operator()(const f32x4 (&acc)[2][2][4][2], const Unit& u, int wr, int wc, int fr, int fq) const {
        const int row0 = u.pm * BM + wr * 64 + fr, col0 = u.pn * BM + wc * 32 + 8 * fq;
#pragma unroll
        for (int ai = 0; ai < 2; ++ai) {
            u32x4 gw[4][2], mw[4][2];
#pragma unroll
            for (int m = 0; m < 4; ++m) { const size_t row = (size_t)(row0 + ai * HALF + m * 16);
#pragma unroll
                for (int bj = 0; bj < 2; ++bj) { gw[m][bj] = *(const u32x4*)(G + row * NGATE + gcol0 + col0 + bj * HALF);
                    if (ACCUM) mw[m][bj] = *(const u32x4*)(Mg + row * DM + col0 + bj * HALF); } }
#pragma unroll
            for (int m = 0; m < 4; ++m) { const size_t row = (size_t)(row0 + ai * HALF + m * 16);
#pragma unroll
                for (int bj = 0; bj < 2; ++bj) {
                    float g[8]; unpack8(gw[m][bj], g);
                    float o[8];
                    if (ACCUM) unpack8(mw[m][bj], o);
                    else {
#pragma unroll
                        for (int j = 0; j < 8; ++j) o[j] = 0.f; }
                    const f32x4 v0 = acc[ai][bj][m][0], v1 = acc[ai][bj][m][1];
#pragma unroll
                    for (int j = 0; j < 4; ++j) { o[j] += g[j] * v0[j]; o[4 + j] += g[4 + j] * v1[j]; }
                    *(u32x4*)(Mg + row * DM + col0 + bj * HALF) = pack8(o); } }
            asm volatile("" ::: "memory"); }
    }
};
template <int CTRL> __device__ __forceinline__ float dpp_old(float old, float v) { return __int_as_float(__builtin_amdgcn_update_dpp(__float_as_int(old), __float_as_int(v), CTRL, 0xf, 0xf, false)); }
struct EpiAct {
    static constexpr bool PERM = true, AFTER_DRAIN = false;
    h16* ACT; const float* ss; const float* cv; int cvld; const float* cw; const float* cb; float* edge;
    __device__ __forceinline__ void operator()(const f32x4 (&acc)[2][2][4][2], const Unit& u, int wr, int wc, int fr, int fq) const {
        const int cond = u.pm < 32 ? 0 : (u.pm < 48 ? 1 : 2);
        const int chb = u.pn * 128 + wc * 32 + 8 * fq;
        const int colg = u.pn * BM + wc * 32 + 8 * fq;
        float cg[8], cvv[8], w0[8], w1[8], w2[8], bb[8];
#pragma unroll
        for (int e = 0; e < 8; ++e) { cg[e] = cv[(size_t)cond * cvld + colg + e]; cvv[e] = cv[(size_t)cond * cvld + colg + HALF + e];
            w0[e] = cw[chb + e]; w1[e] = cw[DFF + chb + e]; w2[e] = cw[2 * DFF + chb + e]; bb[e] = cb[chb + e]; }
#pragma unroll
        for (int ai = 0; ai < 2; ++ai) {
            float rs[4]; float g[4][8];
#pragma unroll
            for (int m = 0; m < 4; ++m) { rs[m] = 1.0f / sqrtf(ss[u.pm * BM + ai * HALF + wr * 64 + m * 16 + fr] * (1.0f / DM) + NORM_EPS);
#pragma unroll
                for (int e = 0; e < 8; ++e) g[m][e] = acc[ai][0][m][e >> 2][e & 3] * rs[m] + cg[e]; }
#pragma unroll
            for (int m = 0; m < 4; ++m) {
                const int row = u.pm * BM + ai * HALF + wr * 64 + m * 16 + fr;
                float o[8], pre[8], vv[8];
#pragma unroll
                for (int e = 0; e < 8; ++e) {
                    const float pe = m > 0 ? dpp_f<0x121>(g[m > 0 ? m - 1 : 0][e]) : 0.f;
                    const float prev = dpp_old<0x111>(pe, g[m][e]);
                    const float ne = m < 3 ? dpp_f<0x12F>(g[m < 3 ? m + 1 : 3][e]) : 0.f;
                    const float next = dpp_old<0x101>(ne, g[m][e]);
                    vv[e] = acc[ai][1][m][e >> 2][e & 3] * rs[m] + cvv[e];
                    pre[e] = bb[e] + w0[e] * prev + w1[e] * g[m][e] + w2[e] * next;
                    o[e] = gelu_tanh(pre[e]) * vv[e];
                }
                *(u32x4*)(ACT + (size_t)row * DFF + chb) = pack8(o);
                if ((m == 0 && fr == 0) || (m == 3 && fr == 15)) {
                    float* ep = edge + ((size_t)(u.pm * 8 + 2 * (2 * ai + wr) + (m == 3 ? 1 : 0)) * 3) * DFF + chb;
#pragma unroll
                    for (int e = 0; e < 8; ++e) { ep[e] = g[m][e]; ep[DFF + e] = pre[e]; ep[2 * DFF + e] = vv[e]; }
                }
            }
        }
    }
};
template <bool IN16>
struct EpiRes {
    static constexpr bool PERM = false, AFTER_DRAIN = false;
    const void* base_ctx; const void* base_lat; h16* X; const float* gate;
    h16* Hn; const float* gn; const float* scn; float* ssn;
    LAS unsigned char* scr;
    __device__ __forceinline__ void operator()(const f32x4 (&acc)[2][2][4][2], const Unit& u, int wr, int wc, int fr, int fq) const {
        constexpr int MG = IN16 ? 4 : 2;
        const int cond = u.pm < 32 ? 0 : (u.pm < 48 ? 1 : 2);
        const float* gp = gate + (size_t)cond * 6144;
        const size_t toff = u.pm < 32 ? (size_t)u.pm * BM * DM : (size_t)(u.pm - 32) * BM * DM;
        const void* bsel = u.pm < 32 ? base_ctx : base_lat;
        const h16* bp16 = (const h16*)bsel + toff; const float* bp32 = (const float*)bsel + toff;
        h16* xp = X + (size_t)u.pm * BM * DM;
        const int lane = fq * 16 + fr, wave = wr * 4 + wc;
        LAS unsigned char* my = scr + wave * EPI_SCR_WAVE;
        const int wofs = fr * 144 + fq * 16;
        const int rrow = lane >> 2, rc8 = (lane & 3) * 8;
        const int rofs = rrow * 144 + rc8 * 4;
        const int colw = u.pn * BM + wc * 32 + rc8;
        const unsigned loff = (unsigned)((wr * 64 + rrow) * DM + colw);
        f32x4 gv[2][2], gsn[2][2];
#pragma unroll
        for (int bj = 0; bj < 2; ++bj)
#pragma unroll
            for (int hh = 0; hh < 2; ++hh) { const int c = colw + bj * HALF + 4 * hh; gv[bj][hh] = *(const f32x4*)(gp + c);
                if (Hn) gsn[bj][hh] = *(const f32x4*)(gn + c) * (*(const f32x4*)(scn + (size_t)cond * 6144 + c) + 1.0f); }
        h16* hp = Hn ? Hn + (size_t)u.pm * BM * DM : nullptr;
        float* sp = ssn ? ssn + u.pm * BM : nullptr;
#pragma unroll
        for (int ai = 0; ai < 2; ++ai)
#pragma unroll
        for (int mg = 0; mg < 4 / MG; ++mg) {
            u32x4 bh[MG][2]; f32x4 bf[IN16 ? 1 : MG][2][2];
#pragma unroll
            for (int m2 = 0; m2 < MG; ++m2)
#pragma unroll
                for (int bj = 0; bj < 2; ++bj) { const size_t ro = (size_t)(ai * HALF + (mg * MG + m2) * 16) * DM;
                    if (IN16) bh[m2][bj] = *(const u32x4*)(bp16 + ro + loff + bj * HALF);
                    else { bf[IN16 ? 0 : m2][bj][0] = *(const f32x4*)(bp32 + ro + loff + bj * HALF); bf[IN16 ? 0 : m2][bj][1] = *(const f32x4*)(bp32 + ro + loff + bj * HALF + 4); } }
#pragma unroll
            for (int m2 = 0; m2 < MG; ++m2) { const int m = mg * MG + m2;
                const size_t ro = (size_t)(ai * HALF + m * 16) * DM;
                float q = 0.f;
#pragma unroll
                for (int bj = 0; bj < 2; ++bj) {
                    *(LAS f32x4*)(my + wofs) = acc[ai][bj][m][0]; *(LAS f32x4*)(my + wofs + 64) = acc[ai][bj][m][1];
                    const f32x4 a0 = *(const LAS f32x4*)(my + rofs), a1 = *(const LAS f32x4*)(my + rofs + 16);
                    f32x4 b0, b1;
                    if (IN16) { float t[8]; unpack8(bh[m2][bj], t); b0 = (f32x4){t[0], t[1], t[2], t[3]}; b1 = (f32x4){t[4], t[5], t[6], t[7]}; }
                    else { b0 = bf[IN16 ? 0 : m2][bj][0]; b1 = bf[IN16 ? 0 : m2][bj][1]; }
                    const f32x4 x0 = b0 + gv[bj][0] * a0, x1 = b1 + gv[bj][1] * a1;
                    u32x4 w; w.x = pk_h2(x0[0], x0[1]); w.y = pk_h2(x0[2], x0[3]); w.z = pk_h2(x1[0], x1[1]); w.w = pk_h2(x1[2], x1[3]);
                    *(u32x4*)(xp + ro + loff + bj * HALF) = w;
                    if (Hn) { const f32x4 h0 = x0 * gsn[bj][0], h1 = x1 * gsn[bj][1];
                        u32x4 v; v.x = pk_h2(h0[0], h0[1]); v.y = pk_h2(h0[2], h0[3]); v.z = pk_h2(h1[0], h1[1]); v.w = pk_h2(h1[2], h1[3]);
                        *(u32x4*)(hp + ro + loff + bj * HALF) = v;
                        q += ((x0[0] * x0[0] + x0[1] * x0[1]) + (x0[2] * x0[2] + x0[3] * x0[3])) + ((x1[0] * x1[0] + x1[1] * x1[1]) + (x1[2] * x1[2] + x1[3] * x1[3])); }
                }
                if (Hn) { float t = q; t += dpp_f<0xB1>(t); t += dpp_f<0x4E>(t);
                    if ((lane & 3) == 0) atomicAdd(sp + wr * 64 + ai * HALF + m * 16 + rrow, t); }
            }
            asm volatile("" ::: "memory"); }
    }
};

template <class Epi, class Sched, bool ALIGN_EPI = false, bool SP2 = false>
__device__ __forceinline__ void gemm_phase(LAS unsigned char* lds, const Gemm g, const Sched& S, const Epi& E) {
    int tid_ = threadIdx.x; asm volatile("" : "+v"(tid_));
    const int tid = tid_, wid = __builtin_amdgcn_readfirstlane(tid >> 6), lane = tid & 63, wr = wid >> 2, wc = wid & 3, fr = lane & 15, fq = lane >> 4;
    const int K = g.K, nt = K / BK, lda = g.lda;
    unsigned voffA[2], voffB[2];
#pragma unroll
    for (int i = 0; i < 2; ++i) { int R, C; stage_rc(tid * 16 + i * 8192, R, C); const int Rb = Epi::PERM ? ((R & ~31) + perm32(R & 31)) : R;
        voffA[i] = (unsigned)(R * lda + C) * 2u; voffB[i] = (unsigned)(Rb * K + C) * 2u; }
    const size_t kstep = (size_t)(BK * 2);
    const size_t hstepA = (size_t)HALF * lda * 2, hstepB = (size_t)HALF * K * 2;
    const size_t tstepA = 2 * hstepA, tstepB = 2 * hstepB;
    const unsigned ldsw = (unsigned)wid * 1024u;
    const int aoff = lds_byte(wr * 64 + fr, fq * 8), boff = lds_byte(wc * 32 + fr, fq * 8);
#define PG8_SA(b, h) (((b) * 2 + (h)) * HTB)
#define PG8_SB(b, h) ((4 + (b) * 2 + (h)) * HTB)
#define PG8_STAGE(bufoff, gbase, voff) do { _Pragma("unroll") for (int _i = 0; _i < 2; ++_i) \
        __builtin_amdgcn_global_load_lds((const unsigned*)((const char*)(gbase) + (voff)[_i]), (LAS unsigned*)(lds + (bufoff) + ldsw + _i * 8192), 16, 0, 0); } while (0)
#define PG8_LDA(dst, b, h) do { _Pragma("unroll") for (int m = 0; m < 4; ++m) _Pragma("unroll") for (int k = 0; k < 2; ++k) dst[m][k] = *(const LAS h16x8*)(lds + PG8_SA(b, h) + aoff + m * 2048 + k * 1024); } while (0)
#define PG8_LDB(dst, b, h) do { _Pragma("unroll") for (int n = 0; n < 2; ++n) _Pragma("unroll") for (int k = 0; k < 2; ++k) dst[n][k] = *(const LAS h16x8*)(lds + PG8_SB(b, h) + boff + n * 2048 + k * 1024); } while (0)
#define PG8_MMA(ai, bj, At, Bt) do { __builtin_amdgcn_s_setprio(1); _Pragma("unroll") for (int m = 0; m < 4; ++m) _Pragma("unroll") for (int n = 0; n < 2; ++n) _Pragma("unroll") for (int k = 0; k < 2; ++k) \
        acc[ai][bj][m][n] = __builtin_amdgcn_mfma_f32_16x16x32_f16(Bt[n][k], At[m][k], acc[ai][bj][m][n], 0, 0, 0); __builtin_amdgcn_s_setprio(0); } while (0)
#define PG8_WAIT_V(n) asm volatile("s_waitcnt vmcnt(" #n ")" ::: "memory")
#define PG8_WAIT_L(n) asm volatile("s_waitcnt lgkmcnt(" #n ")" ::: "memory")
#define PG8_BAR __builtin_amdgcn_s_barrier()
#define PG8_SCHED __builtin_amdgcn_sched_barrier(0)
    Unit cur, nxt; int ui = 0;
    if (!S.next(0, cur)) return;
    TSL_START(lds, 10);
    f32x4 acc[2][2][4][2];
#pragma unroll
    for (int a = 0; a < 2; ++a)
#pragma unroll
        for (int b = 0; b < 2; ++b)
#pragma unroll
            for (int m = 0; m < 4; ++m)
#pragma unroll
                for (int n = 0; n < 2; ++n) acc[a][b][m][n] = (f32x4){0.f, 0.f, 0.f, 0.f};
    h16x8 At[4][2], B0[2][2], B1[2][2];
    const char* cA = (const char*)g.A + (size_t)cur.pm * tstepA; const char* cB = (const char*)g.Bt + (size_t)cur.pn * tstepB;
    S.a_ready(cur);
    if constexpr (SP2) {
        PG8_STAGE(PG8_SB(0, 0), cB, voffB); PG8_STAGE(PG8_SB(0, 1), cB + hstepB, voffB); PG8_STAGE(PG8_SA(0, 0), cA, voffA); PG8_STAGE(PG8_SA(0, 1), cA + hstepA, voffA);
        if (wr == 1) PG8_BAR;
        PG8_WAIT_V(2); PG8_BAR;
        PG8_STAGE(PG8_SB(1, 0), cB + kstep, voffB); PG8_STAGE(PG8_SA(1, 0), cA + kstep, voffA); PG8_STAGE(PG8_SB(1, 1), cB + hstepB + kstep, voffB);
        PG8_WAIT_V(6); PG8_BAR;
    } else {
        PG8_STAGE(PG8_SB(0, 0), cB, voffB); PG8_STAGE(PG8_SA(0, 0), cA, voffA); PG8_STAGE(PG8_SB(0, 1), cB + hstepB, voffB); PG8_STAGE(PG8_SA(0, 1), cA + hstepA, voffA);
        if (wr == 1) PG8_BAR;
        PG8_WAIT_V(4); PG8_BAR;
        PG8_STAGE(PG8_SB(1, 0), cB + kstep, voffB); PG8_STAGE(PG8_SA(1, 0), cA + kstep, voffA); PG8_STAGE(PG8_SB(1, 1), cB + hstepB + kstep, voffB);
        PG8_WAIT_V(6); PG8_BAR;
    }
    for (;;) {
        const bool has_next = S.next(ui + 1, nxt);
        const char* nA = has_next ? (const char*)g.A + (size_t)nxt.pm * tstepA : cA; const char* nB = has_next ? (const char*)g.Bt + (size_t)nxt.pn * tstepB : cB;
        for (int t = 0; t < nt; t += 2) {
            const bool last = (t == nt - 2);
            const char* a1 = cA + (size_t)(t + 1) * kstep;
            const char* a2 = last ? nA : cA + (size_t)(t + 2) * kstep; const char* b2 = last ? nB : cB + (size_t)(t + 2) * kstep;
            const char* a3 = a2 + kstep; const char* b3 = b2 + kstep;
            if (last && has_next) S.a_ready(nxt);
            if constexpr (SP2) {
            PG8_LDB(B0, 0, 0); PG8_LDB(B1, 0, 1); PG8_SCHED; PG8_LDA(At, 0, 0); PG8_STAGE(PG8_SA(1, 1), a1 + hstepA, voffA);
            PG8_WAIT_V(8); PG8_WAIT_L(0); PG8_BAR; PG8_MMA(0, 0, At, B0); PG8_MMA(0, 1, At, B1); PG8_BAR; PG8_SCHED;
            PG8_LDA(At, 0, 1); PG8_STAGE(PG8_SB(0, 0), b2, voffB); PG8_STAGE(PG8_SB(0, 1), b2 + hstepB, voffB); PG8_STAGE(PG8_SA(0, 0), a2, voffA);
            PG8_WAIT_V(8); PG8_WAIT_L(0); PG8_BAR; PG8_MMA(1, 0, At, B0); PG8_MMA(1, 1, At, B1); PG8_BAR; PG8_SCHED;
            PG8_LDB(B0, 1, 0); PG8_LDB(B1, 1, 1); PG8_SCHED; PG8_LDA(At, 1, 0); PG8_STAGE(PG8_SA(0, 1), a2 + hstepA, voffA);
            PG8_WAIT_V(8); PG8_WAIT_L(0); PG8_BAR; PG8_MMA(0, 0, At, B0); PG8_MMA(0, 1, At, B1); PG8_BAR; PG8_SCHED;
            PG8_LDA(At, 1, 1); PG8_STAGE(PG8_SB(1, 0), b3, voffB); PG8_STAGE(PG8_SB(1, 1), b3 + hstepB, voffB); PG8_STAGE(PG8_SA(1, 0), a3, voffA);
            PG8_WAIT_V(8); PG8_WAIT_L(0); PG8_BAR; PG8_MMA(1, 0, At, B0); PG8_MMA(1, 1, At, B1); PG8_BAR; PG8_SCHED;
            } else {
            PG8_LDB(B0, 0, 0); PG8_SCHED; PG8_LDA(At, 0, 0); PG8_STAGE(PG8_SA(1, 1), a1 + hstepA, voffA);
            PG8_WAIT_L(8); PG8_BAR; PG8_WAIT_L(0); PG8_MMA(0, 0, At, B0); PG8_BAR; PG8_SCHED;
            PG8_LDB(B1, 0, 1); PG8_STAGE(PG8_SB(0, 0), b2, voffB);
            PG8_BAR; PG8_WAIT_L(0); PG8_MMA(0, 1, At, B1); PG8_BAR;
            PG8_LDA(At, 0, 1); PG8_STAGE(PG8_SA(0, 0), a2, voffA);
            PG8_BAR; PG8_WAIT_L(0); PG8_MMA(1, 0, At, B0); PG8_BAR; PG8_SCHED;
            PG8_STAGE(PG8_SB(0, 1), b2 + hstepB, voffB);
            PG8_WAIT_V(6); PG8_BAR; PG8_MMA(1, 1, At, B1); PG8_BAR;
            PG8_LDB(B0, 1, 0); PG8_SCHED; PG8_LDA(At, 1, 0); PG8_STAGE(PG8_SA(0, 1), a2 + hstepA, voffA);
            PG8_WAIT_L(8); PG8_BAR; PG8_WAIT_L(0); PG8_MMA(0, 0, At, B0); PG8_BAR; PG8_SCHED;
            PG8_LDB(B1, 1, 1); PG8_STAGE(PG8_SB(1, 0), b3, voffB);
            PG8_BAR; PG8_WAIT_L(0); PG8_MMA(0, 1, At, B1); PG8_BAR;
            PG8_LDA(At, 1, 1); PG8_STAGE(PG8_SA(1, 0), a3, voffA);
            PG8_BAR; PG8_WAIT_L(0); PG8_MMA(1, 0, At, B0); PG8_BAR; PG8_SCHED;
            PG8_STAGE(PG8_SB(1, 1), b3 + hstepB, voffB);
            PG8_WAIT_V(6); PG8_BAR; PG8_MMA(1, 1, At, B1); PG8_BAR;
            }
        }
        if constexpr (ALIGN_EPI) { if (wr == 0) PG8_BAR; }
        TSL_STOP(lds, 10); TSL_START(lds, 11);
        if constexpr (!Epi::AFTER_DRAIN) { E(acc, cur, wr, wc, fr, fq); S.done(cur); }
        TSL_STOP(lds, 11); TSL_START(lds, 10);
        if (!has_next) break;
#pragma unroll
        for (int a = 0; a < 2; ++a)
#pragma unroll
            for (int b = 0; b < 2; ++b)
#pragma unroll
                for (int m = 0; m < 4; ++m)
#pragma unroll
                    for (int n = 0; n < 2; ++n) acc[a][b][m][n] = (f32x4){0.f, 0.f, 0.f, 0.f};
        cur = nxt; cA = nA; cB = nB; ++ui;
        if constexpr (ALIGN_EPI) { if (wr == 1) PG8_BAR; }
    }
    PG8_WAIT_V(0);
    if constexpr (!ALIGN_EPI) { if (wr == 0) PG8_BAR; }
    PG8_BAR;
    TSL_STOP(lds, 10);
#undef PG8_SA
#undef PG8_SB
#undef PG8_STAGE
#undef PG8_LDA
#undef PG8_LDB
#undef PG8_MMA
#undef PG8_WAIT_V
#undef PG8_WAIT_L
#undef PG8_BAR
#undef PG8_SCHED
}

struct EpiGM {
    static constexpr bool PERM = true, AFTER_DRAIN = false;
    h16* Mg; h16* S; const float* ss; const float* cv; int cvld;
    __device__ __forceinline__ void operator()(const f32x4 (&acc)[2][2][4][2], const Unit& u, int kind, int wr, int wc, int fr_, int fq_) const {
        int fr = fr_, fq = fq_; asm volatile("" : "+v"(fr), "+v"(fq));
        const int r0 = wr * 64 + fr, c0 = wc * 32 + 8 * fq;
        if ((kind & 15) == 0) {
            const int gi = kind >> 4, cond = u.pm < 32 ? 0 : (u.pm < 48 ? 1 : 2);
            f32x4 ca[2], cb[2];
#pragma unroll
            for (int bj = 0; bj < 2; ++bj) { const float* cp = cv + (size_t)cond * cvld + gi * 1024 + u.pn * BM + c0 + bj * HALF; ca[bj] = *(const f32x4*)cp; cb[bj] = *(const f32x4*)(cp + 4); }
#pragma unroll
            for (int ai = 0; ai < 2; ++ai)
#pragma unroll
                for (int m = 0; m < 4; ++m) { const int rt = r0 + ai * HALF + m * 16;
                    const float rstd = 1.0f / sqrtf(ss[u.pm * BM + rt] * (1.0f / DM) + NORM_EPS);
#pragma unroll
                    for (int bj = 0; bj < 2; ++bj) { f32x4 v0 = acc[ai][bj][m][0] * rstd + ca[bj], v1 = acc[ai][bj][m][1] * rstd + cb[bj];
#pragma unroll
                        for (int j = 0; j < 4; ++j) { v0[j] = sigmoidf_(v0[j]); v1[j] = sigmoidf_(v1[j]); }
                        u32x4 w; w.x = pk_h2(v0[0], v0[1]); w.y = pk_h2(v0[2], v0[3]); w.z = pk_h2(v1[0], v1[1]); w.w = pk_h2(v1[2], v1[3]);
                        *(u32x4*)(S + rt * BM + c0 + bj * HALF) = w; } }
        } else {
            const bool accum = kind == 2;
#pragma unroll
            for (int ai = 0; ai < 2; ++ai)
#pragma unroll
            for (int mh = 0; mh < 2; ++mh) {
                u32x4 gw[2][2], mw[2][2];
#pragma unroll
                for (int m2 = 0; m2 < 2; ++m2) { const int rt = r0 + ai * HALF + (2 * mh + m2) * 16;
#pragma unroll
                    for (int bj = 0; bj < 2; ++bj) { gw[m2][bj] = *(const u32x4*)(S + rt * BM + c0 + bj * HALF);
                        mw[m2][bj] = accum ? *(const u32x4*)(Mg + (size_t)(u.pm * BM + rt) * DM + u.pn * BM + c0 + bj * HALF) : (u32x4){0u, 0u, 0u, 0u}; } }
#pragma unroll
                for (int m2 = 0; m2 < 2; ++m2) { const int m = 2 * mh + m2; const int rt = r0 + ai * HALF + m * 16;
#pragma unroll
                    for (int bj = 0; bj < 2; ++bj) {
                        float g[8], o[8]; unpack8(gw[m2][bj], g); unpack8(mw[m2][bj], o);
                        const f32x4 v0 = acc[ai][bj][m][0], v1 = acc[ai][bj][m][1];
#pragma unroll
                        for (int j = 0; j < 4; ++j) { o[j] += g[j] * v0[j]; o[4 + j] += g[4 + j] * v1[j]; }
                        *(u32x4*)(Mg + (size_t)(u.pm * BM + rt) * DM + u.pn * BM + c0 + bj * HALF) = pack8(o); } }
                asm volatile("" ::: "memory"); }
        }
    }
};
struct Sub { const h16* A; const h16* Bt; int K, lda, kind; };
template <class Jobs, class Epi>
__device__ __forceinline__ void gemm_multi(LAS unsigned char* lds, const Jobs& J, const Epi& E) {
    int tid_ = threadIdx.x; asm volatile("" : "+v"(tid_));
    const int tid = tid_, wid = __builtin_amdgcn_readfirstlane(tid >> 6), lane = tid & 63, wr = wid >> 2, wc = wid & 3, fr = lane & 15, fq = lane >> 4;
    unsigned rA2[2], rB2[2], c2[2];
#pragma unroll
    for (int i = 0; i < 2; ++i) { int R, C; stage_rc(tid * 16 + i * 8192, R, C); const int Rb = Epi::PERM ? ((R & ~31) + perm32(R & 31)) : R;
        rA2[i] = (unsigned)R * 2u; rB2[i] = (unsigned)Rb * 2u; c2[i] = (unsigned)C * 2u; }
    const size_t kstep = (size_t)(BK * 2);
    const unsigned ldsw = (unsigned)wid * 1024u;
    const int aoff = lds_byte(wr * 64 + fr, fq * 8), boff = lds_byte(wc * 32 + fr, fq * 8);
#define PG8_SA(b, h) (((b) * 2 + (h)) * HTB)
#define PG8_SB(b, h) ((4 + (b) * 2 + (h)) * HTB)
#define PG8_STAGE2(bufoff, gbase, rr, ld) do { _Pragma("unroll") for (int _i = 0; _i < 2; ++_i) \
        __builtin_amdgcn_global_load_lds((const unsigned*)((const char*)(gbase) + ((rr)[_i] * (unsigned)(ld) + c2[_i])), (LAS unsigned*)(lds + (bufoff) + ldsw + _i * 8192), 16, 0, 0); } while (0)
#define PG8_LDA(dst, b, h) do { _Pragma("unroll") for (int m = 0; m < 4; ++m) _Pragma("unroll") for (int k = 0; k < 2; ++k) dst[m][k] = *(const LAS h16x8*)(lds + PG8_SA(b, h) + aoff + m * 2048 + k * 1024); } while (0)
#define PG8_LDB(dst, b, h) do { _Pragma("unroll") for (int n = 0; n < 2; ++n) _Pragma("unroll") for (int k = 0; k < 2; ++k) dst[n][k] = *(const LAS h16x8*)(lds + PG8_SB(b, h) + boff + n * 2048 + k * 1024); } while (0)
#define PG8_MMA(ai, bj, At, Bt) do { __builtin_amdgcn_s_setprio(1); _Pragma("unroll") for (int m = 0; m < 4; ++m) _Pragma("unroll") for (int n = 0; n < 2; ++n) _Pragma("unroll") for (int k = 0; k < 2; ++k) \
        acc[ai][bj][m][n] = __builtin_amdgcn_mfma_f32_16x16x32_f16(Bt[n][k], At[m][k], acc[ai][bj][m][n], 0, 0, 0); __builtin_amdgcn_s_setprio(0); } while (0)
#define PG8_WAIT_V(n) asm volatile("s_waitcnt vmcnt(" #n ")" ::: "memory")
#define PG8_WAIT_L(n) asm volatile("s_waitcnt lgkmcnt(" #n ")" ::: "memory")
#define PG8_BAR __builtin_amdgcn_s_barrier()
#define PG8_SCHED __builtin_amdgcn_sched_barrier(0)
    const int njobs = J.count(); if (njobs == 0) return;
    int ui = 0; Unit cur = J.unit(0); Sub cs = J.sub(0);
    f32x4 acc[2][2][4][2];
#pragma unroll
    for (int a = 0; a < 2; ++a)
#pragma unroll
        for (int b = 0; b < 2; ++b)
#pragma unroll
            for (int m = 0; m < 4; ++m)
#pragma unroll
                for (int n = 0; n < 2; ++n) acc[a][b][m][n] = (f32x4){0.f, 0.f, 0.f, 0.f};
    h16x8 At[4][2], B0[2][2], B1[2][2];
    int ldA = cs.lda, ldB = cs.K;
    size_t hA = (size_t)HALF * ldA * 2, hB = (size_t)HALF * ldB * 2;
    const char* cA = (const char*)cs.A + (size_t)cur.pm * 2 * hA; const char* cB = (const char*)cs.Bt + (size_t)cur.pn * 2 * hB;
    PG8_STAGE2(PG8_SB(0, 0), cB, rB2, ldB); PG8_STAGE2(PG8_SB(0, 1), cB + hB, rB2, ldB); PG8_STAGE2(PG8_SA(0, 0), cA, rA2, ldA); PG8_STAGE2(PG8_SA(0, 1), cA + hA, rA2, ldA);
    if (wr == 1) PG8_BAR;
    PG8_WAIT_V(2); PG8_BAR;
    PG8_STAGE2(PG8_SB(1, 0), cB + kstep, rB2, ldB); PG8_STAGE2(PG8_SA(1, 0), cA + kstep, rA2, ldA); PG8_STAGE2(PG8_SB(1, 1), cB + hB + kstep, rB2, ldB);
    PG8_WAIT_V(6); PG8_BAR;
    for (;;) {
        const bool has_next = ui + 1 < njobs;
        const Unit nxt = J.unit(has_next ? ui + 1 : ui); const Sub ns = J.sub(has_next ? ui + 1 : ui);
        const int nldA = has_next ? ns.lda : ldA, nldB = has_next ? ns.K : ldB;
        const size_t nhA = (size_t)HALF * nldA * 2, nhB = (size_t)HALF * nldB * 2;
        const char* nA = has_next ? (const char*)ns.A + (size_t)nxt.pm * 2 * nhA : cA; const char* nB = has_next ? (const char*)ns.Bt + (size_t)nxt.pn * 2 * nhB : cB;
        const int nt = cs.K / BK;
        for (int t = 0; t < nt; t += 2) {
            const bool last = (t == nt - 2);
            const char* a1 = cA + (size_t)(t + 1) * kstep;
            const char* a2 = last ? nA : cA + (size_t)(t + 2) * kstep; const char* b2 = last ? nB : cB + (size_t)(t + 2) * kstep;
            const char* a3 = a2 + kstep; const char* b3 = b2 + kstep;
            const int l2A = last ? nldA : ldA, l2B = last ? nldB : ldB; const size_t h2A = last ? nhA : hA, h2B = last ? nhB : hB;
            PG8_LDB(B0, 0, 0); PG8_LDB(B1, 0, 1); PG8_SCHED; PG8_LDA(At, 0, 0); PG8_STAGE2(PG8_SA(1, 1), a1 + hA, rA2, ldA);
            PG8_WAIT_V(8); PG8_WAIT_L(0); PG8_BAR; PG8_MMA(0, 0, At, B0); PG8_MMA(0, 1, At, B1); PG8_BAR; PG8_SCHED;
            PG8_LDA(At, 0, 1); PG8_STAGE2(PG8_SB(0, 0), b2, rB2, l2B); PG8_STAGE2(PG8_SB(0, 1), b2 + h2B, rB2, l2B); PG8_STAGE2(PG8_SA(0, 0), a2, rA2, l2A);
            PG8_WAIT_V(8); PG8_WAIT_L(0); PG8_BAR; PG8_MMA(1, 0, At, B0); PG8_MMA(1, 1, At, B1); PG8_BAR; PG8_SCHED;
            PG8_LDB(B0, 1, 0); PG8_LDB(B1, 1, 1); PG8_SCHED; PG8_LDA(At, 1, 0); PG8_STAGE2(PG8_SA(0, 1), a2 + h2A, rA2, l2A);
            PG8_WAIT_V(8); PG8_WAIT_L(0); PG8_BAR; PG8_MMA(0, 0, At, B0); PG8_MMA(0, 1, At, B1); PG8_BAR; PG8_SCHED;
            PG8_LDA(At, 1, 1); PG8_STAGE2(PG8_SB(1, 0), b3, rB2, l2B); PG8_STAGE2(PG8_SB(1, 1), b3 + h2B, rB2, l2B); PG8_STAGE2(PG8_SA(1, 0), a3, rA2, l2A);
            PG8_WAIT_V(8); PG8_WAIT_L(0); PG8_BAR; PG8_MMA(1, 0, At, B0); PG8_MMA(1, 1, At, B1); PG8_BAR; PG8_SCHED;
        }
        if (wr == 0) PG8_BAR;
        E(acc, cur, cs.kind, wr, wc, fr, fq);
        if (!has_next) break;
#pragma unroll
        for (int a = 0; a < 2; ++a)
#pragma unroll
            for (int b = 0; b < 2; ++b)
#pragma unroll
                for (int m = 0; m < 4; ++m)
#pragma unroll
                    for (int n = 0; n < 2; ++n) acc[a][b][m][n] = (f32x4){0.f, 0.f, 0.f, 0.f};
        cur = nxt; cs = ns; cA = nA; cB = nB; ldA = nldA; ldB = nldB; hA = nhA; hB = nhB; ++ui;
        if (wr == 1) PG8_BAR;
    }
    PG8_WAIT_V(0);
    PG8_BAR;
#undef PG8_SA
#undef PG8_SB
#undef PG8_STAGE2
#undef PG8_LDA
#undef PG8_LDB
#undef PG8_MMA
#undef PG8_WAIT_V
#undef PG8_WAIT_L
#undef PG8_BAR
#undef PG8_SCHED
}
struct GateMergeJobs {
    StaticOrder S; const unsigned char* ws; size_t wbase;
    __device__ __forceinline__ int count() const { int n = 0; Unit u; while (S.next(n, u)) ++n; return 6 * n; }
    __device__ __forceinline__ Unit unit(int i) const { Unit u; u.pm = 0; u.pn = 0; (void)S.next(i / 6, u); return u; }
    __device__ __forceinline__ Sub sub(int i) const {
        const int k = i % 6, br = k >> 1; const bool gate = (k & 1) == 0; Sub sb;
        const size_t a_off = gate ? WS_H : WS_ZU + (br == 0 ? ZU_OA : (br == 1 ? ZU_OB : ZU_OC));
        const size_t b_off = wbase + (gate ? W_IN + ((size_t)NMAIN + (size_t)br * 1024) * DM * 2 : (br == 0 ? W_OA : (br == 1 ? W_OB : W_OC)));
        sb.A = (const h16*)(ws + a_off); sb.Bt = (const h16*)(ws + b_off);
        sb.K = (gate || br == 0) ? 1024 : 512; sb.lda = sb.K; sb.kind = gate ? (br << 4) : (br == 0 ? 1 : 2);
        return sb;
    }
};
}

constexpr int NWAVES = 8, NTHREADS = 512;

typedef GAS unsigned gu32;
#define RLX_AGENT __ATOMIC_RELAXED, __HIP_MEMORY_SCOPE_AGENT
#define LDS_WAIT() asm volatile("s_waitcnt lgkmcnt(0)" ::: "memory")
#define VM_WAIT() asm volatile("s_waitcnt vmcnt(0)" ::: "memory")

#define XB_TMO      128
#define XB_XCNT(j)  (256  + 64 * (j))
#define XB_XSUB(j)  (1280 + 64 * (j))
#define XB_XGEN(j)  (2304 + 64 * (j))
#define XB_TOP      3328
#define XB_TOPGEN   3392
#define XCD_BAR_WORDS 3456
#define XB_SPIN_CAP (1u << 18)
__device__ __forceinline__ unsigned xb_ld(unsigned* p)              { return __hip_atomic_load(p, __ATOMIC_RELAXED, __HIP_MEMORY_SCOPE_AGENT); }
__device__ __forceinline__ unsigned xb_add(unsigned* p, unsigned v) { return __hip_atomic_fetch_add(p, v, __ATOMIC_RELAXED, __HIP_MEMORY_SCOPE_AGENT); }
__device__ __forceinline__ unsigned xb_xcc_id() { return (unsigned)__builtin_amdgcn_s_getreg((3 << 11) | 20) & 0xFu; }
#define XB_SPIN(cond, bar) do { unsigned _sp = 0; while (cond) { __builtin_amdgcn_s_sleep(1); \
    if ((++_sp & 255u) == 0u) { if (xb_ld(&(bar)[XB_TMO])) break; if (_sp > XB_SPIN_CAP) { atomicAdd(&(bar)[XB_TMO], 1u); break; } } } } while (0)
struct XcdBarrier { unsigned* bar; unsigned x; volatile LAS unsigned* st; };
__device__ __forceinline__ XcdBarrier xcd_barrier_post(unsigned* bar, volatile LAS unsigned* st) {
    XcdBarrier b; b.bar = bar; b.x = xb_xcc_id(); b.st = st;
    if (threadIdx.x == 0) (void)xb_add(&bar[XB_XCNT(b.x)], 1u);
    return b;
}
__device__ __forceinline__ void xcd_barrier_complete(unsigned* bar, unsigned x, unsigned& nloc, unsigned& nx) {
    const unsigned G = gridDim.x * gridDim.y * gridDim.z;
    unsigned sum, cnt, mine, sp = 0u;
    for (;;) {
        sum = 0u; cnt = 0u; mine = 0u;
#pragma unroll
        for (unsigned j = 0; j < 16; ++j) { const unsigned c = xb_ld(&bar[XB_XCNT(j)]); sum += c; cnt += (c > 0u) ? 1u : 0u; mine = (j == x) ? c : mine; }
        if (sum == G) break;
        __builtin_amdgcn_s_sleep(1);
        if ((++sp & 255u) == 0u) { if (xb_ld(&bar[XB_TMO])) break; if (sp > XB_SPIN_CAP) { atomicAdd(&bar[XB_TMO], 1u); break; } }
    }
    nloc = mine > 0u ? mine : 1u; nx = cnt > 0u ? cnt : 1u;
}
__device__ __forceinline__ void xcd_barrier(const XcdBarrier& b) {
    asm volatile("s_waitcnt vmcnt(0)" ::: "memory");
    __syncthreads();
    if (threadIdx.x == 0) {
        unsigned* bar = b.bar;
        __builtin_amdgcn_s_waitcnt(0);
        unsigned nloc = b.st[0], nx = b.st[1];
        if (nloc == 0u) { xcd_barrier_complete(bar, b.x, nloc, nx); b.st[0] = nloc; b.st[1] = nx; }
        const unsigned old = xb_add(&bar[XB_XSUB(b.x)], 1u);
        const unsigned gen = old / nloc;
        if (old + 1u == (gen + 1u) * nloc) {
            __builtin_amdgcn_fence(__ATOMIC_RELEASE, "agent");
            asm volatile("s_waitcnt vmcnt(0)" ::: "memory");
            const unsigned og = xb_add(&bar[XB_TOP], 1u);
            const unsigned tg = og / nx;
            if (og + 1u == (tg + 1u) * nx) xb_add(&bar[XB_TOPGEN], 1u);
            else XB_SPIN(xb_ld(&bar[XB_TOPGEN]) == tg, bar);
            __builtin_amdgcn_fence(__ATOMIC_ACQUIRE, "agent");
            xb_add(&bar[XB_XGEN(b.x)], 1u);
            asm volatile("s_waitcnt vmcnt(0)" ::: "memory");
        } else {
            XB_SPIN(xb_ld(&bar[XB_XGEN(b.x)]) == gen, bar);
            __builtin_amdgcn_fence(__ATOMIC_ACQUIRE, "agent");
            asm volatile("s_waitcnt vmcnt(0)" ::: "memory");
        }
    }
    __syncthreads();
}
constexpr int CW_BAR = 4096;
static_assert((CW_BAR + XCD_BAR_WORDS) * 4 <= (int)CTL_ZERO_BYTES, "ctl");

struct Args {
    const float* in[33]; float* out; unsigned char* ws; int ph_lo, ph_hi;
};
typedef const GAS float* cfp_t;
struct Frame {
    LAS unsigned char* lds;
    int tid, lane, wave, vcu, G, bid, vcu0, G0;
    const __attribute__((address_space(4))) cfp_t* in; float* out; unsigned char* ws; float* out0; unsigned char* ws0;
    __device__ __forceinline__ const float* inp(int i) const { return (const float*)in[i]; }
    __device__ __forceinline__ void refresh() { int t = threadIdx.x; asm volatile("" : "+v"(t)); tid = t; lane = t & 63; wave = __builtin_amdgcn_readfirstlane(t >> 6);
        { int b_ = blockIdx.x, v_ = vcu0, g_ = G0; asm volatile("" : "+s"(b_), "+s"(v_), "+s"(g_)); bid = b_; vcu = v_; G = g_; }
        const __attribute__((address_space(4))) cfp_t* p = (const __attribute__((address_space(4))) cfp_t*)__builtin_amdgcn_kernarg_segment_ptr(); asm volatile("" : "+s"(p)); in = p;
        GAS float* o_ = (GAS float*)out0; GAS unsigned char* w_ = (GAS unsigned char*)ws0; asm volatile("" : "+s"(o_), "+s"(w_)); out = (float*)o_; ws = (unsigned char*)w_; }
};
enum { I_XP = 0, I_XS, I_C, I_CKB, I_CVB, I_CKC, I_CVC, I_STATE, I_CCTX, I_N1G, I_N2G, I_WMOD, I_BMOD, I_WIN, I_LCW, I_LCB, I_LWA, I_LBA, I_LWX, I_LBX, I_LAM,
       I_QNG, I_KNG, I_SINK, I_WOA, I_WOB, I_WOC, I_WOUT, I_WUP, I_FCW, I_FCB, I_WDOWN, I_FING };

__device__ __forceinline__ h16* XS16(const Frame& F) { return (h16*)(F.out + O_Y); }

__device__ __forceinline__ void transpose_item(const float* W, int K, int N, h16* WT, LAS float* scr, int item, int lane, bool upmap = false) {
    const int nblk = N / 32, kb = item / nblk, nb = item % nblk, k0 = 64 * kb, n0 = 32 * nb;
    const int d0 = !upmap ? n0 : (n0 < DFF ? (n0 / 128) * 256 + n0 % 128 : ((n0 - DFF) / 128) * 256 + 128 + (n0 - DFF) % 128);
    f32x4 v[8];
#pragma unroll
    for (int i = 0; i < 8; ++i) v[i] = *(const f32x4*)(W + (size_t)(k0 + 8 * i + (lane >> 3)) * N + n0 + 4 * (lane & 7));
#pragma unroll
    for (int i = 0; i < 8; ++i) { LAS float* d = scr + (8 * i + (lane >> 3)) * 33 + 4 * (lane & 7); d[0] = v[i].x; d[1] = v[i].y; d[2] = v[i].z; d[3] = v[i].w; }
    LDS_WAIT(); asm volatile("" ::: "memory");
    const int c = lane & 7;
#pragma unroll
    for (int j = 0; j < 4; ++j) { const int n = (lane >> 3) + 8 * j; const LAS float* sp = scr + (8 * c) * 33 + n;
        u32x4 o; o.x = pk_h2(sp[0 * 33], sp[1 * 33]); o.y = pk_h2(sp[2 * 33], sp[3 * 33]); o.z = pk_h2(sp[4 * 33], sp[5 * 33]); o.w = pk_h2(sp[6 * 33], sp[7 * 33]);
        *(u32x4*)(WT + (size_t)(d0 + n) * K + k0 + 8 * c) = o; }
    LDS_WAIT(); asm volatile("" ::: "memory");
}
__device__ __forceinline__ void phase_convert_weights(Frame& F, int l, int part = 0, int wg0 = 0) {
    LAS float* scr = (LAS float*)(F.lds + F.wave * 16384);
    const int gw = (part == 0 ? F.vcu : F.bid - wg0) * NWAVES + F.wave, NGW = (part == 0 ? F.G : F.G - wg0) * NWAVES;
    unsigned char* wb = F.ws + wsw(l);
    constexpr int IT_IN = (DM / 64) * (DIN / 32), IT_OA = (1024 / 64) * (DM / 32), IT_OB = (512 / 64) * (DM / 32), IT_OUT = (DM / 64) * (DM / 32),
                  IT_UP = (DM / 64) * (DUP / 32), IT_DOWN = (DFF / 64) * (DM / 32), IT_LRU1 = (128 / 64) * (128 / 32), IT_LRU = 32 * IT_LRU1;
    constexpr int NITEMS = IT_IN + IT_OA + 2 * IT_OB + IT_OUT + IT_UP + IT_DOWN + IT_LRU;
    const int it_lo = part == 2 ? NITEMS / 2 : 0, it_hi = part == 1 ? NITEMS / 2 : NITEMS;
    for (int it = it_lo + gw; it < it_hi; it += NGW) {
        int r = it;
        if (r < IT_IN) { transpose_item(F.inp(I_WIN) + (size_t)l * DM * DIN, DM, DIN, (h16*)(wb + W_IN), scr, r, F.lane); continue; } r -= IT_IN;
        if (r < IT_OA) { transpose_item(F.inp(I_WOA) + (size_t)l * 1024 * DM, 1024, DM, (h16*)(wb + W_OA), scr, r, F.lane); continue; } r -= IT_OA;
        if (r < IT_OB) { transpose_item(F.inp(I_WOB) + (size_t)l * 512 * DM, 512, DM, (h16*)(wb + W_OB), scr, r, F.lane); continue; } r -= IT_OB;
        if (r < IT_OB) { transpose_item(F.inp(I_WOC) + (size_t)l * 512 * DM, 512, DM, (h16*)(wb + W_OC), scr, r, F.lane); continue; } r -= IT_OB;
        if (r < IT_OUT) { transpose_item(F.inp(I_WOUT) + (size_t)l * DM * DM, DM, DM, (h16*)(wb + W_OUT), scr, r, F.lane); continue; } r -= IT_OUT;
        if (r < IT_UP) { transpose_item(F.inp(I_WUP) + (size_t)l * DM * DUP, DM, DUP, (h16*)(wb + W_UP), scr, r, F.lane, true); continue; } r -= IT_UP;
        if (r < IT_DOWN) { transpose_item(F.inp(I_WDOWN) + (size_t)l * DFF * DM, DFF, DM, (h16*)(wb + W_DOWN), scr, r, F.lane); continue; } r -= IT_DOWN;
        {
            const int mi = r / IT_LRU1, sub = r % IT_LRU1, dir = mi >> 4, gate = (mi >> 3) & 1, n = mi & 7;
            const float* src = (gate ? F.inp(I_LWX) : F.inp(I_LWA)) + ((size_t)((l * 2 + dir) * 8 + n)) * 128 * 128;
            transpose_item(src, 128, 128, (h16*)(wb + W_LRU) + (size_t)mi * 128 * 128, scr, sub, F.lane);
        }
    }
}
__device__ __forceinline__ void phase_prep_misc(Frame& F) {
    LAS float* sil = (LAS float*)F.lds;
    LAS float* part = (LAS float*)(F.lds + 16384);
    float* mod = (float*)(F.ws + WS_MOD);
    for (int item = F.vcu; item < 192; item += F.G) {
        const int l = item / 96, n0 = (item % 96) * 64;
        __syncthreads();
        for (int i = F.tid; i < 3 * 1024; i += NTHREADS) { const int j = i >> 10, k = i & 1023;
            const float v = j == 0 ? F.inp(I_CCTX)[k] : F.inp(I_C)[(j - 1) * 1024 + k]; sil[i] = v * sigmoidf_(v); }
        __syncthreads();
        const float* wp = F.inp(I_WMOD) + (size_t)l * DM * 6144 + n0 + F.lane;
        float a0 = 0.f, a1 = 0.f, a2 = 0.f;
        const int kb = F.wave * 128;
#pragma unroll 8
        for (int k = 0; k < 128; ++k) { const float w = wp[(size_t)(kb + k) * 6144]; a0 += w * sil[kb + k]; a1 += w * sil[1024 + kb + k]; a2 += w * sil[2048 + kb + k]; }
        part[(F.wave * 3 + 0) * 64 + F.lane] = a0; part[(F.wave * 3 + 1) * 64 + F.lane] = a1; part[(F.wave * 3 + 2) * 64 + F.lane] = a2;
        __syncthreads();
        if (F.tid < 192) { const int j = F.tid >> 6, c = F.tid & 63; float s = F.inp(I_BMOD)[l * 6144 + n0 + c];
#pragma unroll
            for (int w = 0; w < 8; ++w) s += part[(w * 3 + j) * 64 + c];
            mod[((size_t)l * 3 + j) * 6144 + n0 + c] = s; }
    }
    __syncthreads();
    const int gt = F.vcu * NTHREADS + F.tid, NGT = F.G * NTHREADS;
    float* rope = (float*)(F.ws + WS_ROPE);
    for (int i = gt; i < 64 * 16; i += NGT) { const int pos = i >> 4, fi = i & 15; const float inv = expf(-(float)fi * (1.0f / 16.0f) * 9.210340371976184f);
        const float ang = (float)pos * inv; rope[2 * i] = cosf(ang); rope[2 * i + 1] = sinf(ang); }
    h16* cache = (h16*)(F.ws + WS_CACHE);
    for (int i = gt; i < 4 * 131072 / 4; i += NGT) { const int kind = i / 32768, e = (i % 32768) * 4;
        const float* src = kind == 0 ? F.inp(I_CKB) : kind == 1 ? F.inp(I_CVB) : kind == 2 ? F.inp(I_CKC) : F.inp(I_CVC);
        const f32x4 v = *(const f32x4*)(src + e); u32x2 w; w.x = pk_h2(v[0], v[1]); w.y = pk_h2(v[2], v[3]); *(u32x2*)(cache + (size_t)kind * 131072 + e) = w; }
}

__device__ __forceinline__ const float* xrow_ptr(const Frame& F, int layer_src_is_input, int row) {
    if (layer_src_is_input) return row < NCTX ? F.inp(I_XP) + (size_t)row * DM : F.inp(I_XS) + (size_t)(row - NCTX) * DM;
    return F.out + O_Y + (size_t)row * DM;
}
__device__ __forceinline__ void phase_norm0(Frame& F, const float* g, const float* mod_l, float* ss) {
    const int gw = F.vcu * NWAVES + F.wave, NGW = F.G * NWAVES;
    h16* H = (h16*)(F.ws + WS_H);
    for (int grp = gw; grp < NTOK / 4; grp += NGW) {
        const int row0 = grp * 4;
        const int cond = row0 < NCTX ? 0 : (row0 < NCTX + LSEQ ? 1 : 2);
        const float* mp = mod_l + (size_t)cond * 6144;
        f32x4 v[4][4];
#pragma unroll
        for (int i = 0; i < 4; ++i) { const f32x4* xr = (const f32x4*)xrow_ptr(F, 1, row0 + i) + F.lane;
#pragma unroll
            for (int j = 0; j < 4; ++j) v[i][j] = xr[64 * j]; }
        f32x4 gs[4];
#pragma unroll
        for (int j = 0; j < 4; ++j) { const int c = F.lane * 4 + 256 * j; gs[j] = *(const f32x4*)(g + c) * (*(const f32x4*)(mp + 1024 + c) + 1.0f); }
#pragma unroll
        for (int i = 0; i < 4; ++i) {
            float sq = 0.f;
#pragma unroll
            for (int j = 0; j < 4; ++j) sq += (v[i][j].x * v[i][j].x + v[i][j].y * v[i][j].y) + (v[i][j].z * v[i][j].z + v[i][j].w * v[i][j].w);
            sq = wave_sum(sq);
            if (F.lane == 0) ss[row0 + i] = sq;
            u32x2* o8 = (u32x2*)(H + (size_t)(row0 + i) * DM) + F.lane;
#pragma unroll
            for (int j = 0; j < 4; ++j) { const f32x4 y = v[i][j] * gs[j]; u32x2 w; w.x = pk_h2(y.x, y.y); w.y = pk_h2(y.z, y.w); o8[64 * j] = w; }
        }
    }
}
__device__ __forceinline__ void phase_cvec(Frame& F, int l) {
    const int gw = F.vcu * NWAVES + F.wave, NGW = F.G * NWAVES, lane = F.lane;
    const float* mod_l = (const float*)(F.ws + WS_MOD) + (size_t)l * 3 * 6144;
    float* cv = (float*)(F.ws + WS_CV) + (size_t)l * 3 * (DIN + DUP);
    for (int kind = 0; kind < 2; ++kind) {
        const int N = kind == 0 ? DIN : DUP, sc = kind == 0 ? 0 : 3;
        const h16* Wt = (const h16*)(F.ws + wsw(l) + (kind == 0 ? W_IN : W_UP));
        float sh[3][16];
#pragma unroll
        for (int c = 0; c < 3; ++c)
#pragma unroll
            for (int j = 0; j < 2; ++j)
#pragma unroll
                for (int e = 0; e < 8; ++e) sh[c][8 * j + e] = mod_l[(size_t)c * 6144 + sc * 1024 + 8 * lane + 512 * j + e];
        for (int n0 = gw * 4; n0 < N; n0 += NGW * 4) {
            u32x4 raw[4][2];
#pragma unroll
            for (int i = 0; i < 4; ++i) { raw[i][0] = *(const u32x4*)(Wt + (size_t)(n0 + i) * DM + 8 * lane); raw[i][1] = *(const u32x4*)(Wt + (size_t)(n0 + i) * DM + 512 + 8 * lane); }
#pragma unroll
            for (int i = 0; i < 4; ++i) {
                float w[16]; unpack8(raw[i][0], w); unpack8(raw[i][1], w + 8);
                float a0 = 0.f, a1 = 0.f, a2 = 0.f;
#pragma unroll
                for (int e = 0; e < 16; ++e) { a0 += w[e] * sh[0][e]; a1 += w[e] * sh[1][e]; a2 += w[e] * sh[2][e]; }
                a0 = wave_sum(a0); a1 = wave_sum(a1); a2 = wave_sum(a2);
                if (lane == 0) { float* o = cv + (kind == 0 ? 0 : DIN) + n0 + i; o[0] = a0; o[DIN + DUP] = a1; o[2 * (DIN + DUP)] = a2; }
            }
        }
    }
}
__device__ __forceinline__ void phase_final_norm(Frame& F) {
    const int gw = F.vcu * NWAVES + F.wave, NGW = F.G * NWAVES;
    const h16* X = (const h16*)(F.ws + WS_H);
    f32x4 gg[2][2];
#pragma unroll
    for (int j = 0; j < 2; ++j) { gg[j][0] = *(const f32x4*)(F.inp(I_FING) + F.lane * 8 + 512 * j); gg[j][1] = *(const f32x4*)(F.inp(I_FING) + F.lane * 8 + 512 * j + 4); }
    for (int grp = gw; grp < NTOK / 4; grp += NGW) {
        const int row0 = grp * 4;
        u32x4 raw[4][2];
#pragma unroll
        for (int i = 0; i < 4; ++i)
#pragma unroll
            for (int j = 0; j < 2; ++j) raw[i][j] = *(const u32x4*)(X + (size_t)(row0 + i) * DM + F.lane * 8 + 512 * j);
#pragma unroll
        for (int i = 0; i < 4; ++i) {
            float v[16]; unpack8(raw[i][0], v); unpack8(raw[i][1], v + 8);
            float s = 0.f;
#pragma unroll
            for (int e = 0; e < 16; e += 4) s += (v[e] * v[e] + v[e + 1] * v[e + 1]) + (v[e + 2] * v[e + 2] + v[e + 3] * v[e + 3]);
            const float rstd = 1.0f / sqrtf(wave_sum(s) * (1.0f / DM) + NORM_EPS);
            float* yo = F.out + O_Y + (size_t)(row0 + i) * DM + F.lane * 8;
#pragma unroll
            for (int j = 0; j < 2; ++j) {
                *(f32x4*)(yo + 512 * j) = (f32x4){v[8 * j], v[8 * j + 1], v[8 * j + 2], v[8 * j + 3]} * rstd * gg[j][0];
                *(f32x4*)(yo + 512 * j + 4) = (f32x4){v[8 * j + 4], v[8 * j + 5], v[8 * j + 6], v[8 * j + 7]} * rstd * gg[j][1]; }
        }
    }
}

__device__ __forceinline__ void phase_qk(Frame& F, int l, bool write_out = true) {
    const int gw = F.vcu * NWAVES + F.wave, NGW = F.G * NWAVES, lane = F.lane;
    h16* Z = (h16*)(F.ws + WS_ZU);
    const float* rope = (const float*)(F.ws + WS_ROPE);
    const float* qg = F.inp(I_QNG) + l * 64; const float* kg = F.inp(I_KNG) + l * 64;
    const int hl = lane & 7, hc0 = hl * 8;
    float qgv[8], kgv[8];
#pragma unroll
    for (int j = 0; j < 8; ++j) { qgv[j] = qg[hc0 + j]; kgv[j] = kg[hc0 + j]; }
    for (int row = gw; row < NTOK; row += NGW) {
        const bool is_ctx = row < NCTX;
        int rpos = 0, cpos = 0, b = 0, t = 0;
        if (is_ctx) { b = row >> 8; t = row & 255; } else { const int tt = (row - NCTX) & (LSEQ - 1); rpos = tt >> 6; cpos = tt & 63; }
        h16* zr = Z + (size_t)row * NMAIN;
#pragma unroll
        for (int pass = 0; pass < 3; ++pass) {
            const int col = C_QB + pass * 512 + lane * 8;
            int kind;
            if (pass == 0) kind = 0; else if (pass == 1) kind = lane < 8 * 2 ? 1 : (lane < 8 * 4 ? 2 : 3); else kind = lane < 32 ? 3 : (lane < 48 ? 4 : 5);
            const u32x4 w = *(const u32x4*)(zr + col);
            float x[8]; unpack8(w, x);
            if (kind <= 1) {
                float s = 0.f;
#pragma unroll
                for (int j = 0; j < 8; ++j) s += x[j] * x[j];
                s = sum8(s);
                const float rstd = 1.0f / sqrtf(s * (1.0f / 64.0f) + NORM_EPS);
#pragma unroll
                for (int j = 0; j < 8; ++j) x[j] = x[j] * rstd * (kind == 0 ? qgv[j] : kgv[j]);
            }
            if (!is_ctx) {
                float p[8];
#pragma unroll
                for (int j = 0; j < 8; ++j) p[j] = __shfl_xor(x[j], 2);
                if (kind == 0 || kind == 1 || kind == 3 || kind == 4) {
                    const int half = hl >> 2, second = (hl >> 1) & 1, f0 = (hl & 1) * 8, pos = half ? cpos : rpos;
                    const float* tp = rope + ((size_t)pos * 16 + f0) * 2;
#pragma unroll
                    for (int j = 0; j < 8; ++j) { const float cs = tp[2 * j], sn = tp[2 * j + 1]; x[j] = second ? (p[j] * sn + x[j] * cs) : (x[j] * cs - p[j] * sn); }
                }
            }
            if (kind == 0 || kind == 3) {
#pragma unroll
                for (int j = 0; j < 8; ++j) x[j] *= QSCALE;
            }
            if (kind != 2 && kind != 5) *(u32x4*)(zr + col) = pack8(x);
            if (write_out && is_ctx && (kind == 1 || kind == 2 || kind == 4 || kind == 5)) {
                const size_t ob = kind == 1 ? O_KB : kind == 2 ? O_VB : kind == 4 ? O_KC : O_VC;
                const int c128 = (kind == 1 || kind == 2) ? (col - (kind == 1 ? C_KB : C_VB)) : (col - (kind == 4 ? C_KC : C_VC));
                float* op = F.out + ob + ((size_t)((b * 2 + l) * 256 + t)) * 128 + c128;
                *(f32x4*)op = (f32x4){x[0], x[1], x[2], x[3]}; *(f32x4*)(op + 4) = (f32x4){x[4], x[5], x[6], x[7]};
            }
        }
    }
}

__device__ __forceinline__ int img_off(int row, int ch) { return row * 256 + ((((ch >> 3) ^ (row & 15)) << 4) | ((ch & 7) << 1)); }
template <int MODE, int DIR>
__device__ __forceinline__ void lru_scan(Frame& F, int l, int row0, int n, int lat_b, int lat_chunk, int ctx_b, bool write_out, int cb) {
    LAS unsigned char* img = F.lds; LAS unsigned char* hx = F.lds + 65536;
    const int lane = F.lane, r32 = lane & 31, hi = lane >> 5, hm = hi ^ DIR;
    const int C = n * 128 + cb * 32 + r32;
    h16x8 Br[8], Bi[8];
    if (MODE != 3) {
        const h16* wr_ = (const h16*)(F.ws + wsw(l) + W_LRU) + ((size_t)((DIR * 2 + 0) * 8 + n) * 128 + cb * 32 + r32) * 128 + 8 * hi;
        const h16* wi_ = (const h16*)(F.ws + wsw(l) + W_LRU) + ((size_t)((DIR * 2 + 1) * 8 + n) * 128 + cb * 32 + r32) * 128 + 8 * hi;
#pragma unroll
        for (int ks = 0; ks < 8; ++ks) { Br[ks] = *(const h16x8*)(wr_ + 16 * ks); Bi[ks] = *(const h16x8*)(wi_ + 16 * ks); }
    }
    float k8 = 0.f, nba = 0.f, nbx = 0.f;
    if (MODE != 3) {
        const float ba = F.inp(I_LBA)[(size_t)(l * 2 + DIR) * DLRU + C], bx = F.inp(I_LBX)[(size_t)(l * 2 + DIR) * DLRU + C];
        const float lam = F.inp(I_LAM)[(size_t)(l * 2 + DIR) * DLRU + C];
        const float sp = (-lam > 20.f) ? -lam : log1pf(expf(-lam));
        k8 = -8.0f * sp * LOG2E;
        nba = -LOG2E * ba; nbx = -LOG2E * bx;
    }
    u32x4* stash_u = (u32x4*)(F.ws + WS_STASH) + (size_t)(((lat_b * 2 + DIR) * 16 + lat_chunk) * 8) * (DLRU * 2 * 4);
    const unsigned sl = (unsigned)((C * 2 + hi) * 4);
    unsigned nxt[16];
    if (MODE == 3) { const int rb0 = DIR == 0 ? 0 : 7;
#pragma unroll
        for (int q = 0; q < 4; ++q) { const u32x4 t = stash_u[(size_t)rb0 * (DLRU * 2 * 4) + sl + q]; nxt[4 * q] = t.x; nxt[4 * q + 1] = t.y; nxt[4 * q + 2] = t.z; nxt[4 * q + 3] = t.w; } }
    float H = 0.f, aggP = 1.f;
    if (MODE == 2 || MODE == 3) {
        const float* agg = (const float*)(F.ws + WS_AGG);
        H = F.inp(I_STATE)[(size_t)((lat_b * 2 + l) * 2 + DIR) * DLRU + C];
        float ap[15], au[15];
#pragma unroll
        for (int k = 0; k < 15; ++k) { const int ch = DIR == 0 ? k : 15 - k; const bool use = DIR == 0 ? (ch < lat_chunk) : (ch > lat_chunk);
            const float* p = agg + ((size_t)((lat_b * 16 + (use ? ch : 0)) * 2 + DIR) * DLRU + C) * 2; ap[k] = use ? p[0] : 1.f; au[k] = use ? p[1] : 0.f; }
#pragma unroll
        for (int k = 0; k < 15; ++k) H = ap[k] * H + au[k];
    }
    const int xch = cb * 4 + (r32 >> 3), xel = (r32 & 7) * 2;
    int lo8[8];
#pragma unroll
    for (int ci = 0; ci < 8; ++ci) { const int c = (ci & 3) + 8 * (ci >> 2); lo8[ci] = (((xch ^ (4 * hi)) ^ c) << 4) + xel + (4 * hi) * 256; }
#define LOFF(rn) (lo8s[((rn) & 3) + 4 * (((rn) >> 2) & 1)] + (8 * ((rn) >> 2) + ((rn) & 3)) * 256)
#pragma unroll 1
    for (int step = 0; step < 8; ++step) {
        if (step == 4) __syncthreads();
        const int rb = DIR == 0 ? step : 7 - step;
        int lo8s[8];
#pragma unroll
        for (int ci = 0; ci < 8; ++ci) lo8s[ci] = lo8[ci] + rb * 8192;
        float an[16], un[16];
        if (MODE == 3) {
#pragma unroll
            for (int r = 0; r < 16; ++r) { const h16x2 w = __builtin_bit_cast(h16x2, nxt[r]); an[r] = fast_exp2((float)w[0]); un[r] = (float)w[1]; }
            if (step < 7) { const int rbn = DIR == 0 ? step + 1 : 6 - step;
#pragma unroll
                for (int q = 0; q < 4; ++q) { const u32x4 t = stash_u[(size_t)rbn * (DLRU * 2 * 4) + sl + q]; nxt[4 * q] = t.x; nxt[4 * q + 1] = t.y; nxt[4 * q + 2] = t.z; nxt[4 * q + 3] = t.w; } }
        } else {
        unsigned sw[16];
        f32x16 ar = {}, ai = {};
#pragma unroll
        for (int ks = 0; ks < 8; ++ks) {
            const h16x8 af = *(const LAS h16x8*)(img + (rb * 32 + r32) * 256 + (((2 * ks + hi) ^ (r32 & 15)) << 4));
            ar = __builtin_amdgcn_mfma_f32_32x32x16_f16(af, Br[ks], ar, 0, 0, 0);
            ai = __builtin_amdgcn_mfma_f32_32x32x16_f16(af, Bi[ks], ai, 0, 0, 0);
        }
#pragma unroll
        for (int r = 0; r < 16; ++r) {
            const float xv = (float)*(const LAS h16*)(img + LOFF(r));
            const float d1 = 1.0f + fast_exp2(__builtin_fmaf(ar[r], -LOG2E, nba)), d2 = 1.0f + fast_exp2(__builtin_fmaf(ai[r], -LOG2E, nbx));
            const float R = fast_rcp(d1 * d2);
            const float rr = R * d2, ii = R * d1;
            const float e2 = k8 * rr;
            const float av = fast_exp2(e2);
            an[r] = av;
            un[r] = __builtin_amdgcn_sqrtf(__builtin_fmaf(-av, av, 1.0f)) * (ii * xv);
            if (MODE == 1) sw[r] = pk_h2(e2, un[r]);
        }
        if (MODE == 1) {
#pragma unroll
            for (int q = 0; q < 4; ++q) stash_u[(size_t)rb * (DLRU * 2 * 4) + sl + q] = (u32x4){sw[4 * q], sw[4 * q + 1], sw[4 * q + 2], sw[4 * q + 3]}; }
        }
#define SA(r) (DIR ? an[15 - (r)] : an[(r)])
#define SU(r) (DIR ? un[15 - (r)] : un[(r)])
        float Pe[4], Ue[4], Po[4], Uo[4];
#pragma unroll
        for (int g = 0; g < 4; ++g) {
            float p = 1.f, uu = 0.f;
#pragma unroll
            for (int i = 0; i < 4; ++i) { uu = SA(4 * g + i) * uu + SU(4 * g + i); p *= SA(4 * g + i); }
            const auto sp_ = __builtin_amdgcn_permlane32_swap(__float_as_uint(p), __float_as_uint(p), false, false);
            const auto su_ = __builtin_amdgcn_permlane32_swap(__float_as_uint(uu), __float_as_uint(uu), false, false);
            Pe[g] = __uint_as_float(sp_[DIR]); Po[g] = __uint_as_float(sp_[1 - DIR]); Ue[g] = __uint_as_float(su_[DIR]); Uo[g] = __uint_as_float(su_[1 - DIR]);
        }
        float Hs[4];
        {
            float h = H;
#pragma unroll
            for (int g = 0; g < 4; ++g) { const float he = h; h = Pe[g] * h + Ue[g]; const float ho = h; h = Po[g] * h + Uo[g]; Hs[g] = hm ? ho : he; }
            H = h;
        }
        if (MODE == 1) { float p = 1.f;
#pragma unroll
            for (int g = 0; g < 4; ++g) p *= Pe[g] * Po[g];
            aggP *= p; }
        if (MODE != 1) {
#pragma unroll
            for (int g = 0; g < 4; ++g) { float h = Hs[g];
                float old[4];
#pragma unroll
                for (int i = 0; i < 4; ++i) old[i] = (float)*(const LAS h16*)(hx + LOFF(DIR ? 15 - (4 * g + i) : (4 * g + i)));
#pragma unroll
                for (int i = 0; i < 4; ++i) { const int r = 4 * g + i; h = SA(r) * h + SU(r);
                    const float o = step < 4 ? 0.f : old[i];
                    *(LAS h16*)(hx + LOFF(DIR ? 15 - r : r)) = (h16)(h + o); } }
        }
#undef SA
#undef SU
    }
#undef LOFF
    if (MODE == 0 && hi == 0 && write_out) F.out[O_LRU + (size_t)((ctx_b * 2 + l) * 2 + DIR) * DLRU + C] = H;
    if (MODE == 1 && hi == 0) { float* agg = (float*)(F.ws + WS_AGG) + ((size_t)((lat_b * 16 + lat_chunk) * 2 + DIR) * DLRU + C) * 2; agg[0] = aggP; agg[1] = H; }
}
template <int MODE>
__device__ __forceinline__ void lru_unit(Frame& F, int l, int row0, int n, int seq_first, int seq_last, int lat_b, int lat_chunk, int ctx_b, bool write_out = true, int pv = 0) {
    LAS unsigned char* img = F.lds; LAS unsigned char* hx = F.lds + 65536;
    const h16* Z = (const h16*)(F.ws + WS_ZU);
    const int tid = F.tid;
    __syncthreads();
    if (MODE != 3 && !(pv & 1)) {
        const int cc = tid & 15, tg = tid >> 4; const int ch0 = n * 128 + cc * 8;
        float w0[8], w1[8], w2[8], w3[8], bb[8];
        const float* cw = F.inp(I_LCW) + (size_t)l * 4 * DLRU + ch0; const float* cb = F.inp(I_LCB) + (size_t)l * DLRU + ch0;
#pragma unroll
        for (int j = 0; j < 8; ++j) { w0[j] = cw[j]; w1[j] = cw[DLRU + j]; w2[j] = cw[2 * DLRU + j]; w3[j] = cw[3 * DLRU + j]; bb[j] = cb[j]; }
        const int t0 = tg * 8;
        u32x4 raw[11];
#pragma unroll
        for (int i = 0; i < 11; ++i) { const int t = t0 - 2 + i; const bool ok = (t >= 0 || !seq_first) && (t < 256 || !seq_last);
            const int tc = ok ? t : (t < 0 ? 0 : 255);
            const u32x4 v = *(const u32x4*)(Z + (size_t)(row0 + tc) * NMAIN + C_XA + ch0);
            raw[i].x = ok ? v.x : 0u; raw[i].y = ok ? v.y : 0u; raw[i].z = ok ? v.z : 0u; raw[i].w = ok ? v.w : 0u; }
        float xm2[8], xm1[8], x0[8], xp1[8];
        unpack8(raw[0], xm2); unpack8(raw[1], xm1); unpack8(raw[2], x0);
#pragma unroll
        for (int i = 0; i < 8; ++i) {
            unpack8(raw[3 + i], xp1);
            float y[8];
#pragma unroll
            for (int j = 0; j < 8; ++j) y[j] = bb[j] + w0[j] * xm2[j] + w1[j] * xm1[j] + w2[j] * x0[j] + w3[j] * xp1[j];
            *(LAS u32x4*)(img + img_off(t0 + i, cc * 8)) = pack8(y);
#pragma unroll
            for (int j = 0; j < 8; ++j) { xm2[j] = xm1[j]; xm1[j] = x0[j]; x0[j] = xp1[j]; }
        }
    }
    __syncthreads();
    const int dir = F.wave >> 2, cb = F.wave & 3;
    if (!(pv & 2)) {
    if (dir == 0) lru_scan<MODE, 0>(F, l, row0, n, lat_b, lat_chunk, ctx_b, write_out, cb);
    else          lru_scan<MODE, 1>(F, l, row0, n, lat_b, lat_chunk, ctx_b, write_out, cb);
    }
    if (MODE != 1 && !(pv & 4)) {
        __syncthreads();
        h16* OA = (h16*)(F.ws + WS_ZU + ZU_OA);
#pragma unroll
        for (int k = 0; k < 8; ++k) { const int i = tid + NTHREADS * k, tk = i >> 4, cc = i & 15;
            float hs[8], ya[8], o[8];
            unpack8(*(const LAS u32x4*)(hx + img_off(tk, cc * 8)), hs);
            unpack8(*(const u32x4*)(Z + (size_t)(row0 + tk) * NMAIN + C_YA + n * 128 + cc * 8), ya);
#pragma unroll
            for (int j = 0; j < 8; ++j) o[j] = hs[j] * gelu_tanh(ya[j]);
            *(u32x4*)(OA + (size_t)(row0 + tk) * 1024 + n * 128 + cc * 8) = pack8(o); }
    }
}

struct AttnDesc {
    const h16* Qz; h16* O;
    const h16* Kc; const h16* Vc;
    const h16* Kz; const h16* Vz;
    int nc, zt0, nz;
    int windowed;
    const float* sink;
    int kvh, q0;
};
__device__ __forceinline__ void attn_unit(Frame& F, const AttnDesc& D, const h16* Qrow0  , h16* Orow0  ) {
    LAS unsigned char* lds = F.lds;
    const int tid = F.tid, lane = F.lane, wave = F.wave, r32 = lane & 31, hi = lane >> 5;
    const int head = D.kvh * 4 + (wave >> 1);
    const int qpos = D.q0 + (wave & 1) * 32 + r32;
    const int NT = D.nc + D.nz;
    h16x8 qr[4];
    { const h16* qp = Qrow0 + (size_t)qpos * NMAIN + head * 64 + 8 * hi;
#pragma unroll
      for (int d0 = 0; d0 < 4; ++d0) qr[d0] = *(const h16x8*)(qp + 16 * d0); }
    const int krow = tid >> 3, kch = tid & 7; const int kdst = krow * 128 + ((kch ^ ((krow >> 1) & 7)) << 4);
    const int vrow = 16 * (wave & 3) + (lane >> 2), vcol = (wave >> 2) * 32 + (lane & 3) * 8; const int vdst = wave * 1024 + lane * 16;
    auto ktile_ptr = [&](int j, int row, int col, bool isV) -> const h16* {
        if (j < D.nc) return (isV ? D.Vc : D.Kc) + (size_t)(64 * j + row) * 128 + col;
        return (isV ? D.Vz : D.Kz) + (size_t)((D.zt0 + (j - D.nc)) * 64 + row) * NMAIN + col;
    };
    u32x4 kreg, vreg;
    kreg = *(const u32x4*)ktile_ptr(0, krow, kch * 8, false); vreg = *(const u32x4*)ktile_ptr(0, vrow, vcol, true);
    __syncthreads();
    *(LAS u32x4*)(lds + kdst) = kreg; *(LAS u32x4*)(lds + 16384 + vdst) = vreg;
    __syncthreads();
    float mhat, l_run;
    const bool has_sink = D.sink != nullptr;
    if (has_sink) { mhat = D.sink[head] * LOG2E; l_run = hi == 0 ? 1.f : 0.f; } else { mhat = 0.f; l_run = 0.f; }
    f32x16 negm;
#pragma unroll
    for (int r = 0; r < 16; ++r) negm[r] = -mhat;
    f32x16 o0 = {}, o1 = {};
    LAS float* wsf = (LAS float*)(lds + 32768) + wave * 64;
    const int kfoff = r32 * 128;
    const int ksw = (r32 >> 1) & 7;
    const int vp0 = ((lane >> 4) & 1) * 32 + (lane & 3) * 8 + (4 * hi + ((lane & 15) >> 2)) * 64;
#pragma unroll 1
    for (int j = 0; j < NT; ++j) {
        const int buf = j & 1;
        if (j + 1 < NT) { kreg = *(const u32x4*)ktile_ptr(j + 1, krow, kch * 8, false); vreg = *(const u32x4*)ktile_ptr(j + 1, vrow, vcol, true); }
        LAS unsigned char* Kb = lds + buf * 8192; LAS unsigned char* Vb = lds + 16384 + buf * 8192;
        f32x16 p0, p1;
#pragma unroll
        for (int d0 = 0; d0 < 4; ++d0) {
            const int co = ((2 * d0 + hi) ^ ksw) << 4;
            const h16x8 k0 = *(const LAS h16x8*)(Kb + kfoff + co);
            const h16x8 k1 = *(const LAS h16x8*)(Kb + 4096 + kfoff + co);
            p0 = __builtin_amdgcn_mfma_f32_32x32x16_f16(k0, qr[d0], d0 == 0 ? negm : p0, 0, 0, 0);
            p1 = __builtin_amdgcn_mfma_f32_32x32x16_f16(k1, qr[d0], d0 == 0 ? negm : p1, 0, 0, 0);
        }
        if (D.windowed && j >= D.nc) {
            const int kb0 = (D.zt0 + (j - D.nc)) * 64 + 4 * hi;
#pragma unroll
            for (int r = 0; r < 16; ++r) { const int kp = kb0 + (r & 3) + 8 * (r >> 2);
                const int d0_ = qpos - kp, d1_ = qpos - (kp + 32);
                if (d0_ > 128 || d0_ < -128) p0[r] = -1e30f;
                if (d1_ > 128 || d1_ < -128) p1[r] = -1e30f; }
        }
        if (j == 0) {
            float mx = fmaxf(p0[0], p1[0]);
#pragma unroll
            for (int r = 1; r < 16; ++r) mx = fmaxf(mx, fmaxf(p0[r], p1[r]));
            mx = fmaxf(mx, __shfl_xor(mx, 32));
            const float dl = has_sink ? fmaxf(mx, 0.f) : mx;
#pragma unroll
            for (int r = 0; r < 16; ++r) { p0[r] -= dl; p1[r] -= dl; }
            mhat += dl; if (has_sink) l_run *= fast_exp2(-dl);
#pragma unroll
            for (int r = 0; r < 16; ++r) negm[r] = -mhat;
        }
        float rs = 0.f;
#pragma unroll
        for (int r = 0; r < 16; ++r) { p0[r] = fast_exp2(p0[r]); p1[r] = fast_exp2(p1[r]); rs += p0[r] + p1[r]; }
        if (__builtin_expect(__any(rs > 256.f), 0)) {
            const float rsm = fmaxf(rs, __shfl_xor(rs, 32));
            const float dl = rsm > 256.f ? ceilf(__builtin_log2f(rsm)) : 0.f;
            const float f = fast_exp2(-dl);
#pragma unroll
            for (int r = 0; r < 16; ++r) { p0[r] *= f; p1[r] *= f; }
            rs *= f; l_run *= f; mhat += dl;
#pragma unroll
            for (int r = 0; r < 16; ++r) negm[r] = -mhat;
            if (hi == 0) wsf[r32] = f;
            LDS_WAIT();
#pragma unroll
            for (int r = 0; r < 16; ++r) { const float g = wsf[(r & 3) + 8 * (r >> 2) + 4 * hi]; o0[r] *= g; o1[r] *= g; }
        }
        l_run += rs;
        u32x4 pw[4];
        pw[0] = (u32x4){pk_h2(p0[0], p0[1]), pk_h2(p0[2], p0[3]), pk_h2(p0[4], p0[5]), pk_h2(p0[6], p0[7])};
        pw[1] = (u32x4){pk_h2(p0[8], p0[9]), pk_h2(p0[10], p0[11]), pk_h2(p0[12], p0[13]), pk_h2(p0[14], p0[15])};
        pw[2] = (u32x4){pk_h2(p1[0], p1[1]), pk_h2(p1[2], p1[3]), pk_h2(p1[4], p1[5]), pk_h2(p1[6], p1[7])};
        pw[3] = (u32x4){pk_h2(p1[8], p1[9]), pk_h2(p1[10], p1[11]), pk_h2(p1[12], p1[13]), pk_h2(p1[14], p1[15])};
#pragma unroll
        for (int ks = 0; ks < 4; ++ks) {
            const h16x8 pa = __builtin_bit_cast(h16x8, pw[ks]);
#pragma unroll
            for (int d0 = 0; d0 < 2; ++d0) {
                const s16x4 lo = __builtin_amdgcn_ds_read_tr16_b64_v4i16((LAS s16x4*)(Vb + vp0 + d0 * 4096 + ks * 1024));
                const s16x4 hh = __builtin_amdgcn_ds_read_tr16_b64_v4i16((LAS s16x4*)(Vb + vp0 + d0 * 4096 + ks * 1024 + 512));
                typedef short s16x8 __attribute__((ext_vector_type(8)));
                const s16x8 vv = {lo[0], lo[1], lo[2], lo[3], hh[0], hh[1], hh[2], hh[3]};
                const h16x8 vf = __builtin_bit_cast(h16x8, vv);
                if (d0 == 0) o0 = __builtin_amdgcn_mfma_f32_32x32x16_f16(pa, vf, o0, 0, 0, 0);
                else         o1 = __builtin_amdgcn_mfma_f32_32x32x16_f16(pa, vf, o1, 0, 0, 0);
            }
        }
        if (j + 1 < NT) { *(LAS u32x4*)(lds + (buf ^ 1) * 8192 + kdst) = kreg; *(LAS u32x4*)(lds + 16384 + (buf ^ 1) * 8192 + vdst) = vreg; }
        __syncthreads();
    }
    l_run += __shfl_xor(l_run, 32);
    if (hi == 0) wsf[32 + r32] = l_run;
    LDS_WAIT();
    h16* op = Orow0 + (size_t)(D.q0 + (wave & 1) * 32) * 512 + head * 64 + r32;
#pragma unroll
    for (int r = 0; r < 16; ++r) { const int q = (r & 3) + 8 * (r >> 2) + 4 * hi; const float rl = fast_rcp(wsf[32 + q]);
        op[(size_t)q * 512] = (h16)(o0[r] * rl); op[(size_t)q * 512 + 32] = (h16)(o1[r] * rl); }
}
__device__ __forceinline__ void attn_dispatch(Frame& F, int l, int type, int u) {
    const h16* Z = (const h16*)(F.ws + WS_ZU);
    const h16* cache = (const h16*)(F.ws + WS_CACHE);
    AttnDesc D; D.sink = nullptr; D.windowed = 0; D.Kc = nullptr; D.Vc = nullptr; D.nc = 0;
    const bool isC = type & 1;
    const int qcol = isC ? C_QC : C_QB, kcol = isC ? C_KC : C_KB, vcol = isC ? C_VC : C_VB;
    h16* Obase = (h16*)(F.ws + WS_ZU + (isC ? ZU_OC : ZU_OB));
    size_t row_seq0;
    if (type < 2) {
        const int b = u >> 7, kvh = (u >> 6) & 1, qb = u & 63;
        row_seq0 = (size_t)NCTX + (size_t)b * LSEQ; D.kvh = kvh; D.q0 = qb * 64;
        D.Kc = cache + ((size_t)(isC ? 2 : 0) * 131072) + (size_t)((b * 2 + l) * 256) * 128 + kvh * 64;
        D.Vc = cache + ((size_t)(isC ? 3 : 1) * 131072) + (size_t)((b * 2 + l) * 256) * 128 + kvh * 64;
        D.nc = 4;
        if (!isC) { D.zt0 = 0; D.nz = 64; }
        else { int lo = qb - 2; if (lo < 0) lo = 0; int hi_ = qb + 2; if (hi_ > 63) hi_ = 63; D.zt0 = lo; D.nz = hi_ - lo + 1; D.windowed = 1; }
    } else {
        const int b = u >> 3, kvh = (u >> 2) & 1, qb = u & 3;
        row_seq0 = (size_t)b * SEQ; D.kvh = kvh; D.q0 = qb * 64; D.zt0 = 0; D.nz = 4;
    }
    if (isC) D.sink = F.inp(I_SINK) + l * 8;
    D.Kz = Z + row_seq0 * NMAIN + kcol + D.kvh * 64; D.Vz = Z + row_seq0 * NMAIN + vcol + D.kvh * 64;
    attn_unit(F, D, Z + row_seq0 * NMAIN + qcol, Obase + row_seq0 * 512);
}

__device__ __forceinline__ void phase_ffn_act(Frame& F, int l) {
    h16* U = (h16*)(F.ws + WS_ZU);
    const int gt = F.vcu * NTHREADS + F.tid, NGT = F.G * NTHREADS;
    constexpr int NCC = DFF / 8, RUN = 16, NRUN = NTOK / RUN;
    for (int it = gt; it < NCC * NRUN; it += NGT) {
        const int cc = it % NCC, run = it / NCC; const int c0 = cc * 8, r0 = run * RUN;
        const bool first = (r0 < NCTX) ? ((r0 & 255) == 0) : (((r0 - NCTX) & (LSEQ - 1)) == 0);
        const bool last = (r0 < NCTX) ? (((r0 + RUN) & 255) == 0) : ((((r0 + RUN) - NCTX) & (LSEQ - 1)) == 0);
        float w0[8], w1[8], w2[8], bb[8];
        const float* cw = F.inp(I_FCW) + (size_t)l * 3 * DFF + c0; const float* cb = F.inp(I_FCB) + (size_t)l * DFF + c0;
#pragma unroll
        for (int j = 0; j < 8; ++j) { w0[j] = cw[j]; w1[j] = cw[DFF + j]; w2[j] = cw[2 * DFF + j]; bb[j] = cb[j]; }
        u32x4 gr[RUN + 2], vr[RUN];
#pragma unroll
        for (int i = 0; i < RUN + 2; ++i) { const int r = r0 - 1 + i; const bool ok = !((i == 0 && first) || (i == RUN + 1 && last));
            const int rc = ok ? r : r0; const u32x4 v = *(const u32x4*)(U + (size_t)rc * DUP + c0);
            gr[i].x = ok ? v.x : 0u; gr[i].y = ok ? v.y : 0u; gr[i].z = ok ? v.z : 0u; gr[i].w = ok ? v.w : 0u; }
#pragma unroll
        for (int i = 0; i < RUN; ++i) vr[i] = *(const u32x4*)(U + (size_t)(r0 + i) * DUP + DFF + c0);
        float gp[8], gc[8], gn[8];
        unpack8(gr[0], gp); unpack8(gr[1], gc);
#pragma unroll
        for (int i = 0; i < RUN; ++i) {
            unpack8(gr[i + 2], gn);
            float v[8]; unpack8(vr[i], v);
            float o[8];
#pragma unroll
            for (int j = 0; j < 8; ++j) { const float g = bb[j] + w0[j] * gp[j] + w1[j] * gc[j] + w2[j] * gn[j]; o[j] = gelu_tanh(g) * v[j]; gp[j] = gc[j]; gc[j] = gn[j]; }
            *(u32x4*)(U + (size_t)(r0 + i) * DUP + DFF + c0) = pack8(o);
        }
    }
}

__device__ __forceinline__ void phase_act_fixup(Frame& F, int l) {
    h16* ACT = (h16*)(F.ws + WS_ZU);
    const float* edge = (const float*)(F.ws + WS_EDGE);
    const float* cw = F.inp(I_FCW) + (size_t)l * 3 * DFF;
    const int gt = F.vcu * NTHREADS + F.tid, NGT = F.G * NTHREADS;
    constexpr int NC8 = DFF / 8;
    for (int it = gt; it < 64 * 8 * NC8; it += NGT) {
        const int ch = (it % NC8) * 8, ri = it / NC8, pm = ri >> 3, idx = ri & 7, b = idx >> 1, last = idx & 1;
        const int row = pm * 256 + b * 64 + (last ? 63 : 0);
        const int nrow = last ? row + 1 : row - 1;
        const bool seq_edge = (row < NCTX) ? (last ? ((row & 255) == 255) : ((row & 255) == 0)) : (last ? (((row - NCTX) & (LSEQ - 1)) == LSEQ - 1) : (((row - NCTX) & (LSEQ - 1)) == 0));
        const int nr = seq_edge ? row : nrow;
        const int npm = nr >> 8, nb = (nr >> 6) & 3;
        const float* gp = edge + ((size_t)(npm * 8 + 2 * nb + (last ? 0 : 1)) * 3) * DFF + ch;
        const float* ep = edge + ((size_t)(pm * 8 + idx) * 3) * DFF + ch;
        const float* wp = cw + (last ? 2 : 0) * DFF + ch;
        f32x4 g0 = *(const f32x4*)gp, g1 = *(const f32x4*)(gp + 4), p0 = *(const f32x4*)(ep + DFF), p1 = *(const f32x4*)(ep + DFF + 4);
        const f32x4 v0 = *(const f32x4*)(ep + 2 * DFF), v1 = *(const f32x4*)(ep + 2 * DFF + 4), w0 = *(const f32x4*)wp, w1 = *(const f32x4*)(wp + 4);
        const float nz = seq_edge ? 0.f : 1.f;
        p0 = p0 + w0 * g0 * nz; p1 = p1 + w1 * g1 * nz;
        float o[8];
#pragma unroll
        for (int j = 0; j < 4; ++j) { o[j] = gelu_tanh(p0[j]) * v0[j]; o[4 + j] = gelu_tanh(p1[j]) * v1[j]; }
        *(u32x4*)(ACT + (size_t)row * DFF + ch) = pack8(o);
    }
}

constexpr int N_PHASES = 25;
__global__ void __launch_bounds__(NTHREADS, 2) fwd_kernel(Args args) {
    extern __shared__ __attribute__((aligned(16))) unsigned char lds_raw[];
    Frame F;
    F.lds = (LAS unsigned char*)lds_raw;
    F.tid = threadIdx.x; F.lane = F.tid & 63; F.wave = __builtin_amdgcn_readfirstlane(F.tid >> 6);
    F.G0 = gridDim.x; { const int bx = blockIdx.x; F.vcu0 = (F.G0 % 8 == 0) ? (bx % 8) * (F.G0 / 8) + bx / 8 : bx; }
    F.out0 = args.out; F.ws0 = args.ws; F.refresh();
    volatile LAS unsigned* MISC = (volatile LAS unsigned*)(F.lds + MISC_OFF);
    for (int u = F.tid; u < (LDS_BYTES - LDSCTL_OFF) / 4; u += NTHREADS) ((LAS unsigned*)(F.lds + LDSCTL_OFF))[u] = 0u;
    __syncthreads();
#if !MK_PER_PHASE
    XcdBarrier bar = xcd_barrier_post((unsigned*)(F.ws + WS_CTL) + CW_BAR, MISC + 8);
#define GRID_BAR() xcd_barrier(bar)
#else
    (void)MISC;
#define GRID_BAR() do { } while (0)
#endif
#if MK_PER_PHASE
    const int lo = args.ph_lo, hi_ph = args.ph_hi;
#else
    constexpr int lo = 0, hi_ph = N_PHASES;
#endif
#if defined(TIME_PH)
#ifndef TIME_AMP
#define TIME_AMP 8
#endif
    unsigned long long t_acc = 0, t_0 = 0;
#define TSTART(k) do { TSL_PHASE(F.lds, (k)); if ((k) == TIME_PH) t_0 = __builtin_amdgcn_s_memrealtime(); } while (0)
#define TSTOP(k) do { if ((k) == TIME_PH) t_acc += __builtin_amdgcn_s_memrealtime() - t_0; } while (0)
#else
#define TSTART(k) do { TSL_PHASE(F.lds, (k)); } while (0)
#define TSTOP(k) do { } while (0)
#endif
#define IN(k) (lo <= (k) && (k) < hi_ph)
#define SEAM(k) do { if (IN((k) + 1)) GRID_BAR(); } while (0)
    { constexpr int l = 0; constexpr int pb = 12 * l;
        if (l == 0 && IN(pb + 0)) { TSTART(0); F.refresh(); phase_convert_weights(F, l); phase_prep_misc(F); SEAM(pb + 0); TSTOP(0); }
        if (IN(pb + 1)) { TSTART(1); F.refresh();
            if (l == 0) phase_norm0(F, F.inp(I_N1G), (const float*)(F.ws + WS_MOD), (float*)(F.ws + WS_SS));
            phase_cvec(F, l);
            SEAM(pb + 1); TSTOP(1); }
        if (IN(pb + 2)) { TSTART(2); F.refresh();
            pg8::Gemm g{(const h16*)(F.ws + WS_H), (const h16*)(F.ws + wsw(l) + W_IN), NTOK, NMAIN, DM, DM}; pg8::StaticOrder S; S.init(NTOK, NMAIN, F.G, F.bid);
            pg8::EpiF16<0> E{(h16*)(F.ws + WS_ZU), NMAIN, (const float*)(F.ws + WS_SS) + (size_t)(2 * l) * NTOK, (const float*)(F.ws + WS_CV) + (size_t)l * 3 * (DIN + DUP), DIN + DUP};
            pg8::gemm_phase<pg8::EpiF16<0>, pg8::StaticOrder, true, true>(F.lds, g, S, E);
            if (l + 1 < DEPTH && F.bid >= F.G / 2) phase_convert_weights(F, l + 1, 1, F.G / 2);
            SEAM(pb + 2); TSTOP(2); }
        if (IN(pb + 3)) { TSTART(3); F.refresh();
            phase_qk(F, l);
            for (int u = F.vcu; u < 512; u += F.G) {
                if (u < 256) lru_unit<0>(F, l, (u >> 3) * 256, u & 7, 1, 1, 0, 0, u >> 3);
                else { const int v = u - 256, b = v >> 7, ch = (v >> 3) & 15; lru_unit<1>(F, l, NCTX + b * LSEQ + ch * 256, v & 7, ch == 0, ch == 15, b, ch, 0); }
            }
            SEAM(pb + 3); TSTOP(3); }
        if (IN(pb + 4)) { TSTART(4); F.refresh();
            for (int type = 0; type < 4; ++type) { TSL_START(F.lds, 20 + type); for (int u = F.vcu; u < 256; u += F.G) attn_dispatch(F, l, type, u); TSL_STOP(F.lds, 20 + type); }
            TSL_START(F.lds, 24);
            for (int v = F.vcu; v < 256; v += F.G) { const int b = v >> 7, ch = (v >> 3) & 15; lru_unit<3>(F, l, NCTX + b * LSEQ + ch * 256, v & 7, ch == 0, ch == 15, b, ch, 0); }
            TSL_STOP(F.lds, 24);
            SEAM(pb + 4); TSTOP(4); }
        if (IN(pb + 6)) { TSTART(6); F.refresh();
            pg8::StaticOrder S; S.init(NTOK, DM, F.G, F.bid);
            pg8::GateMergeJobs jobs{S, F.ws, wsw(l)};
            pg8::EpiGM E{(h16*)(F.ws + WS_MG), (h16*)(F.ws + WS_ZU) + (size_t)F.bid * 256 * 256, (const float*)(F.ws + WS_SS) + (size_t)(2 * l) * NTOK,
                         (const float*)(F.ws + WS_CV) + (size_t)l * 3 * (DIN + DUP) + NMAIN, DIN + DUP};
            pg8::gemm_multi(F.lds, jobs, E);
            SEAM(pb + 6); TSTOP(6); }
        if (IN(pb + 7)) { TSTART(7); F.refresh();
            pg8::Gemm g{(const h16*)(F.ws + WS_MG), (const h16*)(F.ws + wsw(l) + W_OUT), NTOK, DM, DM, DM}; pg8::StaticOrder S; S.init(NTOK, DM, F.G, F.bid);
            pg8::EpiRes<l != 0> E{l == 0 ? (const void*)F.inp(I_XP) : (const void*)XS16(F), l == 0 ? (const void*)F.inp(I_XS) : (const void*)(XS16(F) + (size_t)NCTX * DM), XS16(F), (const float*)(F.ws + WS_MOD) + (size_t)l * 3 * 6144 + 2 * 1024,
                          (h16*)(F.ws + WS_H2), F.inp(I_N2G) + l * DM, (const float*)(F.ws + WS_MOD) + (size_t)l * 3 * 6144 + 4 * 1024, (float*)(F.ws + WS_SS) + (size_t)(2 * l + 1) * NTOK, F.lds + EPI_SCR_OFF};
            pg8::gemm_phase<pg8::EpiRes<l != 0>, pg8::StaticOrder, true, true>(F.lds, g, S, E);
            SEAM(pb + 7); TSTOP(7); }
        if (IN(pb + 9)) { TSTART(9); F.refresh();
            pg8::Gemm g{(const h16*)(F.ws + WS_H2), (const h16*)(F.ws + wsw(l) + W_UP), NTOK, DUP, DM, DM}; pg8::StaticOrder S; S.init(NTOK, DUP, F.G, F.bid);
            pg8::EpiAct E{(h16*)(F.ws + WS_ZU), (const float*)(F.ws + WS_SS) + (size_t)(2 * l + 1) * NTOK, (const float*)(F.ws + WS_CV) + (size_t)l * 3 * (DIN + DUP) + DIN, DIN + DUP,
                          F.inp(I_FCW) + (size_t)l * 3 * DFF, F.inp(I_FCB) + (size_t)l * DFF, (float*)(F.ws + WS_EDGE)};
            pg8::gemm_phase<pg8::EpiAct, pg8::StaticOrder, true, true>(F.lds, g, S, E);
            if (l + 1 < DEPTH && F.bid >= F.G / 2) phase_convert_weights(F, l + 1, 2, F.G / 2);
            SEAM(pb + 9); TSTOP(9); }
        if (IN(pb + 10)) { TSTART(10); F.refresh(); phase_act_fixup(F, l); SEAM(pb + 10); TSTOP(10); }
        if (IN(pb + 11)) { TSTART(11); F.refresh();
            pg8::Gemm g{(const h16*)(F.ws + WS_ZU), (const h16*)(F.ws + wsw(l) + W_DOWN), NTOK, DM, DFF, DFF}; pg8::StaticOrder S; S.init(NTOK, DM, F.G, F.bid);
            const bool nx = l + 1 < DEPTH;
            pg8::EpiRes<true> E{XS16(F), XS16(F) + (size_t)NCTX * DM, nx ? XS16(F) : (h16*)(F.ws + WS_H), (const float*)(F.ws + WS_MOD) + (size_t)l * 3 * 6144 + 5 * 1024,
                          nx ? (h16*)(F.ws + WS_H) : (h16*)nullptr, F.inp(I_N1G) + (nx ? l + 1 : l) * DM, (const float*)(F.ws + WS_MOD) + (size_t)(nx ? l + 1 : l) * 3 * 6144 + 1 * 1024,
                          nx ? (float*)(F.ws + WS_SS) + (size_t)(2 * (l + 1)) * NTOK : (float*)nullptr, F.lds + EPI_SCR_OFF};
            pg8::gemm_phase<pg8::EpiRes<true>, pg8::StaticOrder, true, true>(F.lds, g, S, E);
            SEAM(pb + 11); TSTOP(11); }
    }
    { constexpr int l = 1; constexpr int pb = 12 * l;
        if (l == 0 && IN(pb + 0)) { TSTART(0); F.refresh(); phase_convert_weights(F, l); phase_prep_misc(F); SEAM(pb + 0); TSTOP(0); }
        if (IN(pb + 1)) { TSTART(1); F.refresh();
            if (l == 0) phase_norm0(F, F.inp(I_N1G), (const float*)(F.ws + WS_MOD), (float*)(F.ws + WS_SS));
            phase_cvec(F, l);
            SEAM(pb + 1); TSTOP(1); }
        if (IN(pb + 2)) { TSTART(2); F.refresh();
            pg8::Gemm g{(const h16*)(F.ws + WS_H), (const h16*)(F.ws + wsw(l) + W_IN), NTOK, NMAIN, DM, DM}; pg8::StaticOrder S; S.init(NTOK, NMAIN, F.G, F.bid);
            pg8::EpiF16<0> E{(h16*)(F.ws + WS_ZU), NMAIN, (const float*)(F.ws + WS_SS) + (size_t)(2 * l) * NTOK, (const float*)(F.ws + WS_CV) + (size_t)l * 3 * (DIN + DUP), DIN + DUP};
            pg8::gemm_phase<pg8::EpiF16<0>, pg8::StaticOrder, true, true>(F.lds, g, S, E);
            if (l + 1 < DEPTH && F.bid >= F.G / 2) phase_convert_weights(F, l + 1, 1, F.G / 2);
            SEAM(pb + 2); TSTOP(2); }
        if (IN(pb + 3)) { TSTART(3); F.refresh();
            phase_qk(F, l);
            for (int u = F.vcu; u < 512; u += F.G) {
                if (u < 256) lru_unit<0>(F, l, (u >> 3) * 256, u & 7, 1, 1, 0, 0, u >> 3);
                else { const int v = u - 256, b = v >> 7, ch = (v >> 3) & 15; lru_unit<1>(F, l, NCTX + b * LSEQ + ch * 256, v & 7, ch == 0, ch == 15, b, ch, 0); }
            }
            SEAM(pb + 3); TSTOP(3); }
        if (IN(pb + 4)) { TSTART(4); F.refresh();
            for (int type = 0; type < 4; ++type) { TSL_START(F.lds, 20 + type); for (int u = F.vcu; u < 256; u += F.G) attn_dispatch(F, l, type, u); TSL_STOP(F.lds, 20 + type); }
            TSL_START(F.lds, 24);
            for (int v = F.vcu; v < 256; v += F.G) { const int b = v >> 7, ch = (v >> 3) & 15; lru_unit<3>(F, l, NCTX + b * LSEQ + ch * 256, v & 7, ch == 0, ch == 15, b, ch, 0); }
            TSL_STOP(F.lds, 24);
            SEAM(pb + 4); TSTOP(4); }
        if (IN(pb + 6)) { TSTART(6); F.refresh();
            pg8::StaticOrder S; S.init(NTOK, DM, F.G, F.bid);
            pg8::GateMergeJobs jobs{S, F.ws, wsw(l)};
            pg8::EpiGM E{(h16*)(F.ws + WS_MG), (h16*)(F.ws + WS_ZU) + (size_t)F.bid * 256 * 256, (const float*)(F.ws + WS_SS) + (size_t)(2 * l) * NTOK,
                         (const float*)(F.ws + WS_CV) + (size_t)l * 3 * (DIN + DUP) + NMAIN, DIN + DUP};
            pg8::gemm_multi(F.lds, jobs, E);
            SEAM(pb + 6); TSTOP(6); }
        if (IN(pb + 7)) { TSTART(7); F.refresh();
            pg8::Gemm g{(const h16*)(F.ws + WS_MG), (const h16*)(F.ws + wsw(l) + W_OUT), NTOK, DM, DM, DM}; pg8::StaticOrder S; S.init(NTOK, DM, F.G, F.bid);
            pg8::EpiRes<l != 0> E{l == 0 ? (const void*)F.inp(I_XP) : (const void*)XS16(F), l == 0 ? (const void*)F.inp(I_XS) : (const void*)(XS16(F) + (size_t)NCTX * DM), XS16(F), (const float*)(F.ws + WS_MOD) + (size_t)l * 3 * 6144 + 2 * 1024,
                          (h16*)(F.ws + WS_H2), F.inp(I_N2G) + l * DM, (const float*)(F.ws + WS_MOD) + (size_t)l * 3 * 6144 + 4 * 1024, (float*)(F.ws + WS_SS) + (size_t)(2 * l + 1) * NTOK, F.lds + EPI_SCR_OFF};
            pg8::gemm_phase<pg8::EpiRes<l != 0>, pg8::StaticOrder, true, true>(F.lds, g, S, E);
            SEAM(pb + 7); TSTOP(7); }
        if (IN(pb + 9)) { TSTART(9); F.refresh();
            pg8::Gemm g{(const h16*)(F.ws + WS_H2), (const h16*)(F.ws + wsw(l) + W_UP), NTOK, DUP, DM, DM}; pg8::StaticOrder S; S.init(NTOK, DUP, F.G, F.bid);
            pg8::EpiAct E{(h16*)(F.ws + WS_ZU), (const float*)(F.ws + WS_SS) + (size_t)(2 * l + 1) * NTOK, (const float*)(F.ws + WS_CV) + (size_t)l * 3 * (DIN + DUP) + DIN, DIN + DUP,
                          F.inp(I_FCW) + (size_t)l * 3 * DFF, F.inp(I_FCB) + (size_t)l * DFF, (float*)(F.ws + WS_EDGE)};
            pg8::gemm_phase<pg8::EpiAct, pg8::StaticOrder, true, true>(F.lds, g, S, E);
            if (l + 1 < DEPTH && F.bid >= F.G / 2) phase_convert_weights(F, l + 1, 2, F.G / 2);
            SEAM(pb + 9); TSTOP(9); }
        if (IN(pb + 10)) { TSTART(10); F.refresh(); phase_act_fixup(F, l); SEAM(pb + 10); TSTOP(10); }
        if (IN(pb + 11)) { TSTART(11); F.refresh();
            pg8::Gemm g{(const h16*)(F.ws + WS_ZU), (const h16*)(F.ws + wsw(l) + W_DOWN), NTOK, DM, DFF, DFF}; pg8::StaticOrder S; S.init(NTOK, DM, F.G, F.bid);
            const bool nx = l + 1 < DEPTH;
            pg8::EpiRes<true> E{XS16(F), XS16(F) + (size_t)NCTX * DM, nx ? XS16(F) : (h16*)(F.ws + WS_H), (const float*)(F.ws + WS_MOD) + (size_t)l * 3 * 6144 + 5 * 1024,
                          nx ? (h16*)(F.ws + WS_H) : (h16*)nullptr, F.inp(I_N1G) + (nx ? l + 1 : l) * DM, (const float*)(F.ws + WS_MOD) + (size_t)(nx ? l + 1 : l) * 3 * 6144 + 1 * 1024,
                          nx ? (float*)(F.ws + WS_SS) + (size_t)(2 * (l + 1)) * NTOK : (float*)nullptr, F.lds + EPI_SCR_OFF};
            pg8::gemm_phase<pg8::EpiRes<true>, pg8::StaticOrder, true, true>(F.lds, g, S, E);
            SEAM(pb + 11); TSTOP(11); }
    }
    if (IN(24)) { TSTART(12); F.refresh(); phase_final_norm(F); TSTOP(12); }
#if defined(TIME_SUB)
    if (blockIdx.x == 0 && threadIdx.x == 0) { const unsigned long long ta = *(volatile LAS unsigned long long*)(F.lds + MISC_OFF + 64); const unsigned long long t1 = __builtin_amdgcn_s_memrealtime(); while (__builtin_amdgcn_s_memrealtime() - t1 < 8ull * ta) __builtin_amdgcn_s_sleep(8); }
#endif
#if defined(TIME_PH)
    if (blockIdx.x == 0 && threadIdx.x == 0) { const unsigned long long t1 = __builtin_amdgcn_s_memrealtime(); while (__builtin_amdgcn_s_memrealtime() - t1 < (unsigned long long)TIME_AMP * t_acc) __builtin_amdgcn_s_sleep(8); }
#endif
#undef IN
#undef SEAM
}

extern "C" void kernel_launch(void* const* d_in, const int* in_sizes, int n_in, void* d_out, int out_size, void* d_ws, size_t ws_size, hipStream_t stream) {
    static int grid = 0;
    if (grid == 0) {
        if (n_in != 33 || out_size != (int)O_END || ws_size < WS_END) { fprintf(stderr, "kernel_launch: unexpected shapes: n_in %d out %d ws %zu (need %zu)\n", n_in, out_size, ws_size, (size_t)WS_END); grid = -1; return; }
        int dev = 0, cus = 0;
        if (hipGetDevice(&dev) != hipSuccess || hipDeviceGetAttribute(&cus, hipDeviceAttributeMultiprocessorCount, dev) != hipSuccess) { grid = -1; return; }
        if (hipFuncSetAttribute((const void*)fwd_kernel, hipFuncAttributeMaxDynamicSharedMemorySize, LDS_BYTES) != hipSuccess) { fprintf(stderr, "kernel_launch: hipFuncSetAttribute failed\n"); grid = -1; return; }
        (void)hipGetLastError();
        grid = cus;
    }
    if (grid < 0) return;
    (void)hipMemsetAsync((char*)d_ws + WS_CTL, 0, CTL_ZERO_BYTES, stream);
    Args a{};
    for (int i = 0; i < 33; ++i) a.in[i] = (const float*)d_in[i];
    a.out = (float*)d_out; a.ws = (unsigned char*)d_ws;
#if MK_PER_PHASE
    for (int ph = 0; ph < N_PHASES; ++ph) { a.ph_lo = ph; a.ph_hi = ph + 1; hipLaunchKernelGGL(fwd_kernel, dim3(grid), dim3(NTHREADS), LDS_BYTES, stream, a); }
#else
    a.ph_lo = 0; a.ph_hi = N_PHASES;
    hipLaunchKernelGGL(fwd_kernel, dim3(grid), dim3(NTHREADS), LDS_BYTES, stream, a);
#endif
}
```
